# Optimizing an MI355X kernel written in HIP

```python
import jax, jax.numpy as jnp
from jax import lax
import numpy as np

D_MODEL = 1024
BATCH = 1
SEQ = 16384
DEPTH = 1

N_MEM = 256
ATT_HEADS = 8
ATT_HD = 64
ATT_W = ATT_HEADS * ATT_HD
IDX_HEADS = 4
IDX_HD = 64
TOPK_MAX = 256
Q_BLOCK = 128
RWKV_HEADS = 8
RWKV_HD = 64
RWKV_W = RWKV_HEADS * RWKV_HD
DECAY_LORA = 64
AAA_LORA = 64
GATE_LORA = 128
GN_EPS = 64e-5
MEM_HEADS = 4
MEM_HD = 128
MEM_W = MEM_HEADS * MEM_HD
N_BRANCH = 3
BRANCH_W = 512
ROPE_THETA = 500000.0
ROPE_FRACTION = 4
NORM_EPS = 1e-6
PEER_KEYS = 128
N_EXPERTS = PEER_KEYS * PEER_KEYS
PEER_HEADS = 8
PEER_QDIM = 256
PEER_TOPK = 16
PEER_BLOCK = 128

ATT_IN = 3 * ATT_W + IDX_HEADS * IDX_HD + IDX_HD + IDX_HEADS
RWKV_IN = 3 * RWKV_W + DECAY_LORA + AAA_LORA + GATE_LORA
GATE_IN = N_BRANCH * D_MODEL
W_IN_COLS = ATT_IN + RWKV_IN + MEM_W + GATE_IN

kernel_name = 'dsa_rwkv7_memory_gated_peer_layer'

F32 = jnp.float32


def split_last(t, sizes):
    offs = np.cumsum(sizes)[:-1].tolist()
    return jnp.split(t, offs, axis=-1)


def rmsnorm(t, gain):
    tf = t.astype(F32)
    out = tf * lax.rsqrt(jnp.mean(tf * tf, axis=-1, keepdims=True) + NORM_EPS) * gain.astype(F32)
    return out.astype(t.dtype)


def rope_tables(positions, head_dim):
    rot = head_dim // ROPE_FRACTION
    inv_freq = 1.0 / (ROPE_THETA ** (jnp.arange(0, rot, 2, dtype=F32) / rot))
    ang = positions.astype(F32)[..., None] * inv_freq
    return jnp.cos(ang)[:, :, None, :], jnp.sin(ang)[:, :, None, :]


def rope_partial(t, cos, sin):
    half = cos.shape[-1]
    t1 = t[..., :half]
    t2 = t[..., half:2 * half]
    out = jnp.concatenate([t1 * cos - t2 * sin, t2 * cos + t1 * sin, t[..., 2 * half:]], axis=-1)
    return out.astype(t.dtype)


def dsa_attention(q, k, v, iq, ik, iw):
    B, S, H, Dh = q.shape
    n_sel = min(TOPK_MAX, S // 4)
    nb = S // Q_BLOCK
    idx_scale = (IDX_HEADS ** -0.5) * (IDX_HD ** -0.5)
    key_pos = jnp.arange(S)
    ikf = ik.astype(F32)

    def blocks(t):
        return jnp.moveaxis(t.reshape(B, nb, Q_BLOCK, *t.shape[2:]), 1, 0)

    def one_block(args):
        qb, iqb, iwb, tq = args
        logits = jnp.einsum('bqhd,bsd->bqhs', iqb.astype(F32), ikf)
        score = jnp.einsum('bqh,bqhs->bqs', iwb.astype(F32) * idx_scale, jax.nn.relu(logits))
        causal = key_pos[None, None, :] <= tq[None, :, None]
        score = jnp.where(causal, score, -jnp.inf)
        _, sel = lax.top_k(score, n_sel)
        valid = sel <= tq[None, :, None]
        k_sel = jax.vmap(lambda kk, ii: kk[ii])(k, sel)
        v_sel = jax.vmap(lambda vv, ii: vv[ii])(v, sel)
        att = jnp.einsum('bqhd,bqnhd->bhqn', qb.astype(F32), k_sel.astype(F32)) * (Dh ** -0.5)
        att = jnp.where(valid[:, None], att, -jnp.inf)
        p = jax.nn.softmax(att, axis=-1)
        out = jnp.einsum('bhqn,bqnhd->bqhd', p, v_sel.astype(F32))
        return out.astype(q.dtype)

    tq_blocks = jnp.arange(S).reshape(nb, Q_BLOCK)
    out = lax.map(one_block, (blocks(q), blocks(iq), blocks(iw), tq_blocks))
    return jnp.moveaxis(out, 0, 1).reshape(B, S, H * Dh)


def wkv7_scan(r, w, k, v, a, b):
    B, S, H, N = r.shape
    tm = lambda t: jnp.moveaxis(t, 1, 0)

    def step(state, inp):
        r_t, w_t, k_t, v_t, a_t, b_t = inp
        sa = jnp.einsum('bhij,bhj->bhi', state, a_t)
        state = state * w_t[:, :, None, :] + sa[..., None] * b_t[:, :, None, :] + v_t[..., :, None] * k_t[:, :, None, :]
        y = jnp.einsum('bhij,bhj->bhi', state, r_t)
        return state, y

    state0 = jnp.zeros((B, H, N, N), F32)
    _, ys = lax.scan(step, state0, (tm(r), tm(w), tm(k), tm(v), tm(a), tm(b)))
    return jnp.moveaxis(ys, 0, 1)


def rwkv7_time_mix(p, mu, w0, w2, a0, a2, g2, k_k, k_a, r_k, ln_w, ln_b):
    B, S, _ = p.shape
    prev = jnp.pad(p, ((0, 0), (1, 0), (0, 0)))[:, :-1]
    p = p + (prev - p) * mu
    r, k, v, wd, ad, gd = [t.astype(F32) for t in split_last(p, (RWKV_W, RWKV_W, RWKV_W, DECAY_LORA, AAA_LORA, GATE_LORA))]
    w_log = -jax.nn.softplus(-(w0.astype(F32) + jnp.tanh(wd) @ w2.astype(F32))) - 0.5
    decay = jnp.exp(-jnp.exp(w_log))
    a = jax.nn.sigmoid(a0.astype(F32) + ad @ a2.astype(F32))
    g = jax.nn.sigmoid(gd) @ g2.astype(F32)
    heads = lambda t: t.reshape(B, S, RWKV_HEADS, RWKV_HD)
    kk = heads(k * k_k.astype(F32))
    kk = kk / jnp.maximum(jnp.sqrt(jnp.sum(kk * kk, axis=-1, keepdims=True)), 1e-12)
    k = k * (1.0 + (a - 1.0) * k_a.astype(F32))
    rh, kh, vh, wh, ah = heads(r), heads(k), heads(v), heads(decay), heads(a)
    y = wkv7_scan(rh, wh, kh, vh, -kk, kk * ah)
    mean = jnp.mean(y, axis=-1, keepdims=True)
    var = jnp.mean(jnp.square(y - mean), axis=-1, keepdims=True)
    y = (y - mean) * lax.rsqrt(var + GN_EPS) * ln_w.astype(F32).reshape(RWKV_HEADS, RWKV_HD) + ln_b.astype(F32).reshape(RWKV_HEADS, RWKV_HD)
    y = y + jnp.sum(rh * kh * r_k.astype(F32), axis=-1, keepdims=True) * vh
    return (y.reshape(B, S, RWKV_W) * g).astype(p.dtype)


def memory_cross_attention(q_p, mem, mem_norm_gain, w_mem_kv, q_gain, k_gain):
    B, S, _ = q_p.shape
    M = mem.shape[1]
    m = rmsnorm(mem, mem_norm_gain)
    km, vm = split_last(m @ w_mem_kv, (MEM_W, MEM_W))
    q = rmsnorm(q_p.reshape(B, S, MEM_HEADS, MEM_HD), q_gain)
    km = rmsnorm(km.reshape(B, M, MEM_HEADS, MEM_HD), k_gain)
    vm = vm.reshape(B, M, MEM_HEADS, MEM_HD)
    s = jnp.einsum('bqhd,bmhd->bhqm', q.astype(F32), km.astype(F32)) * (MEM_HD ** -0.5)
    p = jax.nn.softmax(s, axis=-1)
    out = jnp.einsum('bhqm,bmhd->bqhd', p, vm.astype(F32))
    return out.reshape(B, S, MEM_W).astype(q_p.dtype)


def peer_ffn(xn, w_q, key1, key2, u, v):
    B, S, D = xn.shape
    q = (xn @ w_q).reshape(B, S, PEER_HEADS, 2, PEER_QDIM // 2).astype(F32)
    s1 = jnp.einsum('bshd,kd->bshk', q[..., 0, :], key1.astype(F32))
    s2 = jnp.einsum('bshd,kd->bshk', q[..., 1, :], key2.astype(F32))
    v1, i1 = lax.top_k(s1, PEER_TOPK)
    v2, i2 = lax.top_k(s2, PEER_TOPK)
    cand = (v1[..., :, None] + v2[..., None, :]).reshape(B, S, PEER_HEADS, PEER_TOPK * PEER_TOPK)
    sc, ci = lax.top_k(cand, PEER_TOPK)
    e1 = jnp.take_along_axis(i1, ci // PEER_TOPK, axis=-1)
    e2 = jnp.take_along_axis(i2, ci % PEER_TOPK, axis=-1)
    expert = e1 * PEER_KEYS + e2
    gate = jax.nn.softmax(sc, axis=-1)
    T = B * S
    E = PEER_HEADS * PEER_TOPK
    nb = T // PEER_BLOCK
    xb = xn.reshape(nb, PEER_BLOCK, D)
    eb = expert.reshape(nb, PEER_BLOCK, E)
    gb = gate.reshape(nb, PEER_BLOCK, E)

    def one_block(args):
        xt, et, gt = args
        ue = u[et].astype(F32)
        ve = v[et].astype(F32)
        hid = jax.nn.gelu(jnp.einsum('td,ted->te', xt.astype(F32), ue), approximate=False)
        return jnp.einsum('te,ted->td', gt * hid, ve).astype(xt.dtype)

    out = lax.map(one_block, (xb, eb, gb))
    return out.reshape(B, S, D)


def hybrid_layer(h, mem, cos, sin, mix_norm_gain, w_in, gate_bias, att_q_gain, att_k_gain, mem_norm_gain, w_mem_kv, mem_q_gain, mem_k_gain, rwkv_mu, rwkv_w0, rwkv_w2, rwkv_a0, rwkv_a2, rwkv_g2, rwkv_k_k, rwkv_k_a, rwkv_r_k, rwkv_ln_w, rwkv_ln_b, w_up, w_out, ffn_norm_gain, peer_w_q, peer_key1, peer_key2, peer_u, peer_v):
    B, S, D = h.shape
    n = rmsnorm(h, mix_norm_gain)
    proj = n @ w_in
    att_p, rwkv_p, memq_p, gate_p = split_last(proj, (ATT_IN, RWKV_IN, MEM_W, GATE_IN))
    q, k, v, iq, ik, iw = split_last(att_p, (ATT_W, ATT_W, ATT_W, IDX_HEADS * IDX_HD, IDX_HD, IDX_HEADS))
    q = rope_partial(rmsnorm(q.reshape(B, S, ATT_HEADS, ATT_HD), att_q_gain), cos, sin)
    k = rope_partial(rmsnorm(k.reshape(B, S, ATT_HEADS, ATT_HD), att_k_gain), cos, sin)
    v = v.reshape(B, S, ATT_HEADS, ATT_HD)
    iq = rope_partial(iq.reshape(B, S, IDX_HEADS, IDX_HD), cos, sin)
    ik = rope_partial(ik[:, :, None, :], cos, sin)[:, :, 0]
    y_att = dsa_attention(q, k, v, iq, ik, iw)
    y_rwkv = rwkv7_time_mix(rwkv_p, rwkv_mu, rwkv_w0, rwkv_w2, rwkv_a0, rwkv_a2, rwkv_g2, rwkv_k_k, rwkv_k_a, rwkv_r_k, rwkv_ln_w, rwkv_ln_b)
    y_mem = memory_cross_attention(memq_p, mem, mem_norm_gain, w_mem_kv, mem_q_gain, mem_k_gain)
    branches = jnp.stack([y_att.astype(F32), y_rwkv.astype(F32), y_mem.astype(F32)], axis=2)
    up = jnp.einsum('bscw,cwd->bscd', branches, w_up.astype(F32))
    gates = jax.nn.sigmoid(gate_p.reshape(B, S, N_BRANCH, D).astype(F32) + gate_bias.astype(F32))
    merged = jnp.sum(gates * up, axis=2).astype(h.dtype)
    h = h + merged @ w_out
    h = h + peer_ffn(rmsnorm(h, ffn_norm_gain), peer_w_q, peer_key1, peer_key2, peer_u, peer_v)
    return h


def setup_inputs(seed: int = 0) -> dict:
    key = jax.random.key(seed)
    ks = iter(jax.random.split(key, 48))
    L = DEPTH

    def nrm(shape, scale):
        return jax.random.normal(next(ks), shape, F32) * scale

    def gain(shape):
        return 1.0 + nrm(shape, 0.05)

    x = nrm((BATCH, SEQ, D_MODEL), 1.0)
    mem = nrm((BATCH, N_MEM, D_MODEL), 1.0)
    positions = jax.random.randint(next(ks), (BATCH, 1), 0, 4096, dtype=jnp.int32) + jnp.arange(SEQ, dtype=jnp.int32)[None, :]
    return {
        'x': x,
        'mem': mem,
        'positions': positions,
        'mix_norm_gain': gain((L, D_MODEL)),
        'w_in': nrm((L, D_MODEL, W_IN_COLS), D_MODEL ** -0.5),
        'gate_bias': nrm((L, N_BRANCH, D_MODEL), 0.1),
        'att_q_gain': gain((L, ATT_HD)),
        'att_k_gain': gain((L, ATT_HD)),
        'mem_norm_gain': gain((L, D_MODEL)),
        'w_mem_kv': nrm((L, D_MODEL, 2 * MEM_W), D_MODEL ** -0.5),
        'mem_q_gain': gain((L, MEM_HD)),
        'mem_k_gain': gain((L, MEM_HD)),
        'rwkv_mu': jax.random.uniform(next(ks), (L, RWKV_IN), F32, 0.0, 1.0),
        'rwkv_w0': jax.random.uniform(next(ks), (L, RWKV_W), F32, -3.0, 0.0),
        'rwkv_w2': nrm((L, DECAY_LORA, RWKV_W), 0.5 * DECAY_LORA ** -0.5),
        'rwkv_a0': nrm((L, RWKV_W), 0.1),
        'rwkv_a2': nrm((L, AAA_LORA, RWKV_W), 0.5 * AAA_LORA ** -0.5),
        'rwkv_g2': nrm((L, GATE_LORA, RWKV_W), GATE_LORA ** -0.5),
        'rwkv_k_k': 0.85 + nrm((L, RWKV_W), 0.05),
        'rwkv_k_a': gain((L, RWKV_W)),
        'rwkv_r_k': nrm((L, RWKV_HEADS, RWKV_HD), 0.1),
        'rwkv_ln_w': gain((L, RWKV_W)),
        'rwkv_ln_b': nrm((L, RWKV_W), 0.02),
        'w_up': nrm((L, N_BRANCH, BRANCH_W, D_MODEL), BRANCH_W ** -0.5),
        'w_out': nrm((L, D_MODEL, D_MODEL), D_MODEL ** -0.5),
        'ffn_norm_gain': gain((L, D_MODEL)),
        'peer_w_q': nrm((L, D_MODEL, PEER_HEADS * PEER_QDIM), D_MODEL ** -0.5),
        'peer_key1': nrm((L, PEER_KEYS, PEER_QDIM // 2), (PEER_QDIM // 2) ** -0.5),
        'peer_key2': nrm((L, PEER_KEYS, PEER_QDIM // 2), (PEER_QDIM // 2) ** -0.5),
        'peer_u': nrm((L, N_EXPERTS, D_MODEL), D_MODEL ** -0.5),
        'peer_v': nrm((L, N_EXPERTS, D_MODEL), PEER_HEADS ** -0.5),
    }


def reference(x, mem, positions, mix_norm_gain, w_in, gate_bias, att_q_gain, att_k_gain, mem_norm_gain, w_mem_kv, mem_q_gain, mem_k_gain, rwkv_mu, rwkv_w0, rwkv_w2, rwkv_a0, rwkv_a2, rwkv_g2, rwkv_k_k, rwkv_k_a, rwkv_r_k, rwkv_ln_w, rwkv_ln_b, w_up, w_out, ffn_norm_gain, peer_w_q, peer_key1, peer_key2, peer_u, peer_v):
    cos, sin = rope_tables(positions, ATT_HD)
    h = x
    for layer in range(DEPTH):
        h = hybrid_layer(h, mem, cos, sin, mix_norm_gain[layer], w_in[layer], gate_bias[layer], att_q_gain[layer], att_k_gain[layer], mem_norm_gain[layer], w_mem_kv[layer], mem_q_gain[layer], mem_k_gain[layer], rwkv_mu[layer], rwkv_w0[layer], rwkv_w2[layer], rwkv_a0[layer], rwkv_a2[layer], rwkv_g2[layer], rwkv_k_k[layer], rwkv_k_a[layer], rwkv_r_k[layer], rwkv_ln_w[layer], rwkv_ln_b[layer], w_up[layer], w_out[layer], ffn_norm_gain[layer], peer_w_q[layer], peer_key1[layer], peer_key2[layer], peer_u[layer], peer_v[layer])
    return h
```

```cpp
#include <hip/hip_runtime.h>
#include <cstdio>
#include <cstdint>

typedef unsigned short bf16;
typedef unsigned short u16;
typedef float f32x4 __attribute__((ext_vector_type(4)));
typedef float f32x2 __attribute__((ext_vector_type(2)));
typedef unsigned u32x4 __attribute__((ext_vector_type(4)));
typedef unsigned u32x2 __attribute__((ext_vector_type(2)));
typedef _Float16 half_t;
typedef _Float16 half4 __attribute__((ext_vector_type(4)));
typedef _Float16 half8 __attribute__((ext_vector_type(8)));

constexpr int S_ = 16384, D_ = 1024;
constexpr int NMEM = 256;
constexpr int ATT_W = 512, RW_W = 512, MEM_W = 512;
constexpr int RW_IN = 1792;
constexpr int WIN_COLS = 7236;
constexpr int COL_Q = 0, COL_K = 512, COL_V = 1024, COL_IQ = 1536, COL_IK = 1792, COL_IW = 1856, COL_RW = 1860, COL_MEMQ = 3652, COL_GATE = 4164;
constexpr int P1_TILES = 17, P1_N = P1_TILES * 256;
constexpr float NORM_EPS = 1e-6f, GN_EPS = 64e-5f;
constexpr int NEXP = 16384;

constexpr size_t MiB = 1u << 20;
constexpr size_t WS_CTL = 0;
constexpr size_t WS_RSTDX = 1 * MiB;
constexpr size_t WS_COS = WS_RSTDX + 64 * 1024;
constexpr size_t WS_SIN = WS_COS + 512 * 1024;
constexpr size_t WS_IW = WS_SIN + 512 * 1024;
constexpr size_t WS_RSTDM = WS_IW + 256 * 1024;
constexpr size_t WS_RSTDH = WS_RSTDM + 4096;
constexpr size_t WS_HSQ = 3 * MiB;
constexpr size_t WS_WIN = 4 * MiB;
constexpr size_t WS_WG = WS_WIN + (size_t)P1_N * 1024 * 2;
constexpr size_t WS_WUP = WS_WG + 6 * MiB;
constexpr size_t WS_WOUT = WS_WUP + 3 * MiB;
constexpr size_t WS_WQ = WS_WOUT + 2 * MiB;
constexpr size_t WS_WMEM = WS_WQ + 4 * MiB;
constexpr size_t WS_KEYBD = WS_WMEM + 2 * MiB;
constexpr size_t WS_WLORA = WS_KEYBD + 128 * 1024;
static_assert(WS_WLORA + 768 * 1024 <= 30 * MiB + 512 * 1024, "weights region");
constexpr size_t WS_KMVM = 30 * MiB + 512 * 1024;
constexpr size_t WS_MB = 31 * MiB + 512 * 1024;
constexpr size_t WS_XB = 32 * MiB;
constexpr size_t WS_Q = 64 * MiB, WS_K = 80 * MiB, WS_V = 96 * MiB;
constexpr size_t WS_IQ = 112 * MiB;
constexpr size_t WS_IK = 120 * MiB;
constexpr size_t WS_MEMQ = 122 * MiB;
constexpr size_t WS_RWP = 138 * MiB;
constexpr size_t WS_Y = 194 * MiB;
constexpr size_t WS_SEL = 242 * MiB;
constexpr size_t DO_E = 0, DO_A = 16 * MiB, DO_G = 32 * MiB, DO_LIN = 48 * MiB;
constexpr size_t WS_GATES = 64 * MiB;
constexpr size_t WS_MERGED = 160 * MiB;
constexpr size_t WS_PQ = 64 * MiB;
constexpr size_t WS_SC = 128 * MiB;
constexpr size_t WS_EIDX = 144 * MiB;
constexpr size_t WS_EGATE = 152 * MiB;
constexpr size_t WS_END = 256 * MiB;

__device__ __forceinline__ unsigned f2bf(float f) { unsigned u = __builtin_bit_cast(unsigned, f); return (u + 0x7fffu + ((u >> 16) & 1u)) >> 16; }
__device__ __forceinline__ unsigned pk2(float lo, float hi) { return f2bf(lo) | (f2bf(hi) << 16); }
__device__ __forceinline__ float bf2f(unsigned short b) { return __builtin_bit_cast(float, ((unsigned)b) << 16); }
__device__ __forceinline__ float bflo(unsigned w) { return __builtin_bit_cast(float, w << 16); }
__device__ __forceinline__ float bfhi(unsigned w) { return __builtin_bit_cast(float, w & 0xffff0000u); }
__device__ __forceinline__ float wave_sum(float v) {
#pragma unroll
    for (int o = 1; o < 64; o <<= 1) v += __shfl_xor(v, o);
    return v;
}
__device__ __forceinline__ float wave_max(float v) {
#pragma unroll
    for (int o = 1; o < 64; o <<= 1) v = fmaxf(v, __shfl_xor(v, o));
    return v;
}
namespace pg8 {
#define PG8_LAS __attribute__((address_space(3)))
typedef unsigned short bf16_t;
typedef short bf16x8 __attribute__((ext_vector_type(8)));
typedef float f32x4 __attribute__((ext_vector_type(4)));
typedef unsigned u32x4 __attribute__((ext_vector_type(4)));
typedef unsigned u32x2 __attribute__((ext_vector_type(2)));
constexpr int BM = 256, BK = 64, HALF = 128, HTB = HALF * BK * 2, STAGE_BYTES = 8 * HTB, NXCD = 8, WGM = 8;

__host__ __device__ __forceinline__ int lds_byte(int r, int c) { const int st = (r >> 4) * 2 + (c >> 5), rr = r & 15, cc = c & 31, ob = rr * 64 + cc * 2; return st * 1024 + (ob ^ (((ob >> 9) & 1) << 5)); }
__host__ __device__ __forceinline__ void stage_rc(int b, int& R, int& C) { const int st = b / 1024, sb = b % 1024, swz = sb ^ (((sb >> 9) & 1) << 5); R = (st >> 1) * 16 + swz / 64; C = (st & 1) * 32 + (swz % 64) / 2; }

struct Unit { int pm, pn; };
struct Gemm { const bf16_t* A; const bf16_t* Bt; int M, N, K; int lda, ldb; long a_pn_step, b_pn_step; };

struct StaticOrder {
    int nM, nN, nwg, G, c;
    __host__ __device__ void init(int M, int N, int G_, int c_) { nM = M / BM; nN = N / BM; nwg = nM * nN; G = G_; c = c_; }
    __host__ __device__ bool next(int i, Unit& u) const {
        const long L = (long)i * G + c; if (L >= nwg) return false;
        int wgid = (int)L; { const int q = nwg / NXCD, r = nwg % NXCD, xcd = wgid % NXCD, off = wgid / NXCD; wgid = (xcd < r ? xcd * (q + 1) : r * (q + 1) + (xcd - r) * q) + off; }
        const int nig = WGM * nN, gid = wgid / nig, fm = gid * WGM, gsz = (nM - fm) < WGM ? (nM - fm) : WGM;
        u.pm = fm + ((wgid % nig) % gsz); u.pn = (wgid % nig) / gsz; return true;
    }
};

__device__ __forceinline__ unsigned cvt_pk_bf16(float lo, float hi) { unsigned r; asm volatile("v_cvt_pk_bf16_f32 %0, %1, %2" : "=v"(r) : "v"(lo), "v"(hi)); return r; }

template <class Epi>
__device__ __forceinline__ void gemm_phase(PG8_LAS unsigned char* lds, const Gemm g, const StaticOrder& S, const Epi& E) {
    const int tid = threadIdx.x, wid = __builtin_amdgcn_readfirstlane(tid >> 6), lane = tid & 63, wr = wid >> 2, wc = wid & 3, fr = lane & 15, fq = lane >> 4;
    const int K = g.K, nt = K / BK;
    unsigned voffA[2], voffB[2];
#pragma unroll
    for (int i = 0; i < 2; ++i) { int R, C; stage_rc(tid * 16 + i * 8192, R, C);
        voffA[i] = (unsigned)(R * g.lda + C) * 2u; voffB[i] = (unsigned)(R * g.ldb + C) * 2u; }
    const size_t kstep = (size_t)(BK * 2);
    const size_t hstepA = (size_t)HALF * g.lda * 2, hstepB = (size_t)HALF * g.ldb * 2;
    const size_t tstepA = 2 * hstepA;
    const unsigned ldsw = (unsigned)wid * 1024u;
    const int aoff = lds_byte(wr * 64 + fr, fq * 8), boff = lds_byte(wc * 32 + fr, fq * 8);
#define PG8_SA(b, h) (((b) * 2 + (h)) * HTB)
#define PG8_SB(b, h) ((4 + (b) * 2 + (h)) * HTB)
#define PG8_STAGE(bufoff, gbase, voff) do { _Pragma("unroll") for (int _i = 0; _i < 2; ++_i) \
        __builtin_amdgcn_global_load_lds((const unsigned*)((const char*)(gbase) + (voff)[_i]), (PG8_LAS unsigned*)(lds + (bufoff) + ldsw + _i * 8192), 16, 0, 0); } while (0)
#define PG8_LDA(dst, b, h) do { _Pragma("unroll") for (int m = 0; m < 4; ++m) _Pragma("unroll") for (int k = 0; k < 2; ++k) dst[m][k] = *(const PG8_LAS bf16x8*)(lds + PG8_SA(b, h) + aoff + m * 2048 + k * 1024); } while (0)
#define PG8_LDB(dst, b, h) do { _Pragma("unroll") for (int n = 0; n < 2; ++n) _Pragma("unroll") for (int k = 0; k < 2; ++k) dst[n][k] = *(const PG8_LAS bf16x8*)(lds + PG8_SB(b, h) + boff + n * 2048 + k * 1024); } while (0)
#define PG8_MMA(ai, bj, At, Bt) do { __builtin_amdgcn_s_setprio(1); _Pragma("unroll") for (int m = 0; m < 4; ++m) _Pragma("unroll") for (int n = 0; n < 2; ++n) _Pragma("unroll") for (int k = 0; k < 2; ++k) \
        acc[ai][bj][m][n] = __builtin_amdgcn_mfma_f32_16x16x32_bf16(Bt[n][k], At[m][k], acc[ai][bj][m][n], 0, 0, 0); __builtin_amdgcn_s_setprio(0); } while (0)
#define PG8_WAIT_V(n) asm volatile("s_waitcnt vmcnt(" #n ")" ::: "memory")
#define PG8_WAIT_L(n) asm volatile("s_waitcnt lgkmcnt(" #n ")" ::: "memory")
#define PG8_BAR __builtin_amdgcn_s_barrier()
#define PG8_SCHED __builtin_amdgcn_sched_barrier(0)
    Unit cur, nxt; int ui = 0;
    if (!S.next(0, cur)) return;
    f32x4 acc[2][2][4][2];
#pragma unroll
    for (int a = 0; a < 2; ++a)
#pragma unroll
        for (int b = 0; b < 2; ++b)
#pragma unroll
            for (int m = 0; m < 4; ++m)
#pragma unroll
                for (int n = 0; n < 2; ++n) acc[a][b][m][n] = (f32x4){0.f, 0.f, 0.f, 0.f};
    bf16x8 At[4][2], B0[2][2], B1[2][2];
    const char* cA = (const char*)g.A + (size_t)cur.pm * tstepA + (size_t)cur.pn * g.a_pn_step * 2; const char* cB = (const char*)g.Bt + (size_t)cur.pn * g.b_pn_step * 2;
    PG8_STAGE(PG8_SB(0, 0), cB, voffB); PG8_STAGE(PG8_SA(0, 0), cA, voffA); PG8_STAGE(PG8_SB(0, 1), cB + hstepB, voffB); PG8_STAGE(PG8_SA(0, 1), cA + hstepA, voffA);
    if (wr == 1) PG8_BAR;
    PG8_WAIT_V(4); PG8_BAR;
    PG8_STAGE(PG8_SB(1, 0), cB + kstep, voffB); PG8_STAGE(PG8_SA(1, 0), cA + kstep, voffA); PG8_STAGE(PG8_SB(1, 1), cB + hstepB + kstep, voffB);
    PG8_WAIT_V(6); PG8_BAR;
    for (;;) {
        const bool has_next = S.next(ui + 1, nxt);
        const char* nA = has_next ? (const char*)g.A + (size_t)nxt.pm * tstepA + (size_t)nxt.pn * g.a_pn_step * 2 : cA; const char* nB = has_next ? (const char*)g.Bt + (size_t)nxt.pn * g.b_pn_step * 2 : cB;
        for (int t = 0; t < nt; t += 2) {
            const bool last = (t == nt - 2);
            const char* a1 = cA + (size_t)(t + 1) * kstep;
            const char* a2 = last ? nA : cA + (size_t)(t + 2) * kstep; const char* b2 = last ? nB : cB + (size_t)(t + 2) * kstep;
            const char* a3 = a2 + kstep; const char* b3 = b2 + kstep;
            PG8_LDB(B0, 0, 0); PG8_SCHED; PG8_LDA(At, 0, 0); PG8_STAGE(PG8_SA(1, 1), a1 + hstepA, voffA);
            PG8_WAIT_L(8); PG8_BAR; PG8_WAIT_L(0); PG8_MMA(0, 0, At, B0); PG8_BAR; PG8_SCHED;
            PG8_LDB(B1, 0, 1); PG8_STAGE(PG8_SB(0, 0), b2, voffB);
            PG8_BAR; PG8_WAIT_L(0); PG8_MMA(0, 1, At, B1); PG8_BAR;
            PG8_LDA(At, 0, 1); PG8_STAGE(PG8_SA(0, 0), a2, voffA);
            PG8_BAR; PG8_WAIT_L(0); PG8_MMA(1, 0, At, B0); PG8_BAR; PG8_SCHED;
            PG8_STAGE(PG8_SB(0, 1), b2 + hstepB, voffB);
            PG8_WAIT_V(6); PG8_BAR; PG8_MMA(1, 1, At, B1); PG8_BAR;
            PG8_LDB(B0, 1, 0); PG8_SCHED; PG8_LDA(At, 1, 0); PG8_STAGE(PG8_SA(0, 1), a2 + hstepA, voffA);
            PG8_WAIT_L(8); PG8_BAR; PG8_WAIT_L(0); PG8_MMA(0, 0, At, B0); PG8_BAR; PG8_SCHED;
            PG8_LDB(B1, 1, 1); PG8_STAGE(PG8_SB(1, 0), b3, voffB);
            PG8_BAR; PG8_WAIT_L(0); PG8_MMA(0, 1, At, B1); PG8_BAR;
            PG8_LDA(At, 1, 1); PG8_STAGE(PG8_SA(1, 0), a3, voffA);
            PG8_BAR; PG8_WAIT_L(0); PG8_MMA(1, 0, At, B0); PG8_BAR; PG8_SCHED;
            PG8_STAGE(PG8_SB(1, 1), b3 + hstepB, voffB);
            PG8_WAIT_V(6); PG8_BAR; PG8_MMA(1, 1, At, B1); PG8_BAR;
        }
        E(acc, cur, wr, wc, fr, fq);
        if (!has_next) break;
#pragma unroll
        for (int a = 0; a < 2; ++a)
#pragma unroll
            for (int b = 0; b < 2; ++b)
#pragma unroll
                for (int m = 0; m < 4; ++m)
#pragma unroll
                    for (int n = 0; n < 2; ++n) acc[a][b][m][n] = (f32x4){0.f, 0.f, 0.f, 0.f};
        cur = nxt; cA = nA; cB = nB; ++ui;
    }
    PG8_WAIT_V(0);
    if (wr == 0) PG8_BAR;
    PG8_BAR;
#undef PG8_SA
#undef PG8_SB
#undef PG8_STAGE
#undef PG8_LDA
#undef PG8_LDB
#undef PG8_MMA
#undef PG8_WAIT_V
#undef PG8_WAIT_L
#undef PG8_BAR
#undef PG8_SCHED
}
}
#define LAS __attribute__((address_space(3)))
#define LDS_WAIT() asm volatile("s_waitcnt lgkmcnt(0)" ::: "memory")
constexpr int NT = 512, NW = 8;

struct Params {
    const float* in[31];
    float* out;
    unsigned char* ws;
};

__device__ __forceinline__ void tr_item(const float* W, int ldw, bf16* WT, int K, int k0, int nphys0, int lbase, int cnt, const float* kg, LAS float* scr, int lane) {
    const int c = lane & 31;
#pragma unroll 8
    for (int i = 0; i < 32; ++i) { const int kk = 2 * i + (lane >> 5); float v = 0.f;
        if (c < cnt) { v = W[(size_t)(k0 + kk) * ldw + lbase + c]; if (kg) v *= kg[k0 + kk]; }
        scr[kk * 33 + c] = v; }
    LDS_WAIT();
    const int c8 = lane & 7;
#pragma unroll
    for (int j = 0; j < 4; ++j) { const int n = (lane >> 3) + 8 * j; const LAS float* s = scr + (8 * c8) * 33 + n;
        u32x4 o; o.x = pk2(s[0 * 33], s[1 * 33]); o.y = pk2(s[2 * 33], s[3 * 33]); o.z = pk2(s[4 * 33], s[5 * 33]); o.w = pk2(s[6 * 33], s[7 * 33]);
        *(u32x4*)(WT + (size_t)(nphys0 + n) * K + k0 + 8 * c8) = o; }
    LDS_WAIT();
}
__device__ __forceinline__ void p1_group(int g, int& lbase, int& cnt) {
    const int tile = g >> 3, gi = g & 7, bj = gi >> 2, wc = gi & 3; cnt = 32;
    if (tile < 2) lbase = COL_Q + (4 * tile + wc) * 64 + 32 * bj;
    else if (tile < 4) lbase = COL_K + (4 * (tile - 2) + wc) * 64 + 32 * bj;
    else if (tile < 6) lbase = COL_V + (tile - 4) * 256 + 32 * gi;
    else if (tile == 6) lbase = COL_IQ + wc * 64 + 32 * bj;
    else if (tile == 7) { if (wc == 0) lbase = COL_IK + 32 * bj; else if (gi == 1) { lbase = COL_IW; cnt = 4; } else { lbase = 0; cnt = 0; } }
    else if (tile < 15) lbase = COL_RW + (tile - 8) * 256 + 32 * gi;
    else lbase = COL_MEMQ + (tile - 15) * 256 + 32 * gi;
}

__device__ __forceinline__ void prologue_phase(const Params& P, LAS unsigned char* lds, int bid, int nblk) {
    const int tid = threadIdx.x, lane = tid & 63, wave = tid >> 6;
    const int gw = bid * NW + wave, NGW = nblk * NW;
    unsigned char* ws = P.ws;
    LAS float* scr = (LAS float*)(lds + wave * 16384);
    constexpr int I_P1 = 16 * (P1_N / 32), I_WG = 16 * 96, I_UP = 8 * 32, I_OUT = 16 * 32, I_WQ = 16 * 64, I_MEM = 16 * 32;
    constexpr int NITEMS = I_P1 + I_WG + 3 * I_UP + I_OUT + I_WQ + I_MEM;
    for (int it = gw; it < NITEMS; it += NGW) {
        int r = it;
        if (r < I_P1) { const int ng = P1_N / 32, kb = r / ng, g = r % ng; int lb, cnt; p1_group(g, lb, cnt);
            tr_item(P.in[4], WIN_COLS, (bf16*)(ws + WS_WIN), 1024, 64 * kb, 32 * g, lb, cnt, P.in[3], scr, lane); continue; } r -= I_P1;
        if (r < I_WG) { const int kb = r / 96, g = r % 96;
            tr_item(P.in[4], WIN_COLS, (bf16*)(ws + WS_WG), 1024, 64 * kb, 32 * g, COL_GATE + 32 * g, 32, P.in[3], scr, lane); continue; } r -= I_WG;
        if (r < 3 * I_UP) { const int c = r / I_UP, rr = r % I_UP, kb = rr / 32, g = rr % 32;
            tr_item(P.in[23] + (size_t)c * 512 * 1024, 1024, (bf16*)(ws + WS_WUP) + (size_t)c * 1024 * 512, 512, 64 * kb, 32 * g, 32 * g, 32, nullptr, scr, lane); continue; } r -= 3 * I_UP;
        if (r < I_OUT) { const int kb = r / 32, g = r % 32;
            tr_item(P.in[24], 1024, (bf16*)(ws + WS_WOUT), 1024, 64 * kb, 32 * g, 32 * g, 32, nullptr, scr, lane); continue; } r -= I_OUT;
        if (r < I_WQ) { const int kb = r / 64, g = r % 64;
            tr_item(P.in[26], 2048, (bf16*)(ws + WS_WQ), 1024, 64 * kb, 32 * g, 32 * g, 32, P.in[25], scr, lane); continue; } r -= I_WQ;
        { const int kb = r / 32, g = r % 32;
            tr_item(P.in[9], 1024, (bf16*)(ws + WS_WMEM), 1024, 64 * kb, 32 * g, 32 * g, 32, P.in[8], scr, lane); }
    }
    for (int m = gw; m < S_ + NMEM; m += NGW) {
        const bool isx = m < S_; const int r = isx ? m : m - S_;
        const f32x4* xr = (const f32x4*)((isx ? P.in[0] : P.in[1]) + (size_t)r * D_) + lane;
        f32x4 v[4]; float s = 0.f;
#pragma unroll
        for (int j = 0; j < 4; ++j) { v[j] = xr[64 * j]; s += (v[j].x * v[j].x + v[j].y * v[j].y) + (v[j].z * v[j].z + v[j].w * v[j].w); }
        s = wave_sum(s);
        const float rstd = 1.0f / sqrtf(s * (1.0f / D_) + NORM_EPS);
        if (lane == 0) ((float*)(ws + (isx ? WS_RSTDX : WS_RSTDM)))[r] = rstd;
        unsigned long long* o8 = (unsigned long long*)((bf16*)(ws + (isx ? WS_XB : WS_MB)) + (size_t)r * D_) + lane;
#pragma unroll
        for (int j = 0; j < 4; ++j) o8[64 * j] = (unsigned long long)pk2(v[j].x, v[j].y) | ((unsigned long long)pk2(v[j].z, v[j].w) << 32);
    }
    const int gt = bid * NT + tid, NGT = nblk * NT;
    for (int i = gt; i < S_ * 8; i += NGT) { const int t = i >> 3, f = i & 7;
        const double inv = pow(500000.0, -(double)f / 8.0); const double ang = (double)((const int*)P.in[2])[t] * inv;
        ((float*)(ws + WS_COS))[i] = (float)cos(ang); ((float*)(ws + WS_SIN))[i] = (float)sin(ang); }
    for (int i = gt; i < 256 * 256; i += NGT) { const int n = i >> 8, k = i & 255; float v = 0.f;
        if (n < 128) { if (k < 128) v = P.in[27][n * 128 + k]; } else { if (k >= 128) v = P.in[28][(n - 128) * 128 + (k - 128)]; }
        ((bf16*)(ws + WS_KEYBD))[i] = (bf16)f2bf(v); }
    for (int i = gt; i < 1536 * 256; i += NGT) { const int n = i >> 8, k = i & 255; float v = 0.f;
        if (n < 512) { if (k < 64) v = P.in[14][k * 512 + n]; }
        else if (n < 1024) { if (k >= 64 && k < 128) v = P.in[16][(k - 64) * 512 + (n - 512)]; }
        else { if (k >= 128) v = P.in[17][(k - 128) * 512 + (n - 1024)]; }
        ((bf16*)(ws + WS_WLORA))[i] = (bf16)f2bf(v); }
}

typedef const f32x4 (&AccRef)[2][2][4][2];
__device__ __forceinline__ void st_bf4(bf16* p, f32x4 v) { u32x2 w; w.x = pk2(v[0], v[1]); w.y = pk2(v[2], v[3]); *(u32x2*)p = w; }
__device__ __forceinline__ void st_h4(half_t* p, f32x4 v) { half4 h; h[0] = (half_t)v[0]; h[1] = (half_t)v[1]; h[2] = (half_t)v[2]; h[3] = (half_t)v[3]; *(half4*)p = h; }

__device__ __forceinline__ f32x4 rope4(f32x4 v, int fq, const float* cs, const float* sn) {
    f32x4 o;
#pragma unroll
    for (int j = 0; j < 4; ++j) { const float p = __shfl_xor(v[j], 32); const int i = 4 * (fq & 1) + j; const float c = cs[i], s = sn[i];
        o[j] = (fq < 2) ? (v[j] * c - p * s) : (v[j] * c + p * s); }
    return o;
}

struct EpiP1 {
    const float* rstd; const float* cs; const float* sn; const float* qgain; const float* kgain;
    bf16 *Q, *K, *V, *RWP, *MEMQ; half_t *IQ, *IK; float* IW;
    __device__ __forceinline__ void operator()(AccRef acc, const pg8::Unit& u, int wr, int wc, int fr, int fq) const {
        const int pn = u.pn;
#pragma unroll
        for (int ai = 0; ai < 2; ++ai)
#pragma unroll
            for (int m = 0; m < 4; ++m) {
                const int row = u.pm * 256 + ai * 128 + wr * 64 + m * 16 + fr; const float rs = rstd[row];
                f32x4 v[2][2];
#pragma unroll
                for (int bj = 0; bj < 2; ++bj)
#pragma unroll
                    for (int n = 0; n < 2; ++n) v[bj][n] = acc[ai][bj][m][n] * rs;
                if (pn < 4) {
                    float ss = 0.f;
#pragma unroll
                    for (int bj = 0; bj < 2; ++bj)
#pragma unroll
                        for (int n = 0; n < 2; ++n) ss += (v[bj][n][0] * v[bj][n][0] + v[bj][n][1] * v[bj][n][1]) + (v[bj][n][2] * v[bj][n][2] + v[bj][n][3] * v[bj][n][3]);
                    ss += __shfl_xor(ss, 16); ss += __shfl_xor(ss, 32);
                    const float rh = 1.0f / sqrtf(ss * (1.0f / 64.0f) + NORM_EPS);
                    const float* gn = (pn < 2) ? qgain : kgain;
#pragma unroll
                    for (int bj = 0; bj < 2; ++bj)
#pragma unroll
                        for (int n = 0; n < 2; ++n) { const f32x4 gv = *(const f32x4*)(gn + 32 * bj + 16 * n + 4 * fq); v[bj][n] = v[bj][n] * rh * gv; }
                    v[0][0] = rope4(v[0][0], fq, cs + row * 8, sn + row * 8);
                    bf16* dst = ((pn < 2) ? Q : K) + (size_t)row * 512 + ((pn & 1) * 4 + wc) * 64 + 4 * fq;
#pragma unroll
                    for (int bj = 0; bj < 2; ++bj)
#pragma unroll
                        for (int n = 0; n < 2; ++n) st_bf4(dst + 32 * bj + 16 * n, v[bj][n]);
                } else if (pn < 6) {
                    bf16* dst = V + (size_t)row * 512 + (pn - 4) * 256 + 32 * wc + 4 * fq;
#pragma unroll
                    for (int bj = 0; bj < 2; ++bj)
#pragma unroll
                        for (int n = 0; n < 2; ++n) st_bf4(dst + 128 * bj + 16 * n, v[bj][n]);
                } else if (pn == 6) {
                    v[0][0] = rope4(v[0][0], fq, cs + row * 8, sn + row * 8);
                    half_t* dst = IQ + (size_t)row * 256 + wc * 64 + 4 * fq;
#pragma unroll
                    for (int bj = 0; bj < 2; ++bj)
#pragma unroll
                        for (int n = 0; n < 2; ++n) st_h4(dst + 32 * bj + 16 * n, v[bj][n]);
                } else if (pn == 7) {
                    if (wc == 0) {
                        v[0][0] = rope4(v[0][0], fq, cs + row * 8, sn + row * 8);
                        half_t* dst = IK + (size_t)row * 64 + 4 * fq;
#pragma unroll
                        for (int bj = 0; bj < 2; ++bj)
#pragma unroll
                            for (int n = 0; n < 2; ++n) st_h4(dst + 32 * bj + 16 * n, v[bj][n]);
                    } else if (wc == 1) { if (fq == 0) *(f32x4*)(IW + (size_t)row * 4) = v[0][0]; }
                } else if (pn < 15) {
                    bf16* dst = RWP + (size_t)row * RW_IN + (pn - 8) * 256 + 32 * wc + 4 * fq;
#pragma unroll
                    for (int bj = 0; bj < 2; ++bj)
#pragma unroll
                        for (int n = 0; n < 2; ++n) st_bf4(dst + 128 * bj + 16 * n, v[bj][n]);
                } else {
                    bf16* dst = MEMQ + (size_t)row * 512 + (pn - 15) * 256 + 32 * wc + 4 * fq;
#pragma unroll
                    for (int bj = 0; bj < 2; ++bj)
#pragma unroll
                        for (int n = 0; n < 2; ++n) st_bf4(dst + 128 * bj + 16 * n, v[bj][n]);
                }
            }
    }
};

struct EpiF32 {
    float* C; int ldc; const float* rstd;
    __device__ __forceinline__ void operator()(AccRef acc, const pg8::Unit& u, int wr, int wc, int fr, int fq) const {
#pragma unroll
        for (int ai = 0; ai < 2; ++ai)
#pragma unroll
            for (int m = 0; m < 4; ++m) { const int row = u.pm * 256 + ai * 128 + wr * 64 + m * 16 + fr; const float rs = rstd ? rstd[row] : 1.0f;
                float* dst = C + (size_t)row * ldc + u.pn * 256 + 32 * wc + 4 * fq;
#pragma unroll
                for (int bj = 0; bj < 2; ++bj)
#pragma unroll
                    for (int n = 0; n < 2; ++n) *(f32x4*)(dst + 128 * bj + 16 * n) = acc[ai][bj][m][n] * rs; }
    }
};
struct EpiBf {
    bf16* C; int ldc; const float* rstd;
    __device__ __forceinline__ void operator()(AccRef acc, const pg8::Unit& u, int wr, int wc, int fr, int fq) const {
#pragma unroll
        for (int ai = 0; ai < 2; ++ai)
#pragma unroll
            for (int m = 0; m < 4; ++m) { const int row = u.pm * 256 + ai * 128 + wr * 64 + m * 16 + fr; const float rs = rstd ? rstd[row] : 1.0f;
                bf16* dst = C + (size_t)row * ldc + u.pn * 256 + 32 * wc + 4 * fq;
#pragma unroll
                for (int bj = 0; bj < 2; ++bj)
#pragma unroll
                    for (int n = 0; n < 2; ++n) st_bf4(dst + 128 * bj + 16 * n, acc[ai][bj][m][n] * rs); }
    }
};
__device__ __forceinline__ float sigmoidf_(float x) { return 1.0f / (1.0f + __expf(-x)); }
struct EpiLora {
    bf16 *E, *A, *G; const float* w0; const float* a0;
    __device__ __forceinline__ void operator()(AccRef acc, const pg8::Unit& u, int wr, int wc, int fr, int fq) const {
        const int kind = u.pn >> 1;
#pragma unroll
        for (int ai = 0; ai < 2; ++ai)
#pragma unroll
            for (int m = 0; m < 4; ++m) { const int row = u.pm * 256 + ai * 128 + wr * 64 + m * 16 + fr;
#pragma unroll
                for (int bj = 0; bj < 2; ++bj)
#pragma unroll
                    for (int n = 0; n < 2; ++n) { const int c = (u.pn & 1) * 256 + 128 * bj + 32 * wc + 16 * n + 4 * fq; f32x4 v = acc[ai][bj][m][n];
                        if (kind == 0) { const f32x4 b = *(const f32x4*)(w0 + c);
#pragma unroll
                            for (int j = 0; j < 4; ++j) { const float z = v[j] + b[j]; const float sp = fmaxf(-z, 0.f) + __logf(1.0f + __expf(-fabsf(z))); v[j] = __expf(-sp - 0.5f); }
                            st_bf4(E + (size_t)row * 512 + c, v);
                        } else if (kind == 1) { const f32x4 b = *(const f32x4*)(a0 + c);
#pragma unroll
                            for (int j = 0; j < 4; ++j) v[j] = sigmoidf_(v[j] + b[j]);
                            st_bf4(A + (size_t)row * 512 + c, v);
                        } else st_bf4(G + (size_t)row * 512 + c, v); } }
    }
};
struct EpiGate {
    bf16* Gt; const float* rstd; const float* bias;
    __device__ __forceinline__ void operator()(AccRef acc, const pg8::Unit& u, int wr, int wc, int fr, int fq) const {
#pragma unroll
        for (int ai = 0; ai < 2; ++ai)
#pragma unroll
            for (int m = 0; m < 4; ++m) { const int row = u.pm * 256 + ai * 128 + wr * 64 + m * 16 + fr; const float rs = rstd[row];
#pragma unroll
                for (int bj = 0; bj < 2; ++bj)
#pragma unroll
                    for (int n = 0; n < 2; ++n) { const int c = u.pn * 256 + 128 * bj + 32 * wc + 16 * n + 4 * fq; const f32x4 b = *(const f32x4*)(bias + c); f32x4 v = acc[ai][bj][m][n] * rs + b;
#pragma unroll
                        for (int j = 0; j < 4; ++j) v[j] = sigmoidf_(v[j]);
                        st_bf4(Gt + (size_t)row * 3072 + c, v); } }
    }
};
struct EpiMerge {
    const bf16* Gt; float* accf; bf16* merged; int c;
    __device__ __forceinline__ void operator()(AccRef acc, const pg8::Unit& u, int wr, int wc, int fr, int fq) const {
#pragma unroll
        for (int ai = 0; ai < 2; ++ai)
#pragma unroll
            for (int m = 0; m < 4; ++m) { const int row = u.pm * 256 + ai * 128 + wr * 64 + m * 16 + fr;
#pragma unroll
                for (int bj = 0; bj < 2; ++bj)
#pragma unroll
                    for (int n = 0; n < 2; ++n) { const int col = u.pn * 256 + 128 * bj + 32 * wc + 16 * n + 4 * fq;
                        const u32x2 gw = *(const u32x2*)(Gt + (size_t)row * 3072 + c * 1024 + col);
                        f32x4 v = acc[ai][bj][m][n]; v[0] *= bflo(gw.x); v[1] *= bfhi(gw.x); v[2] *= bflo(gw.y); v[3] *= bfhi(gw.y);
                        float* ap = accf + (size_t)row * 1024 + col;
                        if (c > 0) v = v + *(const f32x4*)ap;
                        if (c < 2) *(f32x4*)ap = v; else st_bf4(merged + (size_t)row * 1024 + col, v); } }
    }
};
struct EpiOut {
    const float* x; float* out; bf16* HB; float* HSQ;
    __device__ __forceinline__ void operator()(AccRef acc, const pg8::Unit& u, int wr, int wc, int fr, int fq) const {
#pragma unroll
        for (int ai = 0; ai < 2; ++ai)
#pragma unroll
            for (int m = 0; m < 4; ++m) { const int row = u.pm * 256 + ai * 128 + wr * 64 + m * 16 + fr; float ss = 0.f;
#pragma unroll
                for (int bj = 0; bj < 2; ++bj)
#pragma unroll
                    for (int n = 0; n < 2; ++n) { const size_t o = (size_t)row * 1024 + u.pn * 256 + 128 * bj + 32 * wc + 16 * n + 4 * fq;
                        const f32x4 v = acc[ai][bj][m][n] + *(const f32x4*)(x + o); *(f32x4*)(out + o) = v; st_bf4(HB + o, v);
                        ss += (v[0] * v[0] + v[1] * v[1]) + (v[2] * v[2] + v[3] * v[3]); }
                ss += __shfl_xor(ss, 16); ss += __shfl_xor(ss, 32);
                if (fq == 0) HSQ[(size_t)row * 16 + u.pn * 4 + wc] = ss; }
    }
};
__device__ __forceinline__ void lora_in_phase(const Params& P, int bid, int nblk) {
    const bf16* RWP = (const bf16*)(P.ws + WS_RWP); bf16* LIN = (bf16*)((unsigned char*)P.out + DO_LIN); const float* mu = P.in[12];
    const int gt = bid * NT + threadIdx.x, NGT = nblk * NT;
    for (int i = gt; i < S_ * 64; i += NGT) { const int t = i >> 6, c4 = (i & 63) * 4;
        const u32x2 pw = *(const u32x2*)(RWP + (size_t)t * RW_IN + 1536 + c4);
        u32x2 qw; qw.x = 0u; qw.y = 0u; if (t > 0) qw = *(const u32x2*)(RWP + (size_t)(t - 1) * RW_IN + 1536 + c4);
        const f32x4 m4 = *(const f32x4*)(mu + 1536 + c4);
        f32x4 p = {bflo(pw.x), bfhi(pw.x), bflo(pw.y), bfhi(pw.y)}, q = {bflo(qw.x), bfhi(qw.x), bflo(qw.y), bfhi(qw.y)};
        f32x4 s = p + (q - p) * m4;
        if (c4 < 64) { for (int j = 0; j < 4; ++j) s[j] = tanhf(s[j]); }
        else if (c4 >= 128) { for (int j = 0; j < 4; ++j) s[j] = sigmoidf_(s[j]); }
        st_bf4(LIN + (size_t)t * 256 + c4, s); }
}

constexpr int TC = 32;
__device__ __forceinline__ float shift3(const bf16* RWP, const float* mu, int t, int col) {
    const float p = bf2f(RWP[(size_t)t * RW_IN + col]); const float q = t > 0 ? bf2f(RWP[(size_t)(t - 1) * RW_IN + col]) : 0.f;
    return p + (q - p) * mu[col];
}
__device__ __forceinline__ void rwkv_scan_v1(const Params& P, LAS unsigned char* lds, int h) {
    const bf16* RWP = (const bf16*)(P.ws + WS_RWP);
    const bf16* Eb = (const bf16*)((unsigned char*)P.out + DO_E); const bf16* Ab = (const bf16*)((unsigned char*)P.out + DO_A); const bf16* Gb = (const bf16*)((unsigned char*)P.out + DO_G);
    bf16* Y = (bf16*)(P.ws + WS_Y);
    const float* mu = P.in[12]; const float* k_k = P.in[18]; const float* k_a = P.in[19]; const float* r_k = P.in[20]; const float* ln_w = P.in[21]; const float* ln_b = P.in[22];
    LAS float* sR = (LAS float*)lds; LAS float* sW = sR + TC * 64; LAS float* sK = sW + TC * 64; LAS float* sV = sK + TC * 64;
    LAS float* sA = sV + TC * 64; LAS float* sB = sA + TC * 64; LAS float* sY = sB + TC * 64; LAS float* sG = sY + TC * 64;
    const int tid = threadIdx.x;
    const int tok = tid >> 4, j0 = (tid & 15) * 4;
    const int si = tid >> 3, jg = tid & 7;
    float S[8];
#pragma unroll
    for (int c = 0; c < 8; ++c) S[c] = 0.f;
    for (int t0 = 0; t0 < S_; t0 += TC) {
        {
            const int t = t0 + tok; float kkv[4], ss = 0.f, rr[4], kk_[4], vv[4], aa[4], ee[4], gg[4];
#pragma unroll
            for (int j = 0; j < 4; ++j) { const int c = h * 64 + j0 + j;
                rr[j] = shift3(RWP, mu, t, c); kk_[j] = shift3(RWP, mu, t, 512 + c); vv[j] = shift3(RWP, mu, t, 1024 + c);
                aa[j] = bf2f(Ab[(size_t)t * 512 + c]); ee[j] = bf2f(Eb[(size_t)t * 512 + c]); gg[j] = bf2f(Gb[(size_t)t * 512 + c]);
                kkv[j] = kk_[j] * k_k[c]; ss += kkv[j] * kkv[j]; }
            ss += __shfl_xor(ss, 1); ss += __shfl_xor(ss, 2); ss += __shfl_xor(ss, 4); ss += __shfl_xor(ss, 8);
            const float inv = 1.0f / fmaxf(sqrtf(ss), 1e-12f);
#pragma unroll
            for (int j = 0; j < 4; ++j) { const int c = h * 64 + j0 + j; const int o = tok * 64 + j0 + j; const float kn = kkv[j] * inv;
                sR[o] = rr[j]; sW[o] = __expf(-ee[j]); sK[o] = kk_[j] * (1.0f + (aa[j] - 1.0f) * k_a[c]); sV[o] = vv[j]; sA[o] = -kn; sB[o] = kn * aa[j]; sG[o] = gg[j]; }
        }
        __syncthreads();
        for (int tt = 0; tt < TC; ++tt) {
            const LAS float* pa = sA + tt * 64 + 8 * jg; const LAS float* pb = sB + tt * 64 + 8 * jg; const LAS float* pw = sW + tt * 64 + 8 * jg;
            const LAS float* pk = sK + tt * 64 + 8 * jg; const LAS float* pr = sR + tt * 64 + 8 * jg;
            const float vi = sV[tt * 64 + si];
            float sa = 0.f;
#pragma unroll
            for (int c = 0; c < 8; ++c) sa += S[c] * pa[c];
            sa += __shfl_xor(sa, 1); sa += __shfl_xor(sa, 2); sa += __shfl_xor(sa, 4);
            float y = 0.f;
#pragma unroll
            for (int c = 0; c < 8; ++c) { S[c] = S[c] * pw[c] + sa * pb[c] + vi * pk[c]; y += S[c] * pr[c]; }
            y += __shfl_xor(y, 1); y += __shfl_xor(y, 2); y += __shfl_xor(y, 4);
            if (jg == 0) sY[tt * 64 + si] = y;
        }
        __syncthreads();
        {
            const int t = t0 + tok; float y4[4], s1 = 0.f, bon = 0.f;
#pragma unroll
            for (int j = 0; j < 4; ++j) { const int o = tok * 64 + j0 + j; y4[j] = sY[o]; s1 += y4[j]; bon += sR[o] * sK[o] * r_k[h * 64 + j0 + j]; }
            s1 += __shfl_xor(s1, 1); s1 += __shfl_xor(s1, 2); s1 += __shfl_xor(s1, 4); s1 += __shfl_xor(s1, 8);
            bon += __shfl_xor(bon, 1); bon += __shfl_xor(bon, 2); bon += __shfl_xor(bon, 4); bon += __shfl_xor(bon, 8);
            const float mean = s1 * (1.0f / 64.0f); float s2 = 0.f;
#pragma unroll
            for (int j = 0; j < 4; ++j) { const float d = y4[j] - mean; s2 += d * d; }
            s2 += __shfl_xor(s2, 1); s2 += __shfl_xor(s2, 2); s2 += __shfl_xor(s2, 4); s2 += __shfl_xor(s2, 8);
            const float rstd = 1.0f / sqrtf(s2 * (1.0f / 64.0f) + GN_EPS);
            f32x4 o4;
#pragma unroll
            for (int j = 0; j < 4; ++j) { const int c = h * 64 + j0 + j; const int o = tok * 64 + j0 + j;
                o4[j] = ((y4[j] - mean) * rstd * ln_w[c] + ln_b[c] + bon * sV[o]) * sG[o]; }
            st_bf4(Y + (size_t)t * 1536 + 512 + h * 64 + j0, o4);
        }
        __syncthreads();
    }
}

__device__ __forceinline__ unsigned ordkey(float f) { const unsigned u = __builtin_bit_cast(unsigned, f); return (u & 0x80000000u) ? ~u : (u | 0x80000000u); }
constexpr int DSA_LDS_SCORES = 0, DSA_LDS_IQ = 65536, DSA_LDS_HIST = DSA_LDS_IQ + 1024, DSA_LDS_MISC = DSA_LDS_HIST + 1024, DSA_LDS_SEL = DSA_LDS_MISC + 256,
              DSA_LDS_O = DSA_LDS_SEL + 1024, DSA_LDS_ML = DSA_LDS_O + 8 * 512 * 4, DSA_LDS_END = DSA_LDS_ML + 8 * 8 * 2 * 4;
__device__ __forceinline__ void dsa_query_v1(const Params& P, LAS unsigned char* lds, int t) {
    const half_t* IQ = (const half_t*)(P.ws + WS_IQ); const half_t* IK = (const half_t*)(P.ws + WS_IK); const float* IW = (const float*)(P.ws + WS_IW);
    const bf16* Q = (const bf16*)(P.ws + WS_Q); const bf16* Kb = (const bf16*)(P.ws + WS_K); const bf16* Vb = (const bf16*)(P.ws + WS_V);
    bf16* Y = (bf16*)(P.ws + WS_Y);
    LAS float* sc = (LAS float*)(lds + DSA_LDS_SCORES); LAS float* siq = (LAS float*)(lds + DSA_LDS_IQ); LAS unsigned* hist = (LAS unsigned*)(lds + DSA_LDS_HIST);
    LAS unsigned* misc = (LAS unsigned*)(lds + DSA_LDS_MISC); LAS unsigned* sel = (LAS unsigned*)(lds + DSA_LDS_SEL);
    LAS float* so = (LAS float*)(lds + DSA_LDS_O); LAS float* sml = (LAS float*)(lds + DSA_LDS_ML);
    const int tid = threadIdx.x, lane = tid & 63, wave = tid >> 6;
    const int n = t + 1;
    if (tid < 256) siq[tid] = (float)IQ[(size_t)t * 256 + tid];
    if (tid < 256) sel[tid] = 0xFFFFu;
    __syncthreads();
    float w4[4];
#pragma unroll
    for (int hh = 0; hh < 4; ++hh) w4[hh] = IW[(size_t)t * 4 + hh] * 0.0625f;
    for (int s = tid; s < n; s += NT) {
        const half8* kp = (const half8*)(IK + (size_t)s * 64);
        float d0 = 0.f, d1 = 0.f, d2 = 0.f, d3 = 0.f;
#pragma unroll
        for (int c = 0; c < 8; ++c) { const half8 kv = kp[c];
#pragma unroll
            for (int j = 0; j < 8; ++j) { const float kf = (float)kv[j]; const int d = c * 8 + j;
                d0 += siq[d] * kf; d1 += siq[64 + d] * kf; d2 += siq[128 + d] * kf; d3 += siq[192 + d] * kf; } }
        float v = w4[0] * fmaxf(d0, 0.f) + w4[1] * fmaxf(d1, 0.f) + w4[2] * fmaxf(d2, 0.f) + w4[3] * fmaxf(d3, 0.f);
        sc[s] = v + 0.0f;
    }
    __syncthreads();
    if (n <= 256) { if (tid < n) sel[tid] = (unsigned)tid; __syncthreads(); }
    else {
        unsigned prefix = 0u, krem = 256u;
        for (int pass = 3; pass >= 0; --pass) {
            const int shift = pass * 8;
            if (tid < 256) hist[tid] = 0u;
            __syncthreads();
            for (int s = tid; s < n; s += NT) { const unsigned k = ordkey(sc[s]);
                if (pass == 3 || (k >> (shift + 8)) == (prefix >> (shift + 8))) atomicAdd((unsigned*)&hist[(k >> shift) & 255u], 1u); }
            __syncthreads();
            if (tid == 0) { unsigned cum = 0u; int b = 255; for (; b > 0; --b) { const unsigned hb = hist[b]; if (cum + hb >= krem) break; cum += hb; }
                misc[0] = prefix | ((unsigned)b << shift); misc[1] = krem - cum; }
            __syncthreads();
            prefix = misc[0]; krem = misc[1];
            __syncthreads();
        }
        const unsigned T = prefix; unsigned selbase = 0u, eqbase = 0u;
        for (int c0 = 0; c0 < n; c0 += NT) {
            const int s = c0 + tid; const unsigned k = (s < n) ? ordkey(sc[s]) : 0u; const bool gt = (s < n) && k > T, eq = (s < n) && k == T;
            const unsigned long long beq = __ballot(eq); const unsigned eqpre = __popcll(beq & ((1ull << lane) - 1ull));
            if (lane == 0) misc[8 + wave] = (unsigned)__popcll(beq);
            __syncthreads();
            unsigned eqoff = eqbase, eqtot = 0u;
#pragma unroll
            for (int w = 0; w < 8; ++w) { const unsigned cw = misc[8 + w]; if (w < wave) eqoff += cw; eqtot += cw; }
            const bool take = gt || (eq && (eqoff + eqpre) < krem);
            const unsigned long long bt = __ballot(take); const unsigned tpre = __popcll(bt & ((1ull << lane) - 1ull));
            if (lane == 0) misc[16 + wave] = (unsigned)__popcll(bt);
            __syncthreads();
            unsigned toff = selbase, ttot = 0u;
#pragma unroll
            for (int w = 0; w < 8; ++w) { const unsigned cw = misc[16 + w]; if (w < wave) toff += cw; ttot += cw; }
            if (take && (toff + tpre) < 256u) sel[toff + tpre] = (unsigned)s;
            selbase += ttot; eqbase += eqtot;
            __syncthreads();
        }
    }
    {
        u16* SEL = (u16*)(P.ws + WS_SEL);
        if (tid < 256) SEL[(size_t)t * 256 + tid] = (u16)sel[tid];
        const u32x4 qw = *(const u32x4*)(Q + (size_t)t * 512 + 8 * lane);
        float q[8] = {bflo(qw.x), bfhi(qw.x), bflo(qw.y), bfhi(qw.y), bflo(qw.z), bfhi(qw.z), bflo(qw.w), bfhi(qw.w)};
        float lg[32]; float mx = -INFINITY;
#pragma unroll
        for (int i = 0; i < 32; ++i) { const unsigned id = sel[wave * 32 + i];
            float d = -INFINITY;
            if (id != 0xFFFFu) { const u32x4 kw = *(const u32x4*)(Kb + (size_t)id * 512 + 8 * lane);
                d = q[0] * bflo(kw.x) + q[1] * bfhi(kw.x) + q[2] * bflo(kw.y) + q[3] * bfhi(kw.y) + q[4] * bflo(kw.z) + q[5] * bfhi(kw.z) + q[6] * bflo(kw.w) + q[7] * bfhi(kw.w);
                d += __shfl_xor(d, 1); d += __shfl_xor(d, 2); d += __shfl_xor(d, 4); d *= 0.125f; }
            lg[i] = d; mx = fmaxf(mx, d); }
        float l = 0.f, o[8];
#pragma unroll
        for (int c = 0; c < 8; ++c) o[c] = 0.f;
#pragma unroll
        for (int i = 0; i < 32; ++i) { const unsigned id = sel[wave * 32 + i];
            if (id != 0xFFFFu) { const float p = __expf(lg[i] - mx); l += p;
                const u32x4 vw = *(const u32x4*)(Vb + (size_t)id * 512 + 8 * lane);
                o[0] += p * bflo(vw.x); o[1] += p * bfhi(vw.x); o[2] += p * bflo(vw.y); o[3] += p * bfhi(vw.y); o[4] += p * bflo(vw.z); o[5] += p * bfhi(vw.z); o[6] += p * bflo(vw.w); o[7] += p * bfhi(vw.w); } }
#pragma unroll
        for (int c = 0; c < 8; ++c) so[wave * 512 + 8 * lane + c] = o[c];
        if ((lane & 7) == 0) { sml[(wave * 8 + (lane >> 3)) * 2] = mx; sml[(wave * 8 + (lane >> 3)) * 2 + 1] = l; }
        __syncthreads();
        {
            const int hh = tid >> 6; float M = -INFINITY;
#pragma unroll
            for (int w = 0; w < 8; ++w) M = fmaxf(M, sml[(w * 8 + hh) * 2]);
            float L = 0.f, acc = 0.f;
#pragma unroll
            for (int w = 0; w < 8; ++w) { const float mw = sml[(w * 8 + hh) * 2]; const float f = (mw == -INFINITY) ? 0.f : __expf(mw - M); L += f * sml[(w * 8 + hh) * 2 + 1]; acc += f * so[w * 512 + tid]; }
            Y[(size_t)t * 1536 + tid] = (bf16)f2bf(acc / L);
        }
        __syncthreads();
    }
}

constexpr int MA_KSTRIDE = 264;
constexpr int MA_LDS_K = 0, MA_LDS_V = 256 * MA_KSTRIDE, MA_LDS_P = MA_LDS_V + 256 * 256, MA_LDS_Q = MA_LDS_P + 8 * 256 * 4, MA_LDS_END = MA_LDS_Q + 8 * 128 * 4;
__device__ __forceinline__ void mem_attn_phase(const Params& P, LAS unsigned char* lds, int bid, int nblk) {
    const float* KMVM = (const float*)(P.ws + WS_KMVM); const bf16* MEMQ = (const bf16*)(P.ws + WS_MEMQ); bf16* Y = (bf16*)(P.ws + WS_Y);
    const float* qg = P.in[10]; const float* kg = P.in[11];
    const int tid = threadIdx.x, lane = tid & 63, wave = tid >> 6;
    const int h = bid & 3, sub = bid >> 2, nsub = nblk >> 2;
    for (int r = wave; r < 256; r += NW) {
        const f32x2 kv = *(const f32x2*)(KMVM + (size_t)r * 1024 + h * 128 + 2 * lane);
        const float ss = wave_sum(kv.x * kv.x + kv.y * kv.y); const float rk = 1.0f / sqrtf(ss * (1.0f / 128.0f) + NORM_EPS);
        *(LAS unsigned*)(lds + MA_LDS_K + r * MA_KSTRIDE + 4 * lane) = pk2(kv.x * rk * kg[2 * lane], kv.y * rk * kg[2 * lane + 1]);
        const f32x2 vv = *(const f32x2*)(KMVM + (size_t)r * 1024 + 512 + h * 128 + 2 * lane);
        *(LAS unsigned*)(lds + MA_LDS_V + r * 256 + 4 * lane) = pk2(vv.x, vv.y);
    }
    __syncthreads();
    LAS float* pb = (LAS float*)(lds + MA_LDS_P) + wave * 256; LAS float* qb = (LAS float*)(lds + MA_LDS_Q) + wave * 128;
    for (int r = sub * NW + wave; r < S_; r += nsub * NW) {
        const unsigned qw = *(const unsigned*)(MEMQ + (size_t)r * 512 + h * 128 + 2 * lane);
        const float q0 = bflo(qw), q1 = bfhi(qw);
        const float ss = wave_sum(q0 * q0 + q1 * q1); const float rq = 1.0f / sqrtf(ss * (1.0f / 128.0f) + NORM_EPS) * 0.08838834764831845f;
        qb[2 * lane] = q0 * rq * qg[2 * lane]; qb[2 * lane + 1] = q1 * rq * qg[2 * lane + 1];
        LDS_WAIT(); __builtin_amdgcn_wave_barrier();
        float lg[4] = {0.f, 0.f, 0.f, 0.f};
#pragma unroll 4
        for (int d4 = 0; d4 < 32; ++d4) { const f32x4 qv = *(const LAS f32x4*)(qb + 4 * d4);
#pragma unroll
            for (int c = 0; c < 4; ++c) { const u32x2 kw = *(const LAS u32x2*)(lds + MA_LDS_K + (lane + 64 * c) * MA_KSTRIDE + 8 * d4);
                lg[c] += qv[0] * bflo(kw.x) + qv[1] * bfhi(kw.x) + qv[2] * bflo(kw.y) + qv[3] * bfhi(kw.y); } }
        const float mx = wave_max(fmaxf(fmaxf(lg[0], lg[1]), fmaxf(lg[2], lg[3])));
        float p[4], l = 0.f;
#pragma unroll
        for (int c = 0; c < 4; ++c) { p[c] = __expf(lg[c] - mx); l += p[c]; }
        l = wave_sum(l); const float il = 1.0f / l;
#pragma unroll
        for (int c = 0; c < 4; ++c) pb[lane + 64 * c] = p[c] * il;
        LDS_WAIT(); __builtin_amdgcn_wave_barrier();
        float o0 = 0.f, o1 = 0.f;
#pragma unroll 8
        for (int k4 = 0; k4 < 64; ++k4) { const f32x4 pv = *(const LAS f32x4*)(pb + 4 * k4);
#pragma unroll
            for (int c = 0; c < 4; ++c) { const unsigned vw = *(const LAS unsigned*)(lds + MA_LDS_V + (4 * k4 + c) * 256 + 4 * lane); o0 += pv[c] * bflo(vw); o1 += pv[c] * bfhi(vw); } }
        *(unsigned*)(Y + (size_t)r * 1536 + 1024 + h * 128 + 2 * lane) = pk2(o0, o1);
        LDS_WAIT(); __builtin_amdgcn_wave_barrier();
    }
}

__device__ __forceinline__ void rstdh_phase(const Params& P, int bid, int nblk) {
    const float* HSQ = (const float*)(P.ws + WS_HSQ); float* R = (float*)(P.ws + WS_RSTDH);
    for (int r = bid * NT + threadIdx.x; r < S_; r += nblk * NT) { float s = 0.f;
#pragma unroll
        for (int i = 0; i < 16; ++i) s += HSQ[(size_t)r * 16 + i];
        R[r] = 1.0f / sqrtf(s * (1.0f / 1024.0f) + NORM_EPS); }
}
#define BUBBLE16(v, ix, x, c) do { if ((x) > v[15]) { v[15] = (x); ix[15] = (c); _Pragma("unroll") for (int _p = 15; _p > 0; --_p) { \
        const bool _sw = v[_p] > v[_p - 1]; const float _a = v[_p], _b = v[_p - 1]; const int _ia = ix[_p], _ib = ix[_p - 1]; \
        v[_p] = _sw ? _b : _a; v[_p - 1] = _sw ? _a : _b; ix[_p] = _sw ? _ib : _ia; ix[_p - 1] = _sw ? _ia : _ib; } } } while (0)
__device__ __forceinline__ void peer_topk_phase(const Params& P, LAS unsigned char* lds, int h, int bid, int nblk) {
    const float* SC = (const float*)(P.ws + WS_SC); int* EIDX = (int*)(P.ws + WS_EIDX); float* EG = (float*)(P.ws + WS_EGATE);
    LAS float* sv = (LAS float*)lds; LAS int* sx = (LAS int*)(lds + 256 * 2 * 16 * 4);
    const int tid = threadIdx.x, rl = tid >> 1, half = tid & 1;
    for (int r0 = bid * 256; r0 < S_; r0 += nblk * 256) {
        const int row = r0 + rl;
        float v[16]; int ix[16];
#pragma unroll
        for (int p = 0; p < 16; ++p) { v[p] = -INFINITY; ix[p] = 0; }
        const f32x4* sp = (const f32x4*)(SC + (size_t)row * 256 + half * 128);
        for (int c4 = 0; c4 < 32; ++c4) { const f32x4 x = sp[c4];
#pragma unroll
            for (int j = 0; j < 4; ++j) { const float xv = x[j]; const int cc = 4 * c4 + j; BUBBLE16(v, ix, xv, cc); } }
#pragma unroll
        for (int p = 0; p < 16; ++p) { sv[(rl * 2 + half) * 16 + p] = v[p]; sx[(rl * 2 + half) * 16 + p] = ix[p]; }
        __syncthreads();
        if (half == 0) {
            float cv[16]; int ci[16];
#pragma unroll
            for (int p = 0; p < 16; ++p) { cv[p] = -INFINITY; ci[p] = 0; }
            for (int i = 0; i < 16; ++i) { const float a = sv[(rl * 2) * 16 + i];
                for (int j = 0; j < 16; ++j) { const float s = a + sv[(rl * 2 + 1) * 16 + j]; const int f = i * 16 + j; BUBBLE16(cv, ci, s, f); } }
            float l = 0.f, pe[16];
#pragma unroll
            for (int p = 0; p < 16; ++p) { pe[p] = __expf(cv[p] - cv[0]); l += pe[p]; }
            const float il = 1.0f / l;
#pragma unroll
            for (int p = 0; p < 16; ++p) { const int e1 = sx[(rl * 2) * 16 + (ci[p] >> 4)], e2 = sx[(rl * 2 + 1) * 16 + (ci[p] & 15)];
                EIDX[(size_t)row * 128 + h * 16 + p] = e1 * 128 + e2; EG[(size_t)row * 128 + h * 16 + p] = pe[p] * il; }
        }
        __syncthreads();
    }
}
__device__ __forceinline__ void peer_expert_phase_v1(const Params& P, int bid, int nblk) {
    const int* EIDX = (const int*)(P.ws + WS_EIDX); const float* EG = (const float*)(P.ws + WS_EGATE); const float* RH = (const float*)(P.ws + WS_RSTDH);
    const float* U = P.in[29]; const float* Vt = P.in[30]; const float* gain = P.in[25];
    const int lane = threadIdx.x & 63, wave = threadIdx.x >> 6;
    for (int row = bid * NW + wave; row < S_; row += nblk * NW) {
        float* hp = P.out + (size_t)row * 1024; const float rs = RH[row];
        f32x4 hv[4], xn[4], o[4];
#pragma unroll
        for (int j = 0; j < 4; ++j) { hv[j] = *(const f32x4*)(hp + 4 * lane + 256 * j); xn[j] = hv[j] * rs * *(const f32x4*)(gain + 4 * lane + 256 * j); o[j] = (f32x4){0.f, 0.f, 0.f, 0.f}; }
        const int e_lo = EIDX[(size_t)row * 128 + lane], e_hi = EIDX[(size_t)row * 128 + 64 + lane];
        const float g_lo = EG[(size_t)row * 128 + lane], g_hi = EG[(size_t)row * 128 + 64 + lane];
        for (int e = 0; e < 128; ++e) {
            const int idx = __shfl((e < 64) ? e_lo : e_hi, e & 63); const float gt = __shfl((e < 64) ? g_lo : g_hi, e & 63);
            const float* up = U + (size_t)idx * 1024; float d = 0.f;
#pragma unroll
            for (int j = 0; j < 4; ++j) { const f32x4 uv = *(const f32x4*)(up + 4 * lane + 256 * j); d += (xn[j][0] * uv[0] + xn[j][1] * uv[1]) + (xn[j][2] * uv[2] + xn[j][3] * uv[3]); }
            d = wave_sum(d);
            const float w = gt * 0.5f * d * (1.0f + erff(d * 0.70710678118654752f));
            const float* vp = Vt + (size_t)idx * 1024;
#pragma unroll
            for (int j = 0; j < 4; ++j) o[j] = o[j] + *(const f32x4*)(vp + 4 * lane + 256 * j) * w;
        }
#pragma unroll
        for (int j = 0; j < 4; ++j) *(f32x4*)(hp + 4 * lane + 256 * j) = hv[j] + o[j];
    }
}
extern __shared__ __attribute__((aligned(16))) unsigned char dyn_lds[];
#define LDSP ((LAS unsigned char*)dyn_lds)

struct GemmArgs { const bf16* A; const bf16* Bt; long a_pn_step, b_pn_step; int M, N, K, lda, ldb, pad; };
__device__ __forceinline__ pg8::Gemm mk_gemm(const GemmArgs& a) { pg8::Gemm g; g.A = a.A; g.Bt = a.Bt; g.M = a.M; g.N = a.N; g.K = a.K; g.lda = a.lda; g.ldb = a.ldb; g.a_pn_step = a.a_pn_step; g.b_pn_step = a.b_pn_step; return g; }

__global__ void __launch_bounds__(NT, 2) k_prologue(Params P) { prologue_phase(P, LDSP, blockIdx.x, gridDim.x); }
__global__ void __launch_bounds__(NT, 2) k_gemm_memkv(Params P) {
    pg8::Gemm g{(const bf16*)(P.ws + WS_MB), (const bf16*)(P.ws + WS_WMEM), 256, 1024, 1024, 1024, 1024, 0, 256 * 1024};
    pg8::StaticOrder S; S.init(g.M, g.N, gridDim.x, blockIdx.x);
    EpiF32 E{(float*)(P.ws + WS_KMVM), 1024, (const float*)(P.ws + WS_RSTDM)};
    pg8::gemm_phase(LDSP, g, S, E);
}
__global__ void __launch_bounds__(NT, 2) k_gemm_p1(Params P) {
    pg8::Gemm g{(const bf16*)(P.ws + WS_XB), (const bf16*)(P.ws + WS_WIN), S_, P1_N, 1024, 1024, 1024, 0, 256 * 1024};
    pg8::StaticOrder S; S.init(g.M, g.N, gridDim.x, blockIdx.x);
    EpiP1 E{(const float*)(P.ws + WS_RSTDX), (const float*)(P.ws + WS_COS), (const float*)(P.ws + WS_SIN), P.in[6], P.in[7],
            (bf16*)(P.ws + WS_Q), (bf16*)(P.ws + WS_K), (bf16*)(P.ws + WS_V), (bf16*)(P.ws + WS_RWP), (bf16*)(P.ws + WS_MEMQ), (half_t*)(P.ws + WS_IQ), (half_t*)(P.ws + WS_IK), (float*)(P.ws + WS_IW)};
    pg8::gemm_phase(LDSP, g, S, E);
}
__global__ void __launch_bounds__(NT, 2) k_lora_in(Params P) { lora_in_phase(P, blockIdx.x, gridDim.x); }
__global__ void __launch_bounds__(NT, 2) k_gemm_lora(Params P) {
    unsigned char* dob = (unsigned char*)P.out;
    pg8::Gemm g{(const bf16*)(dob + DO_LIN), (const bf16*)(P.ws + WS_WLORA), S_, 1536, 256, 256, 256, 0, 256 * 256};
    pg8::StaticOrder S; S.init(g.M, g.N, gridDim.x, blockIdx.x);
    EpiLora E{(bf16*)(dob + DO_E), (bf16*)(dob + DO_A), (bf16*)(dob + DO_G), P.in[13], P.in[15]};
    pg8::gemm_phase(LDSP, g, S, E);
}
__global__ void __launch_bounds__(NT, 2) k_rwkv_scan(Params P) { rwkv_scan_v1(P, LDSP, blockIdx.x); }
__global__ void __launch_bounds__(NT, 2) k_dsa(Params P) { dsa_query_v1(P, LDSP, blockIdx.x); }
__global__ void __launch_bounds__(NT, 2) k_memattn(Params P) { mem_attn_phase(P, LDSP, blockIdx.x, gridDim.x); }
__global__ void __launch_bounds__(NT, 2) k_gemm_gates(Params P) {
    pg8::Gemm g{(const bf16*)(P.ws + WS_XB), (const bf16*)(P.ws + WS_WG), S_, 3072, 1024, 1024, 1024, 0, 256 * 1024};
    pg8::StaticOrder S; S.init(g.M, g.N, gridDim.x, blockIdx.x);
    EpiGate E{(bf16*)(P.ws + WS_GATES), (const float*)(P.ws + WS_RSTDX), P.in[5]};
    pg8::gemm_phase(LDSP, g, S, E);
}
__global__ void __launch_bounds__(NT, 2) k_gemm_merge(Params P, int c) {
    pg8::Gemm g{(const bf16*)(P.ws + WS_Y) + c * 512, (const bf16*)(P.ws + WS_WUP) + (size_t)c * 1024 * 512, S_, 1024, 512, 1536, 512, 0, 256 * 512};
    pg8::StaticOrder S; S.init(g.M, g.N, gridDim.x, blockIdx.x);
    EpiMerge E{(const bf16*)(P.ws + WS_GATES), P.out, (bf16*)(P.ws + WS_MERGED), c};
    pg8::gemm_phase(LDSP, g, S, E);
}
__global__ void __launch_bounds__(NT, 2) k_gemm_out(Params P) {
    pg8::Gemm g{(const bf16*)(P.ws + WS_MERGED), (const bf16*)(P.ws + WS_WOUT), S_, 1024, 1024, 1024, 1024, 0, 256 * 1024};
    pg8::StaticOrder S; S.init(g.M, g.N, gridDim.x, blockIdx.x);
    EpiOut E{P.in[0], P.out, (bf16*)(P.ws + WS_XB), (float*)(P.ws + WS_HSQ)};
    pg8::gemm_phase(LDSP, g, S, E);
}
__global__ void __launch_bounds__(NT, 2) k_rstdh(Params P) { rstdh_phase(P, blockIdx.x, gridDim.x); }
__global__ void __launch_bounds__(NT, 2) k_gemm_pq(Params P) {
    pg8::Gemm g{(const bf16*)(P.ws + WS_XB), (const bf16*)(P.ws + WS_WQ), S_, 2048, 1024, 1024, 1024, 0, 256 * 1024};
    pg8::StaticOrder S; S.init(g.M, g.N, gridDim.x, blockIdx.x);
    EpiBf E{(bf16*)(P.ws + WS_PQ), 2048, (const float*)(P.ws + WS_RSTDH)};
    pg8::gemm_phase(LDSP, g, S, E);
}
__global__ void __launch_bounds__(NT, 2) k_gemm_sc(Params P, int h) {
    pg8::Gemm g{(const bf16*)(P.ws + WS_PQ) + h * 256, (const bf16*)(P.ws + WS_KEYBD), S_, 256, 256, 2048, 256, 0, 0};
    pg8::StaticOrder S; S.init(g.M, g.N, gridDim.x, blockIdx.x);
    EpiF32 E{(float*)(P.ws + WS_SC), 256, nullptr};
    pg8::gemm_phase(LDSP, g, S, E);
}
__global__ void __launch_bounds__(NT, 2) k_topk(Params P, int h) { peer_topk_phase(P, LDSP, h, blockIdx.x, gridDim.x); }
__global__ void __launch_bounds__(NT, 2) k_experts(Params P) { peer_expert_phase_v1(P, blockIdx.x, gridDim.x); }

constexpr int LDS_GEMM = 131072;
extern "C" void kernel_launch(void* const* d_in, const int* in_sizes, int n_in, void* d_out, int out_size, void* d_ws, size_t ws_size, hipStream_t stream) {
    static int inited = 0;
    if (!inited) {
        if (n_in != 31 || out_size != S_ * D_ || ws_size < WS_END) { fprintf(stderr, "kernel_launch: unexpected problem (n_in %d out %d ws %zu)\n", n_in, out_size, ws_size); inited = -1; return; }
        const void* big[] = {(const void*)k_prologue, (const void*)k_gemm_memkv, (const void*)k_gemm_p1, (const void*)k_gemm_lora, (const void*)k_dsa, (const void*)k_memattn, (const void*)k_gemm_gates,
                             (const void*)k_gemm_merge, (const void*)k_gemm_out, (const void*)k_gemm_pq, (const void*)k_gemm_sc, (const void*)k_rwkv_scan, (const void*)k_topk};
        for (const void* f : big) if (hipFuncSetAttribute(f, hipFuncAttributeMaxDynamicSharedMemorySize, 160 * 1024) != hipSuccess) { fprintf(stderr, "kernel_launch: hipFuncSetAttribute failed\n"); inited = -1; return; }
        inited = 1;
    }
    if (inited < 0) return;
    Params P{};
    for (int i = 0; i < 31; ++i) P.in[i] = (const float*)d_in[i];
    P.out = (float*)d_out; P.ws = (unsigned char*)d_ws;
    const int G = 256;
    hipLaunchKernelGGL(k_prologue, dim3(G), dim3(NT), LDS_GEMM, stream, P);
    hipLaunchKernelGGL(k_gemm_memkv, dim3(G), dim3(NT), LDS_GEMM, stream, P);
    hipLaunchKernelGGL(k_gemm_p1, dim3(G), dim3(NT), LDS_GEMM, stream, P);
    hipLaunchKernelGGL(k_lora_in, dim3(G), dim3(NT), 0, stream, P);
    hipLaunchKernelGGL(k_gemm_lora, dim3(G), dim3(NT), LDS_GEMM, stream, P);
    hipLaunchKernelGGL(k_rwkv_scan, dim3(8), dim3(NT), 8 * TC * 64 * 4, stream, P);
    hipLaunchKernelGGL(k_dsa, dim3(S_), dim3(NT), DSA_LDS_END, stream, P);
    hipLaunchKernelGGL(k_memattn, dim3(G), dim3(NT), MA_LDS_END, stream, P);
    hipLaunchKernelGGL(k_gemm_gates, dim3(G), dim3(NT), LDS_GEMM, stream, P);
    for (int c = 0; c < 3; ++c) hipLaunchKernelGGL(k_gemm_merge, dim3(G), dim3(NT), LDS_GEMM, stream, P, c);
    hipLaunchKernelGGL(k_gemm_out, dim3(G), dim3(NT), LDS_GEMM, stream, P);
    hipLaunchKernelGGL(k_rstdh, dim3(G), dim3(NT), 0, stream, P);
    hipLaunchKernelGGL(k_gemm_pq, dim3(G), dim3(NT), LDS_GEMM, stream, P);
    for (int h = 0; h < 8; ++h) {
        hipLaunchKernelGGL(k_gemm_sc, dim3(G), dim3(NT), LDS_GEMM, stream, P, h);
        hipLaunchKernelGGL(k_topk, dim3(G), dim3(NT), 256 * 2 * 16 * 8, stream, P, h);
    }
    hipLaunchKernelGGL(k_experts, dim3(G), dim3(NT), 0, stream, P);
}
```

```cpp
#include <hip/hip_runtime.h>
#include <cstdio>
#include <cstdint>

typedef unsigned short bf16;
typedef unsigned short u16;
typedef float f32x4 __attribute__((ext_vector_type(4)));
typedef float f32x2 __attribute__((ext_vector_type(2)));
typedef unsigned u32x4 __attribute__((ext_vector_type(4)));
typedef unsigned u32x2 __attribute__((ext_vector_type(2)));
typedef _Float16 half_t;
typedef _Float16 half4 __attribute__((ext_vector_type(4)));
typedef _Float16 half8 __attribute__((ext_vector_type(8)));

constexpr int S_ = 16384, D_ = 1024;
constexpr int NMEM = 256;
constexpr int ATT_W = 512, RW_W = 512, MEM_W = 512;
constexpr int RW_IN = 1792;
constexpr int WIN_COLS = 7236;
constexpr int COL_Q = 0, COL_K = 512, COL_V = 1024, COL_IQ = 1536, COL_IK = 1792, COL_IW = 1856, COL_RW = 1860, COL_MEMQ = 3652, COL_GATE = 4164;
constexpr int P1_TILES = 17, P1_N = P1_TILES * 256;
constexpr float NORM_EPS = 1e-6f, GN_EPS = 64e-5f;
constexpr int NEXP = 16384;

constexpr size_t MiB = 1u << 20;
constexpr size_t WS_CTL = 0;
constexpr size_t WS_RSTDX = 1 * MiB;
constexpr size_t WS_COS = WS_RSTDX + 64 * 1024;
constexpr size_t WS_SIN = WS_COS + 512 * 1024;
constexpr size_t WS_IW = WS_SIN + 512 * 1024;
constexpr size_t WS_RSTDM = WS_IW + 256 * 1024;
constexpr size_t WS_RSTDH = WS_RSTDM + 4096;
constexpr size_t WS_HSQ = 3 * MiB;
constexpr size_t WS_WIN = 4 * MiB;
constexpr size_t WS_WG = WS_WIN + (size_t)P1_N * 1024 * 2;
constexpr size_t WS_WUP = WS_WG + 6 * MiB;
constexpr size_t WS_WOUT = WS_WUP + 3 * MiB;
constexpr size_t WS_WQ = WS_WOUT + 2 * MiB;
constexpr size_t WS_WMEM = WS_WQ + 4 * MiB;
constexpr size_t WS_KEYBD = WS_WMEM + 2 * MiB;
constexpr size_t WS_WLORA = WS_KEYBD + 128 * 1024;
static_assert(WS_WLORA + 768 * 1024 <= 30 * MiB + 512 * 1024, "weights region");
constexpr size_t WS_KMVM = 30 * MiB + 512 * 1024;
constexpr size_t WS_MB = 31 * MiB + 512 * 1024;
constexpr size_t WS_XB = 32 * MiB;
constexpr size_t WS_Q = 64 * MiB, WS_K = 80 * MiB, WS_V = 96 * MiB;
constexpr size_t WS_IQ = 112 * MiB;
constexpr size_t WS_IK = 120 * MiB;
constexpr size_t WS_MEMQ = 122 * MiB;
constexpr size_t WS_RWP = 138 * MiB;
constexpr size_t WS_Y = 194 * MiB;
constexpr size_t WS_SEL = 242 * MiB;
constexpr size_t DO_E = 0, DO_A = 16 * MiB, DO_G = 32 * MiB, DO_LIN = 48 * MiB;
constexpr size_t WS_GATES = 64 * MiB;
constexpr size_t WS_MERGED = 160 * MiB;
constexpr size_t WS_PQ = 64 * MiB;
constexpr size_t WS_SC = 128 * MiB;
constexpr size_t WS_EIDX = 192 * MiB;
constexpr size_t WS_EGATE = 200 * MiB;
constexpr size_t WS_END = 256 * MiB;

__device__ __forceinline__ unsigned f2bf(float f) { unsigned u = __builtin_bit_cast(unsigned, f); return (u + 0x7fffu + ((u >> 16) & 1u)) >> 16; }
__device__ __forceinline__ unsigned pk2(float lo, float hi) { return f2bf(lo) | (f2bf(hi) << 16); }
__device__ __forceinline__ unsigned pk2h(float lo, float hi) { typedef _Float16 h2 __attribute__((ext_vector_type(2))); h2 v; v[0] = (_Float16)lo; v[1] = (_Float16)hi; return __builtin_bit_cast(unsigned, v); }
__device__ __forceinline__ float bf2f(unsigned short b) { return __builtin_bit_cast(float, ((unsigned)b) << 16); }
__device__ __forceinline__ float bflo(unsigned w) { return __builtin_bit_cast(float, w << 16); }
__device__ __forceinline__ float bfhi(unsigned w) { return __builtin_bit_cast(float, w & 0xffff0000u); }
__device__ __forceinline__ float wave_sum(float v) {
#pragma unroll
    for (int o = 1; o < 64; o <<= 1) v += __shfl_xor(v, o);
    return v;
}
__device__ __forceinline__ float wave_max(float v) {
#pragma unroll
    for (int o = 1; o < 64; o <<= 1) v = fmaxf(v, __shfl_xor(v, o));
    return v;
}

__device__ __forceinline__ int tid_opaque() { int t = threadIdx.x; asm volatile("" : "+v"(t)); return t; }
namespace pg8 {
#define PG8_LAS __attribute__((address_space(3)))
typedef unsigned short bf16_t;
typedef short bf16x8 __attribute__((ext_vector_type(8)));
typedef float f32x4 __attribute__((ext_vector_type(4)));
typedef unsigned u32x4 __attribute__((ext_vector_type(4)));
typedef unsigned u32x2 __attribute__((ext_vector_type(2)));
constexpr int BM = 256, BK = 64, HALF = 128, HTB = HALF * BK * 2, STAGE_BYTES = 8 * HTB, NXCD = 8, WGM = 8;

__host__ __device__ __forceinline__ int lds_byte(int r, int c) { const int st = (r >> 4) * 2 + (c >> 5), rr = r & 15, cc = c & 31, ob = rr * 64 + cc * 2; return st * 1024 + (ob ^ (((ob >> 9) & 1) << 5)); }
__host__ __device__ __forceinline__ void stage_rc(int b, int& R, int& C) { const int st = b / 1024, sb = b % 1024, swz = sb ^ (((sb >> 9) & 1) << 5); R = (st >> 1) * 16 + swz / 64; C = (st & 1) * 32 + (swz % 64) / 2; }

struct Unit { int pm, pn; };
struct Gemm { const bf16_t* A; const bf16_t* Bt; int M, N, K; int lda, ldb; long a_pn_step, b_pn_step; };

struct StaticOrder {
    int nM, nN, nwg, G, c;
    __host__ __device__ void init(int M, int N, int G_, int c_) { nM = M / BM; nN = N / BM; nwg = nM * nN; G = G_; c = c_; }
    __host__ __device__ bool next(int i, Unit& u) const {
        const long L = (long)i * G + c; if (L >= nwg) return false;
        int wgid = (int)L; { const int q = nwg / NXCD, r = nwg % NXCD, xcd = wgid % NXCD, off = wgid / NXCD; wgid = (xcd < r ? xcd * (q + 1) : r * (q + 1) + (xcd - r) * q) + off; }
        const int nig = WGM * nN, gid = wgid / nig, fm = gid * WGM, gsz = (nM - fm) < WGM ? (nM - fm) : WGM;
        u.pm = fm + ((wgid % nig) % gsz); u.pn = (wgid % nig) / gsz; return true;
    }
};

__device__ __forceinline__ unsigned cvt_pk_bf16(float lo, float hi) { unsigned r; asm volatile("v_cvt_pk_bf16_f32 %0, %1, %2" : "=v"(r) : "v"(lo), "v"(hi)); return r; }

typedef _Float16 f16x8 __attribute__((ext_vector_type(8)));
template <bool F16> __device__ __forceinline__ f32x4 mma16(bf16x8 a, bf16x8 b, f32x4 c) {
    if constexpr (F16) return __builtin_amdgcn_mfma_f32_16x16x32_f16(__builtin_bit_cast(f16x8, a), __builtin_bit_cast(f16x8, b), c, 0, 0, 0);
    else return __builtin_amdgcn_mfma_f32_16x16x32_bf16(a, b, c, 0, 0, 0);
}
struct PanelOrder {
    int pm0, pn0, nsteps, valid;
    __host__ __device__ void init(int M, int G_, int c_, int nsteps_) { StaticOrder S; S.init(M, 1024, G_, c_); Unit u; valid = S.next(0, u) ? 1 : 0; pm0 = u.pm; pn0 = u.pn; nsteps = nsteps_; }
    __host__ __device__ bool next(int i, Unit& u) const { if (!valid || i >= nsteps) return false; u.pm = pm0; u.pn = pn0 + 4 * i; return true; }
};
struct OneUnit { Unit u0; __host__ __device__ bool next(int i, Unit& u) const { if (i != 0) return false; u = u0; return true; } };
template <bool F16, class Sched, class Epi>
__device__ __forceinline__ void gemm_phase(PG8_LAS unsigned char* lds, const Gemm g, const Sched& S, const Epi& E) {
    int tid = threadIdx.x; asm volatile("" : "+v"(tid));
    const int wid = __builtin_amdgcn_readfirstlane(tid >> 6), lane = tid & 63, wr = wid >> 2, wc = wid & 3, fr = lane & 15, fq = lane >> 4;
    const int K = g.K, nt = K / BK;
    unsigned voffA[2], voffB[2];
#pragma unroll
    for (int i = 0; i < 2; ++i) { int R, C; stage_rc(tid * 16 + i * 8192, R, C);
        voffA[i] = (unsigned)(R * g.lda + C) * 2u; voffB[i] = (unsigned)(R * g.ldb + C) * 2u; }
    const size_t kstep = (size_t)(BK * 2);
    const size_t hstepA = (size_t)HALF * g.lda * 2, hstepB = (size_t)HALF * g.ldb * 2;
    const size_t tstepA = 2 * hstepA;
    const unsigned ldsw = (unsigned)wid * 1024u;
    const int aoff = lds_byte(wr * 64 + fr, fq * 8), boff = lds_byte(wc * 32 + fr, fq * 8);
#define PG8_SA(b, h) (((b) * 2 + (h)) * HTB)
#define PG8_SB(b, h) ((4 + (b) * 2 + (h)) * HTB)
#define PG8_STAGE(bufoff, gbase, voff) do { _Pragma("unroll") for (int _i = 0; _i < 2; ++_i) \
        __builtin_amdgcn_global_load_lds((const unsigned*)((const char*)(gbase) + (voff)[_i]), (PG8_LAS unsigned*)(lds + (bufoff) + ldsw + _i * 8192), 16, 0, 0); } while (0)
#define PG8_LDA(dst, b, h) do { _Pragma("unroll") for (int m = 0; m < 4; ++m) _Pragma("unroll") for (int k = 0; k < 2; ++k) dst[m][k] = *(const PG8_LAS bf16x8*)(lds + PG8_SA(b, h) + aoff + m * 2048 + k * 1024); } while (0)
#define PG8_LDB(dst, b, h) do { _Pragma("unroll") for (int n = 0; n < 2; ++n) _Pragma("unroll") for (int k = 0; k < 2; ++k) dst[n][k] = *(const PG8_LAS bf16x8*)(lds + PG8_SB(b, h) + boff + n * 2048 + k * 1024); } while (0)
#define PG8_MMA(ai, bj, At, Bt) do { __builtin_amdgcn_s_setprio(1); _Pragma("unroll") for (int m = 0; m < 4; ++m) _Pragma("unroll") for (int n = 0; n < 2; ++n) _Pragma("unroll") for (int k = 0; k < 2; ++k) \
        acc[ai][bj][m][n] = mma16<F16>(Bt[n][k], At[m][k], acc[ai][bj][m][n]); __builtin_amdgcn_s_setprio(0); } while (0)
#define PG8_WAIT_V(n) asm volatile("s_waitcnt vmcnt(" #n ")" ::: "memory")
#define PG8_WAIT_L(n) asm volatile("s_waitcnt lgkmcnt(" #n ")" ::: "memory")
#define PG8_BAR __builtin_amdgcn_s_barrier()
#define PG8_SCHED __builtin_amdgcn_sched_barrier(0)
    Unit cur, nxt; int ui = 0;
    if (!S.next(0, cur)) return;
    f32x4 acc[2][2][4][2];
#pragma unroll
    for (int a = 0; a < 2; ++a)
#pragma unroll
        for (int b = 0; b < 2; ++b)
#pragma unroll
            for (int m = 0; m < 4; ++m)
#pragma unroll
                for (int n = 0; n < 2; ++n) acc[a][b][m][n] = (f32x4){0.f, 0.f, 0.f, 0.f};
    bf16x8 At[4][2], B0[2][2], B1[2][2];
    const char* cA = (const char*)g.A + (size_t)cur.pm * tstepA + (size_t)cur.pn * g.a_pn_step * 2; const char* cB = (const char*)g.Bt + (size_t)cur.pn * g.b_pn_step * 2;
    PG8_STAGE(PG8_SB(0, 0), cB, voffB); PG8_STAGE(PG8_SA(0, 0), cA, voffA); PG8_STAGE(PG8_SB(0, 1), cB + hstepB, voffB); PG8_STAGE(PG8_SA(0, 1), cA + hstepA, voffA);
    if (wr == 1) PG8_BAR;
    PG8_WAIT_V(4); PG8_BAR;
    PG8_STAGE(PG8_SB(1, 0), cB + kstep, voffB); PG8_STAGE(PG8_SA(1, 0), cA + kstep, voffA); PG8_STAGE(PG8_SB(1, 1), cB + hstepB + kstep, voffB);
    PG8_WAIT_V(6); PG8_BAR;
    for (;;) {
        const bool has_next = S.next(ui + 1, nxt);
        const char* nA = has_next ? (const char*)g.A + (size_t)nxt.pm * tstepA + (size_t)nxt.pn * g.a_pn_step * 2 : cA; const char* nB = has_next ? (const char*)g.Bt + (size_t)nxt.pn * g.b_pn_step * 2 : cB;
        for (int t = 0; t < nt; t += 2) {
            const bool last = (t == nt - 2);
            const char* a1 = cA + (size_t)(t + 1) * kstep;
            const char* a2 = last ? nA : cA + (size_t)(t + 2) * kstep; const char* b2 = last ? nB : cB + (size_t)(t + 2) * kstep;
            const char* a3 = a2 + kstep; const char* b3 = b2 + kstep;
            PG8_LDB(B0, 0, 0); PG8_SCHED; PG8_LDA(At, 0, 0); PG8_STAGE(PG8_SA(1, 1), a1 + hstepA, voffA);
            PG8_WAIT_L(8); PG8_BAR; PG8_WAIT_L(0); PG8_MMA(0, 0, At, B0); PG8_BAR; PG8_SCHED;
            PG8_LDB(B1, 0, 1); PG8_STAGE(PG8_SB(0, 0), b2, voffB);
            PG8_BAR; PG8_WAIT_L(0); PG8_MMA(0, 1, At, B1); PG8_BAR;
            PG8_LDA(At, 0, 1); PG8_STAGE(PG8_SA(0, 0), a2, voffA);
            PG8_BAR; PG8_WAIT_L(0); PG8_MMA(1, 0, At, B0); PG8_BAR; PG8_SCHED;
            PG8_STAGE(PG8_SB(0, 1), b2 + hstepB, voffB);
            PG8_WAIT_V(6); PG8_BAR; PG8_MMA(1, 1, At, B1); PG8_BAR;
            PG8_LDB(B0, 1, 0); PG8_SCHED; PG8_LDA(At, 1, 0); PG8_STAGE(PG8_SA(0, 1), a2 + hstepA, voffA);
            PG8_WAIT_L(8); PG8_BAR; PG8_WAIT_L(0); PG8_MMA(0, 0, At, B0); PG8_BAR; PG8_SCHED;
            PG8_LDB(B1, 1, 1); PG8_STAGE(PG8_SB(1, 0), b3, voffB);
            PG8_BAR; PG8_WAIT_L(0); PG8_MMA(0, 1, At, B1); PG8_BAR;
            PG8_LDA(At, 1, 1); PG8_STAGE(PG8_SA(1, 0), a3, voffA);
            PG8_BAR; PG8_WAIT_L(0); PG8_MMA(1, 0, At, B0); PG8_BAR; PG8_SCHED;
            PG8_STAGE(PG8_SB(1, 1), b3 + hstepB, voffB);
            PG8_WAIT_V(6); PG8_BAR; PG8_MMA(1, 1, At, B1); PG8_BAR;
        }
        { int fr_ = fr, fq_ = fq; asm volatile("" : "+v"(fr_), "+v"(fq_)); E(acc, cur, wr, wc, fr_, fq_); }
        if (!has_next) break;
#pragma unroll
        for (int a = 0; a < 2; ++a)
#pragma unroll
            for (int b = 0; b < 2; ++b)
#pragma unroll
                for (int m = 0; m < 4; ++m)
#pragma unroll
                    for (int n = 0; n < 2; ++n) acc[a][b][m][n] = (f32x4){0.f, 0.f, 0.f, 0.f};
        cur = nxt; cA = nA; cB = nB; ++ui;
    }
    PG8_WAIT_V(0);
    if (wr == 0) PG8_BAR;
    PG8_BAR;
#undef PG8_SA
#undef PG8_SB
#undef PG8_STAGE
#undef PG8_LDA
#undef PG8_LDB
#undef PG8_MMA
#undef PG8_WAIT_V
#undef PG8_WAIT_L
#undef PG8_BAR
#undef PG8_SCHED
}
}
#define LAS __attribute__((address_space(3)))
#define LDS_WAIT() asm volatile("s_waitcnt lgkmcnt(0)" ::: "memory")
constexpr int NT = 512, NW = 8;

struct Params {
    const float* in[31];
    float* out;
    unsigned char* ws;
};

__device__ __forceinline__ void tr_item(const float* W, int ldw, bf16* WT, int K, int k0, int nphys0, int lbase, int cnt, const float* kg, LAS float* scr, int lane, bool f16 = false) {
    const int c = lane & 31;
#pragma unroll 8
    for (int i = 0; i < 32; ++i) { const int kk = 2 * i + (lane >> 5); float v = 0.f;
        if (c < cnt) { v = W[(size_t)(k0 + kk) * ldw + lbase + c]; if (kg) v *= kg[k0 + kk]; }
        scr[kk * 33 + c] = v; }
    LDS_WAIT();
    const int c8 = lane & 7;
#pragma unroll
    for (int j = 0; j < 4; ++j) { const int n = (lane >> 3) + 8 * j; const LAS float* s = scr + (8 * c8) * 33 + n;
        u32x4 o;
        if (f16) { o.x = pk2h(s[0 * 33], s[1 * 33]); o.y = pk2h(s[2 * 33], s[3 * 33]); o.z = pk2h(s[4 * 33], s[5 * 33]); o.w = pk2h(s[6 * 33], s[7 * 33]); }
        else { o.x = pk2(s[0 * 33], s[1 * 33]); o.y = pk2(s[2 * 33], s[3 * 33]); o.z = pk2(s[4 * 33], s[5 * 33]); o.w = pk2(s[6 * 33], s[7 * 33]); }
        *(u32x4*)(WT + (size_t)(nphys0 + n) * K + k0 + 8 * c8) = o; }
    LDS_WAIT();
}
__device__ __forceinline__ void p1_group(int g, int& lbase, int& cnt) {
    const int tile = g >> 3, gi = g & 7, bj = gi >> 2, wc = gi & 3; cnt = 32;
    if (tile < 2) lbase = COL_Q + (4 * tile + wc) * 64 + 32 * bj;
    else if (tile < 4) lbase = COL_K + (4 * (tile - 2) + wc) * 64 + 32 * bj;
    else if (tile < 6) lbase = COL_V + (tile - 4) * 256 + 32 * gi;
    else if (tile == 6) lbase = COL_IQ + wc * 64 + 32 * bj;
    else if (tile == 7) { if (wc == 0) lbase = COL_IK + 32 * bj; else if (gi == 1) { lbase = COL_IW; cnt = 4; } else { lbase = 0; cnt = 0; } }
    else if (tile < 15) lbase = COL_RW + (tile - 8) * 256 + 32 * gi;
    else lbase = COL_MEMQ + (tile - 15) * 256 + 32 * gi;
}

__device__ __forceinline__ void prologue_phase(const Params& P, LAS unsigned char* lds, int bid, int nblk) {
    const int tid = tid_opaque(), lane = tid & 63, wave = tid >> 6;
    const int gw = bid * NW + wave, NGW = nblk * NW;
    unsigned char* ws = P.ws;
    LAS float* scr = (LAS float*)(lds + wave * 16384);
    constexpr int I_P1 = 16 * (P1_N / 32), I_WG = 16 * 96, I_UP = 8 * 32, I_OUT = 16 * 32, I_WQ = 16 * 64, I_MEM = 16 * 32;
    constexpr int NITEMS = I_P1 + I_WG + 3 * I_UP + I_OUT + I_WQ + I_MEM;
    for (int it = gw; it < NITEMS; it += NGW) {
        int r = it;
        if (r < I_P1) { const int ng = P1_N / 32, kb = r / ng, g = r % ng; int lb, cnt; p1_group(g, lb, cnt);
            tr_item(P.in[4], WIN_COLS, (bf16*)(ws + WS_WIN), 1024, 64 * kb, 32 * g, lb, cnt, P.in[3], scr, lane); continue; } r -= I_P1;
        if (r < I_WG) { const int kb = r / 96, g = r % 96;
            tr_item(P.in[4], WIN_COLS, (bf16*)(ws + WS_WG), 1024, 64 * kb, 32 * g, COL_GATE + 32 * g, 32, P.in[3], scr, lane); continue; } r -= I_WG;
        if (r < 3 * I_UP) { const int c = r / I_UP, rr = r % I_UP, kb = rr / 32, g = rr % 32;
            tr_item(P.in[23] + (size_t)c * 512 * 1024, 1024, (bf16*)(ws + WS_WUP) + (size_t)c * 1024 * 512, 512, 64 * kb, 32 * g, 32 * g, 32, nullptr, scr, lane); continue; } r -= 3 * I_UP;
        if (r < I_OUT) { const int kb = r / 32, g = r % 32;
            tr_item(P.in[24], 1024, (bf16*)(ws + WS_WOUT), 1024, 64 * kb, 32 * g, 32 * g, 32, nullptr, scr, lane); continue; } r -= I_OUT;
        if (r < I_WQ) { const int kb = r / 64, g = r % 64;
            tr_item(P.in[26], 2048, (bf16*)(ws + WS_WQ), 1024, 64 * kb, 32 * g, 32 * g, 32, P.in[25], scr, lane, true); continue; } r -= I_WQ;
        { const int kb = r / 32, g = r % 32;
            tr_item(P.in[9], 1024, (bf16*)(ws + WS_WMEM), 1024, 64 * kb, 32 * g, 32 * g, 32, P.in[8], scr, lane); }
    }
    for (int m = gw; m < S_ + NMEM; m += NGW) {
        const bool isx = m < S_; const int r = isx ? m : m - S_;
        const f32x4* xr = (const f32x4*)((isx ? P.in[0] : P.in[1]) + (size_t)r * D_) + lane;
        f32x4 v[4]; float s = 0.f;
#pragma unroll
        for (int j = 0; j < 4; ++j) { v[j] = xr[64 * j]; s += (v[j].x * v[j].x + v[j].y * v[j].y) + (v[j].z * v[j].z + v[j].w * v[j].w); }
        s = wave_sum(s);
        const float rstd = 1.0f / sqrtf(s * (1.0f / D_) + NORM_EPS);
        if (lane == 0) ((float*)(ws + (isx ? WS_RSTDX : WS_RSTDM)))[r] = rstd;
        unsigned long long* o8 = (unsigned long long*)((bf16*)(ws + (isx ? WS_XB : WS_MB)) + (size_t)r * D_) + lane;
#pragma unroll
        for (int j = 0; j < 4; ++j) o8[64 * j] = (unsigned long long)pk2(v[j].x, v[j].y) | ((unsigned long long)pk2(v[j].z, v[j].w) << 32);
    }
    const int gt = bid * NT + tid, NGT = nblk * NT;
    for (int i = gt; i < S_ * 8; i += NGT) { const int t = i >> 3, f = i & 7;
        const double inv = pow(500000.0, -(double)f / 8.0); const double ang = (double)((const int*)P.in[2])[t] * inv;
        ((float*)(ws + WS_COS))[i] = (float)cos(ang); ((float*)(ws + WS_SIN))[i] = (float)sin(ang); }
    for (int i = gt; i < 256 * 256; i += NGT) { const int n = i >> 8, k = i & 255; float v = 0.f;
        if (n < 128) { if (k < 128) v = P.in[27][n * 128 + k]; } else { if (k >= 128) v = P.in[28][(n - 128) * 128 + (k - 128)]; }
        ((half_t*)(ws + WS_KEYBD))[i] = (half_t)v; }
    for (int i = gt; i < 1536 * 256; i += NGT) { const int n = i >> 8, k = i & 255; float v = 0.f;
        if (n < 512) { if (k < 64) v = P.in[14][k * 512 + n]; }
        else if (n < 1024) { if (k >= 64 && k < 128) v = P.in[16][(k - 64) * 512 + (n - 512)]; }
        else { if (k >= 128) v = P.in[17][(k - 128) * 512 + (n - 1024)]; }
        ((bf16*)(ws + WS_WLORA))[i] = (bf16)f2bf(v); }
}

typedef const f32x4 (&AccRef)[2][2][4][2];
__device__ __forceinline__ void st_bf4(bf16* p, f32x4 v) { u32x2 w; w.x = pk2(v[0], v[1]); w.y = pk2(v[2], v[3]); *(u32x2*)p = w; }
__device__ __forceinline__ void st_h4(half_t* p, f32x4 v) { half4 h; h[0] = (half_t)v[0]; h[1] = (half_t)v[1]; h[2] = (half_t)v[2]; h[3] = (half_t)v[3]; *(half4*)p = h; }

__device__ __forceinline__ f32x4 rope4(f32x4 v, int fq, const float* cs, const float* sn) {
    f32x4 o;
#pragma unroll
    for (int j = 0; j < 4; ++j) { const float p = __shfl_xor(v[j], 32); const int i = 4 * (fq & 1) + j; const float c = cs[i], s = sn[i];
        o[j] = (fq < 2) ? (v[j] * c - p * s) : (v[j] * c + p * s); }
    return o;
}

struct EpiP1 {
    const float* rstd; const float* cs; const float* sn; const float* qgain; const float* kgain;
    bf16 *Q, *K, *V, *RWP, *MEMQ; half_t *IQ, *IK; float* IW;
    __device__ __forceinline__ void operator()(AccRef acc, const pg8::Unit& u, int wr, int wc, int fr, int fq) const {
        const int pn = u.pn;
#pragma unroll
        for (int ai = 0; ai < 2; ++ai)
#pragma unroll
            for (int m = 0; m < 4; ++m) {
                const int row = u.pm * 256 + ai * 128 + wr * 64 + m * 16 + fr; const float rs = rstd[row];
                f32x4 v[2][2];
#pragma unroll
                for (int bj = 0; bj < 2; ++bj)
#pragma unroll
                    for (int n = 0; n < 2; ++n) v[bj][n] = acc[ai][bj][m][n] * rs;
                if (pn < 4) {
                    float ss = 0.f;
#pragma unroll
                    for (int bj = 0; bj < 2; ++bj)
#pragma unroll
                        for (int n = 0; n < 2; ++n) ss += (v[bj][n][0] * v[bj][n][0] + v[bj][n][1] * v[bj][n][1]) + (v[bj][n][2] * v[bj][n][2] + v[bj][n][3] * v[bj][n][3]);
                    ss += __shfl_xor(ss, 16); ss += __shfl_xor(ss, 32);
                    const float rh = 1.0f / sqrtf(ss * (1.0f / 64.0f) + NORM_EPS);
                    const float* gn = (pn < 2) ? qgain : kgain;
#pragma unroll
                    for (int bj = 0; bj < 2; ++bj)
#pragma unroll
                        for (int n = 0; n < 2; ++n) { const f32x4 gv = *(const f32x4*)(gn + 32 * bj + 16 * n + 4 * fq); v[bj][n] = v[bj][n] * rh * gv; }
                    v[0][0] = rope4(v[0][0], fq, cs + row * 8, sn + row * 8);
                    bf16* dst = ((pn < 2) ? Q : K) + (size_t)row * 512 + ((pn & 1) * 4 + wc) * 64 + 4 * fq;
#pragma unroll
                    for (int bj = 0; bj < 2; ++bj)
#pragma unroll
                        for (int n = 0; n < 2; ++n) st_bf4(dst + 32 * bj + 16 * n, v[bj][n]);
                } else if (pn < 6) {
                    bf16* dst = V + (size_t)row * 512 + (pn - 4) * 256 + 32 * wc + 4 * fq;
#pragma unroll
                    for (int bj = 0; bj < 2; ++bj)
#pragma unroll
                        for (int n = 0; n < 2; ++n) st_bf4(dst + 128 * bj + 16 * n, v[bj][n]);
                } else if (pn == 6) {
                    v[0][0] = rope4(v[0][0], fq, cs + row * 8, sn + row * 8);
                    half_t* dst = IQ + (size_t)row * 256 + wc * 64 + 4 * fq;
#pragma unroll
                    for (int bj = 0; bj < 2; ++bj)
#pragma unroll
                        for (int n = 0; n < 2; ++n) st_h4(dst + 32 * bj + 16 * n, v[bj][n]);
                } else if (pn == 7) {
                    if (wc == 0) {
                        v[0][0] = rope4(v[0][0], fq, cs + row * 8, sn + row * 8);
                        half_t* dst = IK + (size_t)row * 64 + 4 * fq;
#pragma unroll
                        for (int bj = 0; bj < 2; ++bj)
#pragma unroll
                            for (int n = 0; n < 2; ++n) st_h4(dst + 32 * bj + 16 * n, v[bj][n]);
                    } else if (wc == 1) { if (fq == 0) *(f32x4*)(IW + (size_t)row * 4) = v[0][0]; }
                } else if (pn < 15) {
                    bf16* dst = RWP + (size_t)row * RW_IN + (pn - 8) * 256 + 32 * wc + 4 * fq;
#pragma unroll
                    for (int bj = 0; bj < 2; ++bj)
#pragma unroll
                        for (int n = 0; n < 2; ++n) st_bf4(dst + 128 * bj + 16 * n, v[bj][n]);
                } else {
                    bf16* dst = MEMQ + (size_t)row * 512 + (pn - 15) * 256 + 32 * wc + 4 * fq;
#pragma unroll
                    for (int bj = 0; bj < 2; ++bj)
#pragma unroll
                        for (int n = 0; n < 2; ++n) st_bf4(dst + 128 * bj + 16 * n, v[bj][n]);
                }
            }
    }
};

struct EpiF32 {
    float* C; int ldc; const float* rstd;
    __device__ __forceinline__ void operator()(AccRef acc, const pg8::Unit& u, int wr, int wc, int fr, int fq) const {
#pragma unroll
        for (int ai = 0; ai < 2; ++ai)
#pragma unroll
            for (int m = 0; m < 4; ++m) { const int row = u.pm * 256 + ai * 128 + wr * 64 + m * 16 + fr; const float rs = rstd ? rstd[row] : 1.0f;
                float* dst = C + (size_t)row * ldc + u.pn * 256 + 32 * wc + 4 * fq;
#pragma unroll
                for (int bj = 0; bj < 2; ++bj)
#pragma unroll
                    for (int n = 0; n < 2; ++n) *(f32x4*)(dst + 128 * bj + 16 * n) = acc[ai][bj][m][n] * rs; }
    }
};
struct EpiBf {
    bf16* C; int ldc; const float* rstd;
    __device__ __forceinline__ void operator()(AccRef acc, const pg8::Unit& u, int wr, int wc, int fr, int fq) const {
#pragma unroll
        for (int ai = 0; ai < 2; ++ai)
#pragma unroll
            for (int m = 0; m < 4; ++m) { const int row = u.pm * 256 + ai * 128 + wr * 64 + m * 16 + fr; const float rs = rstd ? rstd[row] : 1.0f;
                bf16* dst = C + (size_t)row * ldc + u.pn * 256 + 32 * wc + 4 * fq;
#pragma unroll
                for (int bj = 0; bj < 2; ++bj)
#pragma unroll
                    for (int n = 0; n < 2; ++n) st_bf4(dst + 128 * bj + 16 * n, acc[ai][bj][m][n] * rs); }
    }
};
__device__ __forceinline__ float sigmoidf_(float x) { return 1.0f / (1.0f + __expf(-x)); }
struct EpiLora {
    bf16 *E, *A, *G; const float* w0; const float* a0;
    __device__ __forceinline__ void operator()(AccRef acc, const pg8::Unit& u, int wr, int wc, int fr, int fq) const {
        const int kind = u.pn >> 1;
#pragma unroll
        for (int ai = 0; ai < 2; ++ai)
#pragma unroll
            for (int m = 0; m < 4; ++m) { const int row = u.pm * 256 + ai * 128 + wr * 64 + m * 16 + fr;
#pragma unroll
                for (int bj = 0; bj < 2; ++bj)
#pragma unroll
                    for (int n = 0; n < 2; ++n) { const int c = (u.pn & 1) * 256 + 128 * bj + 32 * wc + 16 * n + 4 * fq; f32x4 v = acc[ai][bj][m][n];
                        if (kind == 0) { const f32x4 b = *(const f32x4*)(w0 + c);
#pragma unroll
                            for (int j = 0; j < 4; ++j) { const float z = v[j] + b[j]; const float sp = fmaxf(-z, 0.f) + __logf(1.0f + __expf(-fabsf(z))); v[j] = __expf(-sp - 0.5f); }
                            st_bf4(E + (size_t)row * 512 + c, v);
                        } else if (kind == 1) { const f32x4 b = *(const f32x4*)(a0 + c);
#pragma unroll
                            for (int j = 0; j < 4; ++j) v[j] = sigmoidf_(v[j] + b[j]);
                            st_bf4(A + (size_t)row * 512 + c, v);
                        } else st_bf4(G + (size_t)row * 512 + c, v); } }
    }
};
struct EpiGate {
    bf16* Gt; const float* rstd; const float* bias;
    __device__ __forceinline__ void operator()(AccRef acc, const pg8::Unit& u, int wr, int wc, int fr, int fq) const {
#pragma unroll
        for (int ai = 0; ai < 2; ++ai)
#pragma unroll
            for (int m = 0; m < 4; ++m) { const int row = u.pm * 256 + ai * 128 + wr * 64 + m * 16 + fr; const float rs = rstd[row];
#pragma unroll
                for (int bj = 0; bj < 2; ++bj)
#pragma unroll
                    for (int n = 0; n < 2; ++n) { const int c = u.pn * 256 + 128 * bj + 32 * wc + 16 * n + 4 * fq; const f32x4 b = *(const f32x4*)(bias + c); f32x4 v = acc[ai][bj][m][n] * rs + b;
#pragma unroll
                        for (int j = 0; j < 4; ++j) v[j] = sigmoidf_(v[j]);
                        st_bf4(Gt + (size_t)row * 3072 + c, v); } }
    }
};
struct EpiMerge {
    const bf16* Gt; float* accf; bf16* merged; int c;
    __device__ __forceinline__ void operator()(AccRef acc, const pg8::Unit& u, int wr, int wc, int fr, int fq) const {
#pragma unroll
        for (int ai = 0; ai < 2; ++ai)
#pragma unroll
            for (int m = 0; m < 4; ++m) { const int row = u.pm * 256 + ai * 128 + wr * 64 + m * 16 + fr;
#pragma unroll
                for (int bj = 0; bj < 2; ++bj)
#pragma unroll
                    for (int n = 0; n < 2; ++n) { const int col = u.pn * 256 + 128 * bj + 32 * wc + 16 * n + 4 * fq;
                        const u32x2 gw = *(const u32x2*)(Gt + (size_t)row * 3072 + c * 1024 + col);
                        f32x4 v = acc[ai][bj][m][n]; v[0] *= bflo(gw.x); v[1] *= bfhi(gw.x); v[2] *= bflo(gw.y); v[3] *= bfhi(gw.y);
                        float* ap = accf + (size_t)row * 1024 + col;
                        if (c > 0) v = v + *(const f32x4*)ap;
                        if (c < 2) *(f32x4*)ap = v; else st_bf4(merged + (size_t)row * 1024 + col, v); } }
    }
};
struct EpiOut {
    const float* x; float* out; bf16* HB; float* HSQ;
    __device__ __forceinline__ void operator()(AccRef acc, const pg8::Unit& u, int wr, int wc, int fr, int fq) const {
#pragma unroll
        for (int ai = 0; ai < 2; ++ai)
#pragma unroll
            for (int m = 0; m < 4; ++m) { const int row = u.pm * 256 + ai * 128 + wr * 64 + m * 16 + fr; float ss = 0.f;
#pragma unroll
                for (int bj = 0; bj < 2; ++bj)
#pragma unroll
                    for (int n = 0; n < 2; ++n) { const size_t o = (size_t)row * 1024 + u.pn * 256 + 128 * bj + 32 * wc + 16 * n + 4 * fq;
                        const f32x4 v = acc[ai][bj][m][n] + *(const f32x4*)(x + o); *(f32x4*)(out + o) = v; st_h4((half_t*)HB + o, v);
                        ss += (v[0] * v[0] + v[1] * v[1]) + (v[2] * v[2] + v[3] * v[3]); }
                ss += __shfl_xor(ss, 16); ss += __shfl_xor(ss, 32);
                if (fq == 0) HSQ[(size_t)row * 16 + u.pn * 4 + wc] = ss; }
    }
};

__device__ __forceinline__ float rstd_h_row(const float* HSQ, int row) {
    const f32x4* hp = (const f32x4*)(HSQ + (size_t)row * 16); const f32x4 a = hp[0], b = hp[1], c = hp[2], d = hp[3];
    const float s = ((a[0] + a[1]) + (a[2] + a[3])) + ((b[0] + b[1]) + (b[2] + b[3])) + ((c[0] + c[1]) + (c[2] + c[3])) + ((d[0] + d[1]) + (d[2] + d[3]));
    return 1.0f / sqrtf(s * (1.0f / 1024.0f) + NORM_EPS);
}
__device__ __forceinline__ void lora_in_phase(const Params& P, int bid, int nblk) {
    const bf16* RWP = (const bf16*)(P.ws + WS_RWP); bf16* LIN = (bf16*)((unsigned char*)P.out + DO_LIN); const float* mu = P.in[12];
    const int gt = bid * NT + tid_opaque(), NGT = nblk * NT;
    for (int i = gt; i < S_ * 64; i += NGT) { const int t = i >> 6, c4 = (i & 63) * 4;
        const u32x2 pw = *(const u32x2*)(RWP + (size_t)t * RW_IN + 1536 + c4);
        u32x2 qw; qw.x = 0u; qw.y = 0u; if (t > 0) qw = *(const u32x2*)(RWP + (size_t)(t - 1) * RW_IN + 1536 + c4);
        const f32x4 m4 = *(const f32x4*)(mu + 1536 + c4);
        f32x4 p = {bflo(pw.x), bfhi(pw.x), bflo(pw.y), bfhi(pw.y)}, q = {bflo(qw.x), bfhi(qw.x), bflo(qw.y), bfhi(qw.y)};
        f32x4 s = p + (q - p) * m4;
        if (c4 < 64) { for (int j = 0; j < 4; ++j) s[j] = tanhf(s[j]); }
        else if (c4 >= 128) { for (int j = 0; j < 4; ++j) s[j] = sigmoidf_(s[j]); }
        st_bf4(LIN + (size_t)t * 256 + c4, s); }
}

constexpr int TC = 32;
__device__ __forceinline__ float shift3(const bf16* RWP, const float* mu, int t, int col) {
    const float p = bf2f(RWP[(size_t)t * RW_IN + col]); const float q = t > 0 ? bf2f(RWP[(size_t)(t - 1) * RW_IN + col]) : 0.f;
    return p + (q - p) * mu[col];
}
__device__ __forceinline__ void rwkv_scan_v1(const Params& P, LAS unsigned char* lds, int h) {
    const bf16* RWP = (const bf16*)(P.ws + WS_RWP);
    const bf16* Eb = (const bf16*)((unsigned char*)P.out + DO_E); const bf16* Ab = (const bf16*)((unsigned char*)P.out + DO_A); const bf16* Gb = (const bf16*)((unsigned char*)P.out + DO_G);
    bf16* Y = (bf16*)(P.ws + WS_Y);
    const float* mu = P.in[12]; const float* k_k = P.in[18]; const float* k_a = P.in[19]; const float* r_k = P.in[20]; const float* ln_w = P.in[21]; const float* ln_b = P.in[22];
    LAS float* sR = (LAS float*)lds; LAS float* sW = sR + TC * 64; LAS float* sK = sW + TC * 64; LAS float* sV = sK + TC * 64;
    LAS float* sA = sV + TC * 64; LAS float* sB = sA + TC * 64; LAS float* sY = sB + TC * 64; LAS float* sG = sY + TC * 64;
    const int tid = tid_opaque();
    const int tok = tid >> 4, j0 = (tid & 15) * 4;
    const int si = tid >> 3, jg = tid & 7;
    float S[8];
#pragma unroll
    for (int c = 0; c < 8; ++c) S[c] = 0.f;
    for (int t0 = 0; t0 < S_; t0 += TC) {
        {
            const int t = t0 + tok; float kkv[4], ss = 0.f, rr[4], kk_[4], vv[4], aa[4], ee[4], gg[4];
#pragma unroll
            for (int j = 0; j < 4; ++j) { const int c = h * 64 + j0 + j;
                rr[j] = shift3(RWP, mu, t, c); kk_[j] = shift3(RWP, mu, t, 512 + c); vv[j] = shift3(RWP, mu, t, 1024 + c);
                aa[j] = bf2f(Ab[(size_t)t * 512 + c]); ee[j] = bf2f(Eb[(size_t)t * 512 + c]); gg[j] = bf2f(Gb[(size_t)t * 512 + c]);
                kkv[j] = kk_[j] * k_k[c]; ss += kkv[j] * kkv[j]; }
            ss += __shfl_xor(ss, 1); ss += __shfl_xor(ss, 2); ss += __shfl_xor(ss, 4); ss += __shfl_xor(ss, 8);
            const float inv = 1.0f / fmaxf(sqrtf(ss), 1e-12f);
#pragma unroll
            for (int j = 0; j < 4; ++j) { const int c = h * 64 + j0 + j; const int o = tok * 64 + j0 + j; const float kn = kkv[j] * inv;
                sR[o] = rr[j]; sW[o] = __expf(-ee[j]); sK[o] = kk_[j] * (1.0f + (aa[j] - 1.0f) * k_a[c]); sV[o] = vv[j]; sA[o] = -kn; sB[o] = kn * aa[j]; sG[o] = gg[j]; }
        }
        __syncthreads();
        for (int tt = 0; tt < TC; ++tt) {
            const LAS float* pa = sA + tt * 64 + 8 * jg; const LAS float* pb = sB + tt * 64 + 8 * jg; const LAS float* pw = sW + tt * 64 + 8 * jg;
            const LAS float* pk = sK + tt * 64 + 8 * jg; const LAS float* pr = sR + tt * 64 + 8 * jg;
            const float vi = sV[tt * 64 + si];
            float sa = 0.f;
#pragma unroll
            for (int c = 0; c < 8; ++c) sa += S[c] * pa[c];
            sa += __shfl_xor(sa, 1); sa += __shfl_xor(sa, 2); sa += __shfl_xor(sa, 4);
            float y = 0.f;
#pragma unroll
            for (int c = 0; c < 8; ++c) { S[c] = S[c] * pw[c] + sa * pb[c] + vi * pk[c]; y += S[c] * pr[c]; }
            y += __shfl_xor(y, 1); y += __shfl_xor(y, 2); y += __shfl_xor(y, 4);
            if (jg == 0) sY[tt * 64 + si] = y;
        }
        __syncthreads();
        {
            const int t = t0 + tok; float y4[4], s1 = 0.f, bon = 0.f;
#pragma unroll
            for (int j = 0; j < 4; ++j) { const int o = tok * 64 + j0 + j; y4[j] = sY[o]; s1 += y4[j]; bon += sR[o] * sK[o] * r_k[h * 64 + j0 + j]; }
            s1 += __shfl_xor(s1, 1); s1 += __shfl_xor(s1, 2); s1 += __shfl_xor(s1, 4); s1 += __shfl_xor(s1, 8);
            bon += __shfl_xor(bon, 1); bon += __shfl_xor(bon, 2); bon += __shfl_xor(bon, 4); bon += __shfl_xor(bon, 8);
            const float mean = s1 * (1.0f / 64.0f); float s2 = 0.f;
#pragma unroll
            for (int j = 0; j < 4; ++j) { const float d = y4[j] - mean; s2 += d * d; }
            s2 += __shfl_xor(s2, 1); s2 += __shfl_xor(s2, 2); s2 += __shfl_xor(s2, 4); s2 += __shfl_xor(s2, 8);
            const float rstd = 1.0f / sqrtf(s2 * (1.0f / 64.0f) + GN_EPS);
            f32x4 o4;
#pragma unroll
            for (int j = 0; j < 4; ++j) { const int c = h * 64 + j0 + j; const int o = tok * 64 + j0 + j;
                o4[j] = ((y4[j] - mean) * rstd * ln_w[c] + ln_b[c] + bon * sV[o]) * sG[o]; }
            st_bf4(Y + (size_t)t * 1536 + 512 + h * 64 + j0, o4);
        }
        __syncthreads();
    }
}

__device__ __forceinline__ unsigned ordkey(float f) { const unsigned u = __builtin_bit_cast(unsigned, f); return (u & 0x80000000u) ? ~u : (u | 0x80000000u); }
constexpr int DSA_LDS_SCORES = 0, DSA_LDS_IQ = 65536, DSA_LDS_HIST = DSA_LDS_IQ + 1024, DSA_LDS_MISC = DSA_LDS_HIST + 1024, DSA_LDS_SEL = DSA_LDS_MISC + 256,
              DSA_LDS_O = DSA_LDS_SEL + 1024, DSA_LDS_ML = DSA_LDS_O + 8 * 512 * 4, DSA_LDS_END = DSA_LDS_ML + 8 * 8 * 2 * 4;
__device__ __forceinline__ void dsa_query_v1(const Params& P, LAS unsigned char* lds, int t) {
    const half_t* IQ = (const half_t*)(P.ws + WS_IQ); const half_t* IK = (const half_t*)(P.ws + WS_IK); const float* IW = (const float*)(P.ws + WS_IW);
    const bf16* Q = (const bf16*)(P.ws + WS_Q); const bf16* Kb = (const bf16*)(P.ws + WS_K); const bf16* Vb = (const bf16*)(P.ws + WS_V);
    bf16* Y = (bf16*)(P.ws + WS_Y);
    LAS float* sc = (LAS float*)(lds + DSA_LDS_SCORES); LAS float* siq = (LAS float*)(lds + DSA_LDS_IQ); LAS unsigned* hist = (LAS unsigned*)(lds + DSA_LDS_HIST);
    LAS unsigned* misc = (LAS unsigned*)(lds + DSA_LDS_MISC); LAS unsigned* sel = (LAS unsigned*)(lds + DSA_LDS_SEL);
    LAS float* so = (LAS float*)(lds + DSA_LDS_O); LAS float* sml = (LAS float*)(lds + DSA_LDS_ML);
    const int tid = tid_opaque(), lane = tid & 63, wave = tid >> 6;
    const int n = t + 1;
    if (tid < 256) siq[tid] = (float)IQ[(size_t)t * 256 + tid];
    if (tid < 256) sel[tid] = 0xFFFFu;
    __syncthreads();
    float w4[4];
#pragma unroll
    for (int hh = 0; hh < 4; ++hh) w4[hh] = IW[(size_t)t * 4 + hh] * 0.0625f;
    for (int s = tid; s < n; s += NT) {
        const half8* kp = (const half8*)(IK + (size_t)s * 64);
        float d0 = 0.f, d1 = 0.f, d2 = 0.f, d3 = 0.f;
#pragma unroll
        for (int c = 0; c < 8; ++c) { const half8 kv = kp[c];
#pragma unroll
            for (int j = 0; j < 8; ++j) { const float kf = (float)kv[j]; const int d = c * 8 + j;
                d0 += siq[d] * kf; d1 += siq[64 + d] * kf; d2 += siq[128 + d] * kf; d3 += siq[192 + d] * kf; } }
        float v = w4[0] * fmaxf(d0, 0.f) + w4[1] * fmaxf(d1, 0.f) + w4[2] * fmaxf(d2, 0.f) + w4[3] * fmaxf(d3, 0.f);
        sc[s] = v + 0.0f;
    }
    __syncthreads();
    if (n <= 256) { if (tid < n) sel[tid] = (unsigned)tid; __syncthreads(); }
    else {
        unsigned prefix = 0u, krem = 256u;
        for (int pass = 3; pass >= 0; --pass) {
            const int shift = pass * 8;
            if (tid < 256) hist[tid] = 0u;
            __syncthreads();
            for (int s = tid; s < n; s += NT) { const unsigned k = ordkey(sc[s]);
                if (pass == 3 || (k >> (shift + 8)) == (prefix >> (shift + 8))) atomicAdd((unsigned*)&hist[(k >> shift) & 255u], 1u); }
            __syncthreads();
            if (tid == 0) { unsigned cum = 0u; int b = 255; for (; b > 0; --b) { const unsigned hb = hist[b]; if (cum + hb >= krem) break; cum += hb; }
                misc[0] = prefix | ((unsigned)b << shift); misc[1] = krem - cum; }
            __syncthreads();
            prefix = misc[0]; krem = misc[1];
            __syncthreads();
        }
        const unsigned T = prefix; unsigned selbase = 0u, eqbase = 0u;
        for (int c0 = 0; c0 < n; c0 += NT) {
            const int s = c0 + tid; const unsigned k = (s < n) ? ordkey(sc[s]) : 0u; const bool gt = (s < n) && k > T, eq = (s < n) && k == T;
            const unsigned long long beq = __ballot(eq); const unsigned eqpre = __popcll(beq & ((1ull << lane) - 1ull));
            if (lane == 0) misc[8 + wave] = (unsigned)__popcll(beq);
            __syncthreads();
            unsigned eqoff = eqbase, eqtot = 0u;
#pragma unroll
            for (int w = 0; w < 8; ++w) { const unsigned cw = misc[8 + w]; if (w < wave) eqoff += cw; eqtot += cw; }
            const bool take = gt || (eq && (eqoff + eqpre) < krem);
            const unsigned long long bt = __ballot(take); const unsigned tpre = __popcll(bt & ((1ull << lane) - 1ull));
            if (lane == 0) misc[16 + wave] = (unsigned)__popcll(bt);
            __syncthreads();
            unsigned toff = selbase, ttot = 0u;
#pragma unroll
            for (int w = 0; w < 8; ++w) { const unsigned cw = misc[16 + w]; if (w < wave) toff += cw; ttot += cw; }
            if (take && (toff + tpre) < 256u) sel[toff + tpre] = (unsigned)s;
            selbase += ttot; eqbase += eqtot;
            __syncthreads();
        }
    }
    {
        u16* SEL = (u16*)(P.ws + WS_SEL);
        if (tid < 256) SEL[(size_t)t * 256 + tid] = (u16)sel[tid];
        const u32x4 qw = *(const u32x4*)(Q + (size_t)t * 512 + 8 * lane);
        float q[8] = {bflo(qw.x), bfhi(qw.x), bflo(qw.y), bfhi(qw.y), bflo(qw.z), bfhi(qw.z), bflo(qw.w), bfhi(qw.w)};
        float lg[32]; float mx = -INFINITY;
#pragma unroll
        for (int i = 0; i < 32; ++i) { const unsigned id = sel[wave * 32 + i];
            float d = -INFINITY;
            if (id != 0xFFFFu) { const u32x4 kw = *(const u32x4*)(Kb + (size_t)id * 512 + 8 * lane);
                d = q[0] * bflo(kw.x) + q[1] * bfhi(kw.x) + q[2] * bflo(kw.y) + q[3] * bfhi(kw.y) + q[4] * bflo(kw.z) + q[5] * bfhi(kw.z) + q[6] * bflo(kw.w) + q[7] * bfhi(kw.w);
                d += __shfl_xor(d, 1); d += __shfl_xor(d, 2); d += __shfl_xor(d, 4); d *= 0.125f; }
            lg[i] = d; mx = fmaxf(mx, d); }
        float l = 0.f, o[8];
#pragma unroll
        for (int c = 0; c < 8; ++c) o[c] = 0.f;
#pragma unroll
        for (int i = 0; i < 32; ++i) { const unsigned id = sel[wave * 32 + i];
            if (id != 0xFFFFu) { const float p = __expf(lg[i] - mx); l += p;
                const u32x4 vw = *(const u32x4*)(Vb + (size_t)id * 512 + 8 * lane);
                o[0] += p * bflo(vw.x); o[1] += p * bfhi(vw.x); o[2] += p * bflo(vw.y); o[3] += p * bfhi(vw.y); o[4] += p * bflo(vw.z); o[5] += p * bfhi(vw.z); o[6] += p * bflo(vw.w); o[7] += p * bfhi(vw.w); } }
#pragma unroll
        for (int c = 0; c < 8; ++c) so[wave * 512 + 8 * lane + c] = o[c];
        if ((lane & 7) == 0) { sml[(wave * 8 + (lane >> 3)) * 2] = mx; sml[(wave * 8 + (lane >> 3)) * 2 + 1] = l; }
        __syncthreads();
        {
            const int hh = tid >> 6; float M = -INFINITY;
#pragma unroll
            for (int w = 0; w < 8; ++w) M = fmaxf(M, sml[(w * 8 + hh) * 2]);
            float L = 0.f, acc = 0.f;
#pragma unroll
            for (int w = 0; w < 8; ++w) { const float mw = sml[(w * 8 + hh) * 2]; const float f = (mw == -INFINITY) ? 0.f : __expf(mw - M); L += f * sml[(w * 8 + hh) * 2 + 1]; acc += f * so[w * 512 + tid]; }
            Y[(size_t)t * 1536 + tid] = (bf16)f2bf(acc / L);
        }
        __syncthreads();
    }
}

constexpr int MA_KSTRIDE = 264;
constexpr int MA_LDS_K = 0, MA_LDS_V = 256 * MA_KSTRIDE, MA_LDS_P = MA_LDS_V + 256 * 256, MA_LDS_Q = MA_LDS_P + 8 * 256 * 4, MA_LDS_END = MA_LDS_Q + 8 * 128 * 4;
__device__ __forceinline__ void mem_attn_phase(const Params& P, LAS unsigned char* lds, int bid, int nblk) {
    const float* KMVM = (const float*)(P.ws + WS_KMVM); const bf16* MEMQ = (const bf16*)(P.ws + WS_MEMQ); bf16* Y = (bf16*)(P.ws + WS_Y);
    const float* qg = P.in[10]; const float* kg = P.in[11];
    const int tid = tid_opaque(), lane = tid & 63, wave = tid >> 6;
    const int h = bid & 3, sub = bid >> 2, nsub = nblk >> 2;
    for (int r = wave; r < 256; r += NW) {
        const f32x2 kv = *(const f32x2*)(KMVM + (size_t)r * 1024 + h * 128 + 2 * lane);
        const float ss = wave_sum(kv.x * kv.x + kv.y * kv.y); const float rk = 1.0f / sqrtf(ss * (1.0f / 128.0f) + NORM_EPS);
        *(LAS unsigned*)(lds + MA_LDS_K + r * MA_KSTRIDE + 4 * lane) = pk2(kv.x * rk * kg[2 * lane], kv.y * rk * kg[2 * lane + 1]);
        const f32x2 vv = *(const f32x2*)(KMVM + (size_t)r * 1024 + 512 + h * 128 + 2 * lane);
        *(LAS unsigned*)(lds + MA_LDS_V + r * 256 + 4 * lane) = pk2(vv.x, vv.y);
    }
    __syncthreads();
    LAS float* pb = (LAS float*)(lds + MA_LDS_P) + wave * 256; LAS float* qb = (LAS float*)(lds + MA_LDS_Q) + wave * 128;
    for (int r = sub * NW + wave; r < S_; r += nsub * NW) {
        const unsigned qw = *(const unsigned*)(MEMQ + (size_t)r * 512 + h * 128 + 2 * lane);
        const float q0 = bflo(qw), q1 = bfhi(qw);
        const float ss = wave_sum(q0 * q0 + q1 * q1); const float rq = 1.0f / sqrtf(ss * (1.0f / 128.0f) + NORM_EPS) * 0.08838834764831845f;
        qb[2 * lane] = q0 * rq * qg[2 * lane]; qb[2 * lane + 1] = q1 * rq * qg[2 * lane + 1];
        LDS_WAIT(); __builtin_amdgcn_wave_barrier();
        float lg[4] = {0.f, 0.f, 0.f, 0.f};
#pragma unroll 4
        for (int d4 = 0; d4 < 32; ++d4) { const f32x4 qv = *(const LAS f32x4*)(qb + 4 * d4);
#pragma unroll
            for (int c = 0; c < 4; ++c) { const u32x2 kw = *(const LAS u32x2*)(lds + MA_LDS_K + (lane + 64 * c) * MA_KSTRIDE + 8 * d4);
                lg[c] += qv[0] * bflo(kw.x) + qv[1] * bfhi(kw.x) + qv[2] * bflo(kw.y) + qv[3] * bfhi(kw.y); } }
        const float mx = wave_max(fmaxf(fmaxf(lg[0], lg[1]), fmaxf(lg[2], lg[3])));
        float p[4], l = 0.f;
#pragma unroll
        for (int c = 0; c < 4; ++c) { p[c] = __expf(lg[c] - mx); l += p[c]; }
        l = wave_sum(l); const float il = 1.0f / l;
#pragma unroll
        for (int c = 0; c < 4; ++c) pb[lane + 64 * c] = p[c] * il;
        LDS_WAIT(); __builtin_amdgcn_wave_barrier();
        float o0 = 0.f, o1 = 0.f;
#pragma unroll 8
        for (int k4 = 0; k4 < 64; ++k4) { const f32x4 pv = *(const LAS f32x4*)(pb + 4 * k4);
#pragma unroll
            for (int c = 0; c < 4; ++c) { const unsigned vw = *(const LAS unsigned*)(lds + MA_LDS_V + (4 * k4 + c) * 256 + 4 * lane); o0 += pv[c] * bflo(vw); o1 += pv[c] * bfhi(vw); } }
        *(unsigned*)(Y + (size_t)r * 1536 + 1024 + h * 128 + 2 * lane) = pk2(o0, o1);
        LDS_WAIT(); __builtin_amdgcn_wave_barrier();
    }
}

__device__ __forceinline__ void rstdh_phase(const Params& P, int bid, int nblk) {
    const float* HSQ = (const float*)(P.ws + WS_HSQ); float* R = (float*)(P.ws + WS_RSTDH);
    for (int r = bid * NT + tid_opaque(); r < S_; r += nblk * NT) { float s = 0.f;
#pragma unroll
        for (int i = 0; i < 16; ++i) s += HSQ[(size_t)r * 16 + i];
        R[r] = 1.0f / sqrtf(s * (1.0f / 1024.0f) + NORM_EPS); }
}
#define BUBBLE16(v, ix, x, c) do { if ((x) > v[15]) { v[15] = (x); ix[15] = (c); _Pragma("unroll") for (int _p = 15; _p > 0; --_p) { \
        const bool _sw = v[_p] > v[_p - 1]; const float _a = v[_p], _b = v[_p - 1]; const int _ia = ix[_p], _ib = ix[_p - 1]; \
        v[_p] = _sw ? _b : _a; v[_p - 1] = _sw ? _a : _b; ix[_p] = _sw ? _ib : _ia; ix[_p - 1] = _sw ? _ia : _ib; } } } while (0)
__device__ __forceinline__ void peer_topk_phase(const Params& P, LAS unsigned char* lds, int h, int bid, int nblk) {
    const float* SC = (const float*)(P.ws + WS_SC); int* EIDX = (int*)(P.ws + WS_EIDX); float* EG = (float*)(P.ws + WS_EGATE);
    LAS float* sv = (LAS float*)lds; LAS int* sx = (LAS int*)(lds + 256 * 2 * 16 * 4);
    const int tid = tid_opaque(), rl = tid >> 1, half = tid & 1;
    for (int r0 = bid * 256; r0 < S_; r0 += nblk * 256) {
        const int row = r0 + rl;
        float v[16]; int ix[16];
#pragma unroll
        for (int p = 0; p < 16; ++p) { v[p] = -INFINITY; ix[p] = 0; }
        const f32x4* sp = (const f32x4*)(SC + (size_t)row * 256 + half * 128);
        for (int c4 = 0; c4 < 32; ++c4) { const f32x4 x = sp[c4];
#pragma unroll
            for (int j = 0; j < 4; ++j) { const float xv = x[j]; const int cc = 4 * c4 + j; BUBBLE16(v, ix, xv, cc); } }
#pragma unroll
        for (int p = 0; p < 16; ++p) { sv[(rl * 2 + half) * 16 + p] = v[p]; sx[(rl * 2 + half) * 16 + p] = ix[p]; }
        __syncthreads();
        if (half == 0) {
            float cv[16]; int ci[16];
#pragma unroll
            for (int p = 0; p < 16; ++p) { cv[p] = -INFINITY; ci[p] = 0; }
            for (int i = 0; i < 16; ++i) { const float a = sv[(rl * 2) * 16 + i];
                for (int j = 0; j < 16; ++j) { const float s = a + sv[(rl * 2 + 1) * 16 + j]; const int f = i * 16 + j; BUBBLE16(cv, ci, s, f); } }
            float l = 0.f, pe[16];
#pragma unroll
            for (int p = 0; p < 16; ++p) { pe[p] = __expf(cv[p] - cv[0]); l += pe[p]; }
            const float il = 1.0f / l;
#pragma unroll
            for (int p = 0; p < 16; ++p) { const int e1 = sx[(rl * 2) * 16 + (ci[p] >> 4)], e2 = sx[(rl * 2 + 1) * 16 + (ci[p] & 15)];
                EIDX[(size_t)row * 128 + h * 16 + p] = e1 * 128 + e2; EG[(size_t)row * 128 + h * 16 + p] = pe[p] * il; }
        }
        __syncthreads();
    }
}
__device__ __forceinline__ void peer_expert_phase_v1(const Params& P, int bid, int nblk) {
    const int* EIDX = (const int*)(P.ws + WS_EIDX); const float* EG = (const float*)(P.ws + WS_EGATE); const float* HSQ = (const float*)(P.ws + WS_HSQ);
    const float* U = P.in[29]; const float* Vt = P.in[30]; const float* gain = P.in[25];
    const int tid = tid_opaque(), lane = tid & 63, wave = tid >> 6;
    for (int row = bid * NW + wave; row < S_; row += nblk * NW) {
        float* hp = P.out + (size_t)row * 1024; const float rs = rstd_h_row(HSQ, row);
        f32x4 hv[4], xn[4], o[4];
#pragma unroll
        for (int j = 0; j < 4; ++j) { hv[j] = *(const f32x4*)(hp + 4 * lane + 256 * j); xn[j] = hv[j] * rs * *(const f32x4*)(gain + 4 * lane + 256 * j); o[j] = (f32x4){0.f, 0.f, 0.f, 0.f}; }
        const int e_lo = EIDX[(size_t)row * 128 + lane], e_hi = EIDX[(size_t)row * 128 + 64 + lane];
        const float g_lo = EG[(size_t)row * 128 + lane], g_hi = EG[(size_t)row * 128 + 64 + lane];
        for (int e = 0; e < 128; ++e) {
            const int idx = __shfl((e < 64) ? e_lo : e_hi, e & 63); const float gt = __shfl((e < 64) ? g_lo : g_hi, e & 63);
            const float* up = U + (size_t)idx * 1024; float d = 0.f;
#pragma unroll
            for (int j = 0; j < 4; ++j) { const f32x4 uv = *(const f32x4*)(up + 4 * lane + 256 * j); d += (xn[j][0] * uv[0] + xn[j][1] * uv[1]) + (xn[j][2] * uv[2] + xn[j][3] * uv[3]); }
            d = wave_sum(d);
            const float w = gt * 0.5f * d * (1.0f + erff(d * 0.70710678118654752f));
            const float* vp = Vt + (size_t)idx * 1024;
#pragma unroll
            for (int j = 0; j < 4; ++j) o[j] = o[j] + *(const f32x4*)(vp + 4 * lane + 256 * j) * w;
        }
#pragma unroll
        for (int j = 0; j < 4; ++j) *(f32x4*)(hp + 4 * lane + 256 * j) = hv[j] + o[j];
    }
}
struct EpiPQ {
    half_t* PQ; const float* HSQ;
    __device__ __forceinline__ void operator()(AccRef acc, const pg8::Unit& u, int wr, int wc, int fr, int fq) const {
#pragma unroll
        for (int ai = 0; ai < 2; ++ai)
#pragma unroll
            for (int m = 0; m < 4; ++m) { const int row = u.pm * 256 + ai * 128 + wr * 64 + m * 16 + fr;
                const f32x4* hp = (const f32x4*)(HSQ + (size_t)row * 16); const f32x4 a = hp[0], b = hp[1], c = hp[2], d = hp[3];
                const float s = ((a[0] + a[1]) + (a[2] + a[3])) + ((b[0] + b[1]) + (b[2] + b[3])) + ((c[0] + c[1]) + (c[2] + c[3])) + ((d[0] + d[1]) + (d[2] + d[3]));
                const float rs = 1.0f / sqrtf(s * (1.0f / 1024.0f) + NORM_EPS);
                half_t* dst = PQ + (size_t)row * 2048 + u.pn * 256 + 32 * wc + 4 * fq;
#pragma unroll
                for (int bj = 0; bj < 2; ++bj)
#pragma unroll
                    for (int n = 0; n < 2; ++n) st_h4(dst + 128 * bj + 16 * n, acc[ai][bj][m][n] * rs); }
    }
};
#define PEER_CAND(I, J) do { if (((I) + 1) * ((J) + 1) <= 16) { const float _s = v1[I] + v2[J]; const int _e = i1[I] * 128 + i2[J]; BUBBLE16(cv, ce, _s, _e); } } while (0)
__device__ __forceinline__ void peer_topk_tile(const float* scr, int pm, int head, int* EIDX, float* EG) {
    const int tid = tid_opaque(), lrow = tid >> 1, kh = tid & 1;
    float v[16]; int ix[16];
#pragma unroll
    for (int p = 0; p < 16; ++p) { v[p] = -INFINITY; ix[p] = 0; }
    const f32x4* sp = (const f32x4*)(scr + (size_t)lrow * 256 + kh * 128);
#pragma unroll 1
    for (int c4 = 0; c4 < 32; ++c4) { const f32x4 x = sp[c4];
#pragma unroll
        for (int j = 0; j < 4; ++j) { const float xv = x[j]; const int cc = 4 * c4 + j; BUBBLE16(v, ix, xv, cc); } }
    float v1[16], v2[16]; int i1[16], i2[16];
#pragma unroll
    for (int p = 0; p < 16; ++p) { const float ov = __shfl_xor(v[p], 1); const int oi = __shfl_xor(ix[p], 1);
        v1[p] = kh ? ov : v[p]; i1[p] = kh ? oi : ix[p]; v2[p] = kh ? v[p] : ov; i2[p] = kh ? ix[p] : oi; }
    float cv[16]; int ce[16];
#pragma unroll
    for (int p = 0; p < 16; ++p) { cv[p] = -INFINITY; ce[p] = 0; }
#pragma unroll
    for (int I = 0; I < 16; ++I) {
#pragma unroll
        for (int J = 0; J < 16; ++J) PEER_CAND(I, J); }
    if (kh == 0) {
        float l = 0.f, pe[16];
#pragma unroll
        for (int p = 0; p < 16; ++p) { pe[p] = __expf(cv[p] - cv[0]); l += pe[p]; }
        const float il = 1.0f / l; const int row = pm * 256 + lrow;
        int* ep = EIDX + (size_t)row * 128 + head * 16; float* gp = EG + (size_t)row * 128 + head * 16;
#pragma unroll
        for (int p4 = 0; p4 < 4; ++p4) { *(f32x4*)(gp + 4 * p4) = (f32x4){pe[4 * p4] * il, pe[4 * p4 + 1] * il, pe[4 * p4 + 2] * il, pe[4 * p4 + 3] * il};
            typedef int i32x4 __attribute__((ext_vector_type(4))); *(i32x4*)(ep + 4 * p4) = (i32x4){ce[4 * p4], ce[4 * p4 + 1], ce[4 * p4 + 2], ce[4 * p4 + 3]}; }
    }
}
struct EpiTile {
    float* scr;
    __device__ __forceinline__ void operator()(AccRef acc, const pg8::Unit& u, int wr, int wc, int fr, int fq) const {
#pragma unroll
        for (int ai = 0; ai < 2; ++ai)
#pragma unroll
            for (int m = 0; m < 4; ++m) { float* dst = scr + (size_t)(ai * 128 + wr * 64 + m * 16 + fr) * 256 + 32 * wc + 4 * fq;
#pragma unroll
                for (int bj = 0; bj < 2; ++bj)
#pragma unroll
                    for (int n = 0; n < 2; ++n) *(f32x4*)(dst + 128 * bj + 16 * n) = acc[ai][bj][m][n]; }
    }
};
#include <hip/hip_cooperative_groups.h>
namespace cg = cooperative_groups;
extern __shared__ __attribute__((aligned(16))) unsigned char dyn_lds[];
#define LDSP ((LAS unsigned char*)dyn_lds)
constexpr int LDS_BYTES = 150 * 1024;
static_assert(MA_LDS_END <= LDS_BYTES && DSA_LDS_END <= LDS_BYTES && 131072 <= LDS_BYTES, "LDS budget");
constexpr int NSCAN = 8;

typedef const __attribute__((address_space(4))) Params* KargPtr;
__device__ __forceinline__ Params load_params() {
    Params r;
#if defined(__HIP_DEVICE_COMPILE__)
    KargPtr kp = (KargPtr)__builtin_amdgcn_kernarg_segment_ptr(); asm volatile("" : "+s"(kp));
#pragma unroll
    for (int i = 0; i < 31; ++i) r.in[i] = kp->in[i];
    r.out = kp->out; r.ws = kp->ws;
#endif
    return r;
}
__global__ void __launch_bounds__(NT, 2) mega(Params P_unused) {
    cg::grid_group grid = cg::this_grid();
    const int bid = blockIdx.x, nb = gridDim.x;
#define PH_BEGIN const Params P = load_params(); unsigned char* ws = P.ws; unsigned char* dob = (unsigned char*)P.out; (void)ws; (void)dob;
    { PH_BEGIN prologue_phase(P, LDSP, bid, nb); }
    grid.sync();
    { PH_BEGIN
        pg8::Gemm g{(const bf16*)(ws + WS_MB), (const bf16*)(ws + WS_WMEM), 256, 1024, 1024, 1024, 1024, 0, 256 * 1024};
        pg8::StaticOrder S; S.init(g.M, g.N, nb, bid);
        EpiF32 E{(float*)(ws + WS_KMVM), 1024, (const float*)(ws + WS_RSTDM)};
        pg8::gemm_phase<false>(LDSP, g, S, E);
    }
    { PH_BEGIN
        pg8::Gemm g{(const bf16*)(ws + WS_XB), (const bf16*)(ws + WS_WIN), S_, P1_N, 1024, 1024, 1024, 0, 256 * 1024};
        pg8::StaticOrder S; S.init(g.M, g.N, nb, bid);
        EpiP1 E{(const float*)(ws + WS_RSTDX), (const float*)(ws + WS_COS), (const float*)(ws + WS_SIN), P.in[6], P.in[7],
                (bf16*)(ws + WS_Q), (bf16*)(ws + WS_K), (bf16*)(ws + WS_V), (bf16*)(ws + WS_RWP), (bf16*)(ws + WS_MEMQ), (half_t*)(ws + WS_IQ), (half_t*)(ws + WS_IK), (float*)(ws + WS_IW)};
        pg8::gemm_phase<false>(LDSP, g, S, E);
    }
    grid.sync();
    { PH_BEGIN lora_in_phase(P, bid, nb); }
    grid.sync();
    { PH_BEGIN
        pg8::Gemm g{(const bf16*)(dob + DO_LIN), (const bf16*)(ws + WS_WLORA), S_, 1536, 256, 256, 256, 0, 256 * 256};
        pg8::StaticOrder S; S.init(g.M, g.N, nb, bid);
        EpiLora E{(bf16*)(dob + DO_E), (bf16*)(dob + DO_A), (bf16*)(dob + DO_G), P.in[13], P.in[15]};
        pg8::gemm_phase<false>(LDSP, g, S, E);
    }
    grid.sync();
    if (bid < NSCAN) { PH_BEGIN rwkv_scan_v1(P, LDSP, bid); }
    else {
        { PH_BEGIN for (int t = bid - NSCAN; t < S_; t += nb - NSCAN) dsa_query_v1(P, LDSP, t); }
        { PH_BEGIN mem_attn_phase(P, LDSP, bid - NSCAN, nb - NSCAN); }
    }
    grid.sync();
    { PH_BEGIN
        pg8::Gemm g{(const bf16*)(ws + WS_XB), (const bf16*)(ws + WS_WG), S_, 3072, 1024, 1024, 1024, 0, 256 * 1024};
        pg8::PanelOrder S; S.init(S_, nb, bid, 3);
        EpiGate E{(bf16*)(ws + WS_GATES), (const float*)(ws + WS_RSTDX), P.in[5]};
        pg8::gemm_phase<false>(LDSP, g, S, E);
    }
    for (int c = 0; c < 3; ++c) { PH_BEGIN
        pg8::Gemm g{(const bf16*)(ws + WS_Y) + c * 512, (const bf16*)(ws + WS_WUP) + (size_t)c * 1024 * 512, S_, 1024, 512, 1536, 512, 0, 256 * 512};
        pg8::StaticOrder S; S.init(g.M, g.N, nb, bid);
        EpiMerge E{(const bf16*)(ws + WS_GATES), P.out, (bf16*)(ws + WS_MERGED), c};
        pg8::gemm_phase<false>(LDSP, g, S, E);
    }
    grid.sync();
    { PH_BEGIN
        pg8::Gemm g{(const bf16*)(ws + WS_MERGED), (const bf16*)(ws + WS_WOUT), S_, 1024, 1024, 1024, 1024, 0, 256 * 1024};
        pg8::StaticOrder S; S.init(g.M, g.N, nb, bid);
        EpiOut E{P.in[0], P.out, (bf16*)(ws + WS_XB), (float*)(ws + WS_HSQ)};
        pg8::gemm_phase<false>(LDSP, g, S, E);
    }
    grid.sync();
    { PH_BEGIN
        pg8::Gemm g{(const bf16*)(ws + WS_XB), (const bf16*)(ws + WS_WQ), S_, 2048, 1024, 1024, 1024, 0, 256 * 1024};
        pg8::StaticOrder S; S.init(g.M, g.N, nb, bid);
        EpiPQ E{(half_t*)(ws + WS_PQ), (const float*)(ws + WS_HSQ)};
        pg8::gemm_phase<true>(LDSP, g, S, E);
    }
    grid.sync();
    { PH_BEGIN
        pg8::Gemm g{(const bf16*)(ws + WS_PQ), (const bf16*)(ws + WS_KEYBD), S_, 2048, 256, 2048, 256, 256, 0};
        pg8::StaticOrder S; S.init(g.M, g.N, nb, bid);
        float* scr = (float*)(ws + WS_SC) + (size_t)bid * 65536;
        pg8::Unit u;
        for (int i = 0; S.next(i, u); ++i) {
            pg8::OneUnit O{u}; EpiTile E{scr};
            pg8::gemm_phase<true>(LDSP, g, O, E);
            __syncthreads();
            peer_topk_tile(scr, u.pm, u.pn, (int*)(ws + WS_EIDX), (float*)(ws + WS_EGATE));
            __syncthreads();
        }
    }
    grid.sync();
    { PH_BEGIN peer_expert_phase_v1(P, bid, nb); }
#undef PH_BEGIN
}

extern "C" void kernel_launch(void* const* d_in, const int* in_sizes, int n_in, void* d_out, int out_size, void* d_ws, size_t ws_size, hipStream_t stream) {
    static int grid = 0;
    if (grid == 0) {
        if (n_in != 31 || out_size != S_ * D_ || ws_size < WS_END) { fprintf(stderr, "kernel_launch: unexpected problem (n_in %d out %d ws %zu)\n", n_in, out_size, ws_size); grid = -1; return; }
        int dev = 0, cus = 0, per_cu = 0;
        if (hipGetDevice(&dev) != hipSuccess || hipDeviceGetAttribute(&cus, hipDeviceAttributeMultiprocessorCount, dev) != hipSuccess) { grid = -1; return; }
        if (hipFuncSetAttribute((const void*)mega, hipFuncAttributeMaxDynamicSharedMemorySize, LDS_BYTES) != hipSuccess) { fprintf(stderr, "kernel_launch: hipFuncSetAttribute failed\n"); grid = -1; return; }
        if (hipOccupancyMaxActiveBlocksPerMultiprocessor(&per_cu, (const void*)mega, NT, LDS_BYTES) != hipSuccess || per_cu < 1) { fprintf(stderr, "kernel_launch: occupancy query failed (%d)\n", per_cu); grid = -1; return; }
        grid = cus;
        if (grid != 256) { fprintf(stderr, "kernel_launch: built for 256 CUs, device has %d\n", cus); grid = -1; return; }
    }
    if (grid < 0) return;
    Params P{};
    for (int i = 0; i < 31; ++i) P.in[i] = (const float*)d_in[i];
    P.out = (float*)d_out; P.ws = (unsigned char*)d_ws;
    void* args[] = {&P};
    hipError_t e = hipLaunchCooperativeKernel((const void*)mega, dim3(grid), dim3(NT), args, LDS_BYTES, stream);
    if (e != hipSuccess) fprintf(stderr, "kernel_launch: cooperative launch failed: %s\n", hipGetErrorString(e));
}
```

```cpp
#include <hip/hip_runtime.h>
#include <cstdio>
#include <cstdint>

typedef unsigned short bf16;
typedef unsigned short u16;
typedef float f32x4 __attribute__((ext_vector_type(4)));
typedef float f32x2 __attribute__((ext_vector_type(2)));
typedef unsigned u32x4 __attribute__((ext_vector_type(4)));
typedef unsigned u32x2 __attribute__((ext_vector_type(2)));
typedef _Float16 half_t;
typedef _Float16 half4 __attribute__((ext_vector_type(4)));
typedef _Float16 half8 __attribute__((ext_vector_type(8)));

constexpr int S_ = 16384, D_ = 1024;
constexpr int NMEM = 256;
constexpr int ATT_W = 512, RW_W = 512, MEM_W = 512;
constexpr int RW_IN = 1792;
constexpr int WIN_COLS = 7236;
constexpr int COL_Q = 0, COL_K = 512, COL_V = 1024, COL_IQ = 1536, COL_IK = 1792, COL_IW = 1856, COL_RW = 1860, COL_MEMQ = 3652, COL_GATE = 4164;
constexpr int P1_TILES = 17, P1_N = P1_TILES * 256;
constexpr float NORM_EPS = 1e-6f, GN_EPS = 64e-5f;
constexpr int NEXP = 16384;

constexpr size_t MiB = 1u << 20;
constexpr size_t WS_CTL = 0;
constexpr size_t WS_RSTDX = 1 * MiB;
constexpr size_t WS_COS = WS_RSTDX + 64 * 1024;
constexpr size_t WS_SIN = WS_COS + 512 * 1024;
constexpr size_t WS_IW = WS_SIN + 512 * 1024;
constexpr size_t WS_RSTDM = WS_IW + 256 * 1024;
constexpr size_t WS_RSTDH = WS_RSTDM + 4096;
constexpr size_t WS_HSQ = 3 * MiB;
constexpr size_t WS_WIN = 4 * MiB;
constexpr size_t WS_WG = WS_WIN + (size_t)P1_N * 1024 * 2;
constexpr size_t WS_WUP = WS_WG + 6 * MiB;
constexpr size_t WS_WOUT = WS_WUP + 3 * MiB;
constexpr size_t WS_WQ = WS_WOUT + 2 * MiB;
constexpr size_t WS_WMEM = WS_WQ + 4 * MiB;
constexpr size_t WS_KEYBD = WS_WMEM + 2 * MiB;
constexpr size_t WS_WLORA = WS_KEYBD + 128 * 1024;
static_assert(WS_WLORA + 768 * 1024 <= 30 * MiB + 512 * 1024, "weights region");
constexpr size_t WS_KMVM = 30 * MiB + 512 * 1024;
constexpr size_t WS_MB = 31 * MiB + 512 * 1024;
constexpr size_t WS_XB = 32 * MiB;
constexpr size_t WS_Q = 64 * MiB, WS_K = 80 * MiB, WS_V = 96 * MiB;
constexpr size_t WS_IQ = 112 * MiB;
constexpr size_t WS_IK = 120 * MiB;
constexpr size_t WS_MEMQ = 122 * MiB;
constexpr size_t WS_RWP = 138 * MiB;
constexpr size_t WS_Y = 194 * MiB;
constexpr size_t WS_SEL = 242 * MiB;
constexpr size_t DO_E = 0, DO_A = 16 * MiB, DO_G = 32 * MiB, DO_LIN = 48 * MiB;
constexpr size_t WS_GATES = 64 * MiB;
constexpr size_t WS_MERGED = 160 * MiB;
constexpr size_t WS_PQ = 64 * MiB;
constexpr size_t WS_SC = 128 * MiB;
constexpr size_t WS_EIDX = 192 * MiB;
constexpr size_t WS_EGATE = 200 * MiB;
constexpr size_t WS_END = 256 * MiB;

__device__ __forceinline__ unsigned f2bf(float f) { unsigned u = __builtin_bit_cast(unsigned, f); return (u + 0x7fffu + ((u >> 16) & 1u)) >> 16; }
__device__ __forceinline__ unsigned pk2(float lo, float hi) { return f2bf(lo) | (f2bf(hi) << 16); }
__device__ __forceinline__ unsigned pk2h(float lo, float hi) { typedef _Float16 h2 __attribute__((ext_vector_type(2))); h2 v; v[0] = (_Float16)lo; v[1] = (_Float16)hi; return __builtin_bit_cast(unsigned, v); }
__device__ __forceinline__ float bf2f(unsigned short b) { return __builtin_bit_cast(float, ((unsigned)b) << 16); }
__device__ __forceinline__ float bflo(unsigned w) { return __builtin_bit_cast(float, w << 16); }
__device__ __forceinline__ float bfhi(unsigned w) { return __builtin_bit_cast(float, w & 0xffff0000u); }
__device__ __forceinline__ float wave_sum(float v) {
#pragma unroll
    for (int o = 1; o < 64; o <<= 1) v += __shfl_xor(v, o);
    return v;
}
__device__ __forceinline__ float wave_max(float v) {
#pragma unroll
    for (int o = 1; o < 64; o <<= 1) v = fmaxf(v, __shfl_xor(v, o));
    return v;
}

__device__ __forceinline__ int tid_opaque() { int t = threadIdx.x; asm volatile("" : "+v"(t)); return t; }
namespace pg8 {
#define PG8_LAS __attribute__((address_space(3)))
typedef unsigned short bf16_t;
typedef short bf16x8 __attribute__((ext_vector_type(8)));
typedef float f32x4 __attribute__((ext_vector_type(4)));
typedef unsigned u32x4 __attribute__((ext_vector_type(4)));
typedef unsigned u32x2 __attribute__((ext_vector_type(2)));
constexpr int BM = 256, BK = 64, HALF = 128, HTB = HALF * BK * 2, STAGE_BYTES = 8 * HTB, NXCD = 8, WGM = 8;

__host__ __device__ __forceinline__ int lds_byte(int r, int c) { const int st = (r >> 4) * 2 + (c >> 5), rr = r & 15, cc = c & 31, ob = rr * 64 + cc * 2; return st * 1024 + (ob ^ (((ob >> 9) & 1) << 5)); }
__host__ __device__ __forceinline__ void stage_rc(int b, int& R, int& C) { const int st = b / 1024, sb = b % 1024, swz = sb ^ (((sb >> 9) & 1) << 5); R = (st >> 1) * 16 + swz / 64; C = (st & 1) * 32 + (swz % 64) / 2; }

struct Unit { int pm, pn; };
struct Gemm { const bf16_t* A; const bf16_t* Bt; int M, N, K; int lda, ldb; long a_pn_step, b_pn_step; };

struct StaticOrder {
    int nM, nN, nwg, G, c;
    __host__ __device__ __forceinline__ void init(int M, int N, int G_, int c_) { nM = M / BM; nN = N / BM; nwg = nM * nN; G = G_; c = c_; }
    __host__ __device__ __forceinline__ bool next(int i, Unit& u) const {
        const long L = (long)i * G + c; if (L >= nwg) return false;
        int wgid = (int)L; { const int q = nwg / NXCD, r = nwg % NXCD, xcd = wgid % NXCD, off = wgid / NXCD; wgid = (xcd < r ? xcd * (q + 1) : r * (q + 1) + (xcd - r) * q) + off; }
        const int nig = WGM * nN, gid = wgid / nig, fm = gid * WGM, gsz = (nM - fm) < WGM ? (nM - fm) : WGM;
        u.pm = fm + ((wgid % nig) % gsz); u.pn = (wgid % nig) / gsz; return true;
    }
};

__device__ __forceinline__ unsigned cvt_pk_bf16(float lo, float hi) { unsigned r; asm volatile("v_cvt_pk_bf16_f32 %0, %1, %2" : "=v"(r) : "v"(lo), "v"(hi)); return r; }

typedef _Float16 f16x8 __attribute__((ext_vector_type(8)));
template <bool F16> __device__ __forceinline__ f32x4 mma16(bf16x8 a, bf16x8 b, f32x4 c) {
    if constexpr (F16) return __builtin_amdgcn_mfma_f32_16x16x32_f16(__builtin_bit_cast(f16x8, a), __builtin_bit_cast(f16x8, b), c, 0, 0, 0);
    else return __builtin_amdgcn_mfma_f32_16x16x32_bf16(a, b, c, 0, 0, 0);
}
struct PanelOrder {
    int pm0, pn0, nsteps, valid;
    __host__ __device__ __forceinline__ void init(int M, int G_, int c_, int nsteps_) { StaticOrder S; S.init(M, 1024, G_, c_); Unit u; valid = S.next(0, u) ? 1 : 0; pm0 = u.pm; pn0 = u.pn; nsteps = nsteps_; }
    __host__ __device__ __forceinline__ bool next(int i, Unit& u) const { if (!valid || i >= nsteps) return false; u.pm = pm0; u.pn = pn0 + 4 * i; return true; }
};
struct OneUnit { Unit u0; __host__ __device__ __forceinline__ bool next(int i, Unit& u) const { if (i != 0) return false; u = u0; return true; } };
template <bool F16, class Sched, class Epi>
__device__ __forceinline__ void gemm_phase(PG8_LAS unsigned char* lds, const Gemm g, const Sched& S, const Epi& E) {
    int tid = threadIdx.x; asm volatile("" : "+v"(tid));
    const int wid = __builtin_amdgcn_readfirstlane(tid >> 6), lane = tid & 63, wr = wid >> 2, wc = wid & 3, fr = lane & 15, fq = lane >> 4;
    const int K = g.K, nt = K / BK;
    unsigned voffA[2], voffB[2];
#pragma unroll
    for (int i = 0; i < 2; ++i) { int R, C; stage_rc(tid * 16 + i * 8192, R, C);
        voffA[i] = (unsigned)(R * g.lda + C) * 2u; voffB[i] = (unsigned)(R * g.ldb + C) * 2u; }
    const size_t kstep = (size_t)(BK * 2);
    const size_t hstepA = (size_t)HALF * g.lda * 2, hstepB = (size_t)HALF * g.ldb * 2;
    const size_t tstepA = 2 * hstepA;
    const unsigned ldsw = (unsigned)wid * 1024u;
    const int aoff = lds_byte(wr * 64 + fr, fq * 8), boff = lds_byte(wc * 32 + fr, fq * 8);
#define PG8_SA(b, h) (((b) * 2 + (h)) * HTB)
#define PG8_SB(b, h) ((4 + (b) * 2 + (h)) * HTB)
#define PG8_STAGE(bufoff, gbase, voff) do { _Pragma("unroll") for (int _i = 0; _i < 2; ++_i) \
        __builtin_amdgcn_global_load_lds((const unsigned*)((const char*)(gbase) + (voff)[_i]), (PG8_LAS unsigned*)(lds + (bufoff) + ldsw + _i * 8192), 16, 0, 0); } while (0)
#define PG8_LDA(dst, b, h) do { _Pragma("unroll") for (int m = 0; m < 4; ++m) _Pragma("unroll") for (int k = 0; k < 2; ++k) dst[m][k] = *(const PG8_LAS bf16x8*)(lds + PG8_SA(b, h) + aoff + m * 2048 + k * 1024); } while (0)
#define PG8_LDB(dst, b, h) do { _Pragma("unroll") for (int n = 0; n < 2; ++n) _Pragma("unroll") for (int k = 0; k < 2; ++k) dst[n][k] = *(const PG8_LAS bf16x8*)(lds + PG8_SB(b, h) + boff + n * 2048 + k * 1024); } while (0)
#define PG8_MMA(ai, bj, At, Bt) do { __builtin_amdgcn_s_setprio(1); _Pragma("unroll") for (int m = 0; m < 4; ++m) _Pragma("unroll") for (int n = 0; n < 2; ++n) _Pragma("unroll") for (int k = 0; k < 2; ++k) \
        acc[ai][bj][m][n] = mma16<F16>(Bt[n][k], At[m][k], acc[ai][bj][m][n]); __builtin_amdgcn_s_setprio(0); } while (0)
#define PG8_WAIT_V(n) asm volatile("s_waitcnt vmcnt(" #n ")" ::: "memory")
#define PG8_WAIT_L(n) asm volatile("s_waitcnt lgkmcnt(" #n ")" ::: "memory")
#define PG8_BAR __builtin_amdgcn_s_barrier()
#define PG8_SCHED __builtin_amdgcn_sched_barrier(0)
    Unit cur, nxt; int ui = 0;
    if (!S.next(0, cur)) return;
    f32x4 acc[2][2][4][2];
#pragma unroll
    for (int a = 0; a < 2; ++a)
#pragma unroll
        for (int b = 0; b < 2; ++b)
#pragma unroll
            for (int m = 0; m < 4; ++m)
#pragma unroll
                for (int n = 0; n < 2; ++n) acc[a][b][m][n] = (f32x4){0.f, 0.f, 0.f, 0.f};
    bf16x8 At[4][2], B0[2][2], B1[2][2];
    const char* cA = (const char*)g.A + (size_t)cur.pm * tstepA + (size_t)cur.pn * g.a_pn_step * 2; const char* cB = (const char*)g.Bt + (size_t)cur.pn * g.b_pn_step * 2;
    PG8_STAGE(PG8_SB(0, 0), cB, voffB); PG8_STAGE(PG8_SA(0, 0), cA, voffA); PG8_STAGE(PG8_SB(0, 1), cB + hstepB, voffB); PG8_STAGE(PG8_SA(0, 1), cA + hstepA, voffA);
    if (wr == 1) PG8_BAR;
    PG8_WAIT_V(4); PG8_BAR;
    PG8_STAGE(PG8_SB(1, 0), cB + kstep, voffB); PG8_STAGE(PG8_SA(1, 0), cA + kstep, voffA); PG8_STAGE(PG8_SB(1, 1), cB + hstepB + kstep, voffB);
    PG8_WAIT_V(6); PG8_BAR;
    for (;;) {
        const bool has_next = S.next(ui + 1, nxt);
        const char* nA = has_next ? (const char*)g.A + (size_t)nxt.pm * tstepA + (size_t)nxt.pn * g.a_pn_step * 2 : cA; const char* nB = has_next ? (const char*)g.Bt + (size_t)nxt.pn * g.b_pn_step * 2 : cB;
        for (int t = 0; t < nt; t += 2) {
            const bool last = (t == nt - 2);
            const char* a1 = cA + (size_t)(t + 1) * kstep;
            const char* a2 = last ? nA : cA + (size_t)(t + 2) * kstep; const char* b2 = last ? nB : cB + (size_t)(t + 2) * kstep;
            const char* a3 = a2 + kstep; const char* b3 = b2 + kstep;
            PG8_LDB(B0, 0, 0); PG8_SCHED; PG8_LDA(At, 0, 0); PG8_STAGE(PG8_SA(1, 1), a1 + hstepA, voffA);
            PG8_WAIT_L(8); PG8_BAR; PG8_WAIT_L(0); PG8_MMA(0, 0, At, B0); PG8_BAR; PG8_SCHED;
            PG8_LDB(B1, 0, 1); PG8_STAGE(PG8_SB(0, 0), b2, voffB);
            PG8_BAR; PG8_WAIT_L(0); PG8_MMA(0, 1, At, B1); PG8_BAR;
            PG8_LDA(At, 0, 1); PG8_STAGE(PG8_SA(0, 0), a2, voffA);
            PG8_BAR; PG8_WAIT_L(0); PG8_MMA(1, 0, At, B0); PG8_BAR; PG8_SCHED;
            PG8_STAGE(PG8_SB(0, 1), b2 + hstepB, voffB);
            PG8_WAIT_V(6); PG8_BAR; PG8_MMA(1, 1, At, B1); PG8_BAR;
            PG8_LDB(B0, 1, 0); PG8_SCHED; PG8_LDA(At, 1, 0); PG8_STAGE(PG8_SA(0, 1), a2 + hstepA, voffA);
            PG8_WAIT_L(8); PG8_BAR; PG8_WAIT_L(0); PG8_MMA(0, 0, At, B0); PG8_BAR; PG8_SCHED;
            PG8_LDB(B1, 1, 1); PG8_STAGE(PG8_SB(1, 0), b3, voffB);
            PG8_BAR; PG8_WAIT_L(0); PG8_MMA(0, 1, At, B1); PG8_BAR;
            PG8_LDA(At, 1, 1); PG8_STAGE(PG8_SA(1, 0), a3, voffA);
            PG8_BAR; PG8_WAIT_L(0); PG8_MMA(1, 0, At, B0); PG8_BAR; PG8_SCHED;
            PG8_STAGE(PG8_SB(1, 1), b3 + hstepB, voffB);
            PG8_WAIT_V(6); PG8_BAR; PG8_MMA(1, 1, At, B1); PG8_BAR;
        }
        { int fr_ = fr, fq_ = fq; asm volatile("" : "+v"(fr_), "+v"(fq_)); E(acc, cur, wr, wc, fr_, fq_); }
        if (!has_next) break;
#pragma unroll
        for (int a = 0; a < 2; ++a)
#pragma unroll
            for (int b = 0; b < 2; ++b)
#pragma unroll
                for (int m = 0; m < 4; ++m)
#pragma unroll
                    for (int n = 0; n < 2; ++n) acc[a][b][m][n] = (f32x4){0.f, 0.f, 0.f, 0.f};
        cur = nxt; cA = nA; cB = nB; ++ui;
    }
    PG8_WAIT_V(0);
    if (wr == 0) PG8_BAR;
    PG8_BAR;
#undef PG8_SA
#undef PG8_SB
#undef PG8_STAGE
#undef PG8_LDA
#undef PG8_LDB
#undef PG8_MMA
#undef PG8_WAIT_V
#undef PG8_WAIT_L
#undef PG8_BAR
#undef PG8_SCHED
}
}
#define LAS __attribute__((address_space(3)))
#define LDS_WAIT() asm volatile("s_waitcnt lgkmcnt(0)" ::: "memory")
constexpr int NT = 512, NW = 8;

struct Params {
    const float* in[31];
    float* out;
    unsigned char* ws;
};

__device__ __forceinline__ void tr_item(const float* W, int ldw, bf16* WT, int K, int k0, int nphys0, int lbase, int cnt, const float* kg, LAS float* scr, int lane, bool f16 = false) {
    const int c = lane & 31;
#pragma unroll 8
    for (int i = 0; i < 32; ++i) { const int kk = 2 * i + (lane >> 5); float v = 0.f;
        if (c < cnt) { v = W[(size_t)(k0 + kk) * ldw + lbase + c]; if (kg) v *= kg[k0 + kk]; }
        scr[kk * 33 + c] = v; }
    LDS_WAIT();
    const int c8 = lane & 7;
#pragma unroll
    for (int j = 0; j < 4; ++j) { const int n = (lane >> 3) + 8 * j; const LAS float* s = scr + (8 * c8) * 33 + n;
        u32x4 o;
        if (f16) { o.x = pk2h(s[0 * 33], s[1 * 33]); o.y = pk2h(s[2 * 33], s[3 * 33]); o.z = pk2h(s[4 * 33], s[5 * 33]); o.w = pk2h(s[6 * 33], s[7 * 33]); }
        else { o.x = pk2(s[0 * 33], s[1 * 33]); o.y = pk2(s[2 * 33], s[3 * 33]); o.z = pk2(s[4 * 33], s[5 * 33]); o.w = pk2(s[6 * 33], s[7 * 33]); }
        *(u32x4*)(WT + (size_t)(nphys0 + n) * K + k0 + 8 * c8) = o; }
    LDS_WAIT();
}
__device__ __forceinline__ void p1_group(int g, int& lbase, int& cnt) {
    const int tile = g >> 3, gi = g & 7, bj = gi >> 2, wc = gi & 3; cnt = 32;
    if (tile < 2) lbase = COL_Q + (4 * tile + wc) * 64 + 32 * bj;
    else if (tile < 4) lbase = COL_K + (4 * (tile - 2) + wc) * 64 + 32 * bj;
    else if (tile < 6) lbase = COL_V + (tile - 4) * 256 + 32 * gi;
    else if (tile == 6) lbase = COL_IQ + wc * 64 + 32 * bj;
    else if (tile == 7) { if (wc == 0) lbase = COL_IK + 32 * bj; else if (gi == 1) { lbase = COL_IW; cnt = 4; } else { lbase = 0; cnt = 0; } }
    else if (tile < 15) lbase = COL_RW + (tile - 8) * 256 + 32 * gi;
    else lbase = COL_MEMQ + (tile - 15) * 256 + 32 * gi;
}

__device__ __forceinline__ void prologue_phase(const Params& P, LAS unsigned char* lds, int bid, int nblk) {
    const int tid = tid_opaque(), lane = tid & 63, wave = tid >> 6;
    const int gw = bid * NW + wave, NGW = nblk * NW;
    unsigned char* ws = P.ws;
    LAS float* scr = (LAS float*)(lds + wave * 16384);
    constexpr int I_P1 = 16 * (P1_N / 32), I_WG = 16 * 96, I_UP = 8 * 32, I_OUT = 16 * 32, I_WQ = 16 * 64, I_MEM = 16 * 32;
    constexpr int NITEMS = I_P1 + I_WG + 3 * I_UP + I_OUT + I_WQ + I_MEM;
    for (int it = gw; it < NITEMS; it += NGW) {
        int r = it;
        if (r < I_P1) { const int ng = P1_N / 32, kb = r / ng, g = r % ng; int lb, cnt; p1_group(g, lb, cnt);
            tr_item(P.in[4], WIN_COLS, (bf16*)(ws + WS_WIN), 1024, 64 * kb, 32 * g, lb, cnt, P.in[3], scr, lane); continue; } r -= I_P1;
        if (r < I_WG) { const int kb = r / 96, g = r % 96;
            tr_item(P.in[4], WIN_COLS, (bf16*)(ws + WS_WG), 1024, 64 * kb, 32 * g, COL_GATE + 32 * g, 32, P.in[3], scr, lane); continue; } r -= I_WG;
        if (r < 3 * I_UP) { const int c = r / I_UP, rr = r % I_UP, kb = rr / 32, g = rr % 32;
            tr_item(P.in[23] + (size_t)c * 512 * 1024, 1024, (bf16*)(ws + WS_WUP) + (size_t)c * 1024 * 512, 512, 64 * kb, 32 * g, 32 * g, 32, nullptr, scr, lane); continue; } r -= 3 * I_UP;
        if (r < I_OUT) { const int kb = r / 32, g = r % 32;
            tr_item(P.in[24], 1024, (bf16*)(ws + WS_WOUT), 1024, 64 * kb, 32 * g, 32 * g, 32, nullptr, scr, lane); continue; } r -= I_OUT;
        if (r < I_WQ) { const int kb = r / 64, g = r % 64;
            tr_item(P.in[26], 2048, (bf16*)(ws + WS_WQ), 1024, 64 * kb, 32 * g, 32 * g, 32, P.in[25], scr, lane, true); continue; } r -= I_WQ;
        { const int kb = r / 32, g = r % 32;
            tr_item(P.in[9], 1024, (bf16*)(ws + WS_WMEM), 1024, 64 * kb, 32 * g, 32 * g, 32, P.in[8], scr, lane); }
    }
    for (int m = gw; m < S_ + NMEM; m += NGW) {
        const bool isx = m < S_; const int r = isx ? m : m - S_;
        const f32x4* xr = (const f32x4*)((isx ? P.in[0] : P.in[1]) + (size_t)r * D_) + lane;
        f32x4 v[4]; float s = 0.f;
#pragma unroll
        for (int j = 0; j < 4; ++j) { v[j] = xr[64 * j]; s += (v[j].x * v[j].x + v[j].y * v[j].y) + (v[j].z * v[j].z + v[j].w * v[j].w); }
        s = wave_sum(s);
        const float rstd = 1.0f / sqrtf(s * (1.0f / D_) + NORM_EPS);
        if (lane == 0) ((float*)(ws + (isx ? WS_RSTDX : WS_RSTDM)))[r] = rstd;
        unsigned long long* o8 = (unsigned long long*)((bf16*)(ws + (isx ? WS_XB : WS_MB)) + (size_t)r * D_) + lane;
#pragma unroll
        for (int j = 0; j < 4; ++j) o8[64 * j] = (unsigned long long)pk2(v[j].x, v[j].y) | ((unsigned long long)pk2(v[j].z, v[j].w) << 32);
    }
    const int gt = bid * NT + tid, NGT = nblk * NT;
    for (int i = gt; i < S_ * 8; i += NGT) { const int t = i >> 3, f = i & 7;
        const double inv = pow(500000.0, -(double)f / 8.0); const double ang = (double)((const int*)P.in[2])[t] * inv;
        ((float*)(ws + WS_COS))[i] = (float)cos(ang); ((float*)(ws + WS_SIN))[i] = (float)sin(ang); }
    for (int i = gt; i < 256 * 256; i += NGT) { const int n = i >> 8, k = i & 255; float v = 0.f;
        if (n < 128) { if (k < 128) v = P.in[27][n * 128 + k]; } else { if (k >= 128) v = P.in[28][(n - 128) * 128 + (k - 128)]; }
        ((half_t*)(ws + WS_KEYBD))[i] = (half_t)v; }
    for (int i = gt; i < 1536 * 256; i += NGT) { const int n = i >> 8, k = i & 255; float v = 0.f;
        if (n < 512) { if (k < 64) v = P.in[14][k * 512 + n]; }
        else if (n < 1024) { if (k >= 64 && k < 128) v = P.in[16][(k - 64) * 512 + (n - 512)]; }
        else { if (k >= 128) v = P.in[17][(k - 128) * 512 + (n - 1024)]; }
        ((bf16*)(ws + WS_WLORA))[i] = (bf16)f2bf(v); }
}

typedef const f32x4 (&AccRef)[2][2][4][2];
__device__ __forceinline__ void st_bf4(bf16* p, f32x4 v) { u32x2 w; w.x = pk2(v[0], v[1]); w.y = pk2(v[2], v[3]); *(u32x2*)p = w; }
__device__ __forceinline__ void st_h4(half_t* p, f32x4 v) { half4 h; h[0] = (half_t)v[0]; h[1] = (half_t)v[1]; h[2] = (half_t)v[2]; h[3] = (half_t)v[3]; *(half4*)p = h; }

__device__ __forceinline__ f32x4 rope4(f32x4 v, int fq, const float* cs, const float* sn) {
    f32x4 o;
#pragma unroll
    for (int j = 0; j < 4; ++j) { const float p = __shfl_xor(v[j], 32); const int i = 4 * (fq & 1) + j; const float c = cs[i], s = sn[i];
        o[j] = (fq < 2) ? (v[j] * c - p * s) : (v[j] * c + p * s); }
    return o;
}

struct EpiP1 {
    const float* rstd; const float* cs; const float* sn; const float* qgain; const float* kgain;
    bf16 *Q, *K, *V, *RWP, *MEMQ; half_t *IQ, *IK; float* IW;
    __device__ __forceinline__ void operator()(AccRef acc, const pg8::Unit& u, int wr, int wc, int fr, int fq) const {
        const int pn = u.pn;
#pragma unroll
        for (int ai = 0; ai < 2; ++ai)
#pragma unroll
            for (int m = 0; m < 4; ++m) {
                const int row = u.pm * 256 + ai * 128 + wr * 64 + m * 16 + fr; const float rs = rstd[row];
                f32x4 v[2][2];
#pragma unroll
                for (int bj = 0; bj < 2; ++bj)
#pragma unroll
                    for (int n = 0; n < 2; ++n) v[bj][n] = acc[ai][bj][m][n] * rs;
                if (pn < 4) {
                    float ss = 0.f;
#pragma unroll
                    for (int bj = 0; bj < 2; ++bj)
#pragma unroll
                        for (int n = 0; n < 2; ++n) ss += (v[bj][n][0] * v[bj][n][0] + v[bj][n][1] * v[bj][n][1]) + (v[bj][n][2] * v[bj][n][2] + v[bj][n][3] * v[bj][n][3]);
                    ss += __shfl_xor(ss, 16); ss += __shfl_xor(ss, 32);
                    const float rh = 1.0f / sqrtf(ss * (1.0f / 64.0f) + NORM_EPS);
                    const float* gn = (pn < 2) ? qgain : kgain;
#pragma unroll
                    for (int bj = 0; bj < 2; ++bj)
#pragma unroll
                        for (int n = 0; n < 2; ++n) { const f32x4 gv = *(const f32x4*)(gn + 32 * bj + 16 * n + 4 * fq); v[bj][n] = v[bj][n] * rh * gv; }
                    v[0][0] = rope4(v[0][0], fq, cs + row * 8, sn + row * 8);
                    const int head = (pn & 1) * 4 + wc;
                    bf16* dst = (pn < 2) ? (Q + (size_t)row * 512 + head * 64 + 4 * fq) : (K + ((size_t)head * S_ + row) * 64 + 4 * fq);
#pragma unroll
                    for (int bj = 0; bj < 2; ++bj)
#pragma unroll
                        for (int n = 0; n < 2; ++n) st_bf4(dst + 32 * bj + 16 * n, v[bj][n]);
                } else if (pn < 6) {
#pragma unroll
                    for (int bj = 0; bj < 2; ++bj)
#pragma unroll
                        for (int n = 0; n < 2; ++n) { const int head = (pn - 4) * 4 + 2 * bj + (wc >> 1);
                            st_bf4(V + ((size_t)head * S_ + row) * 64 + 32 * (wc & 1) + 16 * n + 4 * fq, v[bj][n]); }
                } else if (pn == 6) {
                    v[0][0] = rope4(v[0][0], fq, cs + row * 8, sn + row * 8);
                    half_t* dst = IQ + (size_t)row * 256 + wc * 64 + 4 * fq;
#pragma unroll
                    for (int bj = 0; bj < 2; ++bj)
#pragma unroll
                        for (int n = 0; n < 2; ++n) st_h4(dst + 32 * bj + 16 * n, v[bj][n]);
                } else if (pn == 7) {
                    if (wc == 0) {
                        v[0][0] = rope4(v[0][0], fq, cs + row * 8, sn + row * 8);
                        half_t* dst = IK + (size_t)row * 64 + 4 * fq;
#pragma unroll
                        for (int bj = 0; bj < 2; ++bj)
#pragma unroll
                            for (int n = 0; n < 2; ++n) st_h4(dst + 32 * bj + 16 * n, v[bj][n]);
                    } else if (wc == 1) { if (fq == 0) *(f32x4*)(IW + (size_t)row * 4) = v[0][0]; }
                } else if (pn < 15) {
                    bf16* dst = RWP + (size_t)row * RW_IN + (pn - 8) * 256 + 32 * wc + 4 * fq;
#pragma unroll
                    for (int bj = 0; bj < 2; ++bj)
#pragma unroll
                        for (int n = 0; n < 2; ++n) st_bf4(dst + 128 * bj + 16 * n, v[bj][n]);
                } else {
                    bf16* dst = MEMQ + (size_t)row * 512 + (pn - 15) * 256 + 32 * wc + 4 * fq;
#pragma unroll
                    for (int bj = 0; bj < 2; ++bj)
#pragma unroll
                        for (int n = 0; n < 2; ++n) st_bf4(dst + 128 * bj + 16 * n, v[bj][n]);
                }
            }
    }
};

struct EpiF32 {
    float* C; int ldc; const float* rstd;
    __device__ __forceinline__ void operator()(AccRef acc, const pg8::Unit& u, int wr, int wc, int fr, int fq) const {
#pragma unroll
        for (int ai = 0; ai < 2; ++ai)
#pragma unroll
            for (int m = 0; m < 4; ++m) { const int row = u.pm * 256 + ai * 128 + wr * 64 + m * 16 + fr; const float rs = rstd ? rstd[row] : 1.0f;
                float* dst = C + (size_t)row * ldc + u.pn * 256 + 32 * wc + 4 * fq;
#pragma unroll
                for (int bj = 0; bj < 2; ++bj)
#pragma unroll
                    for (int n = 0; n < 2; ++n) *(f32x4*)(dst + 128 * bj + 16 * n) = acc[ai][bj][m][n] * rs; }
    }
};
struct EpiBf {
    bf16* C; int ldc; const float* rstd;
    __device__ __forceinline__ void operator()(AccRef acc, const pg8::Unit& u, int wr, int wc, int fr, int fq) const {
#pragma unroll
        for (int ai = 0; ai < 2; ++ai)
#pragma unroll
            for (int m = 0; m < 4; ++m) { const int row = u.pm * 256 + ai * 128 + wr * 64 + m * 16 + fr; const float rs = rstd ? rstd[row] : 1.0f;
                bf16* dst = C + (size_t)row * ldc + u.pn * 256 + 32 * wc + 4 * fq;
#pragma unroll
                for (int bj = 0; bj < 2; ++bj)
#pragma unroll
                    for (int n = 0; n < 2; ++n) st_bf4(dst + 128 * bj + 16 * n, acc[ai][bj][m][n] * rs); }
    }
};
__device__ __forceinline__ float sigmoidf_(float x) { return 1.0f / (1.0f + __expf(-x)); }
struct EpiLora {
    bf16 *E, *A, *G; const float* w0; const float* a0;
    __device__ __forceinline__ void operator()(AccRef acc, const pg8::Unit& u, int wr, int wc, int fr, int fq) const {
        const int kind = u.pn >> 1;
#pragma unroll
        for (int ai = 0; ai < 2; ++ai)
#pragma unroll
            for (int m = 0; m < 4; ++m) { const int row = u.pm * 256 + ai * 128 + wr * 64 + m * 16 + fr;
#pragma unroll
                for (int bj = 0; bj < 2; ++bj)
#pragma unroll
                    for (int n = 0; n < 2; ++n) { const int c = (u.pn & 1) * 256 + 128 * bj + 32 * wc + 16 * n + 4 * fq; f32x4 v = acc[ai][bj][m][n];
                        if (kind == 0) { const f32x4 b = *(const f32x4*)(w0 + c);
#pragma unroll
                            for (int j = 0; j < 4; ++j) { const float z = v[j] + b[j]; const float sp = fmaxf(-z, 0.f) + __logf(1.0f + __expf(-fabsf(z))); v[j] = __expf(-sp - 0.5f); }
                            st_bf4(E + (size_t)row * 512 + c, v);
                        } else if (kind == 1) { const f32x4 b = *(const f32x4*)(a0 + c);
#pragma unroll
                            for (int j = 0; j < 4; ++j) v[j] = sigmoidf_(v[j] + b[j]);
                            st_bf4(A + (size_t)row * 512 + c, v);
                        } else st_bf4(G + (size_t)row * 512 + c, v); } }
    }
};
struct EpiGate {
    bf16* Gt; const float* rstd; const float* bias;
    __device__ __forceinline__ void operator()(AccRef acc, const pg8::Unit& u, int wr, int wc, int fr, int fq) const {
#pragma unroll
        for (int ai = 0; ai < 2; ++ai)
#pragma unroll
            for (int m = 0; m < 4; ++m) { const int row = u.pm * 256 + ai * 128 + wr * 64 + m * 16 + fr; const float rs = rstd[row];
#pragma unroll
                for (int bj = 0; bj < 2; ++bj)
#pragma unroll
                    for (int n = 0; n < 2; ++n) { const int c = u.pn * 256 + 128 * bj + 32 * wc + 16 * n + 4 * fq; const f32x4 b = *(const f32x4*)(bias + c); f32x4 v = acc[ai][bj][m][n] * rs + b;
#pragma unroll
                        for (int j = 0; j < 4; ++j) v[j] = sigmoidf_(v[j]);
                        st_bf4(Gt + (size_t)row * 3072 + c, v); } }
    }
};
struct EpiMerge {
    const bf16* Gt; float* accf; bf16* merged; int c;
    __device__ __forceinline__ void operator()(AccRef acc, const pg8::Unit& u, int wr, int wc, int fr, int fq) const {
#pragma unroll
        for (int ai = 0; ai < 2; ++ai)
#pragma unroll
            for (int m = 0; m < 4; ++m) { const int row = u.pm * 256 + ai * 128 + wr * 64 + m * 16 + fr;
#pragma unroll
                for (int bj = 0; bj < 2; ++bj)
#pragma unroll
                    for (int n = 0; n < 2; ++n) { const int col = u.pn * 256 + 128 * bj + 32 * wc + 16 * n + 4 * fq;
                        const u32x2 gw = *(const u32x2*)(Gt + (size_t)row * 3072 + c * 1024 + col);
                        f32x4 v = acc[ai][bj][m][n]; v[0] *= bflo(gw.x); v[1] *= bfhi(gw.x); v[2] *= bflo(gw.y); v[3] *= bfhi(gw.y);
                        float* ap = accf + (size_t)row * 1024 + col;
                        if (c > 0) v = v + *(const f32x4*)ap;
                        if (c < 2) *(f32x4*)ap = v; else st_bf4(merged + (size_t)row * 1024 + col, v); } }
    }
};
struct EpiOut {
    const float* x; float* out; bf16* HB; float* HSQ;
    __device__ __forceinline__ void operator()(AccRef acc, const pg8::Unit& u, int wr, int wc, int fr, int fq) const {
#pragma unroll
        for (int ai = 0; ai < 2; ++ai)
#pragma unroll
            for (int m = 0; m < 4; ++m) { const int row = u.pm * 256 + ai * 128 + wr * 64 + m * 16 + fr; float ss = 0.f;
#pragma unroll
                for (int bj = 0; bj < 2; ++bj)
#pragma unroll
                    for (int n = 0; n < 2; ++n) { const size_t o = (size_t)row * 1024 + u.pn * 256 + 128 * bj + 32 * wc + 16 * n + 4 * fq;
                        const f32x4 v = acc[ai][bj][m][n] + *(const f32x4*)(x + o); *(f32x4*)(out + o) = v; st_h4((half_t*)HB + o, v);
                        ss += (v[0] * v[0] + v[1] * v[1]) + (v[2] * v[2] + v[3] * v[3]); }
                ss += __shfl_xor(ss, 16); ss += __shfl_xor(ss, 32);
                if (fq == 0) HSQ[(size_t)row * 16 + u.pn * 4 + wc] = ss; }
    }
};

__device__ __forceinline__ float rstd_h_row(const float* HSQ, int row) {
    const f32x4* hp = (const f32x4*)(HSQ + (size_t)row * 16); const f32x4 a = hp[0], b = hp[1], c = hp[2], d = hp[3];
    const float s = ((a[0] + a[1]) + (a[2] + a[3])) + ((b[0] + b[1]) + (b[2] + b[3])) + ((c[0] + c[1]) + (c[2] + c[3])) + ((d[0] + d[1]) + (d[2] + d[3]));
    return 1.0f / sqrtf(s * (1.0f / 1024.0f) + NORM_EPS);
}
__device__ __forceinline__ void lora_in_phase(const Params& P, int bid, int nblk) {
    const bf16* RWP = (const bf16*)(P.ws + WS_RWP); bf16* LIN = (bf16*)((unsigned char*)P.out + DO_LIN); const float* mu = P.in[12];
    const int gt = bid * NT + tid_opaque(), NGT = nblk * NT;
    for (int i = gt; i < S_ * 64; i += NGT) { const int t = i >> 6, c4 = (i & 63) * 4;
        const u32x2 pw = *(const u32x2*)(RWP + (size_t)t * RW_IN + 1536 + c4);
        u32x2 qw; qw.x = 0u; qw.y = 0u; if (t > 0) qw = *(const u32x2*)(RWP + (size_t)(t - 1) * RW_IN + 1536 + c4);
        const f32x4 m4 = *(const f32x4*)(mu + 1536 + c4);
        f32x4 p = {bflo(pw.x), bfhi(pw.x), bflo(pw.y), bfhi(pw.y)}, q = {bflo(qw.x), bfhi(qw.x), bflo(qw.y), bfhi(qw.y)};
        f32x4 s = p + (q - p) * m4;
        if (c4 < 64) { for (int j = 0; j < 4; ++j) s[j] = tanhf(s[j]); }
        else if (c4 >= 128) { for (int j = 0; j < 4; ++j) s[j] = sigmoidf_(s[j]); }
        st_bf4(LIN + (size_t)t * 256 + c4, s); }
}

constexpr int TC = 32;
__device__ __forceinline__ float shift3(const bf16* RWP, const float* mu, int t, int col) {
    const float p = bf2f(RWP[(size_t)t * RW_IN + col]); const float q = t > 0 ? bf2f(RWP[(size_t)(t - 1) * RW_IN + col]) : 0.f;
    return p + (q - p) * mu[col];
}
__device__ __forceinline__ void rwkv_scan_v1(const Params& P, LAS unsigned char* lds, int h) {
    const bf16* RWP = (const bf16*)(P.ws + WS_RWP);
    const bf16* Eb = (const bf16*)((unsigned char*)P.out + DO_E); const bf16* Ab = (const bf16*)((unsigned char*)P.out + DO_A); const bf16* Gb = (const bf16*)((unsigned char*)P.out + DO_G);
    bf16* Y = (bf16*)(P.ws + WS_Y);
    const float* mu = P.in[12]; const float* k_k = P.in[18]; const float* k_a = P.in[19]; const float* r_k = P.in[20]; const float* ln_w = P.in[21]; const float* ln_b = P.in[22];
    LAS float* sR = (LAS float*)lds; LAS float* sW = sR + TC * 64; LAS float* sK = sW + TC * 64; LAS float* sV = sK + TC * 64;
    LAS float* sA = sV + TC * 64; LAS float* sB = sA + TC * 64; LAS float* sY = sB + TC * 64; LAS float* sG = sY + TC * 64;
    const int tid = tid_opaque();
    const int tok = tid >> 4, j0 = (tid & 15) * 4;
    const int si = tid >> 3, jg = tid & 7;
    float S[8];
#pragma unroll
    for (int c = 0; c < 8; ++c) S[c] = 0.f;
    for (int t0 = 0; t0 < S_; t0 += TC) {
        {
            const int t = t0 + tok; float kkv[4], ss = 0.f, rr[4], kk_[4], vv[4], aa[4], ee[4], gg[4];
#pragma unroll
            for (int j = 0; j < 4; ++j) { const int c = h * 64 + j0 + j;
                rr[j] = shift3(RWP, mu, t, c); kk_[j] = shift3(RWP, mu, t, 512 + c); vv[j] = shift3(RWP, mu, t, 1024 + c);
                aa[j] = bf2f(Ab[(size_t)t * 512 + c]); ee[j] = bf2f(Eb[(size_t)t * 512 + c]); gg[j] = bf2f(Gb[(size_t)t * 512 + c]);
                kkv[j] = kk_[j] * k_k[c]; ss += kkv[j] * kkv[j]; }
            ss += __shfl_xor(ss, 1); ss += __shfl_xor(ss, 2); ss += __shfl_xor(ss, 4); ss += __shfl_xor(ss, 8);
            const float inv = 1.0f / fmaxf(sqrtf(ss), 1e-12f);
#pragma unroll
            for (int j = 0; j < 4; ++j) { const int c = h * 64 + j0 + j; const int o = tok * 64 + j0 + j; const float kn = kkv[j] * inv;
                sR[o] = rr[j]; sW[o] = __expf(-ee[j]); sK[o] = kk_[j] * (1.0f + (aa[j] - 1.0f) * k_a[c]); sV[o] = vv[j]; sA[o] = -kn; sB[o] = kn * aa[j]; sG[o] = gg[j]; }
        }
        __syncthreads();
        for (int tt = 0; tt < TC; ++tt) {
            const LAS float* pa = sA + tt * 64 + 8 * jg; const LAS float* pb = sB + tt * 64 + 8 * jg; const LAS float* pw = sW + tt * 64 + 8 * jg;
            const LAS float* pk = sK + tt * 64 + 8 * jg; const LAS float* pr = sR + tt * 64 + 8 * jg;
            const float vi = sV[tt * 64 + si];
            float sa = 0.f;
#pragma unroll
            for (int c = 0; c < 8; ++c) sa += S[c] * pa[c];
            sa += __shfl_xor(sa, 1); sa += __shfl_xor(sa, 2); sa += __shfl_xor(sa, 4);
            float y = 0.f;
#pragma unroll
            for (int c = 0; c < 8; ++c) { S[c] = S[c] * pw[c] + sa * pb[c] + vi * pk[c]; y += S[c] * pr[c]; }
            y += __shfl_xor(y, 1); y += __shfl_xor(y, 2); y += __shfl_xor(y, 4);
            if (jg == 0) sY[tt * 64 + si] = y;
        }
        __syncthreads();
        {
            const int t = t0 + tok; float y4[4], s1 = 0.f, bon = 0.f;
#pragma unroll
            for (int j = 0; j < 4; ++j) { const int o = tok * 64 + j0 + j; y4[j] = sY[o]; s1 += y4[j]; bon += sR[o] * sK[o] * r_k[h * 64 + j0 + j]; }
            s1 += __shfl_xor(s1, 1); s1 += __shfl_xor(s1, 2); s1 += __shfl_xor(s1, 4); s1 += __shfl_xor(s1, 8);
            bon += __shfl_xor(bon, 1); bon += __shfl_xor(bon, 2); bon += __shfl_xor(bon, 4); bon += __shfl_xor(bon, 8);
            const float mean = s1 * (1.0f / 64.0f); float s2 = 0.f;
#pragma unroll
            for (int j = 0; j < 4; ++j) { const float d = y4[j] - mean; s2 += d * d; }
            s2 += __shfl_xor(s2, 1); s2 += __shfl_xor(s2, 2); s2 += __shfl_xor(s2, 4); s2 += __shfl_xor(s2, 8);
            const float rstd = 1.0f / sqrtf(s2 * (1.0f / 64.0f) + GN_EPS);
            f32x4 o4;
#pragma unroll
            for (int j = 0; j < 4; ++j) { const int c = h * 64 + j0 + j; const int o = tok * 64 + j0 + j;
                o4[j] = ((y4[j] - mean) * rstd * ln_w[c] + ln_b[c] + bon * sV[o]) * sG[o]; }
            st_bf4(Y + (size_t)t * 1536 + 512 + h * 64 + j0, o4);
        }
        __syncthreads();
    }
}

__device__ __forceinline__ unsigned ordkey(float f) { const unsigned u = __builtin_bit_cast(unsigned, f); return (u & 0x80000000u) ? ~u : (u | 0x80000000u); }
constexpr int DSA_LDS_SCORES = 0, DSA_LDS_IQ = 65536, DSA_LDS_HIST = DSA_LDS_IQ + 1024, DSA_LDS_MISC = DSA_LDS_HIST + 1024, DSA_LDS_SEL = DSA_LDS_MISC + 256,
              DSA_LDS_O = DSA_LDS_SEL + 1024, DSA_LDS_ML = DSA_LDS_O + 8 * 512 * 4, DSA_LDS_END = DSA_LDS_ML + 8 * 8 * 2 * 4;
__device__ __forceinline__ void dsa_query_v1(const Params& P, LAS unsigned char* lds, int t) {
    const half_t* IQ = (const half_t*)(P.ws + WS_IQ); const half_t* IK = (const half_t*)(P.ws + WS_IK); const float* IW = (const float*)(P.ws + WS_IW);
    const bf16* Q = (const bf16*)(P.ws + WS_Q); const bf16* Kb = (const bf16*)(P.ws + WS_K); const bf16* Vb = (const bf16*)(P.ws + WS_V);
    bf16* Y = (bf16*)(P.ws + WS_Y);
    LAS float* sc = (LAS float*)(lds + DSA_LDS_SCORES); LAS float* siq = (LAS float*)(lds + DSA_LDS_IQ); LAS unsigned* hist = (LAS unsigned*)(lds + DSA_LDS_HIST);
    LAS unsigned* misc = (LAS unsigned*)(lds + DSA_LDS_MISC); LAS unsigned* sel = (LAS unsigned*)(lds + DSA_LDS_SEL);
    LAS float* so = (LAS float*)(lds + DSA_LDS_O); LAS float* sml = (LAS float*)(lds + DSA_LDS_ML);
    const int tid = tid_opaque(), lane = tid & 63, wave = tid >> 6;
    const int n = t + 1;
    if (tid < 256) siq[tid] = (float)IQ[(size_t)t * 256 + tid];
    if (tid < 256) sel[tid] = 0xFFFFu;
    __syncthreads();
    float w4[4];
#pragma unroll
    for (int hh = 0; hh < 4; ++hh) w4[hh] = IW[(size_t)t * 4 + hh] * 0.0625f;
    for (int s = tid; s < n; s += NT) {
        const half8* kp = (const half8*)(IK + (size_t)s * 64);
        float d0 = 0.f, d1 = 0.f, d2 = 0.f, d3 = 0.f;
#pragma unroll
        for (int c = 0; c < 8; ++c) { const half8 kv = kp[c];
#pragma unroll
            for (int j = 0; j < 8; ++j) { const float kf = (float)kv[j]; const int d = c * 8 + j;
                d0 += siq[d] * kf; d1 += siq[64 + d] * kf; d2 += siq[128 + d] * kf; d3 += siq[192 + d] * kf; } }
        float v = w4[0] * fmaxf(d0, 0.f) + w4[1] * fmaxf(d1, 0.f) + w4[2] * fmaxf(d2, 0.f) + w4[3] * fmaxf(d3, 0.f);
        sc[s] = v + 0.0f;
    }
    __syncthreads();
    if (n <= 256) { if (tid < n) sel[tid] = (unsigned)tid; __syncthreads(); }
    else {
        unsigned prefix = 0u, krem = 256u;
        for (int pass = 3; pass >= 0; --pass) {
            const int shift = pass * 8;
            if (tid < 256) hist[tid] = 0u;
            __syncthreads();
            for (int s = tid; s < n; s += NT) { const unsigned k = ordkey(sc[s]);
                if (pass == 3 || (k >> (shift + 8)) == (prefix >> (shift + 8))) atomicAdd((unsigned*)&hist[(k >> shift) & 255u], 1u); }
            __syncthreads();
            if (tid == 0) { unsigned cum = 0u; int b = 255; for (; b > 0; --b) { const unsigned hb = hist[b]; if (cum + hb >= krem) break; cum += hb; }
                misc[0] = prefix | ((unsigned)b << shift); misc[1] = krem - cum; }
            __syncthreads();
            prefix = misc[0]; krem = misc[1];
            __syncthreads();
        }
        const unsigned T = prefix; unsigned selbase = 0u, eqbase = 0u;
        for (int c0 = 0; c0 < n; c0 += NT) {
            const int s = c0 + tid; const unsigned k = (s < n) ? ordkey(sc[s]) : 0u; const bool gt = (s < n) && k > T, eq = (s < n) && k == T;
            const unsigned long long beq = __ballot(eq); const unsigned eqpre = __popcll(beq & ((1ull << lane) - 1ull));
            if (lane == 0) misc[8 + wave] = (unsigned)__popcll(beq);
            __syncthreads();
            unsigned eqoff = eqbase, eqtot = 0u;
#pragma unroll
            for (int w = 0; w < 8; ++w) { const unsigned cw = misc[8 + w]; if (w < wave) eqoff += cw; eqtot += cw; }
            const bool take = gt || (eq && (eqoff + eqpre) < krem);
            const unsigned long long bt = __ballot(take); const unsigned tpre = __popcll(bt & ((1ull << lane) - 1ull));
            if (lane == 0) misc[16 + wave] = (unsigned)__popcll(bt);
            __syncthreads();
            unsigned toff = selbase, ttot = 0u;
#pragma unroll
            for (int w = 0; w < 8; ++w) { const unsigned cw = misc[16 + w]; if (w < wave) toff += cw; ttot += cw; }
            if (take && (toff + tpre) < 256u) sel[toff + tpre] = (unsigned)s;
            selbase += ttot; eqbase += eqtot;
            __syncthreads();
        }
    }
    {
        u16* SEL = (u16*)(P.ws + WS_SEL);
        if (tid < 256) SEL[(size_t)t * 256 + tid] = (u16)sel[tid];
        const u32x4 qw = *(const u32x4*)(Q + (size_t)t * 512 + 8 * lane);
        float q[8] = {bflo(qw.x), bfhi(qw.x), bflo(qw.y), bfhi(qw.y), bflo(qw.z), bfhi(qw.z), bflo(qw.w), bfhi(qw.w)};
        float lg[32]; float mx = -INFINITY;
#pragma unroll
        for (int i = 0; i < 32; ++i) { const unsigned id = sel[wave * 32 + i];
            float d = -INFINITY;
            if (id != 0xFFFFu) { const u32x4 kw = *(const u32x4*)(Kb + (size_t)id * 512 + 8 * lane);
                d = q[0] * bflo(kw.x) + q[1] * bfhi(kw.x) + q[2] * bflo(kw.y) + q[3] * bfhi(kw.y) + q[4] * bflo(kw.z) + q[5] * bfhi(kw.z) + q[6] * bflo(kw.w) + q[7] * bfhi(kw.w);
                d += __shfl_xor(d, 1); d += __shfl_xor(d, 2); d += __shfl_xor(d, 4); d *= 0.125f; }
            lg[i] = d; mx = fmaxf(mx, d); }
        float l = 0.f, o[8];
#pragma unroll
        for (int c = 0; c < 8; ++c) o[c] = 0.f;
#pragma unroll
        for (int i = 0; i < 32; ++i) { const unsigned id = sel[wave * 32 + i];
            if (id != 0xFFFFu) { const float p = __expf(lg[i] - mx); l += p;
                const u32x4 vw = *(const u32x4*)(Vb + (size_t)id * 512 + 8 * lane);
                o[0] += p * bflo(vw.x); o[1] += p * bfhi(vw.x); o[2] += p * bflo(vw.y); o[3] += p * bfhi(vw.y); o[4] += p * bflo(vw.z); o[5] += p * bfhi(vw.z); o[6] += p * bflo(vw.w); o[7] += p * bfhi(vw.w); } }
#pragma unroll
        for (int c = 0; c < 8; ++c) so[wave * 512 + 8 * lane + c] = o[c];
        if ((lane & 7) == 0) { sml[(wave * 8 + (lane >> 3)) * 2] = mx; sml[(wave * 8 + (lane >> 3)) * 2 + 1] = l; }
        __syncthreads();
        {
            const int hh = tid >> 6; float M = -INFINITY;
#pragma unroll
            for (int w = 0; w < 8; ++w) M = fmaxf(M, sml[(w * 8 + hh) * 2]);
            float L = 0.f, acc = 0.f;
#pragma unroll
            for (int w = 0; w < 8; ++w) { const float mw = sml[(w * 8 + hh) * 2]; const float f = (mw == -INFINITY) ? 0.f : __expf(mw - M); L += f * sml[(w * 8 + hh) * 2 + 1]; acc += f * so[w * 512 + tid]; }
            Y[(size_t)t * 1536 + tid] = (bf16)f2bf(acc / L);
        }
        __syncthreads();
    }
}

constexpr int MA_KSTRIDE = 264;
constexpr int MA_LDS_K = 0, MA_LDS_V = 256 * MA_KSTRIDE, MA_LDS_P = MA_LDS_V + 256 * 256, MA_LDS_Q = MA_LDS_P + 8 * 256 * 4, MA_LDS_END = MA_LDS_Q + 8 * 128 * 4;
__device__ __forceinline__ void mem_attn_phase(const Params& P, LAS unsigned char* lds, int bid, int nblk) {
    const float* KMVM = (const float*)(P.ws + WS_KMVM); const bf16* MEMQ = (const bf16*)(P.ws + WS_MEMQ); bf16* Y = (bf16*)(P.ws + WS_Y);
    const float* qg = P.in[10]; const float* kg = P.in[11];
    const int tid = tid_opaque(), lane = tid & 63, wave = tid >> 6;
    const int h = bid & 3, sub = bid >> 2, nsub = nblk >> 2;
    for (int r = wave; r < 256; r += NW) {
        const f32x2 kv = *(const f32x2*)(KMVM + (size_t)r * 1024 + h * 128 + 2 * lane);
        const float ss = wave_sum(kv.x * kv.x + kv.y * kv.y); const float rk = 1.0f / sqrtf(ss * (1.0f / 128.0f) + NORM_EPS);
        *(LAS unsigned*)(lds + MA_LDS_K + r * MA_KSTRIDE + 4 * lane) = pk2(kv.x * rk * kg[2 * lane], kv.y * rk * kg[2 * lane + 1]);
        const f32x2 vv = *(const f32x2*)(KMVM + (size_t)r * 1024 + 512 + h * 128 + 2 * lane);
        *(LAS unsigned*)(lds + MA_LDS_V + r * 256 + 4 * lane) = pk2(vv.x, vv.y);
    }
    __syncthreads();
    LAS float* pb = (LAS float*)(lds + MA_LDS_P) + wave * 256; LAS float* qb = (LAS float*)(lds + MA_LDS_Q) + wave * 128;
    for (int r = sub * NW + wave; r < S_; r += nsub * NW) {
        const unsigned qw = *(const unsigned*)(MEMQ + (size_t)r * 512 + h * 128 + 2 * lane);
        const float q0 = bflo(qw), q1 = bfhi(qw);
        const float ss = wave_sum(q0 * q0 + q1 * q1); const float rq = 1.0f / sqrtf(ss * (1.0f / 128.0f) + NORM_EPS) * 0.08838834764831845f;
        qb[2 * lane] = q0 * rq * qg[2 * lane]; qb[2 * lane + 1] = q1 * rq * qg[2 * lane + 1];
        LDS_WAIT(); __builtin_amdgcn_wave_barrier();
        float lg[4] = {0.f, 0.f, 0.f, 0.f};
#pragma unroll 4
        for (int d4 = 0; d4 < 32; ++d4) { const f32x4 qv = *(const LAS f32x4*)(qb + 4 * d4);
#pragma unroll
            for (int c = 0; c < 4; ++c) { const u32x2 kw = *(const LAS u32x2*)(lds + MA_LDS_K + (lane + 64 * c) * MA_KSTRIDE + 8 * d4);
                lg[c] += qv[0] * bflo(kw.x) + qv[1] * bfhi(kw.x) + qv[2] * bflo(kw.y) + qv[3] * bfhi(kw.y); } }
        const float mx = wave_max(fmaxf(fmaxf(lg[0], lg[1]), fmaxf(lg[2], lg[3])));
        float p[4], l = 0.f;
#pragma unroll
        for (int c = 0; c < 4; ++c) { p[c] = __expf(lg[c] - mx); l += p[c]; }
        l = wave_sum(l); const float il = 1.0f / l;
#pragma unroll
        for (int c = 0; c < 4; ++c) pb[lane + 64 * c] = p[c] * il;
        LDS_WAIT(); __builtin_amdgcn_wave_barrier();
        float o0 = 0.f, o1 = 0.f;
#pragma unroll 8
        for (int k4 = 0; k4 < 64; ++k4) { const f32x4 pv = *(const LAS f32x4*)(pb + 4 * k4);
#pragma unroll
            for (int c = 0; c < 4; ++c) { const unsigned vw = *(const LAS unsigned*)(lds + MA_LDS_V + (4 * k4 + c) * 256 + 4 * lane); o0 += pv[c] * bflo(vw); o1 += pv[c] * bfhi(vw); } }
        *(unsigned*)(Y + (size_t)r * 1536 + 1024 + h * 128 + 2 * lane) = pk2(o0, o1);
        LDS_WAIT(); __builtin_amdgcn_wave_barrier();
    }
}

__device__ __forceinline__ void rstdh_phase(const Params& P, int bid, int nblk) {
    const float* HSQ = (const float*)(P.ws + WS_HSQ); float* R = (float*)(P.ws + WS_RSTDH);
    for (int r = bid * NT + tid_opaque(); r < S_; r += nblk * NT) { float s = 0.f;
#pragma unroll
        for (int i = 0; i < 16; ++i) s += HSQ[(size_t)r * 16 + i];
        R[r] = 1.0f / sqrtf(s * (1.0f / 1024.0f) + NORM_EPS); }
}
#define BUBBLE16(v, ix, x, c) do { if ((x) > v[15]) { v[15] = (x); ix[15] = (c); _Pragma("unroll") for (int _p = 15; _p > 0; --_p) { \
        const bool _sw = v[_p] > v[_p - 1]; const float _a = v[_p], _b = v[_p - 1]; const int _ia = ix[_p], _ib = ix[_p - 1]; \
        v[_p] = _sw ? _b : _a; v[_p - 1] = _sw ? _a : _b; ix[_p] = _sw ? _ib : _ia; ix[_p - 1] = _sw ? _ia : _ib; } } } while (0)
__device__ __forceinline__ void peer_topk_phase(const Params& P, LAS unsigned char* lds, int h, int bid, int nblk) {
    const float* SC = (const float*)(P.ws + WS_SC); int* EIDX = (int*)(P.ws + WS_EIDX); float* EG = (float*)(P.ws + WS_EGATE);
    LAS float* sv = (LAS float*)lds; LAS int* sx = (LAS int*)(lds + 256 * 2 * 16 * 4);
    const int tid = tid_opaque(), rl = tid >> 1, half = tid & 1;
    for (int r0 = bid * 256; r0 < S_; r0 += nblk * 256) {
        const int row = r0 + rl;
        float v[16]; int ix[16];
#pragma unroll
        for (int p = 0; p < 16; ++p) { v[p] = -INFINITY; ix[p] = 0; }
        const f32x4* sp = (const f32x4*)(SC + (size_t)row * 256 + half * 128);
        for (int c4 = 0; c4 < 32; ++c4) { const f32x4 x = sp[c4];
#pragma unroll
            for (int j = 0; j < 4; ++j) { const float xv = x[j]; const int cc = 4 * c4 + j; BUBBLE16(v, ix, xv, cc); } }
#pragma unroll
        for (int p = 0; p < 16; ++p) { sv[(rl * 2 + half) * 16 + p] = v[p]; sx[(rl * 2 + half) * 16 + p] = ix[p]; }
        __syncthreads();
        if (half == 0) {
            float cv[16]; int ci[16];
#pragma unroll
            for (int p = 0; p < 16; ++p) { cv[p] = -INFINITY; ci[p] = 0; }
            for (int i = 0; i < 16; ++i) { const float a = sv[(rl * 2) * 16 + i];
                for (int j = 0; j < 16; ++j) { const float s = a + sv[(rl * 2 + 1) * 16 + j]; const int f = i * 16 + j; BUBBLE16(cv, ci, s, f); } }
            float l = 0.f, pe[16];
#pragma unroll
            for (int p = 0; p < 16; ++p) { pe[p] = __expf(cv[p] - cv[0]); l += pe[p]; }
            const float il = 1.0f / l;
#pragma unroll
            for (int p = 0; p < 16; ++p) { const int e1 = sx[(rl * 2) * 16 + (ci[p] >> 4)], e2 = sx[(rl * 2 + 1) * 16 + (ci[p] & 15)];
                EIDX[(size_t)row * 128 + h * 16 + p] = e1 * 128 + e2; EG[(size_t)row * 128 + h * 16 + p] = pe[p] * il; }
        }
        __syncthreads();
    }
}
__device__ __forceinline__ void peer_expert_phase_v1(const Params& P, int bid, int nblk) {
    const int* EIDX = (const int*)(P.ws + WS_EIDX); const float* EG = (const float*)(P.ws + WS_EGATE); const float* HSQ = (const float*)(P.ws + WS_HSQ);
    const float* U = P.in[29]; const float* Vt = P.in[30]; const float* gain = P.in[25];
    const int tid = tid_opaque(), lane = tid & 63, wave = tid >> 6;
    for (int row = bid * NW + wave; row < S_; row += nblk * NW) {
        float* hp = P.out + (size_t)row * 1024; const float rs = rstd_h_row(HSQ, row);
        f32x4 hv[4], xn[4], o[4];
#pragma unroll
        for (int j = 0; j < 4; ++j) { hv[j] = *(const f32x4*)(hp + 4 * lane + 256 * j); xn[j] = hv[j] * rs * *(const f32x4*)(gain + 4 * lane + 256 * j); o[j] = (f32x4){0.f, 0.f, 0.f, 0.f}; }
        const int e_lo = EIDX[(size_t)row * 128 + lane], e_hi = EIDX[(size_t)row * 128 + 64 + lane];
        const float g_lo = EG[(size_t)row * 128 + lane], g_hi = EG[(size_t)row * 128 + 64 + lane];
        for (int e = 0; e < 128; ++e) {
            const int idx = __shfl((e < 64) ? e_lo : e_hi, e & 63); const float gt = __shfl((e < 64) ? g_lo : g_hi, e & 63);
            const float* up = U + (size_t)idx * 1024; float d = 0.f;
#pragma unroll
            for (int j = 0; j < 4; ++j) { const f32x4 uv = *(const f32x4*)(up + 4 * lane + 256 * j); d += (xn[j][0] * uv[0] + xn[j][1] * uv[1]) + (xn[j][2] * uv[2] + xn[j][3] * uv[3]); }
            d = wave_sum(d);
            const float w = gt * 0.5f * d * (1.0f + erff(d * 0.70710678118654752f));
            const float* vp = Vt + (size_t)idx * 1024;
#pragma unroll
            for (int j = 0; j < 4; ++j) o[j] = o[j] + *(const f32x4*)(vp + 4 * lane + 256 * j) * w;
        }
#pragma unroll
        for (int j = 0; j < 4; ++j) *(f32x4*)(hp + 4 * lane + 256 * j) = hv[j] + o[j];
    }
}
struct EpiPQ {
    half_t* PQ; const float* HSQ;
    __device__ __forceinline__ void operator()(AccRef acc, const pg8::Unit& u, int wr, int wc, int fr, int fq) const {
#pragma unroll
        for (int ai = 0; ai < 2; ++ai)
#pragma unroll
            for (int m = 0; m < 4; ++m) { const int row = u.pm * 256 + ai * 128 + wr * 64 + m * 16 + fr;
                const f32x4* hp = (const f32x4*)(HSQ + (size_t)row * 16); const f32x4 a = hp[0], b = hp[1], c = hp[2], d = hp[3];
                const float s = ((a[0] + a[1]) + (a[2] + a[3])) + ((b[0] + b[1]) + (b[2] + b[3])) + ((c[0] + c[1]) + (c[2] + c[3])) + ((d[0] + d[1]) + (d[2] + d[3]));
                const float rs = 1.0f / sqrtf(s * (1.0f / 1024.0f) + NORM_EPS);
                half_t* dst = PQ + (size_t)row * 2048 + u.pn * 256 + 32 * wc + 4 * fq;
#pragma unroll
                for (int bj = 0; bj < 2; ++bj)
#pragma unroll
                    for (int n = 0; n < 2; ++n) st_h4(dst + 128 * bj + 16 * n, acc[ai][bj][m][n] * rs); }
    }
};
#define PEER_CAND(I, J) do { if (((I) + 1) * ((J) + 1) <= 16) { const float _s = v1[I] + v2[J]; const int _e = i1[I] * 128 + i2[J]; BUBBLE16(cv, ce, _s, _e); } } while (0)
__device__ __forceinline__ void peer_topk_tile(const float* scr, int pm, int head, int* EIDX, float* EG) {
    const int tid = tid_opaque(), lrow = tid >> 1, kh = tid & 1;
    float v[16]; int ix[16];
#pragma unroll
    for (int p = 0; p < 16; ++p) { v[p] = -INFINITY; ix[p] = 0; }
    const f32x4* sp = (const f32x4*)(scr + (size_t)lrow * 256 + kh * 128);
#pragma unroll 1
    for (int c4 = 0; c4 < 32; ++c4) { const f32x4 x = sp[c4];
#pragma unroll
        for (int j = 0; j < 4; ++j) { const float xv = x[j]; const int cc = 4 * c4 + j; BUBBLE16(v, ix, xv, cc); } }
    float v1[16], v2[16]; int i1[16], i2[16];
#pragma unroll
    for (int p = 0; p < 16; ++p) { const float ov = __shfl_xor(v[p], 1); const int oi = __shfl_xor(ix[p], 1);
        v1[p] = kh ? ov : v[p]; i1[p] = kh ? oi : ix[p]; v2[p] = kh ? v[p] : ov; i2[p] = kh ? ix[p] : oi; }
    float cv[16]; int ce[16];
#pragma unroll
    for (int p = 0; p < 16; ++p) { cv[p] = -INFINITY; ce[p] = 0; }
#pragma unroll
    for (int I = 0; I < 16; ++I) {
#pragma unroll
        for (int J = 0; J < 16; ++J) PEER_CAND(I, J); }
    if (kh == 0) {
        float l = 0.f, pe[16];
#pragma unroll
        for (int p = 0; p < 16; ++p) { pe[p] = __expf(cv[p] - cv[0]); l += pe[p]; }
        const float il = 1.0f / l; const int row = pm * 256 + lrow;
        int* ep = EIDX + (size_t)row * 128 + head * 16; float* gp = EG + (size_t)row * 128 + head * 16;
#pragma unroll
        for (int p4 = 0; p4 < 4; ++p4) { *(f32x4*)(gp + 4 * p4) = (f32x4){pe[4 * p4] * il, pe[4 * p4 + 1] * il, pe[4 * p4 + 2] * il, pe[4 * p4 + 3] * il};
            typedef int i32x4 __attribute__((ext_vector_type(4))); *(i32x4*)(ep + 4 * p4) = (i32x4){ce[4 * p4], ce[4 * p4 + 1], ce[4 * p4 + 2], ce[4 * p4 + 3]}; }
    }
}
struct EpiTile {
    float* scr;
    __device__ __forceinline__ void operator()(AccRef acc, const pg8::Unit& u, int wr, int wc, int fr, int fq) const {
#pragma unroll
        for (int ai = 0; ai < 2; ++ai)
#pragma unroll
            for (int m = 0; m < 4; ++m) { float* dst = scr + (size_t)(ai * 128 + wr * 64 + m * 16 + fr) * 256 + 32 * wc + 4 * fq;
#pragma unroll
                for (int bj = 0; bj < 2; ++bj)
#pragma unroll
                    for (int n = 0; n < 2; ++n) *(f32x4*)(dst + 128 * bj + 16 * n) = acc[ai][bj][m][n]; }
    }
};
typedef _Float16 h8 __attribute__((ext_vector_type(8)));
constexpr int DQ = 16, DCAP = 1024, DSTEP_TILES = 16;
constexpr int DA_CS = 0, DA_CI = DQ * DCAP * 4, DA_CNT = DA_CI + DQ * DCAP * 2, DA_TAU = DA_CNT + 64, DA_HIST = DA_TAU + 64, DA_SELST = DA_HIST + 8 * 256 * 4, DA_END = DA_SELST + 8 * 512;
__device__ __forceinline__ float inv_ordkey(unsigned u) { return __builtin_bit_cast(float, (u & 0x80000000u) ? (u & 0x7fffffffu) : ~u); }

__device__ __forceinline__ void dsa_compact(LAS unsigned char* lds, int q, int lane, int wave) {
    LAS float* cs = (LAS float*)(lds + DA_CS) + q * DCAP; LAS u16* ci = (LAS u16*)(lds + DA_CI) + q * DCAP;
    LAS unsigned* cnt = (LAS unsigned*)(lds + DA_CNT); LAS float* tau = (LAS float*)(lds + DA_TAU); LAS unsigned* hist = (LAS unsigned*)(lds + DA_HIST) + wave * 256;
    const int n = (int)cnt[q];
    if (n <= 256) return;
    unsigned hi[16], lo[16]; unsigned alive = 0u, valid = 0u;
#pragma unroll
    for (int k = 0; k < 16; ++k) { const int e = lane + 64 * k; const bool v = e < n; hi[k] = v ? ordkey(cs[e]) : 0u; lo[k] = v ? (0xFFFFu - (unsigned)ci[e]) : 0u; if (v) { alive |= 1u << k; valid |= 1u << k; } }
    unsigned krem = 256u, Thi = 0u, Tlo = 0u;
#pragma unroll 1
    for (int pass = 5; pass >= 0; --pass) {
        *(LAS u32x4*)(hist + 4 * lane) = (u32x4){0u, 0u, 0u, 0u};
        const int sh = (pass >= 2) ? 8 * (pass - 2) : 8 * pass;
        unsigned dg[16];
#pragma unroll
        for (int k = 0; k < 16; ++k) { dg[k] = (((pass >= 2) ? hi[k] : lo[k]) >> sh) & 255u; if (alive & (1u << k)) atomicAdd((unsigned*)&hist[dg[k]], 1u); }
        LDS_WAIT();
        const u32x4 h4 = *(const LAS u32x4*)(hist + 4 * lane);
        unsigned suf = h4.x + h4.y + h4.z + h4.w;
#pragma unroll
        for (int o = 1; o < 64; o <<= 1) { const unsigned v = __shfl_down(suf, o); suf += (lane + o < 64) ? v : 0u; }
        const unsigned S0 = suf, S1 = suf - h4.x, S2 = S1 - h4.y, S3 = S2 - h4.z;
        const int nge = __popcll(__ballot(S0 >= krem)) + __popcll(__ballot(S1 >= krem)) + __popcll(__ballot(S2 >= krem)) + __popcll(__ballot(S3 >= krem));
        const int d = nge - 1;
        const unsigned Sd0 = __shfl(S0, d >> 2), Sd1 = __shfl(S1, d >> 2), Sd2 = __shfl(S2, d >> 2), Sd3 = __shfl(S3, d >> 2);
        const unsigned Sd = ((d & 3) == 0) ? Sd0 : ((d & 3) == 1) ? Sd1 : ((d & 3) == 2) ? Sd2 : Sd3;
        const unsigned hd = hist[d];
        krem -= (Sd - hd);
        if (pass >= 2) Thi |= (unsigned)d << sh; else Tlo |= (unsigned)d << sh;
#pragma unroll
        for (int k = 0; k < 16; ++k) if (dg[k] != (unsigned)d) alive &= ~(1u << k);
        LDS_WAIT();
    }
    unsigned base = 0u;
#pragma unroll
    for (int k = 0; k < 16; ++k) { const bool keep = ((valid >> k) & 1u) && (hi[k] > Thi || (hi[k] == Thi && lo[k] >= Tlo));
        const unsigned long long b = __ballot(keep);
        if (keep) { const unsigned pos = base + (unsigned)__popcll(b & ((1ull << lane) - 1ull)); cs[pos] = inv_ordkey(hi[k]); ci[pos] = (u16)(0xFFFFu - lo[k]); }
        base += (unsigned)__popcll(b); }
    if (lane == 0) { cnt[q] = 256u; tau[q] = inv_ordkey(Thi); }
}

__device__ __forceinline__ void dsa_index_item(const Params& P, LAS unsigned char* lds, int item) {
    const half_t* IQ = (const half_t*)(P.ws + WS_IQ); const half_t* IK = (const half_t*)(P.ws + WS_IK); const float* IW = (const float*)(P.ws + WS_IW); u16* SEL = (u16*)(P.ws + WS_SEL);
    LAS float* cs = (LAS float*)(lds + DA_CS); LAS u16* ci = (LAS u16*)(lds + DA_CI); LAS unsigned* cnt = (LAS unsigned*)(lds + DA_CNT); LAS float* tau = (LAS float*)(lds + DA_TAU);
    const int tid = tid_opaque(), lane = tid & 63, wave = __builtin_amdgcn_readfirstlane(tid >> 6), qq = lane & 15, kg = lane >> 4;
    const int q0 = item * DQ, t = q0 + qq, ntiles = item + 1;
    h8 bq[4][2]; float w[4];
#pragma unroll
    for (int h = 0; h < 4; ++h) { w[h] = IW[(size_t)t * 4 + h] * 0.0625f;
#pragma unroll
        for (int ks = 0; ks < 2; ++ks) bq[h][ks] = *(const h8*)(IQ + (size_t)t * 256 + h * 64 + ks * 32 + kg * 8); }
    if (tid < DQ) { cnt[tid] = 0u; tau[tid] = -INFINITY; }
    __syncthreads();
    float tq = -INFINITY;
    for (int base = 0; base < ntiles; base += DSTEP_TILES) {
#pragma unroll
        for (int g = 0; g < 2; ++g) { const int tile = base + g * 8 + wave;
            if (tile < ntiles) { const int s0 = tile * 16;
                const h8 a0 = *(const h8*)(IK + (size_t)(s0 + qq) * 64 + kg * 8), a1 = *(const h8*)(IK + (size_t)(s0 + qq) * 64 + 32 + kg * 8);
                float sc[4] = {0.f, 0.f, 0.f, 0.f};
#pragma unroll
                for (int h = 0; h < 4; ++h) { f32x4 acc = {0.f, 0.f, 0.f, 0.f};
                    acc = __builtin_amdgcn_mfma_f32_16x16x32_f16(a0, bq[h][0], acc, 0, 0, 0); acc = __builtin_amdgcn_mfma_f32_16x16x32_f16(a1, bq[h][1], acc, 0, 0, 0);
#pragma unroll
                    for (int r = 0; r < 4; ++r) sc[r] += w[h] * fmaxf(acc[r], 0.f); }
#pragma unroll
                for (int r = 0; r < 4; ++r) { const float v = sc[r] + 0.0f; const int s = s0 + 4 * kg + r;
                    if (v > tq && s <= t) { const unsigned pos = atomicAdd((unsigned*)&cnt[qq], 1u); cs[qq * DCAP + pos] = v; ci[qq * DCAP + pos] = (u16)s; } } } }
        __syncthreads();
        unsigned mx = 0u;
        { const u32x4 c0 = *(const LAS u32x4*)(cnt), c1 = *(const LAS u32x4*)(cnt + 4), c2 = *(const LAS u32x4*)(cnt + 8), c3 = *(const LAS u32x4*)(cnt + 12);
          mx = max(max(max(c0.x, c0.y), max(c0.z, c0.w)), max(max(c1.x, c1.y), max(c1.z, c1.w))); mx = max(mx, max(max(max(c2.x, c2.y), max(c2.z, c2.w)), max(max(c3.x, c3.y), max(c3.z, c3.w)))); }
        if (mx > (unsigned)(DCAP - 256)) {
            dsa_compact(lds, 2 * wave, lane, wave); dsa_compact(lds, 2 * wave + 1, lane, wave);
            __syncthreads();
            tq = tau[qq];
        }
    }
    LAS u16* st = (LAS u16*)(lds + DA_SELST) + wave * 256;
#pragma unroll 1
    for (int j = 0; j < 2; ++j) { const int q = 2 * wave + j;
        dsa_compact(lds, q, lane, wave);
        LDS_WAIT();
        const int m = (int)cnt[q]; const LAS u16* cq = ci + q * DCAP;
        unsigned id[4], rk[4];
#pragma unroll
        for (int k = 0; k < 4; ++k) { const int e = lane + 64 * k; id[k] = (e < m) ? (unsigned)cq[e] : 0xFFFFu; rk[k] = 0u; }
        *(LAS u32x2*)(st + 4 * lane) = (u32x2){0xFFFFFFFFu, 0xFFFFFFFFu};
        for (int e = 0; e < m; ++e) { const unsigned x = (unsigned)cq[e];
#pragma unroll
            for (int k = 0; k < 4; ++k) rk[k] += (x < id[k]) ? 1u : 0u; }
        LDS_WAIT();
#pragma unroll
        for (int k = 0; k < 4; ++k) if (id[k] != 0xFFFFu) st[rk[k]] = (u16)id[k];
        LDS_WAIT();
        *(u32x2*)(SEL + (size_t)(q0 + q) * 256 + 4 * lane) = *(const LAS u32x2*)(st + 4 * lane);
        LDS_WAIT();
    }
    __syncthreads();
}

__device__ __forceinline__ void dsa_index_phase(const Params& P, LAS unsigned char* lds, int bid, int nblk) {
    constexpr int NITEMS = S_ / DQ;
    for (int r = 0;; ++r) { const int k = r * nblk + ((r & 1) ? (nblk - 1 - bid) : bid); if (k >= NITEMS) break; dsa_index_item(P, lds, NITEMS - 1 - k); }
}

__device__ __forceinline__ void dsa_attn_phase(const Params& P, LAS unsigned char* lds, int bid, int nblk) {
    const bf16* Q = (const bf16*)(P.ws + WS_Q); const bf16* Kh = (const bf16*)(P.ws + WS_K); const bf16* Vh = (const bf16*)(P.ws + WS_V); const u16* SEL = (const u16*)(P.ws + WS_SEL); bf16* Y = (bf16*)(P.ws + WS_Y);
    const int tid = tid_opaque(), lane = tid & 63, wave = __builtin_amdgcn_readfirstlane(tid >> 6), g = lane >> 3, c8 = (lane & 7) * 8;
    const int h = bid & 7, rank = bid >> 3, nr = nblk >> 3;
    LAS u16* sl = (LAS u16*)lds + wave * 256;
    const bf16* Kb = Kh + (size_t)h * S_ * 64 + c8; const bf16* Vb = Vh + (size_t)h * S_ * 64 + c8;
    for (int t = rank * 8 + wave; t < S_; t += nr * 8) {
        *(LAS u32x2*)(sl + 4 * lane) = *(const u32x2*)(SEL + (size_t)t * 256 + 4 * lane);
        const u32x4 qw = *(const u32x4*)(Q + (size_t)t * 512 + h * 64 + c8);
        const float q0 = bflo(qw.x) * 0.125f, q1 = bfhi(qw.x) * 0.125f, q2 = bflo(qw.y) * 0.125f, q3 = bfhi(qw.y) * 0.125f, q4 = bflo(qw.z) * 0.125f, q5 = bfhi(qw.z) * 0.125f, q6 = bflo(qw.w) * 0.125f, q7 = bfhi(qw.w) * 0.125f;
        LDS_WAIT(); __builtin_amdgcn_wave_barrier();
        float lg[32]; float mx = -INFINITY;
#pragma unroll
        for (int i0 = 0; i0 < 32; i0 += 8) {
            u32x4 kw[8]; unsigned id[8];
#pragma unroll
            for (int i = 0; i < 8; ++i) { id[i] = sl[(i0 + i) * 8 + g]; kw[i] = (u32x4){0u, 0u, 0u, 0u}; if (id[i] != 0xFFFFu) kw[i] = *(const u32x4*)(Kb + (size_t)id[i] * 64); }
#pragma unroll
            for (int i = 0; i < 8; ++i) { float d = q0 * bflo(kw[i].x) + q1 * bfhi(kw[i].x) + q2 * bflo(kw[i].y) + q3 * bfhi(kw[i].y) + q4 * bflo(kw[i].z) + q5 * bfhi(kw[i].z) + q6 * bflo(kw[i].w) + q7 * bfhi(kw[i].w);
                d += __shfl_xor(d, 1); d += __shfl_xor(d, 2); d += __shfl_xor(d, 4);
                d = (id[i] != 0xFFFFu) ? d : -INFINITY; lg[i0 + i] = d; mx = fmaxf(mx, d); } }
        mx = fmaxf(mx, __shfl_xor(mx, 8)); mx = fmaxf(mx, __shfl_xor(mx, 16)); mx = fmaxf(mx, __shfl_xor(mx, 32));
        float l = 0.f, o[8];
#pragma unroll
        for (int c = 0; c < 8; ++c) o[c] = 0.f;
#pragma unroll
        for (int i0 = 0; i0 < 32; i0 += 8) {
            u32x4 vw[8]; float p[8];
#pragma unroll
            for (int i = 0; i < 8; ++i) { const unsigned id = sl[(i0 + i) * 8 + g]; vw[i] = (u32x4){0u, 0u, 0u, 0u}; p[i] = 0.f; if (id != 0xFFFFu) { vw[i] = *(const u32x4*)(Vb + (size_t)id * 64); p[i] = __expf(lg[i0 + i] - mx); } }
#pragma unroll
            for (int i = 0; i < 8; ++i) { l += p[i];
                o[0] += p[i] * bflo(vw[i].x); o[1] += p[i] * bfhi(vw[i].x); o[2] += p[i] * bflo(vw[i].y); o[3] += p[i] * bfhi(vw[i].y);
                o[4] += p[i] * bflo(vw[i].z); o[5] += p[i] * bfhi(vw[i].z); o[6] += p[i] * bflo(vw[i].w); o[7] += p[i] * bfhi(vw[i].w); } }
        l += __shfl_xor(l, 8); l += __shfl_xor(l, 16); l += __shfl_xor(l, 32);
#pragma unroll
        for (int c = 0; c < 8; ++c) { o[c] += __shfl_xor(o[c], 8); o[c] += __shfl_xor(o[c], 16); o[c] += __shfl_xor(o[c], 32); }
        const float il = 1.0f / l;
        if (g == 0) { u32x4 w4; w4.x = pk2(o[0] * il, o[1] * il); w4.y = pk2(o[2] * il, o[3] * il); w4.z = pk2(o[4] * il, o[5] * il); w4.w = pk2(o[6] * il, o[7] * il);
            *(u32x4*)(Y + (size_t)t * 1536 + h * 64 + c8) = w4; }
        LDS_WAIT(); __builtin_amdgcn_wave_barrier();
    }
}
#include <hip/hip_cooperative_groups.h>
namespace cg = cooperative_groups;
extern __shared__ __attribute__((aligned(16))) unsigned char dyn_lds[];
#define LDSP ((LAS unsigned char*)dyn_lds)
constexpr int LDS_BYTES = 150 * 1024;
static_assert(MA_LDS_END <= LDS_BYTES && DA_END <= LDS_BYTES && 131072 <= LDS_BYTES, "LDS budget");
constexpr int NSCAN = 8;

typedef const __attribute__((address_space(4))) Params* KargPtr;
__device__ __forceinline__ Params load_params() {
    Params r;
#if defined(__HIP_DEVICE_COMPILE__)
    KargPtr kp = (KargPtr)__builtin_amdgcn_kernarg_segment_ptr(); asm volatile("" : "+s"(kp));
#pragma unroll
    for (int i = 0; i < 31; ++i) r.in[i] = kp->in[i];
    r.out = kp->out; r.ws = kp->ws;
#endif
    return r;
}
__global__ void __launch_bounds__(NT, 2) mega(Params P_unused) {
    cg::grid_group grid = cg::this_grid();
    const int bid = blockIdx.x, nb = gridDim.x;
#define PH_BEGIN const Params P = load_params(); unsigned char* ws = P.ws; unsigned char* dob = (unsigned char*)P.out; (void)ws; (void)dob;
    { PH_BEGIN prologue_phase(P, LDSP, bid, nb); }
    grid.sync();
    { PH_BEGIN
        pg8::Gemm g{(const bf16*)(ws + WS_MB), (const bf16*)(ws + WS_WMEM), 256, 1024, 1024, 1024, 1024, 0, 256 * 1024};
        pg8::StaticOrder S; S.init(g.M, g.N, nb, bid);
        EpiF32 E{(float*)(ws + WS_KMVM), 1024, (const float*)(ws + WS_RSTDM)};
        pg8::gemm_phase<false>(LDSP, g, S, E);
    }
    { PH_BEGIN
        pg8::Gemm g{(const bf16*)(ws + WS_XB), (const bf16*)(ws + WS_WIN), S_, P1_N, 1024, 1024, 1024, 0, 256 * 1024};
        pg8::StaticOrder S; S.init(g.M, g.N, nb, bid);
        EpiP1 E{(const float*)(ws + WS_RSTDX), (const float*)(ws + WS_COS), (const float*)(ws + WS_SIN), P.in[6], P.in[7],
                (bf16*)(ws + WS_Q), (bf16*)(ws + WS_K), (bf16*)(ws + WS_V), (bf16*)(ws + WS_RWP), (bf16*)(ws + WS_MEMQ), (half_t*)(ws + WS_IQ), (half_t*)(ws + WS_IK), (float*)(ws + WS_IW)};
        pg8::gemm_phase<false>(LDSP, g, S, E);
    }
    grid.sync();
    { PH_BEGIN lora_in_phase(P, bid, nb); }
    grid.sync();
    { PH_BEGIN
        pg8::Gemm g{(const bf16*)(dob + DO_LIN), (const bf16*)(ws + WS_WLORA), S_, 1536, 256, 256, 256, 0, 256 * 256};
        pg8::StaticOrder S; S.init(g.M, g.N, nb, bid);
        EpiLora E{(bf16*)(dob + DO_E), (bf16*)(dob + DO_A), (bf16*)(dob + DO_G), P.in[13], P.in[15]};
        pg8::gemm_phase<false>(LDSP, g, S, E);
    }
    grid.sync();
    if (bid < NSCAN) { PH_BEGIN rwkv_scan_v1(P, LDSP, bid); }
    else {
        { PH_BEGIN dsa_index_phase(P, LDSP, bid - NSCAN, nb - NSCAN); }
        { PH_BEGIN mem_attn_phase(P, LDSP, bid - NSCAN, nb - NSCAN); }
    }
    grid.sync();
    { PH_BEGIN dsa_attn_phase(P, LDSP, bid, nb); }
    grid.sync();
    { PH_BEGIN
        pg8::Gemm g{(const bf16*)(ws + WS_XB), (const bf16*)(ws + WS_WG), S_, 3072, 1024, 1024, 1024, 0, 256 * 1024};
        pg8::PanelOrder S; S.init(S_, nb, bid, 3);
        EpiGate E{(bf16*)(ws + WS_GATES), (const float*)(ws + WS_RSTDX), P.in[5]};
        pg8::gemm_phase<false>(LDSP, g, S, E);
    }
    for (int c = 0; c < 3; ++c) { PH_BEGIN
        pg8::Gemm g{(const bf16*)(ws + WS_Y) + c * 512, (const bf16*)(ws + WS_WUP) + (size_t)c * 1024 * 512, S_, 1024, 512, 1536, 512, 0, 256 * 512};
        pg8::StaticOrder S; S.init(g.M, g.N, nb, bid);
        EpiMerge E{(const bf16*)(ws + WS_GATES), P.out, (bf16*)(ws + WS_MERGED), c};
        pg8::gemm_phase<false>(LDSP, g, S, E);
    }
    grid.sync();
    { PH_BEGIN
        pg8::Gemm g{(const bf16*)(ws + WS_MERGED), (const bf16*)(ws + WS_WOUT), S_, 1024, 1024, 1024, 1024, 0, 256 * 1024};
        pg8::StaticOrder S; S.init(g.M, g.N, nb, bid);
        EpiOut E{P.in[0], P.out, (bf16*)(ws + WS_XB), (float*)(ws + WS_HSQ)};
        pg8::gemm_phase<false>(LDSP, g, S, E);
    }
    grid.sync();
    { PH_BEGIN
        pg8::Gemm g{(const bf16*)(ws + WS_XB), (const bf16*)(ws + WS_WQ), S_, 2048, 1024, 1024, 1024, 0, 256 * 1024};
        pg8::StaticOrder S; S.init(g.M, g.N, nb, bid);
        EpiPQ E{(half_t*)(ws + WS_PQ), (const float*)(ws + WS_HSQ)};
        pg8::gemm_phase<true>(LDSP, g, S, E);
    }
    grid.sync();
    { PH_BEGIN
        pg8::Gemm g{(const bf16*)(ws + WS_PQ), (const bf16*)(ws + WS_KEYBD), S_, 2048, 256, 2048, 256, 256, 0};
        pg8::StaticOrder S; S.init(g.M, g.N, nb, bid);
        float* scr = (float*)(ws + WS_SC) + (size_t)bid * 65536;
        pg8::Unit u;
        for (int i = 0; S.next(i, u); ++i) {
            pg8::OneUnit O{u}; EpiTile E{scr};
            pg8::gemm_phase<true>(LDSP, g, O, E);
            __syncthreads();
            peer_topk_tile(scr, u.pm, u.pn, (int*)(ws + WS_EIDX), (float*)(ws + WS_EGATE));
            __syncthreads();
        }
    }
    grid.sync();
    { PH_BEGIN peer_expert_phase_v1(P, bid, nb); }
#undef PH_BEGIN
}

extern "C" void kernel_launch(void* const* d_in, const int* in_sizes, int n_in, void* d_out, int out_size, void* d_ws, size_t ws_size, hipStream_t stream) {
    static int grid = 0;
    if (grid == 0) {
        if (n_in != 31 || out_size != S_ * D_ || ws_size < WS_END) { fprintf(stderr, "kernel_launch: unexpected problem (n_in %d out %d ws %zu)\n", n_in, out_size, ws_size); grid = -1; return; }
        int dev = 0, cus = 0, per_cu = 0;
        if (hipGetDevice(&dev) != hipSuccess || hipDeviceGetAttribute(&cus, hipDeviceAttributeMultiprocessorCount, dev) != hipSuccess) { grid = -1; return; }
        if (hipFuncSetAttribute((const void*)mega, hipFuncAttributeMaxDynamicSharedMemorySize, LDS_BYTES) != hipSuccess) { fprintf(stderr, "kernel_launch: hipFuncSetAttribute failed\n"); grid = -1; return; }
        if (hipOccupancyMaxActiveBlocksPerMultiprocessor(&per_cu, (const void*)mega, NT, LDS_BYTES) != hipSuccess || per_cu < 1) { fprintf(stderr, "kernel_launch: occupancy query failed (%d)\n", per_cu); grid = -1; return; }
        grid = cus;
        if (grid != 256) { fprintf(stderr, "kernel_launch: built for 256 CUs, device has %d\n", cus); grid = -1; return; }
    }
    if (grid < 0) return;
    Params P{};
    for (int i = 0; i < 31; ++i) P.in[i] = (const float*)d_in[i];
    P.out = (float*)d_out; P.ws = (unsigned char*)d_ws;
    void* args[] = {&P};
    hipError_t e = hipLaunchCooperativeKernel((const void*)mega, dim3(grid), dim3(NT), args, LDS_BYTES, stream);
    if (e != hipSuccess) fprintf(stderr, "kernel_launch: cooperative launch failed: %s\n", hipGetErrorString(e));
}
```

```cpp
#include <hip/hip_runtime.h>
#include <cstdio>
#include <cstdint>

typedef unsigned short bf16;
typedef unsigned short u16;
typedef float f32x4 __attribute__((ext_vector_type(4)));
typedef float f32x2 __attribute__((ext_vector_type(2)));
typedef unsigned u32x4 __attribute__((ext_vector_type(4)));
typedef unsigned u32x2 __attribute__((ext_vector_type(2)));
typedef _Float16 half_t;
typedef _Float16 half4 __attribute__((ext_vector_type(4)));
typedef _Float16 half8 __attribute__((ext_vector_type(8)));

constexpr int S_ = 16384, D_ = 1024;
constexpr int NMEM = 256;
constexpr int ATT_W = 512, RW_W = 512, MEM_W = 512;
constexpr int RW_IN = 1792;
constexpr int WIN_COLS = 7236;
constexpr int COL_Q = 0, COL_K = 512, COL_V = 1024, COL_IQ = 1536, COL_IK = 1792, COL_IW = 1856, COL_RW = 1860, COL_MEMQ = 3652, COL_GATE = 4164;
constexpr int P1_TILES = 17, P1_N = P1_TILES * 256;
constexpr float NORM_EPS = 1e-6f, GN_EPS = 64e-5f;
constexpr int NEXP = 16384;

constexpr size_t MiB = 1u << 20;
constexpr size_t WS_CTL = 0;
constexpr size_t WS_RSTDX = 1 * MiB;
constexpr size_t WS_COS = WS_RSTDX + 64 * 1024;
constexpr size_t WS_SIN = WS_COS + 512 * 1024;
constexpr size_t WS_IW = WS_SIN + 512 * 1024;
constexpr size_t WS_RSTDM = WS_IW + 256 * 1024;
constexpr size_t WS_RSTDH = WS_RSTDM + 4096;
constexpr size_t WS_HSQ = 3 * MiB;
constexpr size_t WS_WIN = 4 * MiB;
constexpr size_t WS_WG = WS_WIN + (size_t)P1_N * 1024 * 2;
constexpr size_t WS_WUP = WS_WG + 6 * MiB;
constexpr size_t WS_WOUT = WS_WUP + 3 * MiB;
constexpr size_t WS_WQ = WS_WOUT + 2 * MiB;
constexpr size_t WS_WMEM = WS_WQ + 4 * MiB;
constexpr size_t WS_KEYBD = WS_WMEM + 2 * MiB;
constexpr size_t WS_WLORA = WS_KEYBD + 128 * 1024;
static_assert(WS_WLORA + 768 * 1024 <= 30 * MiB + 512 * 1024, "weights region");
constexpr size_t WS_KMVM = 30 * MiB + 512 * 1024;
constexpr size_t WS_MB = 31 * MiB + 512 * 1024;
constexpr size_t WS_XB = 32 * MiB;
constexpr size_t WS_Q = 64 * MiB, WS_K = 80 * MiB, WS_V = 96 * MiB;
constexpr size_t WS_IQ = 112 * MiB;
constexpr size_t WS_IK = 120 * MiB;
constexpr size_t WS_MEMQ = 122 * MiB;
constexpr size_t WS_RWP = 138 * MiB;
constexpr size_t WS_Y = 194 * MiB;
constexpr size_t WS_SEL = 242 * MiB;
constexpr size_t DO_E = 0, DO_A = 16 * MiB, DO_G = 32 * MiB, DO_LIN = 48 * MiB;
constexpr size_t WS_GATES = 64 * MiB;
constexpr size_t WS_MERGED = 160 * MiB;
constexpr size_t WS_PQ = 64 * MiB;
constexpr size_t WS_SC = 128 * MiB;
constexpr size_t WS_EIDX = 192 * MiB;
constexpr size_t WS_EGATE = 200 * MiB;
constexpr size_t WS_END = 256 * MiB;

__device__ __forceinline__ unsigned f2bf(float f) { unsigned u = __builtin_bit_cast(unsigned, f); return (u + 0x7fffu + ((u >> 16) & 1u)) >> 16; }
__device__ __forceinline__ unsigned pk2(float lo, float hi) { return f2bf(lo) | (f2bf(hi) << 16); }
__device__ __forceinline__ unsigned pk2h(float lo, float hi) { typedef _Float16 h2 __attribute__((ext_vector_type(2))); h2 v; v[0] = (_Float16)lo; v[1] = (_Float16)hi; return __builtin_bit_cast(unsigned, v); }
__device__ __forceinline__ float bf2f(unsigned short b) { return __builtin_bit_cast(float, ((unsigned)b) << 16); }
__device__ __forceinline__ float bflo(unsigned w) { return __builtin_bit_cast(float, w << 16); }
__device__ __forceinline__ float bfhi(unsigned w) { return __builtin_bit_cast(float, w & 0xffff0000u); }
__device__ __forceinline__ float wave_sum(float v) {
#pragma unroll
    for (int o = 1; o < 64; o <<= 1) v += __shfl_xor(v, o);
    return v;
}
__device__ __forceinline__ float wave_max(float v) {
#pragma unroll
    for (int o = 1; o < 64; o <<= 1) v = fmaxf(v, __shfl_xor(v, o));
    return v;
}

__device__ __forceinline__ int tid_opaque() { int t = threadIdx.x; asm volatile("" : "+v"(t)); return t; }
namespace pg8 {
#define PG8_LAS __attribute__((address_space(3)))
typedef unsigned short bf16_t;
typedef short bf16x8 __attribute__((ext_vector_type(8)));
typedef float f32x4 __attribute__((ext_vector_type(4)));
typedef unsigned u32x4 __attribute__((ext_vector_type(4)));
typedef unsigned u32x2 __attribute__((ext_vector_type(2)));
constexpr int BM = 256, BK = 64, HALF = 128, HTB = HALF * BK * 2, STAGE_BYTES = 8 * HTB, NXCD = 8, WGM = 8;

__host__ __device__ __forceinline__ int lds_byte(int r, int c) { const int st = (r >> 4) * 2 + (c >> 5), rr = r & 15, cc = c & 31, ob = rr * 64 + cc * 2; return st * 1024 + (ob ^ (((ob >> 9) & 1) << 5)); }
__host__ __device__ __forceinline__ void stage_rc(int b, int& R, int& C) { const int st = b / 1024, sb = b % 1024, swz = sb ^ (((sb >> 9) & 1) << 5); R = (st >> 1) * 16 + swz / 64; C = (st & 1) * 32 + (swz % 64) / 2; }

struct Unit { int pm, pn; };
struct Gemm { const bf16_t* A; const bf16_t* Bt; int M, N, K; int lda, ldb; long a_pn_step, b_pn_step; };

struct StaticOrder {
    int nM, nN, nwg, G, c;
    __host__ __device__ __forceinline__ void init(int M, int N, int G_, int c_) { nM = M / BM; nN = N / BM; nwg = nM * nN; G = G_; c = c_; }
    __host__ __device__ __forceinline__ bool next(int i, Unit& u) const {
        const long L = (long)i * G + c; if (L >= nwg) return false;
        int wgid = (int)L; { const int q = nwg / NXCD, r = nwg % NXCD, xcd = wgid % NXCD, off = wgid / NXCD; wgid = (xcd < r ? xcd * (q + 1) : r * (q + 1) + (xcd - r) * q) + off; }
        const int nig = WGM * nN, gid = wgid / nig, fm = gid * WGM, gsz = (nM - fm) < WGM ? (nM - fm) : WGM;
        u.pm = fm + ((wgid % nig) % gsz); u.pn = (wgid % nig) / gsz; return true;
    }
};

__device__ __forceinline__ unsigned cvt_pk_bf16(float lo, float hi) { unsigned r; asm volatile("v_cvt_pk_bf16_f32 %0, %1, %2" : "=v"(r) : "v"(lo), "v"(hi)); return r; }

typedef _Float16 f16x8 __attribute__((ext_vector_type(8)));
template <bool F16> __device__ __forceinline__ f32x4 mma16(bf16x8 a, bf16x8 b, f32x4 c) {
    if constexpr (F16) return __builtin_amdgcn_mfma_f32_16x16x32_f16(__builtin_bit_cast(f16x8, a), __builtin_bit_cast(f16x8, b), c, 0, 0, 0);
    else return __builtin_amdgcn_mfma_f32_16x16x32_bf16(a, b, c, 0, 0, 0);
}
struct PanelOrder {
    int pm0, pn0, nsteps, valid;
    __host__ __device__ __forceinline__ void init(int M, int G_, int c_, int nsteps_) { StaticOrder S; S.init(M, 1024, G_, c_); Unit u; valid = S.next(0, u) ? 1 : 0; pm0 = u.pm; pn0 = u.pn; nsteps = nsteps_; }
    __host__ __device__ __forceinline__ bool next(int i, Unit& u) const { if (!valid || i >= nsteps) return false; u.pm = pm0; u.pn = pn0 + 4 * i; return true; }
};
struct OneUnit { Unit u0; __host__ __device__ __forceinline__ bool next(int i, Unit& u) const { if (i != 0) return false; u = u0; return true; } };
template <bool F16, class Sched, class Epi>
__device__ __forceinline__ void gemm_phase(PG8_LAS unsigned char* lds, const Gemm g, const Sched& S, const Epi& E) {
    int tid = threadIdx.x; asm volatile("" : "+v"(tid));
    const int wid = __builtin_amdgcn_readfirstlane(tid >> 6), lane = tid & 63, wr = wid >> 2, wc = wid & 3, fr = lane & 15, fq = lane >> 4;
    const int K = g.K, nt = K / BK;
    unsigned voffA[2], voffB[2];
#pragma unroll
    for (int i = 0; i < 2; ++i) { int R, C; stage_rc(tid * 16 + i * 8192, R, C);
        voffA[i] = (unsigned)(R * g.lda + C) * 2u; voffB[i] = (unsigned)(R * g.ldb + C) * 2u; }
    const size_t kstep = (size_t)(BK * 2);
    const size_t hstepA = (size_t)HALF * g.lda * 2, hstepB = (size_t)HALF * g.ldb * 2;
    const size_t tstepA = 2 * hstepA;
    const unsigned ldsw = (unsigned)wid * 1024u;
    const int aoff = lds_byte(wr * 64 + fr, fq * 8), boff = lds_byte(wc * 32 + fr, fq * 8);
#define PG8_SA(b, h) (((b) * 2 + (h)) * HTB)
#define PG8_SB(b, h) ((4 + (b) * 2 + (h)) * HTB)
#define PG8_STAGE(bufoff, gbase, voff) do { _Pragma("unroll") for (int _i = 0; _i < 2; ++_i) \
        __builtin_amdgcn_global_load_lds((const unsigned*)((const char*)(gbase) + (voff)[_i]), (PG8_LAS unsigned*)(lds + (bufoff) + ldsw + _i * 8192), 16, 0, 0); } while (0)
#define PG8_LDA(dst, b, h) do { _Pragma("unroll") for (int m = 0; m < 4; ++m) _Pragma("unroll") for (int k = 0; k < 2; ++k) dst[m][k] = *(const PG8_LAS bf16x8*)(lds + PG8_SA(b, h) + aoff + m * 2048 + k * 1024); } while (0)
#define PG8_LDB(dst, b, h) do { _Pragma("unroll") for (int n = 0; n < 2; ++n) _Pragma("unroll") for (int k = 0; k < 2; ++k) dst[n][k] = *(const PG8_LAS bf16x8*)(lds + PG8_SB(b, h) + boff + n * 2048 + k * 1024); } while (0)
#define PG8_MMA(ai, bj, At, Bt) do { __builtin_amdgcn_s_setprio(1); _Pragma("unroll") for (int m = 0; m < 4; ++m) _Pragma("unroll") for (int n = 0; n < 2; ++n) _Pragma("unroll") for (int k = 0; k < 2; ++k) \
        acc[ai][bj][m][n] = mma16<F16>(Bt[n][k], At[m][k], acc[ai][bj][m][n]); __builtin_amdgcn_s_setprio(0); } while (0)
#define PG8_WAIT_V(n) asm volatile("s_waitcnt vmcnt(" #n ")" ::: "memory")
#define PG8_WAIT_L(n) asm volatile("s_waitcnt lgkmcnt(" #n ")" ::: "memory")
#define PG8_BAR __builtin_amdgcn_s_barrier()
#define PG8_SCHED __builtin_amdgcn_sched_barrier(0)
    Unit cur, nxt; int ui = 0;
    if (!S.next(0, cur)) return;
    f32x4 acc[2][2][4][2];
#pragma unroll
    for (int a = 0; a < 2; ++a)
#pragma unroll
        for (int b = 0; b < 2; ++b)
#pragma unroll
            for (int m = 0; m < 4; ++m)
#pragma unroll
                for (int n = 0; n < 2; ++n) acc[a][b][m][n] = (f32x4){0.f, 0.f, 0.f, 0.f};
    bf16x8 At[4][2], B0[2][2], B1[2][2];
    const char* cA = (const char*)g.A + (size_t)cur.pm * tstepA + (size_t)cur.pn * g.a_pn_step * 2; const char* cB = (const char*)g.Bt + (size_t)cur.pn * g.b_pn_step * 2;
    PG8_STAGE(PG8_SB(0, 0), cB, voffB); PG8_STAGE(PG8_SA(0, 0), cA, voffA); PG8_STAGE(PG8_SB(0, 1), cB + hstepB, voffB); PG8_STAGE(PG8_SA(0, 1), cA + hstepA, voffA);
    if (wr == 1) PG8_BAR;
    PG8_WAIT_V(4); PG8_BAR;
    PG8_STAGE(PG8_SB(1, 0), cB + kstep, voffB); PG8_STAGE(PG8_SA(1, 0), cA + kstep, voffA); PG8_STAGE(PG8_SB(1, 1), cB + hstepB + kstep, voffB);
    PG8_WAIT_V(6); PG8_BAR;
    for (;;) {
        const bool has_next = S.next(ui + 1, nxt);
        const char* nA = has_next ? (const char*)g.A + (size_t)nxt.pm * tstepA + (size_t)nxt.pn * g.a_pn_step * 2 : cA; const char* nB = has_next ? (const char*)g.Bt + (size_t)nxt.pn * g.b_pn_step * 2 : cB;
        for (int t = 0; t < nt; t += 2) {
            const bool last = (t == nt - 2);
            const char* a1 = cA + (size_t)(t + 1) * kstep;
            const char* a2 = last ? nA : cA + (size_t)(t + 2) * kstep; const char* b2 = last ? nB : cB + (size_t)(t + 2) * kstep;
            const char* a3 = a2 + kstep; const char* b3 = b2 + kstep;
            PG8_LDB(B0, 0, 0); PG8_SCHED; PG8_LDA(At, 0, 0); PG8_STAGE(PG8_SA(1, 1), a1 + hstepA, voffA);
            PG8_WAIT_L(8); PG8_BAR; PG8_WAIT_L(0); PG8_MMA(0, 0, At, B0); PG8_BAR; PG8_SCHED;
            PG8_LDB(B1, 0, 1); PG8_STAGE(PG8_SB(0, 0), b2, voffB);
            PG8_BAR; PG8_WAIT_L(0); PG8_MMA(0, 1, At, B1); PG8_BAR;
            PG8_LDA(At, 0, 1); PG8_STAGE(PG8_SA(0, 0), a2, voffA);
            PG8_BAR; PG8_WAIT_L(0); PG8_MMA(1, 0, At, B0); PG8_BAR; PG8_SCHED;
            PG8_STAGE(PG8_SB(0, 1), b2 + hstepB, voffB);
            PG8_WAIT_V(6); PG8_BAR; PG8_MMA(1, 1, At, B1); PG8_BAR;
            PG8_LDB(B0, 1, 0); PG8_SCHED; PG8_LDA(At, 1, 0); PG8_STAGE(PG8_SA(0, 1), a2 + hstepA, voffA);
            PG8_WAIT_L(8); PG8_BAR; PG8_WAIT_L(0); PG8_MMA(0, 0, At, B0); PG8_BAR; PG8_SCHED;
            PG8_LDB(B1, 1, 1); PG8_STAGE(PG8_SB(1, 0), b3, voffB);
            PG8_BAR; PG8_WAIT_L(0); PG8_MMA(0, 1, At, B1); PG8_BAR;
            PG8_LDA(At, 1, 1); PG8_STAGE(PG8_SA(1, 0), a3, voffA);
            PG8_BAR; PG8_WAIT_L(0); PG8_MMA(1, 0, At, B0); PG8_BAR; PG8_SCHED;
            PG8_STAGE(PG8_SB(1, 1), b3 + hstepB, voffB);
            PG8_WAIT_V(6); PG8_BAR; PG8_MMA(1, 1, At, B1); PG8_BAR;
        }
        { int fr_ = fr, fq_ = fq; asm volatile("" : "+v"(fr_), "+v"(fq_)); E(acc, cur, wr, wc, fr_, fq_); }
        if (!has_next) break;
#pragma unroll
        for (int a = 0; a < 2; ++a)
#pragma unroll
            for (int b = 0; b < 2; ++b)
#pragma unroll
                for (int m = 0; m < 4; ++m)
#pragma unroll
                    for (int n = 0; n < 2; ++n) acc[a][b][m][n] = (f32x4){0.f, 0.f, 0.f, 0.f};
        cur = nxt; cA = nA; cB = nB; ++ui;
    }
    PG8_WAIT_V(0);
    if (wr == 0) PG8_BAR;
    PG8_BAR;
#undef PG8_SA
#undef PG8_SB
#undef PG8_STAGE
#undef PG8_LDA
#undef PG8_LDB
#undef PG8_MMA
#undef PG8_WAIT_V
#undef PG8_WAIT_L
#undef PG8_BAR
#undef PG8_SCHED
}
}
#define LAS __attribute__((address_space(3)))
#define LDS_WAIT() asm volatile("s_waitcnt lgkmcnt(0)" ::: "memory")
constexpr int NT = 512, NW = 8;

struct Params {
    const float* in[31];
    float* out;
    unsigned char* ws;
};

__device__ __forceinline__ void tr_item(const float* W, int ldw, bf16* WT, int K, int k0, int nphys0, int lbase, int cnt, const float* kg, LAS float* scr, int lane, bool f16 = false) {
    const int c = lane & 31;
#pragma unroll 8
    for (int i = 0; i < 32; ++i) { const int kk = 2 * i + (lane >> 5); float v = 0.f;
        if (c < cnt) { v = W[(size_t)(k0 + kk) * ldw + lbase + c]; if (kg) v *= kg[k0 + kk]; }
        scr[kk * 33 + c] = v; }
    LDS_WAIT();
    const int c8 = lane & 7;
#pragma unroll
    for (int j = 0; j < 4; ++j) { const int n = (lane >> 3) + 8 * j; const LAS float* s = scr + (8 * c8) * 33 + n;
        u32x4 o;
        if (f16) { o.x = pk2h(s[0 * 33], s[1 * 33]); o.y = pk2h(s[2 * 33], s[3 * 33]); o.z = pk2h(s[4 * 33], s[5 * 33]); o.w = pk2h(s[6 * 33], s[7 * 33]); }
        else { o.x = pk2(s[0 * 33], s[1 * 33]); o.y = pk2(s[2 * 33], s[3 * 33]); o.z = pk2(s[4 * 33], s[5 * 33]); o.w = pk2(s[6 * 33], s[7 * 33]); }
        *(u32x4*)(WT + (size_t)(nphys0 + n) * K + k0 + 8 * c8) = o; }
    LDS_WAIT();
}
__device__ __forceinline__ void p1_group(int g, int& lbase, int& cnt) {
    const int tile = g >> 3, gi = g & 7, bj = gi >> 2, wc = gi & 3; cnt = 32;
    if (tile < 2) lbase = COL_Q + (4 * tile + wc) * 64 + 32 * bj;
    else if (tile < 4) lbase = COL_K + (4 * (tile - 2) + wc) * 64 + 32 * bj;
    else if (tile < 6) lbase = COL_V + (tile - 4) * 256 + 32 * gi;
    else if (tile == 6) lbase = COL_IQ + wc * 64 + 32 * bj;
    else if (tile == 7) { if (wc == 0) lbase = COL_IK + 32 * bj; else if (gi == 1) { lbase = COL_IW; cnt = 4; } else { lbase = 0; cnt = 0; } }
    else if (tile < 15) lbase = COL_RW + (tile - 8) * 256 + 32 * gi;
    else lbase = COL_MEMQ + (tile - 15) * 256 + 32 * gi;
}

__device__ __forceinline__ void prologue_phase(const Params& P, LAS unsigned char* lds, int bid, int nblk) {
    const int tid = tid_opaque(), lane = tid & 63, wave = tid >> 6;
    const int gw = bid * NW + wave, NGW = nblk * NW;
    unsigned char* ws = P.ws;
    LAS float* scr = (LAS float*)(lds + wave * 16384);
    constexpr int I_P1 = 16 * (P1_N / 32), I_WG = 16 * 96, I_UP = 8 * 32, I_OUT = 16 * 32, I_WQ = 16 * 64, I_MEM = 16 * 32;
    constexpr int NITEMS = I_P1 + I_WG + 3 * I_UP + I_OUT + I_WQ + I_MEM;
    for (int it = gw; it < NITEMS; it += NGW) {
        int r = it;
        if (r < I_P1) { const int ng = P1_N / 32, kb = r / ng, g = r % ng; int lb, cnt; p1_group(g, lb, cnt);
            tr_item(P.in[4], WIN_COLS, (bf16*)(ws + WS_WIN), 1024, 64 * kb, 32 * g, lb, cnt, P.in[3], scr, lane); continue; } r -= I_P1;
        if (r < I_WG) { const int kb = r / 96, g = r % 96;
            tr_item(P.in[4], WIN_COLS, (bf16*)(ws + WS_WG), 1024, 64 * kb, 32 * g, COL_GATE + 32 * g, 32, P.in[3], scr, lane); continue; } r -= I_WG;
        if (r < 3 * I_UP) { const int c = r / I_UP, rr = r % I_UP, kb = rr / 32, g = rr % 32;
            tr_item(P.in[23] + (size_t)c * 512 * 1024, 1024, (bf16*)(ws + WS_WUP) + (size_t)c * 1024 * 512, 512, 64 * kb, 32 * g, 32 * g, 32, nullptr, scr, lane); continue; } r -= 3 * I_UP;
        if (r < I_OUT) { const int kb = r / 32, g = r % 32;
            tr_item(P.in[24], 1024, (bf16*)(ws + WS_WOUT), 1024, 64 * kb, 32 * g, 32 * g, 32, nullptr, scr, lane); continue; } r -= I_OUT;
        if (r < I_WQ) { const int kb = r / 64, g = r % 64;
            tr_item(P.in[26], 2048, (bf16*)(ws + WS_WQ), 1024, 64 * kb, 32 * g, 32 * g, 32, P.in[25], scr, lane, true); continue; } r -= I_WQ;
        { const int kb = r / 32, g = r % 32;
            tr_item(P.in[9], 1024, (bf16*)(ws + WS_WMEM), 1024, 64 * kb, 32 * g, 32 * g, 32, P.in[8], scr, lane); }
    }
    for (int m = gw; m < S_ + NMEM; m += NGW) {
        const bool isx = m < S_; const int r = isx ? m : m - S_;
        const f32x4* xr = (const f32x4*)((isx ? P.in[0] : P.in[1]) + (size_t)r * D_) + lane;
        f32x4 v[4]; float s = 0.f;
#pragma unroll
        for (int j = 0; j < 4; ++j) { v[j] = xr[64 * j]; s += (v[j].x * v[j].x + v[j].y * v[j].y) + (v[j].z * v[j].z + v[j].w * v[j].w); }
        s = wave_sum(s);
        const float rstd = 1.0f / sqrtf(s * (1.0f / D_) + NORM_EPS);
        if (lane == 0) ((float*)(ws + (isx ? WS_RSTDX : WS_RSTDM)))[r] = rstd;
        unsigned long long* o8 = (unsigned long long*)((bf16*)(ws + (isx ? WS_XB : WS_MB)) + (size_t)r * D_) + lane;
#pragma unroll
        for (int j = 0; j < 4; ++j) o8[64 * j] = (unsigned long long)pk2(v[j].x, v[j].y) | ((unsigned long long)pk2(v[j].z, v[j].w) << 32);
    }
    const int gt = bid * NT + tid, NGT = nblk * NT;
    for (int i = gt; i < S_ * 8; i += NGT) { const int t = i >> 3, f = i & 7;
        const double inv = pow(500000.0, -(double)f / 8.0); const double ang = (double)((const int*)P.in[2])[t] * inv;
        ((float*)(ws + WS_COS))[i] = (float)cos(ang); ((float*)(ws + WS_SIN))[i] = (float)sin(ang); }
    for (int i = gt; i < 256 * 256; i += NGT) { const int n = i >> 8, k = i & 255; float v = 0.f;
        if (n < 128) { if (k < 128) v = P.in[27][n * 128 + k]; } else { if (k >= 128) v = P.in[28][(n - 128) * 128 + (k - 128)]; }
        ((half_t*)(ws + WS_KEYBD))[i] = (half_t)v; }
    for (int i = gt; i < 1536 * 256; i += NGT) { const int n = i >> 8, k = i & 255; float v = 0.f;
        if (n < 512) { if (k < 64) v = P.in[14][k * 512 + n]; }
        else if (n < 1024) { if (k >= 64 && k < 128) v = P.in[16][(k - 64) * 512 + (n - 512)]; }
        else { if (k >= 128) v = P.in[17][(k - 128) * 512 + (n - 1024)]; }
        ((bf16*)(ws + WS_WLORA))[i] = (bf16)f2bf(v); }
}

typedef const f32x4 (&AccRef)[2][2][4][2];
__device__ __forceinline__ void st_bf4(bf16* p, f32x4 v) { u32x2 w; w.x = pk2(v[0], v[1]); w.y = pk2(v[2], v[3]); *(u32x2*)p = w; }
__device__ __forceinline__ void st_h4(half_t* p, f32x4 v) { half4 h; h[0] = (half_t)v[0]; h[1] = (half_t)v[1]; h[2] = (half_t)v[2]; h[3] = (half_t)v[3]; *(half4*)p = h; }

__device__ __forceinline__ f32x4 rope4(f32x4 v, int fq, const float* cs, const float* sn) {
    f32x4 o;
#pragma unroll
    for (int j = 0; j < 4; ++j) { const float p = __shfl_xor(v[j], 32); const int i = 4 * (fq & 1) + j; const float c = cs[i], s = sn[i];
        o[j] = (fq < 2) ? (v[j] * c - p * s) : (v[j] * c + p * s); }
    return o;
}

struct EpiP1 {
    const float* rstd; const float* cs; const float* sn; const float* qgain; const float* kgain;
    bf16 *Q, *K, *V, *RWP, *MEMQ; half_t *IQ, *IK; float* IW;
    __device__ __forceinline__ void operator()(AccRef acc, const pg8::Unit& u, int wr, int wc, int fr, int fq) const {
        const int pn = u.pn;
#pragma unroll
        for (int ai = 0; ai < 2; ++ai)
#pragma unroll
            for (int m = 0; m < 4; ++m) {
                const int row = u.pm * 256 + ai * 128 + wr * 64 + m * 16 + fr; const float rs = rstd[row];
                f32x4 v[2][2];
#pragma unroll
                for (int bj = 0; bj < 2; ++bj)
#pragma unroll
                    for (int n = 0; n < 2; ++n) v[bj][n] = acc[ai][bj][m][n] * rs;
                if (pn < 4) {
                    float ss = 0.f;
#pragma unroll
                    for (int bj = 0; bj < 2; ++bj)
#pragma unroll
                        for (int n = 0; n < 2; ++n) ss += (v[bj][n][0] * v[bj][n][0] + v[bj][n][1] * v[bj][n][1]) + (v[bj][n][2] * v[bj][n][2] + v[bj][n][3] * v[bj][n][3]);
                    ss += __shfl_xor(ss, 16); ss += __shfl_xor(ss, 32);
                    const float rh = 1.0f / sqrtf(ss * (1.0f / 64.0f) + NORM_EPS);
                    const float* gn = (pn < 2) ? qgain : kgain;
#pragma unroll
                    for (int bj = 0; bj < 2; ++bj)
#pragma unroll
                        for (int n = 0; n < 2; ++n) { const f32x4 gv = *(const f32x4*)(gn + 32 * bj + 16 * n + 4 * fq); v[bj][n] = v[bj][n] * rh * gv; }
                    v[0][0] = rope4(v[0][0], fq, cs + row * 8, sn + row * 8);
                    const int head = (pn & 1) * 4 + wc;
                    bf16* dst = (pn < 2) ? (Q + (size_t)row * 512 + head * 64 + 4 * fq) : (K + ((size_t)head * S_ + row) * 64 + 4 * fq);
#pragma unroll
                    for (int bj = 0; bj < 2; ++bj)
#pragma unroll
                        for (int n = 0; n < 2; ++n) st_bf4(dst + 32 * bj + 16 * n, v[bj][n]);
                } else if (pn < 6) {
#pragma unroll
                    for (int bj = 0; bj < 2; ++bj)
#pragma unroll
                        for (int n = 0; n < 2; ++n) { const int head = (pn - 4) * 4 + 2 * bj + (wc >> 1);
                            st_bf4(V + ((size_t)head * S_ + row) * 64 + 32 * (wc & 1) + 16 * n + 4 * fq, v[bj][n]); }
                } else if (pn == 6) {
                    v[0][0] = rope4(v[0][0], fq, cs + row * 8, sn + row * 8);
                    half_t* dst = IQ + (size_t)row * 256 + wc * 64 + 4 * fq;
#pragma unroll
                    for (int bj = 0; bj < 2; ++bj)
#pragma unroll
                        for (int n = 0; n < 2; ++n) st_h4(dst + 32 * bj + 16 * n, v[bj][n]);
                } else if (pn == 7) {
                    if (wc == 0) {
                        v[0][0] = rope4(v[0][0], fq, cs + row * 8, sn + row * 8);
                        half_t* dst = IK + (size_t)row * 64 + 4 * fq;
#pragma unroll
                        for (int bj = 0; bj < 2; ++bj)
#pragma unroll
                            for (int n = 0; n < 2; ++n) st_h4(dst + 32 * bj + 16 * n, v[bj][n]);
                    } else if (wc == 1) { if (fq == 0) *(f32x4*)(IW + (size_t)row * 4) = v[0][0]; }
                } else if (pn < 15) {
                    bf16* dst = RWP + (size_t)row * RW_IN + (pn - 8) * 256 + 32 * wc + 4 * fq;
#pragma unroll
                    for (int bj = 0; bj < 2; ++bj)
#pragma unroll
                        for (int n = 0; n < 2; ++n) st_bf4(dst + 128 * bj + 16 * n, v[bj][n]);
                } else {
                    bf16* dst = MEMQ + (size_t)row * 512 + (pn - 15) * 256 + 32 * wc + 4 * fq;
#pragma unroll
                    for (int bj = 0; bj < 2; ++bj)
#pragma unroll
                        for (int n = 0; n < 2; ++n) st_bf4(dst + 128 * bj + 16 * n, v[bj][n]);
                }
            }
    }
};

struct EpiF32 {
    float* C; int ldc; const float* rstd;
    __device__ __forceinline__ void operator()(AccRef acc, const pg8::Unit& u, int wr, int wc, int fr, int fq) const {
#pragma unroll
        for (int ai = 0; ai < 2; ++ai)
#pragma unroll
            for (int m = 0; m < 4; ++m) { const int row = u.pm * 256 + ai * 128 + wr * 64 + m * 16 + fr; const float rs = rstd ? rstd[row] : 1.0f;
                float* dst = C + (size_t)row * ldc + u.pn * 256 + 32 * wc + 4 * fq;
#pragma unroll
                for (int bj = 0; bj < 2; ++bj)
#pragma unroll
                    for (int n = 0; n < 2; ++n) *(f32x4*)(dst + 128 * bj + 16 * n) = acc[ai][bj][m][n] * rs; }
    }
};
struct EpiBf {
    bf16* C; int ldc; const float* rstd;
    __device__ __forceinline__ void operator()(AccRef acc, const pg8::Unit& u, int wr, int wc, int fr, int fq) const {
#pragma unroll
        for (int ai = 0; ai < 2; ++ai)
#pragma unroll
            for (int m = 0; m < 4; ++m) { const int row = u.pm * 256 + ai * 128 + wr * 64 + m * 16 + fr; const float rs = rstd ? rstd[row] : 1.0f;
                bf16* dst = C + (size_t)row * ldc + u.pn * 256 + 32 * wc + 4 * fq;
#pragma unroll
                for (int bj = 0; bj < 2; ++bj)
#pragma unroll
                    for (int n = 0; n < 2; ++n) st_bf4(dst + 128 * bj + 16 * n, acc[ai][bj][m][n] * rs); }
    }
};
__device__ __forceinline__ float sigmoidf_(float x) { return 1.0f / (1.0f + __expf(-x)); }
struct EpiLora {
    bf16 *E, *A, *G; const float* w0; const float* a0;
    __device__ __forceinline__ void operator()(AccRef acc, const pg8::Unit& u, int wr, int wc, int fr, int fq) const {
        const int kind = u.pn >> 1;
#pragma unroll
        for (int ai = 0; ai < 2; ++ai)
#pragma unroll
            for (int m = 0; m < 4; ++m) { const int row = u.pm * 256 + ai * 128 + wr * 64 + m * 16 + fr;
#pragma unroll
                for (int bj = 0; bj < 2; ++bj)
#pragma unroll
                    for (int n = 0; n < 2; ++n) { const int c = (u.pn & 1) * 256 + 128 * bj + 32 * wc + 16 * n + 4 * fq; f32x4 v = acc[ai][bj][m][n];
                        if (kind == 0) { const f32x4 b = *(const f32x4*)(w0 + c);
#pragma unroll
                            for (int j = 0; j < 4; ++j) { const float z = v[j] + b[j]; const float sp = fmaxf(-z, 0.f) + __logf(1.0f + __expf(-fabsf(z))); v[j] = __expf(-sp - 0.5f); }
                            st_bf4(E + (size_t)row * 512 + c, v);
                        } else if (kind == 1) { const f32x4 b = *(const f32x4*)(a0 + c);
#pragma unroll
                            for (int j = 0; j < 4; ++j) v[j] = sigmoidf_(v[j] + b[j]);
                            st_bf4(A + (size_t)row * 512 + c, v);
                        } else st_bf4(G + (size_t)row * 512 + c, v); } }
    }
};
struct EpiGate {
    bf16* Gt; const float* rstd; const float* bias;
    __device__ __forceinline__ void operator()(AccRef acc, const pg8::Unit& u, int wr, int wc, int fr, int fq) const {
#pragma unroll
        for (int ai = 0; ai < 2; ++ai)
#pragma unroll
            for (int m = 0; m < 4; ++m) { const int row = u.pm * 256 + ai * 128 + wr * 64 + m * 16 + fr; const float rs = rstd[row];
#pragma unroll
                for (int bj = 0; bj < 2; ++bj)
#pragma unroll
                    for (int n = 0; n < 2; ++n) { const int c = u.pn * 256 + 128 * bj + 32 * wc + 16 * n + 4 * fq; const f32x4 b = *(const f32x4*)(bias + c); f32x4 v = acc[ai][bj][m][n] * rs + b;
#pragma unroll
                        for (int j = 0; j < 4; ++j) v[j] = sigmoidf_(v[j]);
                        st_bf4(Gt + (size_t)row * 3072 + c, v); } }
    }
};
struct EpiMerge {
    const bf16* Gt; float* accf; bf16* merged; int c;
    __device__ __forceinline__ void operator()(AccRef acc, const pg8::Unit& u, int wr, int wc, int fr, int fq) const {
#pragma unroll
        for (int ai = 0; ai < 2; ++ai)
#pragma unroll
            for (int m = 0; m < 4; ++m) { const int row = u.pm * 256 + ai * 128 + wr * 64 + m * 16 + fr;
#pragma unroll
                for (int bj = 0; bj < 2; ++bj)
#pragma unroll
                    for (int n = 0; n < 2; ++n) { const int col = u.pn * 256 + 128 * bj + 32 * wc + 16 * n + 4 * fq;
                        const u32x2 gw = *(const u32x2*)(Gt + (size_t)row * 3072 + c * 1024 + col);
                        f32x4 v = acc[ai][bj][m][n]; v[0] *= bflo(gw.x); v[1] *= bfhi(gw.x); v[2] *= bflo(gw.y); v[3] *= bfhi(gw.y);
                        float* ap = accf + (size_t)row * 1024 + col;
                        if (c > 0) v = v + *(const f32x4*)ap;
                        if (c < 2) *(f32x4*)ap = v; else st_bf4(merged + (size_t)row * 1024 + col, v); } }
    }
};
struct EpiOut {
    const float* x; float* out; bf16* HB; float* HSQ;
    __device__ __forceinline__ void operator()(AccRef acc, const pg8::Unit& u, int wr, int wc, int fr, int fq) const {
#pragma unroll
        for (int ai = 0; ai < 2; ++ai)
#pragma unroll
            for (int m = 0; m < 4; ++m) { const int row = u.pm * 256 + ai * 128 + wr * 64 + m * 16 + fr; float ss = 0.f;
#pragma unroll
                for (int bj = 0; bj < 2; ++bj)
#pragma unroll
                    for (int n = 0; n < 2; ++n) { const size_t o = (size_t)row * 1024 + u.pn * 256 + 128 * bj + 32 * wc + 16 * n + 4 * fq;
                        const f32x4 v = acc[ai][bj][m][n] + *(const f32x4*)(x + o); *(f32x4*)(out + o) = v; st_h4((half_t*)HB + o, v);
                        ss += (v[0] * v[0] + v[1] * v[1]) + (v[2] * v[2] + v[3] * v[3]); }
                ss += __shfl_xor(ss, 16); ss += __shfl_xor(ss, 32);
                if (fq == 0) HSQ[(size_t)row * 16 + u.pn * 4 + wc] = ss; }
    }
};

__device__ __forceinline__ float rstd_h_row(const float* HSQ, int row) {
    const f32x4* hp = (const f32x4*)(HSQ + (size_t)row * 16); const f32x4 a = hp[0], b = hp[1], c = hp[2], d = hp[3];
    const float s = ((a[0] + a[1]) + (a[2] + a[3])) + ((b[0] + b[1]) + (b[2] + b[3])) + ((c[0] + c[1]) + (c[2] + c[3])) + ((d[0] + d[1]) + (d[2] + d[3]));
    return 1.0f / sqrtf(s * (1.0f / 1024.0f) + NORM_EPS);
}
__device__ __forceinline__ void lora_in_phase(const Params& P, int bid, int nblk) {
    const bf16* RWP = (const bf16*)(P.ws + WS_RWP); bf16* LIN = (bf16*)((unsigned char*)P.out + DO_LIN); const float* mu = P.in[12];
    const int gt = bid * NT + tid_opaque(), NGT = nblk * NT;
    for (int i = gt; i < S_ * 64; i += NGT) { const int t = i >> 6, c4 = (i & 63) * 4;
        const u32x2 pw = *(const u32x2*)(RWP + (size_t)t * RW_IN + 1536 + c4);
        u32x2 qw; qw.x = 0u; qw.y = 0u; if (t > 0) qw = *(const u32x2*)(RWP + (size_t)(t - 1) * RW_IN + 1536 + c4);
        const f32x4 m4 = *(const f32x4*)(mu + 1536 + c4);
        f32x4 p = {bflo(pw.x), bfhi(pw.x), bflo(pw.y), bfhi(pw.y)}, q = {bflo(qw.x), bfhi(qw.x), bflo(qw.y), bfhi(qw.y)};
        f32x4 s = p + (q - p) * m4;
        if (c4 < 64) { for (int j = 0; j < 4; ++j) s[j] = tanhf(s[j]); }
        else if (c4 >= 128) { for (int j = 0; j < 4; ++j) s[j] = sigmoidf_(s[j]); }
        st_bf4(LIN + (size_t)t * 256 + c4, s); }
}

constexpr int TC = 32;
__device__ __forceinline__ float shift3(const bf16* RWP, const float* mu, int t, int col) {
    const float p = bf2f(RWP[(size_t)t * RW_IN + col]); const float q = t > 0 ? bf2f(RWP[(size_t)(t - 1) * RW_IN + col]) : 0.f;
    return p + (q - p) * mu[col];
}
__device__ __forceinline__ void rwkv_scan_v1(const Params& P, LAS unsigned char* lds, int h) {
    const bf16* RWP = (const bf16*)(P.ws + WS_RWP);
    const bf16* Eb = (const bf16*)((unsigned char*)P.out + DO_E); const bf16* Ab = (const bf16*)((unsigned char*)P.out + DO_A); const bf16* Gb = (const bf16*)((unsigned char*)P.out + DO_G);
    bf16* Y = (bf16*)(P.ws + WS_Y);
    const float* mu = P.in[12]; const float* k_k = P.in[18]; const float* k_a = P.in[19]; const float* r_k = P.in[20]; const float* ln_w = P.in[21]; const float* ln_b = P.in[22];
    LAS float* sR = (LAS float*)lds; LAS float* sW = sR + TC * 64; LAS float* sK = sW + TC * 64; LAS float* sV = sK + TC * 64;
    LAS float* sA = sV + TC * 64; LAS float* sB = sA + TC * 64; LAS float* sY = sB + TC * 64; LAS float* sG = sY + TC * 64;
    const int tid = tid_opaque();
    const int tok = tid >> 4, j0 = (tid & 15) * 4;
    const int si = tid >> 3, jg = tid & 7;
    float S[8];
#pragma unroll
    for (int c = 0; c < 8; ++c) S[c] = 0.f;
    for (int t0 = 0; t0 < S_; t0 += TC) {
        {
            const int t = t0 + tok; float kkv[4], ss = 0.f, rr[4], kk_[4], vv[4], aa[4], ee[4], gg[4];
#pragma unroll
            for (int j = 0; j < 4; ++j) { const int c = h * 64 + j0 + j;
                rr[j] = shift3(RWP, mu, t, c); kk_[j] = shift3(RWP, mu, t, 512 + c); vv[j] = shift3(RWP, mu, t, 1024 + c);
                aa[j] = bf2f(Ab[(size_t)t * 512 + c]); ee[j] = bf2f(Eb[(size_t)t * 512 + c]); gg[j] = bf2f(Gb[(size_t)t * 512 + c]);
                kkv[j] = kk_[j] * k_k[c]; ss += kkv[j] * kkv[j]; }
            ss += __shfl_xor(ss, 1); ss += __shfl_xor(ss, 2); ss += __shfl_xor(ss, 4); ss += __shfl_xor(ss, 8);
            const float inv = 1.0f / fmaxf(sqrtf(ss), 1e-12f);
#pragma unroll
            for (int j = 0; j < 4; ++j) { const int c = h * 64 + j0 + j; const int o = tok * 64 + j0 + j; const float kn = kkv[j] * inv;
                sR[o] = rr[j]; sW[o] = __expf(-ee[j]); sK[o] = kk_[j] * (1.0f + (aa[j] - 1.0f) * k_a[c]); sV[o] = vv[j]; sA[o] = -kn; sB[o] = kn * aa[j]; sG[o] = gg[j]; }
        }
        __syncthreads();
        for (int tt = 0; tt < TC; ++tt) {
            const LAS float* pa = sA + tt * 64 + 8 * jg; const LAS float* pb = sB + tt * 64 + 8 * jg; const LAS float* pw = sW + tt * 64 + 8 * jg;
            const LAS float* pk = sK + tt * 64 + 8 * jg; const LAS float* pr = sR + tt * 64 + 8 * jg;
            const float vi = sV[tt * 64 + si];
            float sa = 0.f;
#pragma unroll
            for (int c = 0; c < 8; ++c) sa += S[c] * pa[c];
            sa += __shfl_xor(sa, 1); sa += __shfl_xor(sa, 2); sa += __shfl_xor(sa, 4);
            float y = 0.f;
#pragma unroll
            for (int c = 0; c < 8; ++c) { S[c] = S[c] * pw[c] + sa * pb[c] + vi * pk[c]; y += S[c] * pr[c]; }
            y += __shfl_xor(y, 1); y += __shfl_xor(y, 2); y += __shfl_xor(y, 4);
            if (jg == 0) sY[tt * 64 + si] = y;
        }
        __syncthreads();
        {
            const int t = t0 + tok; float y4[4], s1 = 0.f, bon = 0.f;
#pragma unroll
            for (int j = 0; j < 4; ++j) { const int o = tok * 64 + j0 + j; y4[j] = sY[o]; s1 += y4[j]; bon += sR[o] * sK[o] * r_k[h * 64 + j0 + j]; }
            s1 += __shfl_xor(s1, 1); s1 += __shfl_xor(s1, 2); s1 += __shfl_xor(s1, 4); s1 += __shfl_xor(s1, 8);
            bon += __shfl_xor(bon, 1); bon += __shfl_xor(bon, 2); bon += __shfl_xor(bon, 4); bon += __shfl_xor(bon, 8);
            const float mean = s1 * (1.0f / 64.0f); float s2 = 0.f;
#pragma unroll
            for (int j = 0; j < 4; ++j) { const float d = y4[j] - mean; s2 += d * d; }
            s2 += __shfl_xor(s2, 1); s2 += __shfl_xor(s2, 2); s2 += __shfl_xor(s2, 4); s2 += __shfl_xor(s2, 8);
            const float rstd = 1.0f / sqrtf(s2 * (1.0f / 64.0f) + GN_EPS);
            f32x4 o4;
#pragma unroll
            for (int j = 0; j < 4; ++j) { const int c = h * 64 + j0 + j; const int o = tok * 64 + j0 + j;
                o4[j] = ((y4[j] - mean) * rstd * ln_w[c] + ln_b[c] + bon * sV[o]) * sG[o]; }
            st_bf4(Y + (size_t)t * 1536 + 512 + h * 64 + j0, o4);
        }
        __syncthreads();
    }
}

__device__ __forceinline__ unsigned ordkey(float f) { const unsigned u = __builtin_bit_cast(unsigned, f); return (u & 0x80000000u) ? ~u : (u | 0x80000000u); }
constexpr int DSA_LDS_SCORES = 0, DSA_LDS_IQ = 65536, DSA_LDS_HIST = DSA_LDS_IQ + 1024, DSA_LDS_MISC = DSA_LDS_HIST + 1024, DSA_LDS_SEL = DSA_LDS_MISC + 256,
              DSA_LDS_O = DSA_LDS_SEL + 1024, DSA_LDS_ML = DSA_LDS_O + 8 * 512 * 4, DSA_LDS_END = DSA_LDS_ML + 8 * 8 * 2 * 4;
__device__ __forceinline__ void dsa_query_v1(const Params& P, LAS unsigned char* lds, int t) {
    const half_t* IQ = (const half_t*)(P.ws + WS_IQ); const half_t* IK = (const half_t*)(P.ws + WS_IK); const float* IW = (const float*)(P.ws + WS_IW);
    const bf16* Q = (const bf16*)(P.ws + WS_Q); const bf16* Kb = (const bf16*)(P.ws + WS_K); const bf16* Vb = (const bf16*)(P.ws + WS_V);
    bf16* Y = (bf16*)(P.ws + WS_Y);
    LAS float* sc = (LAS float*)(lds + DSA_LDS_SCORES); LAS float* siq = (LAS float*)(lds + DSA_LDS_IQ); LAS unsigned* hist = (LAS unsigned*)(lds + DSA_LDS_HIST);
    LAS unsigned* misc = (LAS unsigned*)(lds + DSA_LDS_MISC); LAS unsigned* sel = (LAS unsigned*)(lds + DSA_LDS_SEL);
    LAS float* so = (LAS float*)(lds + DSA_LDS_O); LAS float* sml = (LAS float*)(lds + DSA_LDS_ML);
    const int tid = tid_opaque(), lane = tid & 63, wave = tid >> 6;
    const int n = t + 1;
    if (tid < 256) siq[tid] = (float)IQ[(size_t)t * 256 + tid];
    if (tid < 256) sel[tid] = 0xFFFFu;
    __syncthreads();
    float w4[4];
#pragma unroll
    for (int hh = 0; hh < 4; ++hh) w4[hh] = IW[(size_t)t * 4 + hh] * 0.0625f;
    for (int s = tid; s < n; s += NT) {
        const half8* kp = (const half8*)(IK + (size_t)s * 64);
        float d0 = 0.f, d1 = 0.f, d2 = 0.f, d3 = 0.f;
#pragma unroll
        for (int c = 0; c < 8; ++c) { const half8 kv = kp[c];
#pragma unroll
            for (int j = 0; j < 8; ++j) { const float kf = (float)kv[j]; const int d = c * 8 + j;
                d0 += siq[d] * kf; d1 += siq[64 + d] * kf; d2 += siq[128 + d] * kf; d3 += siq[192 + d] * kf; } }
        float v = w4[0] * fmaxf(d0, 0.f) + w4[1] * fmaxf(d1, 0.f) + w4[2] * fmaxf(d2, 0.f) + w4[3] * fmaxf(d3, 0.f);
        sc[s] = v + 0.0f;
    }
    __syncthreads();
    if (n <= 256) { if (tid < n) sel[tid] = (unsigned)tid; __syncthreads(); }
    else {
        unsigned prefix = 0u, krem = 256u;
        for (int pass = 3; pass >= 0; --pass) {
            const int shift = pass * 8;
            if (tid < 256) hist[tid] = 0u;
            __syncthreads();
            for (int s = tid; s < n; s += NT) { const unsigned k = ordkey(sc[s]);
                if (pass == 3 || (k >> (shift + 8)) == (prefix >> (shift + 8))) atomicAdd((unsigned*)&hist[(k >> shift) & 255u], 1u); }
            __syncthreads();
            if (tid == 0) { unsigned cum = 0u; int b = 255; for (; b > 0; --b) { const unsigned hb = hist[b]; if (cum + hb >= krem) break; cum += hb; }
                misc[0] = prefix | ((unsigned)b << shift); misc[1] = krem - cum; }
            __syncthreads();
            prefix = misc[0]; krem = misc[1];
            __syncthreads();
        }
        const unsigned T = prefix; unsigned selbase = 0u, eqbase = 0u;
        for (int c0 = 0; c0 < n; c0 += NT) {
            const int s = c0 + tid; const unsigned k = (s < n) ? ordkey(sc[s]) : 0u; const bool gt = (s < n) && k > T, eq = (s < n) && k == T;
            const unsigned long long beq = __ballot(eq); const unsigned eqpre = __popcll(beq & ((1ull << lane) - 1ull));
            if (lane == 0) misc[8 + wave] = (unsigned)__popcll(beq);
            __syncthreads();
            unsigned eqoff = eqbase, eqtot = 0u;
#pragma unroll
            for (int w = 0; w < 8; ++w) { const unsigned cw = misc[8 + w]; if (w < wave) eqoff += cw; eqtot += cw; }
            const bool take = gt || (eq && (eqoff + eqpre) < krem);
            const unsigned long long bt = __ballot(take); const unsigned tpre = __popcll(bt & ((1ull << lane) - 1ull));
            if (lane == 0) misc[16 + wave] = (unsigned)__popcll(bt);
            __syncthreads();
            unsigned toff = selbase, ttot = 0u;
#pragma unroll
            for (int w = 0; w < 8; ++w) { const unsigned cw = misc[16 + w]; if (w < wave) toff += cw; ttot += cw; }
            if (take && (toff + tpre) < 256u) sel[toff + tpre] = (unsigned)s;
            selbase += ttot; eqbase += eqtot;
            __syncthreads();
        }
    }
    {
        u16* SEL = (u16*)(P.ws + WS_SEL);
        if (tid < 256) SEL[(size_t)t * 256 + tid] = (u16)sel[tid];
        const u32x4 qw = *(const u32x4*)(Q + (size_t)t * 512 + 8 * lane);
        float q[8] = {bflo(qw.x), bfhi(qw.x), bflo(qw.y), bfhi(qw.y), bflo(qw.z), bfhi(qw.z), bflo(qw.w), bfhi(qw.w)};
        float lg[32]; float mx = -INFINITY;
#pragma unroll
        for (int i = 0; i < 32; ++i) { const unsigned id = sel[wave * 32 + i];
            float d = -INFINITY;
            if (id != 0xFFFFu) { const u32x4 kw = *(const u32x4*)(Kb + (size_t)id * 512 + 8 * lane);
                d = q[0] * bflo(kw.x) + q[1] * bfhi(kw.x) + q[2] * bflo(kw.y) + q[3] * bfhi(kw.y) + q[4] * bflo(kw.z) + q[5] * bfhi(kw.z) + q[6] * bflo(kw.w) + q[7] * bfhi(kw.w);
                d += __shfl_xor(d, 1); d += __shfl_xor(d, 2); d += __shfl_xor(d, 4); d *= 0.125f; }
            lg[i] = d; mx = fmaxf(mx, d); }
        float l = 0.f, o[8];
#pragma unroll
        for (int c = 0; c < 8; ++c) o[c] = 0.f;
#pragma unroll
        for (int i = 0; i < 32; ++i) { const unsigned id = sel[wave * 32 + i];
            if (id != 0xFFFFu) { const float p = __expf(lg[i] - mx); l += p;
                const u32x4 vw = *(const u32x4*)(Vb + (size_t)id * 512 + 8 * lane);
                o[0] += p * bflo(vw.x); o[1] += p * bfhi(vw.x); o[2] += p * bflo(vw.y); o[3] += p * bfhi(vw.y); o[4] += p * bflo(vw.z); o[5] += p * bfhi(vw.z); o[6] += p * bflo(vw.w); o[7] += p * bfhi(vw.w); } }
#pragma unroll
        for (int c = 0; c < 8; ++c) so[wave * 512 + 8 * lane + c] = o[c];
        if ((lane & 7) == 0) { sml[(wave * 8 + (lane >> 3)) * 2] = mx; sml[(wave * 8 + (lane >> 3)) * 2 + 1] = l; }
        __syncthreads();
        {
            const int hh = tid >> 6; float M = -INFINITY;
#pragma unroll
            for (int w = 0; w < 8; ++w) M = fmaxf(M, sml[(w * 8 + hh) * 2]);
            float L = 0.f, acc = 0.f;
#pragma unroll
            for (int w = 0; w < 8; ++w) { const float mw = sml[(w * 8 + hh) * 2]; const float f = (mw == -INFINITY) ? 0.f : __expf(mw - M); L += f * sml[(w * 8 + hh) * 2 + 1]; acc += f * so[w * 512 + tid]; }
            Y[(size_t)t * 1536 + tid] = (bf16)f2bf(acc / L);
        }
        __syncthreads();
    }
}

constexpr int MA_KSTRIDE = 264;
constexpr int MA_LDS_K = 0, MA_LDS_V = 256 * MA_KSTRIDE, MA_LDS_P = MA_LDS_V + 256 * 256, MA_LDS_Q = MA_LDS_P + 8 * 256 * 4, MA_LDS_END = MA_LDS_Q + 8 * 128 * 4;
__device__ __forceinline__ void mem_attn_phase(const Params& P, LAS unsigned char* lds, int bid, int nblk) {
    const float* KMVM = (const float*)(P.ws + WS_KMVM); const bf16* MEMQ = (const bf16*)(P.ws + WS_MEMQ); bf16* Y = (bf16*)(P.ws + WS_Y);
    const float* qg = P.in[10]; const float* kg = P.in[11];
    const int tid = tid_opaque(), lane = tid & 63, wave = tid >> 6;
    const int h = bid & 3, sub = bid >> 2, nsub = nblk >> 2;
    for (int r = wave; r < 256; r += NW) {
        const f32x2 kv = *(const f32x2*)(KMVM + (size_t)r * 1024 + h * 128 + 2 * lane);
        const float ss = wave_sum(kv.x * kv.x + kv.y * kv.y); const float rk = 1.0f / sqrtf(ss * (1.0f / 128.0f) + NORM_EPS);
        *(LAS unsigned*)(lds + MA_LDS_K + r * MA_KSTRIDE + 4 * lane) = pk2(kv.x * rk * kg[2 * lane], kv.y * rk * kg[2 * lane + 1]);
        const f32x2 vv = *(const f32x2*)(KMVM + (size_t)r * 1024 + 512 + h * 128 + 2 * lane);
        *(LAS unsigned*)(lds + MA_LDS_V + r * 256 + 4 * lane) = pk2(vv.x, vv.y);
    }
    __syncthreads();
    LAS float* pb = (LAS float*)(lds + MA_LDS_P) + wave * 256; LAS float* qb = (LAS float*)(lds + MA_LDS_Q) + wave * 128;
    for (int r = sub * NW + wave; r < S_; r += nsub * NW) {
        const unsigned qw = *(const unsigned*)(MEMQ + (size_t)r * 512 + h * 128 + 2 * lane);
        const float q0 = bflo(qw), q1 = bfhi(qw);
        const float ss = wave_sum(q0 * q0 + q1 * q1); const float rq = 1.0f / sqrtf(ss * (1.0f / 128.0f) + NORM_EPS) * 0.08838834764831845f;
        qb[2 * lane] = q0 * rq * qg[2 * lane]; qb[2 * lane + 1] = q1 * rq * qg[2 * lane + 1];
        LDS_WAIT(); __builtin_amdgcn_wave_barrier();
        float lg[4] = {0.f, 0.f, 0.f, 0.f};
#pragma unroll 4
        for (int d4 = 0; d4 < 32; ++d4) { const f32x4 qv = *(const LAS f32x4*)(qb + 4 * d4);
#pragma unroll
            for (int c = 0; c < 4; ++c) { const u32x2 kw = *(const LAS u32x2*)(lds + MA_LDS_K + (lane + 64 * c) * MA_KSTRIDE + 8 * d4);
                lg[c] += qv[0] * bflo(kw.x) + qv[1] * bfhi(kw.x) + qv[2] * bflo(kw.y) + qv[3] * bfhi(kw.y); } }
        const float mx = wave_max(fmaxf(fmaxf(lg[0], lg[1]), fmaxf(lg[2], lg[3])));
        float p[4], l = 0.f;
#pragma unroll
        for (int c = 0; c < 4; ++c) { p[c] = __expf(lg[c] - mx); l += p[c]; }
        l = wave_sum(l); const float il = 1.0f / l;
#pragma unroll
        for (int c = 0; c < 4; ++c) pb[lane + 64 * c] = p[c] * il;
        LDS_WAIT(); __builtin_amdgcn_wave_barrier();
        float o0 = 0.f, o1 = 0.f;
#pragma unroll 8
        for (int k4 = 0; k4 < 64; ++k4) { const f32x4 pv = *(const LAS f32x4*)(pb + 4 * k4);
#pragma unroll
            for (int c = 0; c < 4; ++c) { const unsigned vw = *(const LAS unsigned*)(lds + MA_LDS_V + (4 * k4 + c) * 256 + 4 * lane); o0 += pv[c] * bflo(vw); o1 += pv[c] * bfhi(vw); } }
        *(unsigned*)(Y + (size_t)r * 1536 + 1024 + h * 128 + 2 * lane) = pk2(o0, o1);
        LDS_WAIT(); __builtin_amdgcn_wave_barrier();
    }
}

__device__ __forceinline__ void rstdh_phase(const Params& P, int bid, int nblk) {
    const float* HSQ = (const float*)(P.ws + WS_HSQ); float* R = (float*)(P.ws + WS_RSTDH);
    for (int r = bid * NT + tid_opaque(); r < S_; r += nblk * NT) { float s = 0.f;
#pragma unroll
        for (int i = 0; i < 16; ++i) s += HSQ[(size_t)r * 16 + i];
        R[r] = 1.0f / sqrtf(s * (1.0f / 1024.0f) + NORM_EPS); }
}
#define BUBBLE16(v, ix, x, c) do { if ((x) > v[15]) { v[15] = (x); ix[15] = (c); _Pragma("unroll") for (int _p = 15; _p > 0; --_p) { \
        const bool _sw = v[_p] > v[_p - 1]; const float _a = v[_p], _b = v[_p - 1]; const int _ia = ix[_p], _ib = ix[_p - 1]; \
        v[_p] = _sw ? _b : _a; v[_p - 1] = _sw ? _a : _b; ix[_p] = _sw ? _ib : _ia; ix[_p - 1] = _sw ? _ia : _ib; } } } while (0)
__device__ __forceinline__ void peer_topk_phase(const Params& P, LAS unsigned char* lds, int h, int bid, int nblk) {
    const float* SC = (const float*)(P.ws + WS_SC); int* EIDX = (int*)(P.ws + WS_EIDX); float* EG = (float*)(P.ws + WS_EGATE);
    LAS float* sv = (LAS float*)lds; LAS int* sx = (LAS int*)(lds + 256 * 2 * 16 * 4);
    const int tid = tid_opaque(), rl = tid >> 1, half = tid & 1;
    for (int r0 = bid * 256; r0 < S_; r0 += nblk * 256) {
        const int row = r0 + rl;
        float v[16]; int ix[16];
#pragma unroll
        for (int p = 0; p < 16; ++p) { v[p] = -INFINITY; ix[p] = 0; }
        const f32x4* sp = (const f32x4*)(SC + (size_t)row * 256 + half * 128);
        for (int c4 = 0; c4 < 32; ++c4) { const f32x4 x = sp[c4];
#pragma unroll
            for (int j = 0; j < 4; ++j) { const float xv = x[j]; const int cc = 4 * c4 + j; BUBBLE16(v, ix, xv, cc); } }
#pragma unroll
        for (int p = 0; p < 16; ++p) { sv[(rl * 2 + half) * 16 + p] = v[p]; sx[(rl * 2 + half) * 16 + p] = ix[p]; }
        __syncthreads();
        if (half == 0) {
            float cv[16]; int ci[16];
#pragma unroll
            for (int p = 0; p < 16; ++p) { cv[p] = -INFINITY; ci[p] = 0; }
            for (int i = 0; i < 16; ++i) { const float a = sv[(rl * 2) * 16 + i];
                for (int j = 0; j < 16; ++j) { const float s = a + sv[(rl * 2 + 1) * 16 + j]; const int f = i * 16 + j; BUBBLE16(cv, ci, s, f); } }
            float l = 0.f, pe[16];
#pragma unroll
            for (int p = 0; p < 16; ++p) { pe[p] = __expf(cv[p] - cv[0]); l += pe[p]; }
            const float il = 1.0f / l;
#pragma unroll
            for (int p = 0; p < 16; ++p) { const int e1 = sx[(rl * 2) * 16 + (ci[p] >> 4)], e2 = sx[(rl * 2 + 1) * 16 + (ci[p] & 15)];
                EIDX[(size_t)row * 128 + h * 16 + p] = e1 * 128 + e2; EG[(size_t)row * 128 + h * 16 + p] = pe[p] * il; }
        }
        __syncthreads();
    }
}
__device__ __forceinline__ void peer_expert_phase_v1(const Params& P, int bid, int nblk) {
    const int* EIDX = (const int*)(P.ws + WS_EIDX); const float* EG = (const float*)(P.ws + WS_EGATE); const float* HSQ = (const float*)(P.ws + WS_HSQ);
    const float* U = P.in[29]; const float* Vt = P.in[30]; const float* gain = P.in[25];
    const int tid = tid_opaque(), lane = tid & 63, wave = tid >> 6;
    for (int row = bid * NW + wave; row < S_; row += nblk * NW) {
        float* hp = P.out + (size_t)row * 1024; const float rs = rstd_h_row(HSQ, row);
        f32x4 hv[4], xn[4], o[4];
#pragma unroll
        for (int j = 0; j < 4; ++j) { hv[j] = *(const f32x4*)(hp + 4 * lane + 256 * j); xn[j] = hv[j] * rs * *(const f32x4*)(gain + 4 * lane + 256 * j); o[j] = (f32x4){0.f, 0.f, 0.f, 0.f}; }
        const int e_lo = EIDX[(size_t)row * 128 + lane], e_hi = EIDX[(size_t)row * 128 + 64 + lane];
        const float g_lo = EG[(size_t)row * 128 + lane], g_hi = EG[(size_t)row * 128 + 64 + lane];
        for (int e = 0; e < 128; ++e) {
            const int idx = __shfl((e < 64) ? e_lo : e_hi, e & 63); const float gt = __shfl((e < 64) ? g_lo : g_hi, e & 63);
            const float* up = U + (size_t)idx * 1024; float d = 0.f;
#pragma unroll
            for (int j = 0; j < 4; ++j) { const f32x4 uv = *(const f32x4*)(up + 4 * lane + 256 * j); d += (xn[j][0] * uv[0] + xn[j][1] * uv[1]) + (xn[j][2] * uv[2] + xn[j][3] * uv[3]); }
            d = wave_sum(d);
            const float w = gt * 0.5f * d * (1.0f + erff(d * 0.70710678118654752f));
            const float* vp = Vt + (size_t)idx * 1024;
#pragma unroll
            for (int j = 0; j < 4; ++j) o[j] = o[j] + *(const f32x4*)(vp + 4 * lane + 256 * j) * w;
        }
#pragma unroll
        for (int j = 0; j < 4; ++j) *(f32x4*)(hp + 4 * lane + 256 * j) = hv[j] + o[j];
    }
}
struct EpiPQ {
    half_t* PQ; const float* HSQ;
    __device__ __forceinline__ void operator()(AccRef acc, const pg8::Unit& u, int wr, int wc, int fr, int fq) const {
#pragma unroll
        for (int ai = 0; ai < 2; ++ai)
#pragma unroll
            for (int m = 0; m < 4; ++m) { const int row = u.pm * 256 + ai * 128 + wr * 64 + m * 16 + fr;
                const f32x4* hp = (const f32x4*)(HSQ + (size_t)row * 16); const f32x4 a = hp[0], b = hp[1], c = hp[2], d = hp[3];
                const float s = ((a[0] + a[1]) + (a[2] + a[3])) + ((b[0] + b[1]) + (b[2] + b[3])) + ((c[0] + c[1]) + (c[2] + c[3])) + ((d[0] + d[1]) + (d[2] + d[3]));
                const float rs = 1.0f / sqrtf(s * (1.0f / 1024.0f) + NORM_EPS);
                half_t* dst = PQ + (size_t)row * 2048 + u.pn * 256 + 32 * wc + 4 * fq;
#pragma unroll
                for (int bj = 0; bj < 2; ++bj)
#pragma unroll
                    for (int n = 0; n < 2; ++n) st_h4(dst + 128 * bj + 16 * n, acc[ai][bj][m][n] * rs); }
    }
};
#define PEER_CAND(I, J) do { if (((I) + 1) * ((J) + 1) <= 16) { const float _s = v1[I] + v2[J]; const int _e = i1[I] * 128 + i2[J]; BUBBLE16(cv, ce, _s, _e); } } while (0)
__device__ __forceinline__ void peer_topk_tile(const float* scr, int pm, int head, int* EIDX, float* EG) {
    const int tid = tid_opaque(), lrow = tid >> 1, kh = tid & 1;
    float v[16]; int ix[16];
#pragma unroll
    for (int p = 0; p < 16; ++p) { v[p] = -INFINITY; ix[p] = 0; }
    const f32x4* sp = (const f32x4*)(scr + (size_t)lrow * 256 + kh * 128);
#pragma unroll 1
    for (int c4 = 0; c4 < 32; ++c4) { const f32x4 x = sp[c4];
#pragma unroll
        for (int j = 0; j < 4; ++j) { const float xv = x[j]; const int cc = 4 * c4 + j; BUBBLE16(v, ix, xv, cc); } }
    float v1[16], v2[16]; int i1[16], i2[16];
#pragma unroll
    for (int p = 0; p < 16; ++p) { const float ov = __shfl_xor(v[p], 1); const int oi = __shfl_xor(ix[p], 1);
        v1[p] = kh ? ov : v[p]; i1[p] = kh ? oi : ix[p]; v2[p] = kh ? v[p] : ov; i2[p] = kh ? ix[p] : oi; }
    float cv[16]; int ce[16];
#pragma unroll
    for (int p = 0; p < 16; ++p) { cv[p] = -INFINITY; ce[p] = 0; }
#pragma unroll
    for (int I = 0; I < 16; ++I) {
#pragma unroll
        for (int J = 0; J < 16; ++J) PEER_CAND(I, J); }
    if (kh == 0) {
        float l = 0.f, pe[16];
#pragma unroll
        for (int p = 0; p < 16; ++p) { pe[p] = __expf(cv[p] - cv[0]); l += pe[p]; }
        const float il = 1.0f / l; const int row = pm * 256 + lrow;
        int* ep = EIDX + (size_t)row * 128 + head * 16; float* gp = EG + (size_t)row * 128 + head * 16;
#pragma unroll
        for (int p4 = 0; p4 < 4; ++p4) { *(f32x4*)(gp + 4 * p4) = (f32x4){pe[4 * p4] * il, pe[4 * p4 + 1] * il, pe[4 * p4 + 2] * il, pe[4 * p4 + 3] * il};
            typedef int i32x4 __attribute__((ext_vector_type(4))); *(i32x4*)(ep + 4 * p4) = (i32x4){ce[4 * p4], ce[4 * p4 + 1], ce[4 * p4 + 2], ce[4 * p4 + 3]}; }
    }
}
struct EpiTile {
    float* scr;
    __device__ __forceinline__ void operator()(AccRef acc, const pg8::Unit& u, int wr, int wc, int fr, int fq) const {
#pragma unroll
        for (int ai = 0; ai < 2; ++ai)
#pragma unroll
            for (int m = 0; m < 4; ++m) { float* dst = scr + (size_t)(ai * 128 + wr * 64 + m * 16 + fr) * 256 + 32 * wc + 4 * fq;
#pragma unroll
                for (int bj = 0; bj < 2; ++bj)
#pragma unroll
                    for (int n = 0; n < 2; ++n) *(f32x4*)(dst + 128 * bj + 16 * n) = acc[ai][bj][m][n]; }
    }
};
typedef _Float16 h8 __attribute__((ext_vector_type(8)));
constexpr int DQ = 16, DCAP = 1024, DSTEP_TILES = 16;
constexpr int DA_CS = 0, DA_CI = DQ * DCAP * 4, DA_CNT = DA_CI + DQ * DCAP * 2, DA_TAU = DA_CNT + 64, DA_HIST = DA_TAU + 64, DA_SELST = DA_HIST + 8 * 256 * 4, DA_END = DA_SELST + 8 * 512;
__device__ __forceinline__ float inv_ordkey(unsigned u) { return __builtin_bit_cast(float, (u & 0x80000000u) ? (u & 0x7fffffffu) : ~u); }

__device__ __forceinline__ void dsa_compact(LAS unsigned char* lds, int q, int lane, int wave) {
    LAS float* cs = (LAS float*)(lds + DA_CS) + q * DCAP; LAS u16* ci = (LAS u16*)(lds + DA_CI) + q * DCAP;
    LAS unsigned* cnt = (LAS unsigned*)(lds + DA_CNT); LAS float* tau = (LAS float*)(lds + DA_TAU); LAS unsigned* hist = (LAS unsigned*)(lds + DA_HIST) + wave * 256;
    const int n = (int)cnt[q];
    if (n <= 256) return;
    unsigned hi[16], lo[16]; unsigned alive = 0u, valid = 0u;
#pragma unroll
    for (int k = 0; k < 16; ++k) { const int e = lane + 64 * k; const bool v = e < n; hi[k] = v ? ordkey(cs[e]) : 0u; lo[k] = v ? (0xFFFFu - (unsigned)ci[e]) : 0u; if (v) { alive |= 1u << k; valid |= 1u << k; } }
    unsigned krem = 256u, Thi = 0u, Tlo = 0u;
#pragma unroll 1
    for (int pass = 5; pass >= 0; --pass) {
        *(LAS u32x4*)(hist + 4 * lane) = (u32x4){0u, 0u, 0u, 0u};
        const int sh = (pass >= 2) ? 8 * (pass - 2) : 8 * pass;
        unsigned dg[16];
#pragma unroll
        for (int k = 0; k < 16; ++k) { dg[k] = (((pass >= 2) ? hi[k] : lo[k]) >> sh) & 255u; if (alive & (1u << k)) atomicAdd((unsigned*)&hist[dg[k]], 1u); }
        LDS_WAIT();
        const u32x4 h4 = *(const LAS u32x4*)(hist + 4 * lane);
        unsigned suf = h4.x + h4.y + h4.z + h4.w;
#pragma unroll
        for (int o = 1; o < 64; o <<= 1) { const unsigned v = __shfl_down(suf, o); suf += (lane + o < 64) ? v : 0u; }
        const unsigned S0 = suf, S1 = suf - h4.x, S2 = S1 - h4.y, S3 = S2 - h4.z;
        const int nge = __popcll(__ballot(S0 >= krem)) + __popcll(__ballot(S1 >= krem)) + __popcll(__ballot(S2 >= krem)) + __popcll(__ballot(S3 >= krem));
        const int d = nge - 1;
        const unsigned Sd0 = __shfl(S0, d >> 2), Sd1 = __shfl(S1, d >> 2), Sd2 = __shfl(S2, d >> 2), Sd3 = __shfl(S3, d >> 2);
        const unsigned Sd = ((d & 3) == 0) ? Sd0 : ((d & 3) == 1) ? Sd1 : ((d & 3) == 2) ? Sd2 : Sd3;
        const unsigned hd = hist[d];
        krem -= (Sd - hd);
        if (pass >= 2) Thi |= (unsigned)d << sh; else Tlo |= (unsigned)d << sh;
#pragma unroll
        for (int k = 0; k < 16; ++k) if (dg[k] != (unsigned)d) alive &= ~(1u << k);
        LDS_WAIT();
    }
    unsigned base = 0u;
#pragma unroll
    for (int k = 0; k < 16; ++k) { const bool keep = ((valid >> k) & 1u) && (hi[k] > Thi || (hi[k] == Thi && lo[k] >= Tlo));
        const unsigned long long b = __ballot(keep);
        if (keep) { const unsigned pos = base + (unsigned)__popcll(b & ((1ull << lane) - 1ull)); cs[pos] = inv_ordkey(hi[k]); ci[pos] = (u16)(0xFFFFu - lo[k]); }
        base += (unsigned)__popcll(b); }
    if (lane == 0) { cnt[q] = 256u; tau[q] = inv_ordkey(Thi); }
}

__device__ __forceinline__ void dsa_index_item(const Params& P, LAS unsigned char* lds, int item) {
    const half_t* IQ = (const half_t*)(P.ws + WS_IQ); const half_t* IK = (const half_t*)(P.ws + WS_IK); const float* IW = (const float*)(P.ws + WS_IW); u16* SEL = (u16*)(P.ws + WS_SEL);
    LAS float* cs = (LAS float*)(lds + DA_CS); LAS u16* ci = (LAS u16*)(lds + DA_CI); LAS unsigned* cnt = (LAS unsigned*)(lds + DA_CNT); LAS float* tau = (LAS float*)(lds + DA_TAU);
    const int tid = tid_opaque(), lane = tid & 63, wave = __builtin_amdgcn_readfirstlane(tid >> 6), qq = lane & 15, kg = lane >> 4;
    const int q0 = item * DQ, t = q0 + qq, ntiles = item + 1;
    h8 bq[4][2]; float w[4];
#pragma unroll
    for (int h = 0; h < 4; ++h) { w[h] = IW[(size_t)t * 4 + h] * 0.0625f;
#pragma unroll
        for (int ks = 0; ks < 2; ++ks) bq[h][ks] = *(const h8*)(IQ + (size_t)t * 256 + h * 64 + ks * 32 + kg * 8); }
    if (tid < DQ) { cnt[tid] = 0u; tau[tid] = -INFINITY; }
    __syncthreads();
    float tq = -INFINITY;
    for (int base = 0; base < ntiles; base += DSTEP_TILES) {
#pragma unroll
        for (int g = 0; g < 2; ++g) { const int tile = base + g * 8 + wave;
            if (tile < ntiles) { const int s0 = tile * 16;
                const h8 a0 = *(const h8*)(IK + (size_t)(s0 + qq) * 64 + kg * 8), a1 = *(const h8*)(IK + (size_t)(s0 + qq) * 64 + 32 + kg * 8);
                float sc[4] = {0.f, 0.f, 0.f, 0.f};
#pragma unroll
                for (int h = 0; h < 4; ++h) { f32x4 acc = {0.f, 0.f, 0.f, 0.f};
                    acc = __builtin_amdgcn_mfma_f32_16x16x32_f16(a0, bq[h][0], acc, 0, 0, 0); acc = __builtin_amdgcn_mfma_f32_16x16x32_f16(a1, bq[h][1], acc, 0, 0, 0);
#pragma unroll
                    for (int r = 0; r < 4; ++r) sc[r] += w[h] * fmaxf(acc[r], 0.f); }
#pragma unroll
                for (int r = 0; r < 4; ++r) { const float v = sc[r] + 0.0f; const int s = s0 + 4 * kg + r;
                    if (v > tq && s <= t) { const unsigned pos = atomicAdd((unsigned*)&cnt[qq], 1u); cs[qq * DCAP + pos] = v; ci[qq * DCAP + pos] = (u16)s; } } } }
        __syncthreads();
        unsigned mx = 0u;
        { const u32x4 c0 = *(const LAS u32x4*)(cnt), c1 = *(const LAS u32x4*)(cnt + 4), c2 = *(const LAS u32x4*)(cnt + 8), c3 = *(const LAS u32x4*)(cnt + 12);
          mx = max(max(max(c0.x, c0.y), max(c0.z, c0.w)), max(max(c1.x, c1.y), max(c1.z, c1.w))); mx = max(mx, max(max(max(c2.x, c2.y), max(c2.z, c2.w)), max(max(c3.x, c3.y), max(c3.z, c3.w)))); }
        if (mx > (unsigned)(DCAP - 256)) {
            dsa_compact(lds, 2 * wave, lane, wave); dsa_compact(lds, 2 * wave + 1, lane, wave);
            __syncthreads();
            tq = tau[qq];
        }
    }
    LAS u16* st = (LAS u16*)(lds + DA_SELST) + wave * 256;
#pragma unroll 1
    for (int j = 0; j < 2; ++j) { const int q = 2 * wave + j;
        dsa_compact(lds, q, lane, wave);
        LDS_WAIT();
        const int m = (int)cnt[q]; const LAS u16* cq = ci + q * DCAP;
        unsigned id[4], rk[4];
#pragma unroll
        for (int k = 0; k < 4; ++k) { const int e = lane + 64 * k; id[k] = (e < m) ? (unsigned)cq[e] : 0xFFFFu; rk[k] = 0u; }
        *(LAS u32x2*)(st + 4 * lane) = (u32x2){0xFFFFFFFFu, 0xFFFFFFFFu};
        for (int e = 0; e < m; ++e) { const unsigned x = (unsigned)cq[e];
#pragma unroll
            for (int k = 0; k < 4; ++k) rk[k] += (x < id[k]) ? 1u : 0u; }
        LDS_WAIT();
#pragma unroll
        for (int k = 0; k < 4; ++k) if (id[k] != 0xFFFFu) st[rk[k]] = (u16)id[k];
        LDS_WAIT();
        *(u32x2*)(SEL + (size_t)(q0 + q) * 256 + 4 * lane) = *(const LAS u32x2*)(st + 4 * lane);
        LDS_WAIT();
    }
    __syncthreads();
}

__device__ __forceinline__ void dsa_index_phase(const Params& P, LAS unsigned char* lds, int bid, int nblk) {
    constexpr int NITEMS = S_ / DQ;
    for (int r = 0;; ++r) { const int k = r * nblk + ((r & 1) ? (nblk - 1 - bid) : bid); if (k >= NITEMS) break; dsa_index_item(P, lds, NITEMS - 1 - k); }
}

__device__ __forceinline__ void dsa_attn_phase(const Params& P, LAS unsigned char* lds, int bid, int nblk) {
    const bf16* Q = (const bf16*)(P.ws + WS_Q); const bf16* Kh = (const bf16*)(P.ws + WS_K); const bf16* Vh = (const bf16*)(P.ws + WS_V); const u16* SEL = (const u16*)(P.ws + WS_SEL); bf16* Y = (bf16*)(P.ws + WS_Y);
    const int tid = tid_opaque(), lane = tid & 63, wave = __builtin_amdgcn_readfirstlane(tid >> 6), g = lane >> 3, c8 = (lane & 7) * 8;
    const int h = bid & 7, rank = bid >> 3, nr = nblk >> 3;
    LAS u16* sl = (LAS u16*)lds + wave * 256;
    const bf16* Kb = Kh + (size_t)h * S_ * 64 + c8; const bf16* Vb = Vh + (size_t)h * S_ * 64 + c8;
    for (int t = rank * 8 + wave; t < S_; t += nr * 8) {
        *(LAS u32x2*)(sl + 4 * lane) = *(const u32x2*)(SEL + (size_t)t * 256 + 4 * lane);
        const u32x4 qw = *(const u32x4*)(Q + (size_t)t * 512 + h * 64 + c8);
        const float q0 = bflo(qw.x) * 0.125f, q1 = bfhi(qw.x) * 0.125f, q2 = bflo(qw.y) * 0.125f, q3 = bfhi(qw.y) * 0.125f, q4 = bflo(qw.z) * 0.125f, q5 = bfhi(qw.z) * 0.125f, q6 = bflo(qw.w) * 0.125f, q7 = bfhi(qw.w) * 0.125f;
        LDS_WAIT(); __builtin_amdgcn_wave_barrier();
        float lg[32]; float mx = -INFINITY;
#pragma unroll
        for (int i0 = 0; i0 < 32; i0 += 8) {
            u32x4 kw[8]; unsigned id[8];
#pragma unroll
            for (int i = 0; i < 8; ++i) { id[i] = sl[(i0 + i) * 8 + g]; kw[i] = (u32x4){0u, 0u, 0u, 0u}; if (id[i] != 0xFFFFu) kw[i] = *(const u32x4*)(Kb + (size_t)id[i] * 64); }
#pragma unroll
            for (int i = 0; i < 8; ++i) { float d = q0 * bflo(kw[i].x) + q1 * bfhi(kw[i].x) + q2 * bflo(kw[i].y) + q3 * bfhi(kw[i].y) + q4 * bflo(kw[i].z) + q5 * bfhi(kw[i].z) + q6 * bflo(kw[i].w) + q7 * bfhi(kw[i].w);
                d += __shfl_xor(d, 1); d += __shfl_xor(d, 2); d += __shfl_xor(d, 4);
                d = (id[i] != 0xFFFFu) ? d : -INFINITY; lg[i0 + i] = d; mx = fmaxf(mx, d); } }
        mx = fmaxf(mx, __shfl_xor(mx, 8)); mx = fmaxf(mx, __shfl_xor(mx, 16)); mx = fmaxf(mx, __shfl_xor(mx, 32));
        float l = 0.f, o[8];
#pragma unroll
        for (int c = 0; c < 8; ++c) o[c] = 0.f;
#pragma unroll
        for (int i0 = 0; i0 < 32; i0 += 8) {
            u32x4 vw[8]; float p[8];
#pragma unroll
            for (int i = 0; i < 8; ++i) { const unsigned id = sl[(i0 + i) * 8 + g]; vw[i] = (u32x4){0u, 0u, 0u, 0u}; p[i] = 0.f; if (id != 0xFFFFu) { vw[i] = *(const u32x4*)(Vb + (size_t)id * 64); p[i] = __expf(lg[i0 + i] - mx); } }
#pragma unroll
            for (int i = 0; i < 8; ++i) { l += p[i];
                o[0] += p[i] * bflo(vw[i].x); o[1] += p[i] * bfhi(vw[i].x); o[2] += p[i] * bflo(vw[i].y); o[3] += p[i] * bfhi(vw[i].y);
                o[4] += p[i] * bflo(vw[i].z); o[5] += p[i] * bfhi(vw[i].z); o[6] += p[i] * bflo(vw[i].w); o[7] += p[i] * bfhi(vw[i].w); } }
        l += __shfl_xor(l, 8); l += __shfl_xor(l, 16); l += __shfl_xor(l, 32);
#pragma unroll
        for (int c = 0; c < 8; ++c) { o[c] += __shfl_xor(o[c], 8); o[c] += __shfl_xor(o[c], 16); o[c] += __shfl_xor(o[c], 32); }
        const float il = 1.0f / l;
        if (g == 0) { u32x4 w4; w4.x = pk2(o[0] * il, o[1] * il); w4.y = pk2(o[2] * il, o[3] * il); w4.z = pk2(o[4] * il, o[5] * il); w4.w = pk2(o[6] * il, o[7] * il);
            *(u32x4*)(Y + (size_t)t * 1536 + h * 64 + c8) = w4; }
        LDS_WAIT(); __builtin_amdgcn_wave_barrier();
    }
}
constexpr int RC = 64, RLD = 72, RARR = 64 * RLD * 2;
constexpr int RO_AT = 0, RO_ATT = RARR, RO_RT = 2 * RARR, RO_BT = 3 * RARR, RO_KT = 4 * RARR, RO_VT = 5 * RARR, RO_WT = 6 * RARR, RO_P1 = 7 * RARR, RO_P2 = 8 * RARR, RO_P3 = 9 * RARR, RO_P4 = 10 * RARR,
              RO_S0 = 11 * RARR, RO_F1 = 12 * RARR, RO_F2 = RO_F1 + 16384, RO_END = RO_F2 + 16384;
typedef short s16x8 __attribute__((ext_vector_type(8)));

__device__ __forceinline__ f32x4 mm16(const LAS bf16* A, const LAS bf16* B, int tr, int tc, int l15, int kg, f32x4 acc) {
#pragma unroll
    for (int ks = 0; ks < 2; ++ks) { const s16x8 a = *(const LAS s16x8*)(A + (16 * tr + l15) * RLD + 32 * ks + 8 * kg); const s16x8 b = *(const LAS s16x8*)(B + (16 * tc + l15) * RLD + 32 * ks + 8 * kg);
        acc = __builtin_amdgcn_mfma_f32_16x16x32_bf16(a, b, acc, 0, 0, 0); }
    return acc;
}
template <int MASK> __device__ __forceinline__ void st_tile(LAS bf16* Out, int tr, int tc, int l15, int kg, f32x4 acc) {
    const int col = 16 * tc + l15, row0 = 16 * tr + 4 * kg;
#pragma unroll
    for (int r = 0; r < 4; ++r) { const int row = row0 + r; bool keep = true; if (MASK == 1) keep = col < row; if (MASK == 2) keep = row < col; if (MASK == 3) keep = row <= col; if (!keep) acc[r] = 0.f; }
    u32x2 w; w.x = pk2(acc[0], acc[1]); w.y = pk2(acc[2], acc[3]);
    *(LAS u32x2*)(Out + col * RLD + row0) = w;
}
__device__ __forceinline__ void ld8(const bf16* p, float* o) { const u32x4 w = *(const u32x4*)p; o[0] = bflo(w.x); o[1] = bfhi(w.x); o[2] = bflo(w.y); o[3] = bfhi(w.y); o[4] = bflo(w.z); o[5] = bfhi(w.z); o[6] = bflo(w.w); o[7] = bfhi(w.w); }
__device__ __forceinline__ void ldf8(const float* p, float* o) { const f32x4 a = *(const f32x4*)p, b = *(const f32x4*)(p + 4); o[0] = a[0]; o[1] = a[1]; o[2] = a[2]; o[3] = a[3]; o[4] = b[0]; o[5] = b[1]; o[6] = b[2]; o[7] = b[3]; }
__device__ __forceinline__ u32x4 pk8(const float* v) { u32x4 w; w.x = pk2(v[0], v[1]); w.y = pk2(v[2], v[3]); w.z = pk2(v[4], v[5]); w.w = pk2(v[6], v[7]); return w; }

struct RwBufs { const bf16* RWP; const bf16* Eb; const bf16* Ab; const bf16* Gb; bf16* MT; bf16* Nn; bf16* S0; bf16* Y; };
__device__ __forceinline__ RwBufs rw_bufs(const Params& P) {
    RwBufs b; unsigned char* dob = (unsigned char*)P.out;
    b.RWP = (const bf16*)(P.ws + WS_RWP); b.Eb = (const bf16*)(dob + DO_E); b.Ab = (const bf16*)(dob + DO_A); b.Gb = (const bf16*)(dob + DO_G);
    b.MT = (bf16*)(dob + DO_LIN); b.Nn = (bf16*)(P.ws + WS_XB); b.S0 = (bf16*)(P.ws + WS_MEMQ); b.Y = (bf16*)(P.ws + WS_Y); return b;
}

template <bool PH3> __device__ __forceinline__ void rw_unit(const Params& P, const RwBufs& B, LAS unsigned char* lds, int h, int c) {
    const float* mu = P.in[12]; const float* k_k = P.in[18]; const float* k_a = P.in[19]; const float* r_k = P.in[20]; const float* ln_w = P.in[21]; const float* ln_b = P.in[22];
    LAS bf16* sAT = (LAS bf16*)(lds + RO_AT); LAS bf16* sATT = (LAS bf16*)(lds + RO_ATT); LAS bf16* sRT = (LAS bf16*)(lds + RO_RT); LAS bf16* sBT = (LAS bf16*)(lds + RO_BT); LAS bf16* sKT = (LAS bf16*)(lds + RO_KT);
    LAS bf16* sVT = (LAS bf16*)(lds + RO_VT); LAS bf16* sWT = (LAS bf16*)(lds + RO_WT); LAS bf16* sP1 = (LAS bf16*)(lds + RO_P1); LAS bf16* sP2 = (LAS bf16*)(lds + RO_P2); LAS bf16* sP3 = (LAS bf16*)(lds + RO_P3);
    LAS bf16* sP4 = (LAS bf16*)(lds + RO_P4); LAS bf16* sS0 = (LAS bf16*)(lds + RO_S0); LAS float* sL = (LAS float*)(lds + RO_F1); LAS float* sF2 = (LAS float*)(lds + RO_F2);
    const int tid = tid_opaque(), lane = tid & 63, wave = __builtin_amdgcn_readfirstlane(tid >> 6), l15 = lane & 15, kg = lane >> 4;
    const int t = tid >> 3, jc = (tid & 7) * 8, tg = c * RC + t, hc = h * 64 + jc;
    const size_t unit = (size_t)h * 256 + c;
    float rr[8], kk[8], vv[8], al[8], ee[8], bb[8], aa[8];
    {
        float p[8], q[8], m8[8];
        ld8(B.RWP + (size_t)tg * RW_IN + hc, p); if (tg > 0) ld8(B.RWP + (size_t)(tg - 1) * RW_IN + hc, q); else { for (int i = 0; i < 8; ++i) q[i] = 0.f; } ldf8(mu + hc, m8);
#pragma unroll
        for (int i = 0; i < 8; ++i) rr[i] = p[i] + (q[i] - p[i]) * m8[i];
        ld8(B.RWP + (size_t)tg * RW_IN + 512 + hc, p); if (tg > 0) ld8(B.RWP + (size_t)(tg - 1) * RW_IN + 512 + hc, q); ldf8(mu + 512 + hc, m8);
#pragma unroll
        for (int i = 0; i < 8; ++i) kk[i] = p[i] + (q[i] - p[i]) * m8[i];
        ld8(B.RWP + (size_t)tg * RW_IN + 1024 + hc, p); if (tg > 0) ld8(B.RWP + (size_t)(tg - 1) * RW_IN + 1024 + hc, q); ldf8(mu + 1024 + hc, m8);
#pragma unroll
        for (int i = 0; i < 8; ++i) vv[i] = p[i] + (q[i] - p[i]) * m8[i];
        ld8(B.Ab + (size_t)tg * 512 + hc, al); ld8(B.Eb + (size_t)tg * 512 + hc, ee);
        float kn[8], kkc[8], kac[8], ss = 0.f; ldf8(k_k + hc, kkc); ldf8(k_a + hc, kac);
#pragma unroll
        for (int i = 0; i < 8; ++i) { kn[i] = kk[i] * kkc[i]; ss += kn[i] * kn[i]; }
        ss += __shfl_xor(ss, 1); ss += __shfl_xor(ss, 2); ss += __shfl_xor(ss, 4);
        const float inv = 1.0f / fmaxf(sqrtf(ss), 1e-12f);
#pragma unroll
        for (int i = 0; i < 8; ++i) { kn[i] *= inv; aa[i] = -kn[i]; bb[i] = kn[i] * al[i]; kk[i] = kk[i] * (1.0f + (al[i] - 1.0f) * kac[i]); }
        *(LAS f32x4*)(sL + t * 64 + jc) = (f32x4){ee[0], ee[1], ee[2], ee[3]}; *(LAS f32x4*)(sL + t * 64 + jc + 4) = (f32x4){ee[4], ee[5], ee[6], ee[7]};
    }
    float bonus = 0.f, gg[8];
    if (PH3) { float rk8[8]; ldf8(r_k + hc, rk8);
#pragma unroll
        for (int i = 0; i < 8; ++i) bonus += rr[i] * kk[i] * rk8[i];
        bonus += __shfl_xor(bonus, 1); bonus += __shfl_xor(bonus, 2); bonus += __shfl_xor(bonus, 4);
        ld8(B.Gb + (size_t)tg * 512 + hc, gg);
        const u32x4 sw = *(const u32x4*)(B.S0 + unit * 4096 + (size_t)t * 64 + jc); *(LAS u32x4*)(sS0 + t * RLD + jc) = sw; }
    __syncthreads();
    if (wave == 0) { float run = 0.f;
#pragma unroll 8
        for (int u = 0; u < 64; ++u) { run += sL[u * 64 + lane]; sL[u * 64 + lane] = run; } }
    __syncthreads();
    {
        float Lt[8], Lp[8], Le[8];
        { const f32x4 a = *(const LAS f32x4*)(sL + t * 64 + jc), b = *(const LAS f32x4*)(sL + t * 64 + jc + 4); Lt[0] = a[0]; Lt[1] = a[1]; Lt[2] = a[2]; Lt[3] = a[3]; Lt[4] = b[0]; Lt[5] = b[1]; Lt[6] = b[2]; Lt[7] = b[3]; }
        if (t > 0) { const f32x4 a = *(const LAS f32x4*)(sL + (t - 1) * 64 + jc), b = *(const LAS f32x4*)(sL + (t - 1) * 64 + jc + 4); Lp[0] = a[0]; Lp[1] = a[1]; Lp[2] = a[2]; Lp[3] = a[3]; Lp[4] = b[0]; Lp[5] = b[1]; Lp[6] = b[2]; Lp[7] = b[3]; }
        else { for (int i = 0; i < 8; ++i) Lp[i] = 0.f; }
        { const f32x4 a = *(const LAS f32x4*)(sL + 63 * 64 + jc), b = *(const LAS f32x4*)(sL + 63 * 64 + jc + 4); Le[0] = a[0]; Le[1] = a[1]; Le[2] = a[2]; Le[3] = a[3]; Le[4] = b[0]; Le[5] = b[1]; Le[6] = b[2]; Le[7] = b[3]; }
        float at[8], rt[8], bt[8], kt[8];
#pragma unroll
        for (int i = 0; i < 8; ++i) { const float ep = __expf(Lt[i]); at[i] = aa[i] * __expf(-Lp[i]); rt[i] = rr[i] * __expf(-Lt[i]); bt[i] = bb[i] * ep; kt[i] = kk[i] * ep; }
        *(LAS u32x4*)(sAT + t * RLD + jc) = pk8(at); *(LAS u32x4*)(sBT + t * RLD + jc) = pk8(bt); *(LAS u32x4*)(sKT + t * RLD + jc) = pk8(kt);
        if (PH3) *(LAS u32x4*)(sRT + t * RLD + jc) = pk8(rt);
#pragma unroll
        for (int i = 0; i < 8; ++i) sVT[(jc + i) * RLD + t] = (bf16)f2bf(vv[i]);
        if (!PH3) {
#pragma unroll
            for (int i = 0; i < 8; ++i) sATT[(jc + i) * RLD + t] = (bf16)f2bf(at[i]);
            float bp[8], kp[8];
#pragma unroll
            for (int i = 0; i < 8; ++i) { const float ed = __expf(-(Le[i] - Lt[i])); bp[i] = bb[i] * ed; kp[i] = kk[i] * ed; }
            *(LAS f32x4*)(sF2 + t * 64 + jc) = (f32x4){bp[0], bp[1], bp[2], bp[3]}; *(LAS f32x4*)(sF2 + t * 64 + jc + 4) = (f32x4){bp[4], bp[5], bp[6], bp[7]};
            *(LAS u32x4*)(sP4 + t * RLD + jc) = pk8(kp);
        }
    }
    __syncthreads();
    const int tr = wave >> 1, tc0 = 2 * (wave & 1);
    const f32x4 z4 = {0.f, 0.f, 0.f, 0.f};
    if (!PH3) {
#pragma unroll
        for (int x = 0; x < 2; ++x) { st_tile<1>(sP1, tr, tc0 + x, l15, kg, mm16(sAT, sBT, tr, tc0 + x, l15, kg, z4)); st_tile<1>(sP2, tr, tc0 + x, l15, kg, mm16(sAT, sKT, tr, tc0 + x, l15, kg, z4)); }
        __syncthreads();
        if (wave == 0) {
#pragma unroll 1
            for (int bt = 7; bt >= 0; --bt) {
                float acc[8];
#pragma unroll
                for (int k2 = 0; k2 < 8; ++k2) acc[k2] = sF2[(8 * bt + k2) * 64 + lane];
#pragma unroll 1
                for (int u8 = bt + 1; u8 < 8; ++u8) { float w8[8];
#pragma unroll
                    for (int x = 0; x < 8; ++x) w8[x] = sF2[(8 * u8 + x) * 64 + lane];
#pragma unroll
                    for (int k2 = 0; k2 < 8; ++k2) { const u32x4 aw = *(const LAS u32x4*)(sP1 + (8 * bt + k2) * RLD + 8 * u8);
                        acc[k2] += bflo(aw.x) * w8[0] + bfhi(aw.x) * w8[1] + bflo(aw.y) * w8[2] + bfhi(aw.y) * w8[3] + bflo(aw.z) * w8[4] + bfhi(aw.z) * w8[5] + bflo(aw.w) * w8[6] + bfhi(aw.w) * w8[7]; } }
#pragma unroll
                for (int k2 = 7; k2 >= 0; --k2) { const u32x4 aw = *(const LAS u32x4*)(sP1 + (8 * bt + k2) * RLD + 8 * bt); const float a8[8] = {bflo(aw.x), bfhi(aw.x), bflo(aw.y), bfhi(aw.y), bflo(aw.z), bfhi(aw.z), bflo(aw.w), bfhi(aw.w)};
#pragma unroll
                    for (int x = k2 + 1; x < 8; ++x) acc[k2] += a8[x] * acc[x]; }
#pragma unroll
                for (int k2 = 0; k2 < 8; ++k2) sF2[(8 * bt + k2) * 64 + lane] = acc[k2];
                *(LAS u32x4*)(sWT + lane * RLD + 8 * bt) = pk8(acc);
            }
        }
        __syncthreads();
#pragma unroll
        for (int x = 0; x < 2; ++x) { const int tc = tc0 + x;
            f32x4 zi; { const int col = 16 * tc + l15;
#pragma unroll
                for (int r = 0; r < 4; ++r) zi[r] = bf2f(sP4[(16 * tr + 4 * kg + r) * RLD + col]); }
            st_tile<0>(sP3, tr, tc, l15, kg, mm16(sP2, sWT, tr, tc, l15, kg, zi));
            f32x4 m = mm16(sATT, sWT, tr, tc, l15, kg, z4);
            { const int col = 16 * tc + l15, row0 = 16 * tr + 4 * kg; const float pc = __expf(-sL[63 * 64 + col]);
#pragma unroll
                for (int r = 0; r < 4; ++r) if (row0 + r == col) m[r] += pc;
                u32x2 w; w.x = pk2(m[0], m[1]); w.y = pk2(m[2], m[3]); *(u32x2*)(B.MT + unit * 4096 + (size_t)col * 64 + row0) = w; } }
        __syncthreads();
#pragma unroll
        for (int x = 0; x < 2; ++x) { const int tc = tc0 + x; const f32x4 nacc = mm16(sP3, sVT, tr, tc, l15, kg, z4);
            u32x2 w; w.x = pk2(nacc[0], nacc[1]); w.y = pk2(nacc[2], nacc[3]); *(u32x2*)(B.Nn + unit * 4096 + (size_t)(16 * tc + l15) * 64 + 16 * tr + 4 * kg) = w; }
        __syncthreads();
    } else {
#pragma unroll
        for (int x = 0; x < 2; ++x) { const int tc = tc0 + x;
            st_tile<2>(sP1, tr, tc, l15, kg, mm16(sBT, sAT, tr, tc, l15, kg, z4)); st_tile<2>(sP2, tr, tc, l15, kg, mm16(sKT, sAT, tr, tc, l15, kg, z4));
            st_tile<3>(sP3, tr, tc, l15, kg, mm16(sBT, sRT, tr, tc, l15, kg, z4)); st_tile<3>(sP4, tr, tc, l15, kg, mm16(sKT, sRT, tr, tc, l15, kg, z4)); }
        __syncthreads();
#pragma unroll
        for (int x = 0; x < 2; ++x) { const int tc = tc0 + x; f32x4 xa = mm16(sAT, sS0, tr, tc, l15, kg, z4); xa = mm16(sP2, sVT, tr, tc, l15, kg, xa);
#pragma unroll
            for (int r = 0; r < 4; ++r) sF2[(16 * tr + 4 * kg + r) * 64 + 16 * tc + l15] = xa[r]; }
        __syncthreads();
        if (wave == 0) {
#pragma unroll 1
            for (int bt = 0; bt < 8; ++bt) {
                float acc[8];
#pragma unroll
                for (int k2 = 0; k2 < 8; ++k2) acc[k2] = sF2[(8 * bt + k2) * 64 + lane];
#pragma unroll 1
                for (int u8 = 0; u8 < bt; ++u8) { float w8[8];
#pragma unroll
                    for (int x = 0; x < 8; ++x) w8[x] = sF2[(8 * u8 + x) * 64 + lane];
#pragma unroll
                    for (int k2 = 0; k2 < 8; ++k2) { const u32x4 aw = *(const LAS u32x4*)(sP1 + (8 * bt + k2) * RLD + 8 * u8);
                        acc[k2] += bflo(aw.x) * w8[0] + bfhi(aw.x) * w8[1] + bflo(aw.y) * w8[2] + bfhi(aw.y) * w8[3] + bflo(aw.z) * w8[4] + bfhi(aw.z) * w8[5] + bflo(aw.w) * w8[6] + bfhi(aw.w) * w8[7]; } }
#pragma unroll
                for (int k2 = 0; k2 < 8; ++k2) { const u32x4 aw = *(const LAS u32x4*)(sP1 + (8 * bt + k2) * RLD + 8 * bt); const float a8[8] = {bflo(aw.x), bfhi(aw.x), bflo(aw.y), bfhi(aw.y), bflo(aw.z), bfhi(aw.z), bflo(aw.w), bfhi(aw.w)};
#pragma unroll
                    for (int x = 0; x < k2; ++x) acc[k2] += a8[x] * acc[x]; }
#pragma unroll
                for (int k2 = 0; k2 < 8; ++k2) sF2[(8 * bt + k2) * 64 + lane] = acc[k2];
                *(LAS u32x4*)(sWT + lane * RLD + 8 * bt) = pk8(acc);
            }
        }
        __syncthreads();
#pragma unroll
        for (int x = 0; x < 2; ++x) { const int tc = tc0 + x; f32x4 ya = mm16(sRT, sS0, tr, tc, l15, kg, z4); ya = mm16(sP3, sWT, tr, tc, l15, kg, ya); ya = mm16(sP4, sVT, tr, tc, l15, kg, ya);
#pragma unroll
            for (int r = 0; r < 4; ++r) sF2[(16 * tr + 4 * kg + r) * 64 + 16 * tc + l15] = ya[r]; }
        __syncthreads();
        {
            float y8[8], s1 = 0.f;
            { const f32x4 a = *(const LAS f32x4*)(sF2 + t * 64 + jc), b = *(const LAS f32x4*)(sF2 + t * 64 + jc + 4); y8[0] = a[0]; y8[1] = a[1]; y8[2] = a[2]; y8[3] = a[3]; y8[4] = b[0]; y8[5] = b[1]; y8[6] = b[2]; y8[7] = b[3]; }
#pragma unroll
            for (int i = 0; i < 8; ++i) s1 += y8[i];
            s1 += __shfl_xor(s1, 1); s1 += __shfl_xor(s1, 2); s1 += __shfl_xor(s1, 4);
            const float mean = s1 * (1.0f / 64.0f); float s2 = 0.f;
#pragma unroll
            for (int i = 0; i < 8; ++i) { const float d = y8[i] - mean; s2 += d * d; }
            s2 += __shfl_xor(s2, 1); s2 += __shfl_xor(s2, 2); s2 += __shfl_xor(s2, 4);
            const float rstd = 1.0f / sqrtf(s2 * (1.0f / 64.0f) + GN_EPS);
            float lw[8], lb[8], o8[8]; ldf8(ln_w + hc, lw); ldf8(ln_b + hc, lb);
#pragma unroll
            for (int i = 0; i < 8; ++i) o8[i] = ((y8[i] - mean) * rstd * lw[i] + lb[i] + bonus * vv[i]) * gg[i];
            *(u32x4*)(B.Y + (size_t)tg * 1536 + 512 + hc) = pk8(o8);
        }
        __syncthreads();
    }
}

__device__ __forceinline__ void rw_scan_phase(const Params& P, LAS unsigned char* lds, int h) {
    const RwBufs B = rw_bufs(P);
    const int tid = tid_opaque(), lane = tid & 63, wave = __builtin_amdgcn_readfirstlane(tid >> 6), l15 = lane & 15, kg = lane >> 4;
    const int tr = wave >> 1, tc0 = 2 * (wave & 1);
    LAS bf16* sS[2] = {(LAS bf16*)lds, (LAS bf16*)(lds + RARR)};
    for (int i = tid; i < 2 * RARR / 4; i += NT) ((LAS unsigned*)lds)[i] = 0u;
    __syncthreads();
    const int trow = tid >> 3, tcol = (tid & 7) * 8;
    s16x8 ma[2]; u32x2 nw[2];
    { const bf16* mt = B.MT + ((size_t)h * 256) * 4096; const bf16* nn = B.Nn + ((size_t)h * 256) * 4096;
#pragma unroll
        for (int ks = 0; ks < 2; ++ks) ma[ks] = *(const s16x8*)(mt + (size_t)(16 * tr + l15) * 64 + 32 * ks + 8 * kg);
#pragma unroll
        for (int x = 0; x < 2; ++x) nw[x] = *(const u32x2*)(nn + (size_t)(16 * (tc0 + x) + l15) * 64 + 16 * tr + 4 * kg); }
    for (int c = 0; c < 256; ++c) {
        const LAS bf16* cur = sS[c & 1]; LAS bf16* nxt = sS[(c + 1) & 1];
        const size_t unit = (size_t)h * 256 + c;
        *(u32x4*)(B.S0 + unit * 4096 + (size_t)trow * 64 + tcol) = *(const LAS u32x4*)(cur + trow * RLD + tcol);
        s16x8 ma_n[2]; u32x2 nw_n[2];
        if (c + 1 < 256) { const bf16* mt = B.MT + (unit + 1) * 4096; const bf16* nn = B.Nn + (unit + 1) * 4096;
#pragma unroll
            for (int ks = 0; ks < 2; ++ks) ma_n[ks] = *(const s16x8*)(mt + (size_t)(16 * tr + l15) * 64 + 32 * ks + 8 * kg);
#pragma unroll
            for (int x = 0; x < 2; ++x) nw_n[x] = *(const u32x2*)(nn + (size_t)(16 * (tc0 + x) + l15) * 64 + 16 * tr + 4 * kg); }
        else { ma_n[0] = ma[0]; ma_n[1] = ma[1]; nw_n[0] = nw[0]; nw_n[1] = nw[1]; }
#pragma unroll
        for (int x = 0; x < 2; ++x) { const int tc = tc0 + x;
            f32x4 acc = {bflo(nw[x].x), bfhi(nw[x].x), bflo(nw[x].y), bfhi(nw[x].y)};
#pragma unroll
            for (int ks = 0; ks < 2; ++ks) { const s16x8 b = *(const LAS s16x8*)(cur + (16 * tc + l15) * RLD + 32 * ks + 8 * kg); acc = __builtin_amdgcn_mfma_f32_16x16x32_bf16(ma[ks], b, acc, 0, 0, 0); }
            u32x2 w; w.x = pk2(acc[0], acc[1]); w.y = pk2(acc[2], acc[3]); *(LAS u32x2*)(nxt + (16 * tc + l15) * RLD + 16 * tr + 4 * kg) = w; }
        ma[0] = ma_n[0]; ma[1] = ma_n[1]; nw[0] = nw_n[0]; nw[1] = nw_n[1];
        __syncthreads();
    }
}
template <bool PH3> __device__ __forceinline__ void rw_units_phase(const Params& P, LAS unsigned char* lds, int bid, int nblk) {
    const RwBufs B = rw_bufs(P);
    for (int u = bid; u < 8 * 256; u += nblk) rw_unit<PH3>(P, B, lds, u >> 8, u & 255);
}

__device__ __forceinline__ void xb_phase(const Params& P, int bid, int nblk) {
    const int tid = tid_opaque(), lane = tid & 63, wave = tid >> 6;
    for (int r = bid * NW + wave; r < S_; r += nblk * NW) {
        const f32x4* xr = (const f32x4*)(P.in[0] + (size_t)r * D_) + lane; unsigned long long* o8 = (unsigned long long*)((bf16*)(P.ws + WS_XB) + (size_t)r * D_) + lane;
#pragma unroll
        for (int j = 0; j < 4; ++j) { const f32x4 v = xr[64 * j]; o8[64 * j] = (unsigned long long)pk2(v.x, v.y) | ((unsigned long long)pk2(v.z, v.w) << 32); }
    }
}
#include <hip/hip_cooperative_groups.h>
namespace cg = cooperative_groups;
extern __shared__ __attribute__((aligned(16))) unsigned char dyn_lds[];
#define LDSP ((LAS unsigned char*)dyn_lds)
constexpr int LDS_BYTES = 150 * 1024;
static_assert(MA_LDS_END <= LDS_BYTES && DA_END <= LDS_BYTES && RO_END <= LDS_BYTES && 131072 <= LDS_BYTES, "LDS budget");

typedef const __attribute__((address_space(4))) Params* KargPtr;
__device__ __forceinline__ Params load_params() {
    Params r;
#if defined(__HIP_DEVICE_COMPILE__)
    KargPtr kp = (KargPtr)__builtin_amdgcn_kernarg_segment_ptr(); asm volatile("" : "+s"(kp));
#pragma unroll
    for (int i = 0; i < 31; ++i) r.in[i] = kp->in[i];
    r.out = kp->out; r.ws = kp->ws;
#endif
    return r;
}
__global__ void __launch_bounds__(NT, 2) mega(Params P_unused) {
    cg::grid_group grid = cg::this_grid();
    const int bid = blockIdx.x, nb = gridDim.x;
#define PH_BEGIN const Params P = load_params(); unsigned char* ws = P.ws; unsigned char* dob = (unsigned char*)P.out; (void)ws; (void)dob;
    { PH_BEGIN prologue_phase(P, LDSP, bid, nb); }
    grid.sync();
    { PH_BEGIN
        pg8::Gemm g{(const bf16*)(ws + WS_MB), (const bf16*)(ws + WS_WMEM), 256, 1024, 1024, 1024, 1024, 0, 256 * 1024};
        pg8::StaticOrder S; S.init(g.M, g.N, nb, bid);
        EpiF32 E{(float*)(ws + WS_KMVM), 1024, (const float*)(ws + WS_RSTDM)};
        pg8::gemm_phase<false>(LDSP, g, S, E);
    }
    { PH_BEGIN
        pg8::Gemm g{(const bf16*)(ws + WS_XB), (const bf16*)(ws + WS_WIN), S_, P1_N, 1024, 1024, 1024, 0, 256 * 1024};
        pg8::StaticOrder S; S.init(g.M, g.N, nb, bid);
        EpiP1 E{(const float*)(ws + WS_RSTDX), (const float*)(ws + WS_COS), (const float*)(ws + WS_SIN), P.in[6], P.in[7],
                (bf16*)(ws + WS_Q), (bf16*)(ws + WS_K), (bf16*)(ws + WS_V), (bf16*)(ws + WS_RWP), (bf16*)(ws + WS_MEMQ), (half_t*)(ws + WS_IQ), (half_t*)(ws + WS_IK), (float*)(ws + WS_IW)};
        pg8::gemm_phase<false>(LDSP, g, S, E);
    }
    grid.sync();
    { PH_BEGIN lora_in_phase(P, bid, nb); }
    grid.sync();
    { PH_BEGIN
        pg8::Gemm g{(const bf16*)(dob + DO_LIN), (const bf16*)(ws + WS_WLORA), S_, 1536, 256, 256, 256, 0, 256 * 256};
        pg8::StaticOrder S; S.init(g.M, g.N, nb, bid);
        EpiLora E{(bf16*)(dob + DO_E), (bf16*)(dob + DO_A), (bf16*)(dob + DO_G), P.in[13], P.in[15]};
        pg8::gemm_phase<false>(LDSP, g, S, E);
    }
    grid.sync();
    { PH_BEGIN dsa_index_phase(P, LDSP, bid, nb); }
    { PH_BEGIN mem_attn_phase(P, LDSP, bid, nb); }
    __syncthreads();
    { PH_BEGIN rw_units_phase<false>(P, LDSP, bid, nb); }
    grid.sync();
    if (bid >= nb - 8) { PH_BEGIN rw_scan_phase(P, LDSP, bid - (nb - 8)); }
    __syncthreads();
    { PH_BEGIN dsa_attn_phase(P, LDSP, bid, nb); }
    grid.sync();
    { PH_BEGIN rw_units_phase<true>(P, LDSP, bid, nb); }
    { PH_BEGIN xb_phase(P, bid, nb); }
    grid.sync();
    { PH_BEGIN
        pg8::Gemm g{(const bf16*)(ws + WS_XB), (const bf16*)(ws + WS_WG), S_, 3072, 1024, 1024, 1024, 0, 256 * 1024};
        pg8::PanelOrder S; S.init(S_, nb, bid, 3);
        EpiGate E{(bf16*)(ws + WS_GATES), (const float*)(ws + WS_RSTDX), P.in[5]};
        pg8::gemm_phase<false>(LDSP, g, S, E);
    }
    for (int c = 0; c < 3; ++c) { PH_BEGIN
        pg8::Gemm g{(const bf16*)(ws + WS_Y) + c * 512, (const bf16*)(ws + WS_WUP) + (size_t)c * 1024 * 512, S_, 1024, 512, 1536, 512, 0, 256 * 512};
        pg8::StaticOrder S; S.init(g.M, g.N, nb, bid);
        EpiMerge E{(const bf16*)(ws + WS_GATES), P.out, (bf16*)(ws + WS_MERGED), c};
        pg8::gemm_phase<false>(LDSP, g, S, E);
    }
    grid.sync();
    { PH_BEGIN
        pg8::Gemm g{(const bf16*)(ws + WS_MERGED), (const bf16*)(ws + WS_WOUT), S_, 1024, 1024, 1024, 1024, 0, 256 * 1024};
        pg8::StaticOrder S; S.init(g.M, g.N, nb, bid);
        EpiOut E{P.in[0], P.out, (bf16*)(ws + WS_XB), (float*)(ws + WS_HSQ)};
        pg8::gemm_phase<false>(LDSP, g, S, E);
    }
    grid.sync();
    { PH_BEGIN
        pg8::Gemm g{(const bf16*)(ws + WS_XB), (const bf16*)(ws + WS_WQ), S_, 2048, 1024, 1024, 1024, 0, 256 * 1024};
        pg8::StaticOrder S; S.init(g.M, g.N, nb, bid);
        EpiPQ E{(half_t*)(ws + WS_PQ), (const float*)(ws + WS_HSQ)};
        pg8::gemm_phase<true>(LDSP, g, S, E);
    }
    grid.sync();
    { PH_BEGIN
        pg8::Gemm g{(const bf16*)(ws + WS_PQ), (const bf16*)(ws + WS_KEYBD), S_, 2048, 256, 2048, 256, 256, 0};
        pg8::StaticOrder S; S.init(g.M, g.N, nb, bid);
        float* scr = (float*)(ws + WS_SC) + (size_t)bid * 65536;
        pg8::Unit u;
        for (int i = 0; S.next(i, u); ++i) {
            pg8::OneUnit O{u}; EpiTile E{scr};
            pg8::gemm_phase<true>(LDSP, g, O, E);
            __syncthreads();
            peer_topk_tile(scr, u.pm, u.pn, (int*)(ws + WS_EIDX), (float*)(ws + WS_EGATE));
            __syncthreads();
        }
    }
    grid.sync();
    { PH_BEGIN peer_expert_phase_v1(P, bid, nb); }
#undef PH_BEGIN
}

extern "C" void kernel_launch(void* const* d_in, const int* in_sizes, int n_in, void* d_out, int out_size, void* d_ws, size_t ws_size, hipStream_t stream) {
    static int grid = 0;
    if (grid == 0) {
        if (n_in != 31 || out_size != S_ * D_ || ws_size < WS_END) { fprintf(stderr, "kernel_launch: unexpected problem (n_in %d out %d ws %zu)\n", n_in, out_size, ws_size); grid = -1; return; }
        int dev = 0, cus = 0, per_cu = 0;
        if (hipGetDevice(&dev) != hipSuccess || hipDeviceGetAttribute(&cus, hipDeviceAttributeMultiprocessorCount, dev) != hipSuccess) { grid = -1; return; }
        if (hipFuncSetAttribute((const void*)mega, hipFuncAttributeMaxDynamicSharedMemorySize, LDS_BYTES) != hipSuccess) { fprintf(stderr, "kernel_launch: hipFuncSetAttribute failed\n"); grid = -1; return; }
        if (hipOccupancyMaxActiveBlocksPerMultiprocessor(&per_cu, (const void*)mega, NT, LDS_BYTES) != hipSuccess || per_cu < 1) { fprintf(stderr, "kernel_launch: occupancy query failed (%d)\n", per_cu); grid = -1; return; }
        grid = cus;
        if (grid != 256) { fprintf(stderr, "kernel_launch: built for 256 CUs, device has %d\n", cus); grid = -1; return; }
    }
    if (grid < 0) return;
    Params P{};
    for (int i = 0; i < 31; ++i) P.in[i] = (const float*)d_in[i];
    P.out = (float*)d_out; P.ws = (unsigned char*)d_ws;
    void* args[] = {&P};
    hipError_t e = hipLaunchCooperativeKernel((const void*)mega, dim3(grid), dim3(NT), args, LDS_BYTES, stream);
    if (e != hipSuccess) fprintf(stderr, "kernel_launch: cooperative launch failed: %s\n", hipGetErrorString(e));
}
```

```cpp
#include <hip/hip_runtime.h>
#include <cstdio>
#include <cstdint>

typedef unsigned short bf16;
typedef unsigned short u16;
typedef float f32x4 __attribute__((ext_vector_type(4)));
typedef float f32x2 __attribute__((ext_vector_type(2)));
typedef unsigned u32x4 __attribute__((ext_vector_type(4)));
typedef unsigned u32x2 __attribute__((ext_vector_type(2)));
typedef _Float16 half_t;
typedef _Float16 half4 __attribute__((ext_vector_type(4)));
typedef _Float16 half8 __attribute__((ext_vector_type(8)));

constexpr int S_ = 16384, D_ = 1024;
constexpr int NMEM = 256;
constexpr int ATT_W = 512, RW_W = 512, MEM_W = 512;
constexpr int RW_IN = 1792;
constexpr int WIN_COLS = 7236;
constexpr int COL_Q = 0, COL_K = 512, COL_V = 1024, COL_IQ = 1536, COL_IK = 1792, COL_IW = 1856, COL_RW = 1860, COL_MEMQ = 3652, COL_GATE = 4164;
constexpr int P1_TILES = 17, P1_N = P1_TILES * 256;
constexpr float NORM_EPS = 1e-6f, GN_EPS = 64e-5f;
constexpr int NEXP = 16384;

constexpr size_t MiB = 1u << 20;
constexpr size_t WS_CTL = 0;
constexpr size_t WS_RSTDX = 1 * MiB;
constexpr size_t WS_COS = WS_RSTDX + 64 * 1024;
constexpr size_t WS_SIN = WS_COS + 512 * 1024;
constexpr size_t WS_IW = WS_SIN + 512 * 1024;
constexpr size_t WS_RSTDM = WS_IW + 256 * 1024;
constexpr size_t WS_RSTDH = WS_RSTDM + 4096;
constexpr size_t WS_HSQ = 3 * MiB;
constexpr size_t WS_WIN = 4 * MiB;
constexpr size_t WS_WG = WS_WIN + (size_t)P1_N * 1024 * 2;
constexpr size_t WS_WUP = WS_WG + 6 * MiB;
constexpr size_t WS_WOUT = WS_WUP + 3 * MiB;
constexpr size_t WS_WQ = WS_WOUT + 2 * MiB;
constexpr size_t WS_WMEM = WS_WQ + 4 * MiB;
constexpr size_t WS_KEYBD = WS_WMEM + 2 * MiB;
constexpr size_t WS_WLORA = WS_KEYBD + 128 * 1024;
static_assert(WS_WLORA + 768 * 1024 <= 30 * MiB + 512 * 1024, "weights region");
constexpr size_t WS_KMVM = 30 * MiB + 512 * 1024;
constexpr size_t WS_MB = 31 * MiB + 512 * 1024;
constexpr size_t WS_XB = 32 * MiB;
constexpr size_t WS_Q = 64 * MiB, WS_K = 80 * MiB, WS_V = 96 * MiB;
constexpr size_t WS_IQ = 112 * MiB;
constexpr size_t WS_IK = 120 * MiB;
constexpr size_t WS_MEMQ = 122 * MiB;
constexpr size_t WS_RWP = 138 * MiB;
constexpr size_t WS_Y = 194 * MiB;
constexpr size_t WS_SEL = 242 * MiB;
constexpr size_t DO_E = 0, DO_A = 16 * MiB, DO_G = 32 * MiB, DO_LIN = 48 * MiB;
constexpr size_t WS_GATES = 64 * MiB;
constexpr size_t WS_MERGED = 160 * MiB;
constexpr size_t WS_PQ = 64 * MiB;
constexpr size_t WS_SC = 128 * MiB;
constexpr size_t WS_EIDX = 32 * MiB;
constexpr size_t WS_EGATE = 40 * MiB;
constexpr size_t WS_END = 256 * MiB;

__device__ __forceinline__ unsigned f2bf(float f) { unsigned u = __builtin_bit_cast(unsigned, f); return (u + 0x7fffu + ((u >> 16) & 1u)) >> 16; }
__device__ __forceinline__ unsigned pk2(float lo, float hi) { return f2bf(lo) | (f2bf(hi) << 16); }
__device__ __forceinline__ unsigned pk2h(float lo, float hi) { typedef _Float16 h2 __attribute__((ext_vector_type(2))); h2 v; v[0] = (_Float16)lo; v[1] = (_Float16)hi; return __builtin_bit_cast(unsigned, v); }
__device__ __forceinline__ float bf2f(unsigned short b) { return __builtin_bit_cast(float, ((unsigned)b) << 16); }
__device__ __forceinline__ float bflo(unsigned w) { return __builtin_bit_cast(float, w << 16); }
__device__ __forceinline__ float bfhi(unsigned w) { return __builtin_bit_cast(float, w & 0xffff0000u); }
__device__ __forceinline__ float wave_sum(float v) {
#pragma unroll
    for (int o = 1; o < 64; o <<= 1) v += __shfl_xor(v, o);
    return v;
}
__device__ __forceinline__ float wave_max(float v) {
#pragma unroll
    for (int o = 1; o < 64; o <<= 1) v = fmaxf(v, __shfl_xor(v, o));
    return v;
}

__device__ __forceinline__ int tid_opaque() { int t = threadIdx.x; asm volatile("" : "+v"(t)); return t; }
namespace pg8 {
#define PG8_LAS __attribute__((address_space(3)))
typedef unsigned short bf16_t;
typedef short bf16x8 __attribute__((ext_vector_type(8)));
typedef float f32x4 __attribute__((ext_vector_type(4)));
typedef unsigned u32x4 __attribute__((ext_vector_type(4)));
typedef unsigned u32x2 __attribute__((ext_vector_type(2)));
constexpr int BM = 256, BK = 64, HALF = 128, HTB = HALF * BK * 2, STAGE_BYTES = 8 * HTB, NXCD = 8, WGM = 8;

__host__ __device__ __forceinline__ int lds_byte(int r, int c) { const int st = (r >> 4) * 2 + (c >> 5), rr = r & 15, cc = c & 31, ob = rr * 64 + cc * 2; return st * 1024 + (ob ^ (((ob >> 9) & 1) << 5)); }
__host__ __device__ __forceinline__ void stage_rc(int b, int& R, int& C) { const int st = b / 1024, sb = b % 1024, swz = sb ^ (((sb >> 9) & 1) << 5); R = (st >> 1) * 16 + swz / 64; C = (st & 1) * 32 + (swz % 64) / 2; }

struct Unit { int pm, pn; };
struct Gemm { const bf16_t* A; const bf16_t* Bt; int M, N, K; int lda, ldb; long a_pn_step, b_pn_step; };

struct StaticOrder {
    int nM, nN, nwg, G, c;
    __host__ __device__ __forceinline__ void init(int M, int N, int G_, int c_) { nM = M / BM; nN = N / BM; nwg = nM * nN; G = G_; c = c_; }
    __host__ __device__ __forceinline__ bool next(int i, Unit& u) const {
        const long L = (long)i * G + c; if (L >= nwg) return false;
        int wgid = (int)L; { const int q = nwg / NXCD, r = nwg % NXCD, xcd = wgid % NXCD, off = wgid / NXCD; wgid = (xcd < r ? xcd * (q + 1) : r * (q + 1) + (xcd - r) * q) + off; }
        const int nig = WGM * nN, gid = wgid / nig, fm = gid * WGM, gsz = (nM - fm) < WGM ? (nM - fm) : WGM;
        u.pm = fm + ((wgid % nig) % gsz); u.pn = (wgid % nig) / gsz; return true;
    }
};

__device__ __forceinline__ unsigned cvt_pk_bf16(float lo, float hi) { unsigned r; asm volatile("v_cvt_pk_bf16_f32 %0, %1, %2" : "=v"(r) : "v"(lo), "v"(hi)); return r; }

typedef _Float16 f16x8 __attribute__((ext_vector_type(8)));
template <bool F16> __device__ __forceinline__ f32x4 mma16(bf16x8 a, bf16x8 b, f32x4 c) {
    if constexpr (F16) return __builtin_amdgcn_mfma_f32_16x16x32_f16(__builtin_bit_cast(f16x8, a), __builtin_bit_cast(f16x8, b), c, 0, 0, 0);
    else return __builtin_amdgcn_mfma_f32_16x16x32_bf16(a, b, c, 0, 0, 0);
}
struct PanelOrder {
    int pm0, pn0, nsteps, valid;
    __host__ __device__ __forceinline__ void init(int M, int G_, int c_, int nsteps_) { StaticOrder S; S.init(M, 1024, G_, c_); Unit u; valid = S.next(0, u) ? 1 : 0; pm0 = u.pm; pn0 = u.pn; nsteps = nsteps_; }
    __host__ __device__ __forceinline__ bool next(int i, Unit& u) const { if (!valid || i >= nsteps) return false; u.pm = pm0; u.pn = pn0 + 4 * i; return true; }
};
struct OneUnit { Unit u0; __host__ __device__ __forceinline__ bool next(int i, Unit& u) const { if (i != 0) return false; u = u0; return true; } };
template <bool F16, class Sched, class Epi>
__device__ __forceinline__ void gemm_phase(PG8_LAS unsigned char* lds, const Gemm g, const Sched& S, const Epi& E) {
    int tid = threadIdx.x; asm volatile("" : "+v"(tid));
    const int wid = __builtin_amdgcn_readfirstlane(tid >> 6), lane = tid & 63, wr = wid >> 2, wc = wid & 3, fr = lane & 15, fq = lane >> 4;
    const int K = g.K, nt = K / BK;
    unsigned voffA[2], voffB[2];
#pragma unroll
    for (int i = 0; i < 2; ++i) { int R, C; stage_rc(tid * 16 + i * 8192, R, C);
        voffA[i] = (unsigned)(R * g.lda + C) * 2u; voffB[i] = (unsigned)(R * g.ldb + C) * 2u; }
    const size_t kstep = (size_t)(BK * 2);
    const size_t hstepA = (size_t)HALF * g.lda * 2, hstepB = (size_t)HALF * g.ldb * 2;
    const size_t tstepA = 2 * hstepA;
    const unsigned ldsw = (unsigned)wid * 1024u;
    const int aoff = lds_byte(wr * 64 + fr, fq * 8), boff = lds_byte(wc * 32 + fr, fq * 8);
#define PG8_SA(b, h) (((b) * 2 + (h)) * HTB)
#define PG8_SB(b, h) ((4 + (b) * 2 + (h)) * HTB)
#define PG8_STAGE(bufoff, gbase, voff) do { _Pragma("unroll") for (int _i = 0; _i < 2; ++_i) \
        __builtin_amdgcn_global_load_lds((const unsigned*)((const char*)(gbase) + (voff)[_i]), (PG8_LAS unsigned*)(lds + (bufoff) + ldsw + _i * 8192), 16, 0, 0); } while (0)
#define PG8_LDA(dst, b, h) do { _Pragma("unroll") for (int m = 0; m < 4; ++m) _Pragma("unroll") for (int k = 0; k < 2; ++k) dst[m][k] = *(const PG8_LAS bf16x8*)(lds + PG8_SA(b, h) + aoff + m * 2048 + k * 1024); } while (0)
#define PG8_LDB(dst, b, h) do { _Pragma("unroll") for (int n = 0; n < 2; ++n) _Pragma("unroll") for (int k = 0; k < 2; ++k) dst[n][k] = *(const PG8_LAS bf16x8*)(lds + PG8_SB(b, h) + boff + n * 2048 + k * 1024); } while (0)
#define PG8_MMA(ai, bj, At, Bt) do { __builtin_amdgcn_s_setprio(1); _Pragma("unroll") for (int m = 0; m < 4; ++m) _Pragma("unroll") for (int n = 0; n < 2; ++n) _Pragma("unroll") for (int k = 0; k < 2; ++k) \
        acc[ai][bj][m][n] = mma16<F16>(Bt[n][k], At[m][k], acc[ai][bj][m][n]); __builtin_amdgcn_s_setprio(0); } while (0)
#define PG8_WAIT_V(n) asm volatile("s_waitcnt vmcnt(" #n ")" ::: "memory")
#define PG8_WAIT_L(n) asm volatile("s_waitcnt lgkmcnt(" #n ")" ::: "memory")
#define PG8_BAR __builtin_amdgcn_s_barrier()
#define PG8_SCHED __builtin_amdgcn_sched_barrier(0)
    Unit cur, nxt; int ui = 0;
    if (!S.next(0, cur)) return;
    f32x4 acc[2][2][4][2];
#pragma unroll
    for (int a = 0; a < 2; ++a)
#pragma unroll
        for (int b = 0; b < 2; ++b)
#pragma unroll
            for (int m = 0; m < 4; ++m)
#pragma unroll
                for (int n = 0; n < 2; ++n) acc[a][b][m][n] = (f32x4){0.f, 0.f, 0.f, 0.f};
    bf16x8 At[4][2], B0[2][2], B1[2][2];
    const char* cA = (const char*)g.A + (size_t)cur.pm * tstepA + (size_t)cur.pn * g.a_pn_step * 2; const char* cB = (const char*)g.Bt + (size_t)cur.pn * g.b_pn_step * 2;
    PG8_STAGE(PG8_SB(0, 0), cB, voffB); PG8_STAGE(PG8_SA(0, 0), cA, voffA); PG8_STAGE(PG8_SB(0, 1), cB + hstepB, voffB); PG8_STAGE(PG8_SA(0, 1), cA + hstepA, voffA);
    if (wr == 1) PG8_BAR;
    PG8_WAIT_V(4); PG8_BAR;
    PG8_STAGE(PG8_SB(1, 0), cB + kstep, voffB); PG8_STAGE(PG8_SA(1, 0), cA + kstep, voffA); PG8_STAGE(PG8_SB(1, 1), cB + hstepB + kstep, voffB);
    PG8_WAIT_V(6); PG8_BAR;
    for (;;) {
        const bool has_next = S.next(ui + 1, nxt);
        const char* nA = has_next ? (const char*)g.A + (size_t)nxt.pm * tstepA + (size_t)nxt.pn * g.a_pn_step * 2 : cA; const char* nB = has_next ? (const char*)g.Bt + (size_t)nxt.pn * g.b_pn_step * 2 : cB;
        for (int t = 0; t < nt; t += 2) {
            const bool last = (t == nt - 2);
            const char* a1 = cA + (size_t)(t + 1) * kstep;
            const char* a2 = last ? nA : cA + (size_t)(t + 2) * kstep; const char* b2 = last ? nB : cB + (size_t)(t + 2) * kstep;
            const char* a3 = a2 + kstep; const char* b3 = b2 + kstep;
            PG8_LDB(B0, 0, 0); PG8_SCHED; PG8_LDA(At, 0, 0); PG8_STAGE(PG8_SA(1, 1), a1 + hstepA, voffA);
            PG8_WAIT_L(8); PG8_BAR; PG8_WAIT_L(0); PG8_MMA(0, 0, At, B0); PG8_BAR; PG8_SCHED;
            PG8_LDB(B1, 0, 1); PG8_STAGE(PG8_SB(0, 0), b2, voffB);
            PG8_BAR; PG8_WAIT_L(0); PG8_MMA(0, 1, At, B1); PG8_BAR;
            PG8_LDA(At, 0, 1); PG8_STAGE(PG8_SA(0, 0), a2, voffA);
            PG8_BAR; PG8_WAIT_L(0); PG8_MMA(1, 0, At, B0); PG8_BAR; PG8_SCHED;
            PG8_STAGE(PG8_SB(0, 1), b2 + hstepB, voffB);
            PG8_WAIT_V(6); PG8_BAR; PG8_MMA(1, 1, At, B1); PG8_BAR;
            PG8_LDB(B0, 1, 0); PG8_SCHED; PG8_LDA(At, 1, 0); PG8_STAGE(PG8_SA(0, 1), a2 + hstepA, voffA);
            PG8_WAIT_L(8); PG8_BAR; PG8_WAIT_L(0); PG8_MMA(0, 0, At, B0); PG8_BAR; PG8_SCHED;
            PG8_LDB(B1, 1, 1); PG8_STAGE(PG8_SB(1, 0), b3, voffB);
            PG8_BAR; PG8_WAIT_L(0); PG8_MMA(0, 1, At, B1); PG8_BAR;
            PG8_LDA(At, 1, 1); PG8_STAGE(PG8_SA(1, 0), a3, voffA);
            PG8_BAR; PG8_WAIT_L(0); PG8_MMA(1, 0, At, B0); PG8_BAR; PG8_SCHED;
            PG8_STAGE(PG8_SB(1, 1), b3 + hstepB, voffB);
            PG8_WAIT_V(6); PG8_BAR; PG8_MMA(1, 1, At, B1); PG8_BAR;
        }
        { int fr_ = fr, fq_ = fq; asm volatile("" : "+v"(fr_), "+v"(fq_)); E(acc, cur, wr, wc, fr_, fq_); }
        if (!has_next) break;
#pragma unroll
        for (int a = 0; a < 2; ++a)
#pragma unroll
            for (int b = 0; b < 2; ++b)
#pragma unroll
                for (int m = 0; m < 4; ++m)
#pragma unroll
                    for (int n = 0; n < 2; ++n) acc[a][b][m][n] = (f32x4){0.f, 0.f, 0.f, 0.f};
        cur = nxt; cA = nA; cB = nB; ++ui;
    }
    PG8_WAIT_V(0);
    if (wr == 0) PG8_BAR;
    PG8_BAR;
#undef PG8_SA
#undef PG8_SB
#undef PG8_STAGE
#undef PG8_LDA
#undef PG8_LDB
#undef PG8_MMA
#undef PG8_WAIT_V
#undef PG8_WAIT_L
#undef PG8_BAR
#undef PG8_SCHED
}
}
#define LAS __attribute__((address_space(3)))
#define LDS_WAIT() asm volatile("s_waitcnt lgkmcnt(0)" ::: "memory")
constexpr int NT = 512, NW = 8;

struct Params {
    const float* in[31];
    float* out;
    unsigned char* ws;
};

__device__ __forceinline__ void tr_item(const float* W, int ldw, bf16* WT, int K, int k0, int nphys0, int lbase, int cnt, const float* kg, LAS float* scr, int lane, bool f16 = false) {
    const int c = lane & 31;
#pragma unroll 8
    for (int i = 0; i < 32; ++i) { const int kk = 2 * i + (lane >> 5); float v = 0.f;
        if (c < cnt) { v = W[(size_t)(k0 + kk) * ldw + lbase + c]; if (kg) v *= kg[k0 + kk]; }
        scr[kk * 33 + c] = v; }
    LDS_WAIT();
    const int c8 = lane & 7;
#pragma unroll
    for (int j = 0; j < 4; ++j) { const int n = (lane >> 3) + 8 * j; const LAS float* s = scr + (8 * c8) * 33 + n;
        u32x4 o;
        if (f16) { o.x = pk2h(s[0 * 33], s[1 * 33]); o.y = pk2h(s[2 * 33], s[3 * 33]); o.z = pk2h(s[4 * 33], s[5 * 33]); o.w = pk2h(s[6 * 33], s[7 * 33]); }
        else { o.x = pk2(s[0 * 33], s[1 * 33]); o.y = pk2(s[2 * 33], s[3 * 33]); o.z = pk2(s[4 * 33], s[5 * 33]); o.w = pk2(s[6 * 33], s[7 * 33]); }
        *(u32x4*)(WT + (size_t)(nphys0 + n) * K + k0 + 8 * c8) = o; }
    LDS_WAIT();
}
__device__ __forceinline__ void p1_group(int g, int& lbase, int& cnt) {
    const int tile = g >> 3, gi = g & 7, bj = gi >> 2, wc = gi & 3; cnt = 32;
    if (tile < 2) lbase = COL_Q + (4 * tile + wc) * 64 + 32 * bj;
    else if (tile < 4) lbase = COL_K + (4 * (tile - 2) + wc) * 64 + 32 * bj;
    else if (tile < 6) lbase = COL_V + (tile - 4) * 256 + 32 * gi;
    else if (tile == 6) lbase = COL_IQ + wc * 64 + 32 * bj;
    else if (tile == 7) { if (wc == 0) lbase = COL_IK + 32 * bj; else if (gi == 1) { lbase = COL_IW; cnt = 4; } else { lbase = 0; cnt = 0; } }
    else if (tile < 15) lbase = COL_RW + (tile - 8) * 256 + 32 * gi;
    else lbase = COL_MEMQ + (tile - 15) * 256 + 32 * gi;
}

__device__ __forceinline__ void prologue_phase(const Params& P, LAS unsigned char* lds, int bid, int nblk) {
    const int tid = tid_opaque(), lane = tid & 63, wave = tid >> 6;
    const int gw = bid * NW + wave, NGW = nblk * NW;
    unsigned char* ws = P.ws;
    LAS float* scr = (LAS float*)(lds + wave * 16384);
    constexpr int I_P1 = 16 * (P1_N / 32), I_WG = 16 * 96, I_UP = 8 * 32, I_OUT = 16 * 32, I_WQ = 16 * 64, I_MEM = 16 * 32;
    constexpr int NITEMS = I_P1 + I_WG + 3 * I_UP + I_OUT + I_WQ + I_MEM;
    for (int it = gw; it < NITEMS; it += NGW) {
        int r = it;
        if (r < I_P1) { const int ng = P1_N / 32, kb = r / ng, g = r % ng; int lb, cnt; p1_group(g, lb, cnt);
            tr_item(P.in[4], WIN_COLS, (bf16*)(ws + WS_WIN), 1024, 64 * kb, 32 * g, lb, cnt, P.in[3], scr, lane); continue; } r -= I_P1;
        if (r < I_WG) { const int kb = r / 96, g = r % 96;
            tr_item(P.in[4], WIN_COLS, (bf16*)(ws + WS_WG), 1024, 64 * kb, 32 * g, COL_GATE + 32 * g, 32, P.in[3], scr, lane); continue; } r -= I_WG;
        if (r < 3 * I_UP) { const int c = r / I_UP, rr = r % I_UP, kb = rr / 32, g = rr % 32;
            tr_item(P.in[23] + (size_t)c * 512 * 1024, 1024, (bf16*)(ws + WS_WUP) + (size_t)c * 1024 * 512, 512, 64 * kb, 32 * g, 32 * g, 32, nullptr, scr, lane); continue; } r -= 3 * I_UP;
        if (r < I_OUT) { const int kb = r / 32, g = r % 32;
            tr_item(P.in[24], 1024, (bf16*)(ws + WS_WOUT), 1024, 64 * kb, 32 * g, 32 * g, 32, nullptr, scr, lane); continue; } r -= I_OUT;
        if (r < I_WQ) { const int kb = r / 64, g = r % 64;
            tr_item(P.in[26], 2048, (bf16*)(ws + WS_WQ), 1024, 64 * kb, 32 * g, 32 * g, 32, P.in[25], scr, lane, true); continue; } r -= I_WQ;
        { const int kb = r / 32, g = r % 32;
            tr_item(P.in[9], 1024, (bf16*)(ws + WS_WMEM), 1024, 64 * kb, 32 * g, 32 * g, 32, P.in[8], scr, lane); }
    }
    for (int m = gw; m < S_ + NMEM; m += NGW) {
        const bool isx = m < S_; const int r = isx ? m : m - S_;
        const f32x4* xr = (const f32x4*)((isx ? P.in[0] : P.in[1]) + (size_t)r * D_) + lane;
        f32x4 v[4]; float s = 0.f;
#pragma unroll
        for (int j = 0; j < 4; ++j) { v[j] = xr[64 * j]; s += (v[j].x * v[j].x + v[j].y * v[j].y) + (v[j].z * v[j].z + v[j].w * v[j].w); }
        s = wave_sum(s);
        const float rstd = 1.0f / sqrtf(s * (1.0f / D_) + NORM_EPS);
        if (lane == 0) ((float*)(ws + (isx ? WS_RSTDX : WS_RSTDM)))[r] = rstd;
        unsigned long long* o8 = (unsigned long long*)((bf16*)(ws + (isx ? WS_XB : WS_MB)) + (size_t)r * D_) + lane;
#pragma unroll
        for (int j = 0; j < 4; ++j) o8[64 * j] = (unsigned long long)pk2(v[j].x, v[j].y) | ((unsigned long long)pk2(v[j].z, v[j].w) << 32);
    }
    const int gt = bid * NT + tid, NGT = nblk * NT;
    for (int i = gt; i < S_ * 8; i += NGT) { const int t = i >> 3, f = i & 7;
        const double inv = pow(500000.0, -(double)f / 8.0); const double ang = (double)((const int*)P.in[2])[t] * inv;
        ((float*)(ws + WS_COS))[i] = (float)cos(ang); ((float*)(ws + WS_SIN))[i] = (float)sin(ang); }
    for (int i = gt; i < 256 * 256; i += NGT) { const int n = i >> 8, k = i & 255; float v = 0.f;
        if (n < 128) { if (k < 128) v = P.in[27][n * 128 + k]; } else { if (k >= 128) v = P.in[28][(n - 128) * 128 + (k - 128)]; }
        ((half_t*)(ws + WS_KEYBD))[i] = (half_t)v; }
    for (int i = gt; i < 1536 * 256; i += NGT) { const int n = i >> 8, k = i & 255; float v = 0.f;
        if (n < 512) { if (k < 64) v = P.in[14][k * 512 + n]; }
        else if (n < 1024) { if (k >= 64 && k < 128) v = P.in[16][(k - 64) * 512 + (n - 512)]; }
        else { if (k >= 128) v = P.in[17][(k - 128) * 512 + (n - 1024)]; }
        ((bf16*)(ws + WS_WLORA))[i] = (bf16)f2bf(v); }
}

typedef const f32x4 (&AccRef)[2][2][4][2];
__device__ __forceinline__ void st_bf4(bf16* p, f32x4 v) { u32x2 w; w.x = pk2(v[0], v[1]); w.y = pk2(v[2], v[3]); *(u32x2*)p = w; }
__device__ __forceinline__ void st_h4(half_t* p, f32x4 v) { half4 h; h[0] = (half_t)v[0]; h[1] = (half_t)v[1]; h[2] = (half_t)v[2]; h[3] = (half_t)v[3]; *(half4*)p = h; }

__device__ __forceinline__ f32x4 rope4(f32x4 v, int fq, const float* cs, const float* sn) {
    f32x4 o;
#pragma unroll
    for (int j = 0; j < 4; ++j) { const float p = __shfl_xor(v[j], 32); const int i = 4 * (fq & 1) + j; const float c = cs[i], s = sn[i];
        o[j] = (fq < 2) ? (v[j] * c - p * s) : (v[j] * c + p * s); }
    return o;
}

struct EpiP1 {
    const float* rstd; const float* cs; const float* sn; const float* qgain; const float* kgain;
    bf16 *Q, *K, *V, *RWP, *MEMQ; half_t *IQ, *IK; float* IW;
    __device__ __forceinline__ void operator()(AccRef acc, const pg8::Unit& u, int wr, int wc, int fr, int fq) const {
        const int pn = u.pn;
#pragma unroll
        for (int ai = 0; ai < 2; ++ai)
#pragma unroll
            for (int m = 0; m < 4; ++m) {
                const int row = u.pm * 256 + ai * 128 + wr * 64 + m * 16 + fr; const float rs = rstd[row];
                f32x4 v[2][2];
#pragma unroll
                for (int bj = 0; bj < 2; ++bj)
#pragma unroll
                    for (int n = 0; n < 2; ++n) v[bj][n] = acc[ai][bj][m][n] * rs;
                if (pn < 4) {
                    float ss = 0.f;
#pragma unroll
                    for (int bj = 0; bj < 2; ++bj)
#pragma unroll
                        for (int n = 0; n < 2; ++n) ss += (v[bj][n][0] * v[bj][n][0] + v[bj][n][1] * v[bj][n][1]) + (v[bj][n][2] * v[bj][n][2] + v[bj][n][3] * v[bj][n][3]);
                    ss += __shfl_xor(ss, 16); ss += __shfl_xor(ss, 32);
                    const float rh = 1.0f / sqrtf(ss * (1.0f / 64.0f) + NORM_EPS);
                    const float* gn = (pn < 2) ? qgain : kgain;
#pragma unroll
                    for (int bj = 0; bj < 2; ++bj)
#pragma unroll
                        for (int n = 0; n < 2; ++n) { const f32x4 gv = *(const f32x4*)(gn + 32 * bj + 16 * n + 4 * fq); v[bj][n] = v[bj][n] * rh * gv; }
                    v[0][0] = rope4(v[0][0], fq, cs + row * 8, sn + row * 8);
                    const int head = (pn & 1) * 4 + wc;
                    bf16* dst = (pn < 2) ? (Q + (size_t)row * 512 + head * 64 + 4 * fq) : (K + ((size_t)head * S_ + row) * 64 + 4 * fq);
#pragma unroll
                    for (int bj = 0; bj < 2; ++bj)
#pragma unroll
                        for (int n = 0; n < 2; ++n) st_bf4(dst + 32 * bj + 16 * n, v[bj][n]);
                } else if (pn < 6) {
#pragma unroll
                    for (int bj = 0; bj < 2; ++bj)
#pragma unroll
                        for (int n = 0; n < 2; ++n) { const int head = (pn - 4) * 4 + 2 * bj + (wc >> 1);
                            st_bf4(V + ((size_t)head * S_ + row) * 64 + 32 * (wc & 1) + 16 * n + 4 * fq, v[bj][n]); }
                } else if (pn == 6) {
                    v[0][0] = rope4(v[0][0], fq, cs + row * 8, sn + row * 8);
                    half_t* dst = IQ + (size_t)row * 256 + wc * 64 + 4 * fq;
#pragma unroll
                    for (int bj = 0; bj < 2; ++bj)
#pragma unroll
                        for (int n = 0; n < 2; ++n) st_h4(dst + 32 * bj + 16 * n, v[bj][n]);
                } else if (pn == 7) {
                    if (wc == 0) {
                        v[0][0] = rope4(v[0][0], fq, cs + row * 8, sn + row * 8);
                        half_t* dst = IK + (size_t)row * 64 + 4 * fq;
#pragma unroll
                        for (int bj = 0; bj < 2; ++bj)
#pragma unroll
                            for (int n = 0; n < 2; ++n) st_h4(dst + 32 * bj + 16 * n, v[bj][n]);
                    } else if (wc == 1) { if (fq == 0) *(f32x4*)(IW + (size_t)row * 4) = v[0][0]; }
                } else if (pn < 15) {
                    bf16* dst = RWP + (size_t)row * RW_IN + (pn - 8) * 256 + 32 * wc + 4 * fq;
#pragma unroll
                    for (int bj = 0; bj < 2; ++bj)
#pragma unroll
                        for (int n = 0; n < 2; ++n) st_bf4(dst + 128 * bj + 16 * n, v[bj][n]);
                } else {
                    bf16* dst = MEMQ + (size_t)row * 512 + (pn - 15) * 256 + 32 * wc + 4 * fq;
#pragma unroll
                    for (int bj = 0; bj < 2; ++bj)
#pragma unroll
                        for (int n = 0; n < 2; ++n) st_bf4(dst + 128 * bj + 16 * n, v[bj][n]);
                }
            }
    }
};

struct EpiF32 {
    float* C; int ldc; const float* rstd;
    __device__ __forceinline__ void operator()(AccRef acc, const pg8::Unit& u, int wr, int wc, int fr, int fq) const {
#pragma unroll
        for (int ai = 0; ai < 2; ++ai)
#pragma unroll
            for (int m = 0; m < 4; ++m) { const int row = u.pm * 256 + ai * 128 + wr * 64 + m * 16 + fr; const float rs = rstd ? rstd[row] : 1.0f;
                float* dst = C + (size_t)row * ldc + u.pn * 256 + 32 * wc + 4 * fq;
#pragma unroll
                for (int bj = 0; bj < 2; ++bj)
#pragma unroll
                    for (int n = 0; n < 2; ++n) *(f32x4*)(dst + 128 * bj + 16 * n) = acc[ai][bj][m][n] * rs; }
    }
};
struct EpiBf {
    bf16* C; int ldc; const float* rstd;
    __device__ __forceinline__ void operator()(AccRef acc, const pg8::Unit& u, int wr, int wc, int fr, int fq) const {
#pragma unroll
        for (int ai = 0; ai < 2; ++ai)
#pragma unroll
            for (int m = 0; m < 4; ++m) { const int row = u.pm * 256 + ai * 128 + wr * 64 + m * 16 + fr; const float rs = rstd ? rstd[row] : 1.0f;
                bf16* dst = C + (size_t)row * ldc + u.pn * 256 + 32 * wc + 4 * fq;
#pragma unroll
                for (int bj = 0; bj < 2; ++bj)
#pragma unroll
                    for (int n = 0; n < 2; ++n) st_bf4(dst + 128 * bj + 16 * n, acc[ai][bj][m][n] * rs); }
    }
};
__device__ __forceinline__ float sigmoidf_(float x) { return 1.0f / (1.0f + __expf(-x)); }
struct EpiLora {
    bf16 *E, *A, *G; const float* w0; const float* a0;
    __device__ __forceinline__ void operator()(AccRef acc, const pg8::Unit& u, int wr, int wc, int fr, int fq) const {
        const int kind = u.pn >> 1;
#pragma unroll
        for (int ai = 0; ai < 2; ++ai)
#pragma unroll
            for (int m = 0; m < 4; ++m) { const int row = u.pm * 256 + ai * 128 + wr * 64 + m * 16 + fr;
#pragma unroll
                for (int bj = 0; bj < 2; ++bj)
#pragma unroll
                    for (int n = 0; n < 2; ++n) { const int c = (u.pn & 1) * 256 + 128 * bj + 32 * wc + 16 * n + 4 * fq; f32x4 v = acc[ai][bj][m][n];
                        if (kind == 0) { const f32x4 b = *(const f32x4*)(w0 + c);
#pragma unroll
                            for (int j = 0; j < 4; ++j) { const float z = v[j] + b[j]; const float sp = fmaxf(-z, 0.f) + __logf(1.0f + __expf(-fabsf(z))); v[j] = __expf(-sp - 0.5f); }
                            st_bf4(E + (size_t)row * 512 + c, v);
                        } else if (kind == 1) { const f32x4 b = *(const f32x4*)(a0 + c);
#pragma unroll
                            for (int j = 0; j < 4; ++j) v[j] = sigmoidf_(v[j] + b[j]);
                            st_bf4(A + (size_t)row * 512 + c, v);
                        } else st_bf4(G + (size_t)row * 512 + c, v); } }
    }
};
struct EpiGate {
    bf16* Gt; const float* rstd; const float* bias;
    __device__ __forceinline__ void operator()(AccRef acc, const pg8::Unit& u, int wr, int wc, int fr, int fq) const {
#pragma unroll
        for (int ai = 0; ai < 2; ++ai)
#pragma unroll
            for (int m = 0; m < 4; ++m) { const int row = u.pm * 256 + ai * 128 + wr * 64 + m * 16 + fr; const float rs = rstd[row];
#pragma unroll
                for (int bj = 0; bj < 2; ++bj)
#pragma unroll
                    for (int n = 0; n < 2; ++n) { const int c = u.pn * 256 + 128 * bj + 32 * wc + 16 * n + 4 * fq; const f32x4 b = *(const f32x4*)(bias + c); f32x4 v = acc[ai][bj][m][n] * rs + b;
#pragma unroll
                        for (int j = 0; j < 4; ++j) v[j] = sigmoidf_(v[j]);
                        st_bf4(Gt + (size_t)row * 3072 + c, v); } }
    }
};
struct EpiMerge {
    const bf16* Gt; float* accf; bf16* merged; int c;
    __device__ __forceinline__ void operator()(AccRef acc, const pg8::Unit& u, int wr, int wc, int fr, int fq) const {
#pragma unroll
        for (int ai = 0; ai < 2; ++ai)
#pragma unroll
            for (int m = 0; m < 4; ++m) { const int row = u.pm * 256 + ai * 128 + wr * 64 + m * 16 + fr;
#pragma unroll
                for (int bj = 0; bj < 2; ++bj)
#pragma unroll
                    for (int n = 0; n < 2; ++n) { const int col = u.pn * 256 + 128 * bj + 32 * wc + 16 * n + 4 * fq;
                        const u32x2 gw = *(const u32x2*)(Gt + (size_t)row * 3072 + c * 1024 + col);
                        f32x4 v = acc[ai][bj][m][n]; v[0] *= bflo(gw.x); v[1] *= bfhi(gw.x); v[2] *= bflo(gw.y); v[3] *= bfhi(gw.y);
                        float* ap = accf + (size_t)row * 1024 + col;
                        if (c > 0) v = v + *(const f32x4*)ap;
                        if (c < 2) *(f32x4*)ap = v; else st_bf4(merged + (size_t)row * 1024 + col, v); } }
    }
};
struct EpiOut {
    const float* x; float* out; bf16* HB; float* HSQ;
    __device__ __forceinline__ void operator()(AccRef acc, const pg8::Unit& u, int wr, int wc, int fr, int fq) const {
#pragma unroll
        for (int ai = 0; ai < 2; ++ai)
#pragma unroll
            for (int m = 0; m < 4; ++m) { const int row = u.pm * 256 + ai * 128 + wr * 64 + m * 16 + fr; float ss = 0.f;
#pragma unroll
                for (int bj = 0; bj < 2; ++bj)
#pragma unroll
                    for (int n = 0; n < 2; ++n) { const size_t o = (size_t)row * 1024 + u.pn * 256 + 128 * bj + 32 * wc + 16 * n + 4 * fq;
                        const f32x4 v = acc[ai][bj][m][n] + *(const f32x4*)(x + o); *(f32x4*)(out + o) = v; st_h4((half_t*)HB + o, v);
                        ss += (v[0] * v[0] + v[1] * v[1]) + (v[2] * v[2] + v[3] * v[3]); }
                ss += __shfl_xor(ss, 16); ss += __shfl_xor(ss, 32);
                if (fq == 0) HSQ[(size_t)row * 16 + u.pn * 4 + wc] = ss; }
    }
};

__device__ __forceinline__ float rstd_h_row(const float* HSQ, int row) {
    const f32x4* hp = (const f32x4*)(HSQ + (size_t)row * 16); const f32x4 a = hp[0], b = hp[1], c = hp[2], d = hp[3];
    const float s = ((a[0] + a[1]) + (a[2] + a[3])) + ((b[0] + b[1]) + (b[2] + b[3])) + ((c[0] + c[1]) + (c[2] + c[3])) + ((d[0] + d[1]) + (d[2] + d[3]));
    return 1.0f / sqrtf(s * (1.0f / 1024.0f) + NORM_EPS);
}
__device__ __forceinline__ void lora_in_phase(const Params& P, int bid, int nblk) {
    const bf16* RWP = (const bf16*)(P.ws + WS_RWP); bf16* LIN = (bf16*)((unsigned char*)P.out + DO_LIN); const float* mu = P.in[12];
    const int gt = bid * NT + tid_opaque(), NGT = nblk * NT;
    for (int i = gt; i < S_ * 64; i += NGT) { const int t = i >> 6, c4 = (i & 63) * 4;
        const u32x2 pw = *(const u32x2*)(RWP + (size_t)t * RW_IN + 1536 + c4);
        u32x2 qw; qw.x = 0u; qw.y = 0u; if (t > 0) qw = *(const u32x2*)(RWP + (size_t)(t - 1) * RW_IN + 1536 + c4);
        const f32x4 m4 = *(const f32x4*)(mu + 1536 + c4);
        f32x4 p = {bflo(pw.x), bfhi(pw.x), bflo(pw.y), bfhi(pw.y)}, q = {bflo(qw.x), bfhi(qw.x), bflo(qw.y), bfhi(qw.y)};
        f32x4 s = p + (q - p) * m4;
        if (c4 < 64) { for (int j = 0; j < 4; ++j) s[j] = tanhf(s[j]); }
        else if (c4 >= 128) { for (int j = 0; j < 4; ++j) s[j] = sigmoidf_(s[j]); }
        st_bf4(LIN + (size_t)t * 256 + c4, s); }
}

constexpr int TC = 32;
__device__ __forceinline__ float shift3(const bf16* RWP, const float* mu, int t, int col) {
    const float p = bf2f(RWP[(size_t)t * RW_IN + col]); const float q = t > 0 ? bf2f(RWP[(size_t)(t - 1) * RW_IN + col]) : 0.f;
    return p + (q - p) * mu[col];
}
__device__ __forceinline__ void rwkv_scan_v1(const Params& P, LAS unsigned char* lds, int h) {
    const bf16* RWP = (const bf16*)(P.ws + WS_RWP);
    const bf16* Eb = (const bf16*)((unsigned char*)P.out + DO_E); const bf16* Ab = (const bf16*)((unsigned char*)P.out + DO_A); const bf16* Gb = (const bf16*)((unsigned char*)P.out + DO_G);
    bf16* Y = (bf16*)(P.ws + WS_Y);
    const float* mu = P.in[12]; const float* k_k = P.in[18]; const float* k_a = P.in[19]; const float* r_k = P.in[20]; const float* ln_w = P.in[21]; const float* ln_b = P.in[22];
    LAS float* sR = (LAS float*)lds; LAS float* sW = sR + TC * 64; LAS float* sK = sW + TC * 64; LAS float* sV = sK + TC * 64;
    LAS float* sA = sV + TC * 64; LAS float* sB = sA + TC * 64; LAS float* sY = sB + TC * 64; LAS float* sG = sY + TC * 64;
    const int tid = tid_opaque();
    const int tok = tid >> 4, j0 = (tid & 15) * 4;
    const int si = tid >> 3, jg = tid & 7;
    float S[8];
#pragma unroll
    for (int c = 0; c < 8; ++c) S[c] = 0.f;
    for (int t0 = 0; t0 < S_; t0 += TC) {
        {
            const int t = t0 + tok; float kkv[4], ss = 0.f, rr[4], kk_[4], vv[4], aa[4], ee[4], gg[4];
#pragma unroll
            for (int j = 0; j < 4; ++j) { const int c = h * 64 + j0 + j;
                rr[j] = shift3(RWP, mu, t, c); kk_[j] = shift3(RWP, mu, t, 512 + c); vv[j] = shift3(RWP, mu, t, 1024 + c);
                aa[j] = bf2f(Ab[(size_t)t * 512 + c]); ee[j] = bf2f(Eb[(size_t)t * 512 + c]); gg[j] = bf2f(Gb[(size_t)t * 512 + c]);
                kkv[j] = kk_[j] * k_k[c]; ss += kkv[j] * kkv[j]; }
            ss += __shfl_xor(ss, 1); ss += __shfl_xor(ss, 2); ss += __shfl_xor(ss, 4); ss += __shfl_xor(ss, 8);
            const float inv = 1.0f / fmaxf(sqrtf(ss), 1e-12f);
#pragma unroll
            for (int j = 0; j < 4; ++j) { const int c = h * 64 + j0 + j; const int o = tok * 64 + j0 + j; const float kn = kkv[j] * inv;
                sR[o] = rr[j]; sW[o] = __expf(-ee[j]); sK[o] = kk_[j] * (1.0f + (aa[j] - 1.0f) * k_a[c]); sV[o] = vv[j]; sA[o] = -kn; sB[o] = kn * aa[j]; sG[o] = gg[j]; }
        }
        __syncthreads();
        for (int tt = 0; tt < TC; ++tt) {
            const LAS float* pa = sA + tt * 64 + 8 * jg; const LAS float* pb = sB + tt * 64 + 8 * jg; const LAS float* pw = sW + tt * 64 + 8 * jg;
            const LAS float* pk = sK + tt * 64 + 8 * jg; const LAS float* pr = sR + tt * 64 + 8 * jg;
            const float vi = sV[tt * 64 + si];
            float sa = 0.f;
#pragma unroll
            for (int c = 0; c < 8; ++c) sa += S[c] * pa[c];
            sa += __shfl_xor(sa, 1); sa += __shfl_xor(sa, 2); sa += __shfl_xor(sa, 4);
            float y = 0.f;
#pragma unroll
            for (int c = 0; c < 8; ++c) { S[c] = S[c] * pw[c] + sa * pb[c] + vi * pk[c]; y += S[c] * pr[c]; }
            y += __shfl_xor(y, 1); y += __shfl_xor(y, 2); y += __shfl_xor(y, 4);
            if (jg == 0) sY[tt * 64 + si] = y;
        }
        __syncthreads();
        {
            const int t = t0 + tok; float y4[4], s1 = 0.f, bon = 0.f;
#pragma unroll
            for (int j = 0; j < 4; ++j) { const int o = tok * 64 + j0 + j; y4[j] = sY[o]; s1 += y4[j]; bon += sR[o] * sK[o] * r_k[h * 64 + j0 + j]; }
            s1 += __shfl_xor(s1, 1); s1 += __shfl_xor(s1, 2); s1 += __shfl_xor(s1, 4); s1 += __shfl_xor(s1, 8);
            bon += __shfl_xor(bon, 1); bon += __shfl_xor(bon, 2); bon += __shfl_xor(bon, 4); bon += __shfl_xor(bon, 8);
            const float mean = s1 * (1.0f / 64.0f); float s2 = 0.f;
#pragma unroll
            for (int j = 0; j < 4; ++j) { const float d = y4[j] - mean; s2 += d * d; }
            s2 += __shfl_xor(s2, 1); s2 += __shfl_xor(s2, 2); s2 += __shfl_xor(s2, 4); s2 += __shfl_xor(s2, 8);
            const float rstd = 1.0f / sqrtf(s2 * (1.0f / 64.0f) + GN_EPS);
            f32x4 o4;
#pragma unroll
            for (int j = 0; j < 4; ++j) { const int c = h * 64 + j0 + j; const int o = tok * 64 + j0 + j;
                o4[j] = ((y4[j] - mean) * rstd * ln_w[c] + ln_b[c] + bon * sV[o]) * sG[o]; }
            st_bf4(Y + (size_t)t * 1536 + 512 + h * 64 + j0, o4);
        }
        __syncthreads();
    }
}

__device__ __forceinline__ unsigned ordkey(float f) { const unsigned u = __builtin_bit_cast(unsigned, f); return (u & 0x80000000u) ? ~u : (u | 0x80000000u); }
constexpr int DSA_LDS_SCORES = 0, DSA_LDS_IQ = 65536, DSA_LDS_HIST = DSA_LDS_IQ + 1024, DSA_LDS_MISC = DSA_LDS_HIST + 1024, DSA_LDS_SEL = DSA_LDS_MISC + 256,
              DSA_LDS_O = DSA_LDS_SEL + 1024, DSA_LDS_ML = DSA_LDS_O + 8 * 512 * 4, DSA_LDS_END = DSA_LDS_ML + 8 * 8 * 2 * 4;
__device__ __forceinline__ void dsa_query_v1(const Params& P, LAS unsigned char* lds, int t) {
    const half_t* IQ = (const half_t*)(P.ws + WS_IQ); const half_t* IK = (const half_t*)(P.ws + WS_IK); const float* IW = (const float*)(P.ws + WS_IW);
    const bf16* Q = (const bf16*)(P.ws + WS_Q); const bf16* Kb = (const bf16*)(P.ws + WS_K); const bf16* Vb = (const bf16*)(P.ws + WS_V);
    bf16* Y = (bf16*)(P.ws + WS_Y);
    LAS float* sc = (LAS float*)(lds + DSA_LDS_SCORES); LAS float* siq = (LAS float*)(lds + DSA_LDS_IQ); LAS unsigned* hist = (LAS unsigned*)(lds + DSA_LDS_HIST);
    LAS unsigned* misc = (LAS unsigned*)(lds + DSA_LDS_MISC); LAS unsigned* sel = (LAS unsigned*)(lds + DSA_LDS_SEL);
    LAS float* so = (LAS float*)(lds + DSA_LDS_O); LAS float* sml = (LAS float*)(lds + DSA_LDS_ML);
    const int tid = tid_opaque(), lane = tid & 63, wave = tid >> 6;
    const int n = t + 1;
    if (tid < 256) siq[tid] = (float)IQ[(size_t)t * 256 + tid];
    if (tid < 256) sel[tid] = 0xFFFFu;
    __syncthreads();
    float w4[4];
#pragma unroll
    for (int hh = 0; hh < 4; ++hh) w4[hh] = IW[(size_t)t * 4 + hh] * 0.0625f;
    for (int s = tid; s < n; s += NT) {
        const half8* kp = (const half8*)(IK + (size_t)s * 64);
        float d0 = 0.f, d1 = 0.f, d2 = 0.f, d3 = 0.f;
#pragma unroll
        for (int c = 0; c < 8; ++c) { const half8 kv = kp[c];
#pragma unroll
            for (int j = 0; j < 8; ++j) { const float kf = (float)kv[j]; const int d = c * 8 + j;
                d0 += siq[d] * kf; d1 += siq[64 + d] * kf; d2 += siq[128 + d] * kf; d3 += siq[192 + d] * kf; } }
        float v = w4[0] * fmaxf(d0, 0.f) + w4[1] * fmaxf(d1, 0.f) + w4[2] * fmaxf(d2, 0.f) + w4[3] * fmaxf(d3, 0.f);
        sc[s] = v + 0.0f;
    }
    __syncthreads();
    if (n <= 256) { if (tid < n) sel[tid] = (unsigned)tid; __syncthreads(); }
    else {
        unsigned prefix = 0u, krem = 256u;
        for (int pass = 3; pass >= 0; --pass) {
            const int shift = pass * 8;
            if (tid < 256) hist[tid] = 0u;
            __syncthreads();
            for (int s = tid; s < n; s += NT) { const unsigned k = ordkey(sc[s]);
                if (pass == 3 || (k >> (shift + 8)) == (prefix >> (shift + 8))) atomicAdd((unsigned*)&hist[(k >> shift) & 255u], 1u); }
            __syncthreads();
            if (tid == 0) { unsigned cum = 0u; int b = 255; for (; b > 0; --b) { const unsigned hb = hist[b]; if (cum + hb >= krem) break; cum += hb; }
                misc[0] = prefix | ((unsigned)b << shift); misc[1] = krem - cum; }
            __syncthreads();
            prefix = misc[0]; krem = misc[1];
            __syncthreads();
        }
        const unsigned T = prefix; unsigned selbase = 0u, eqbase = 0u;
        for (int c0 = 0; c0 < n; c0 += NT) {
            const int s = c0 + tid; const unsigned k = (s < n) ? ordkey(sc[s]) : 0u; const bool gt = (s < n) && k > T, eq = (s < n) && k == T;
            const unsigned long long beq = __ballot(eq); const unsigned eqpre = __popcll(beq & ((1ull << lane) - 1ull));
            if (lane == 0) misc[8 + wave] = (unsigned)__popcll(beq);
            __syncthreads();
            unsigned eqoff = eqbase, eqtot = 0u;
#pragma unroll
            for (int w = 0; w < 8; ++w) { const unsigned cw = misc[8 + w]; if (w < wave) eqoff += cw; eqtot += cw; }
            const bool take = gt || (eq && (eqoff + eqpre) < krem);
            const unsigned long long bt = __ballot(take); const unsigned tpre = __popcll(bt & ((1ull << lane) - 1ull));
            if (lane == 0) misc[16 + wave] = (unsigned)__popcll(bt);
            __syncthreads();
            unsigned toff = selbase, ttot = 0u;
#pragma unroll
            for (int w = 0; w < 8; ++w) { const unsigned cw = misc[16 + w]; if (w < wave) toff += cw; ttot += cw; }
            if (take && (toff + tpre) < 256u) sel[toff + tpre] = (unsigned)s;
            selbase += ttot; eqbase += eqtot;
            __syncthreads();
        }
    }
    {
        u16* SEL = (u16*)(P.ws + WS_SEL);
        if (tid < 256) SEL[(size_t)t * 256 + tid] = (u16)sel[tid];
        const u32x4 qw = *(const u32x4*)(Q + (size_t)t * 512 + 8 * lane);
        float q[8] = {bflo(qw.x), bfhi(qw.x), bflo(qw.y), bfhi(qw.y), bflo(qw.z), bfhi(qw.z), bflo(qw.w), bfhi(qw.w)};
        float lg[32]; float mx = -INFINITY;
#pragma unroll
        for (int i = 0; i < 32; ++i) { const unsigned id = sel[wave * 32 + i];
            float d = -INFINITY;
            if (id != 0xFFFFu) { const u32x4 kw = *(const u32x4*)(Kb + (size_t)id * 512 + 8 * lane);
                d = q[0] * bflo(kw.x) + q[1] * bfhi(kw.x) + q[2] * bflo(kw.y) + q[3] * bfhi(kw.y) + q[4] * bflo(kw.z) + q[5] * bfhi(kw.z) + q[6] * bflo(kw.w) + q[7] * bfhi(kw.w);
                d += __shfl_xor(d, 1); d += __shfl_xor(d, 2); d += __shfl_xor(d, 4); d *= 0.125f; }
            lg[i] = d; mx = fmaxf(mx, d); }
        float l = 0.f, o[8];
#pragma unroll
        for (int c = 0; c < 8; ++c) o[c] = 0.f;
#pragma unroll
        for (int i = 0; i < 32; ++i) { const unsigned id = sel[wave * 32 + i];
            if (id != 0xFFFFu) { const float p = __expf(lg[i] - mx); l += p;
                const u32x4 vw = *(const u32x4*)(Vb + (size_t)id * 512 + 8 * lane);
                o[0] += p * bflo(vw.x); o[1] += p * bfhi(vw.x); o[2] += p * bflo(vw.y); o[3] += p * bfhi(vw.y); o[4] += p * bflo(vw.z); o[5] += p * bfhi(vw.z); o[6] += p * bflo(vw.w); o[7] += p * bfhi(vw.w); } }
#pragma unroll
        for (int c = 0; c < 8; ++c) so[wave * 512 + 8 * lane + c] = o[c];
        if ((lane & 7) == 0) { sml[(wave * 8 + (lane >> 3)) * 2] = mx; sml[(wave * 8 + (lane >> 3)) * 2 + 1] = l; }
        __syncthreads();
        {
            const int hh = tid >> 6; float M = -INFINITY;
#pragma unroll
            for (int w = 0; w < 8; ++w) M = fmaxf(M, sml[(w * 8 + hh) * 2]);
            float L = 0.f, acc = 0.f;
#pragma unroll
            for (int w = 0; w < 8; ++w) { const float mw = sml[(w * 8 + hh) * 2]; const float f = (mw == -INFINITY) ? 0.f : __expf(mw - M); L += f * sml[(w * 8 + hh) * 2 + 1]; acc += f * so[w * 512 + tid]; }
            Y[(size_t)t * 1536 + tid] = (bf16)f2bf(acc / L);
        }
        __syncthreads();
    }
}

constexpr int MA_KSTRIDE = 264;
constexpr int MA_LDS_K = 0, MA_LDS_V = 256 * MA_KSTRIDE, MA_LDS_P = MA_LDS_V + 256 * 256, MA_LDS_Q = MA_LDS_P + 8 * 256 * 4, MA_LDS_END = MA_LDS_Q + 8 * 128 * 4;
__device__ __forceinline__ void mem_attn_phase(const Params& P, LAS unsigned char* lds, int bid, int nblk) {
    const float* KMVM = (const float*)(P.ws + WS_KMVM); const bf16* MEMQ = (const bf16*)(P.ws + WS_MEMQ); bf16* Y = (bf16*)(P.ws + WS_Y);
    const float* qg = P.in[10]; const float* kg = P.in[11];
    const int tid = tid_opaque(), lane = tid & 63, wave = tid >> 6;
    const int h = bid & 3, sub = bid >> 2, nsub = nblk >> 2;
    for (int r = wave; r < 256; r += NW) {
        const f32x2 kv = *(const f32x2*)(KMVM + (size_t)r * 1024 + h * 128 + 2 * lane);
        const float ss = wave_sum(kv.x * kv.x + kv.y * kv.y); const float rk = 1.0f / sqrtf(ss * (1.0f / 128.0f) + NORM_EPS);
        *(LAS unsigned*)(lds + MA_LDS_K + r * MA_KSTRIDE + 4 * lane) = pk2(kv.x * rk * kg[2 * lane], kv.y * rk * kg[2 * lane + 1]);
        const f32x2 vv = *(const f32x2*)(KMVM + (size_t)r * 1024 + 512 + h * 128 + 2 * lane);
        *(LAS unsigned*)(lds + MA_LDS_V + r * 256 + 4 * lane) = pk2(vv.x, vv.y);
    }
    __syncthreads();
    LAS float* pb = (LAS float*)(lds + MA_LDS_P) + wave * 256; LAS float* qb = (LAS float*)(lds + MA_LDS_Q) + wave * 128;
    for (int r = sub * NW + wave; r < S_; r += nsub * NW) {
        const unsigned qw = *(const unsigned*)(MEMQ + (size_t)r * 512 + h * 128 + 2 * lane);
        const float q0 = bflo(qw), q1 = bfhi(qw);
        const float ss = wave_sum(q0 * q0 + q1 * q1); const float rq = 1.0f / sqrtf(ss * (1.0f / 128.0f) + NORM_EPS) * 0.08838834764831845f;
        qb[2 * lane] = q0 * rq * qg[2 * lane]; qb[2 * lane + 1] = q1 * rq * qg[2 * lane + 1];
        LDS_WAIT(); __builtin_amdgcn_wave_barrier();
        float lg[4] = {0.f, 0.f, 0.f, 0.f};
#pragma unroll 4
        for (int d4 = 0; d4 < 32; ++d4) { const f32x4 qv = *(const LAS f32x4*)(qb + 4 * d4);
#pragma unroll
            for (int c = 0; c < 4; ++c) { const u32x2 kw = *(const LAS u32x2*)(lds + MA_LDS_K + (lane + 64 * c) * MA_KSTRIDE + 8 * d4);
                lg[c] += qv[0] * bflo(kw.x) + qv[1] * bfhi(kw.x) + qv[2] * bflo(kw.y) + qv[3] * bfhi(kw.y); } }
        const float mx = wave_max(fmaxf(fmaxf(lg[0], lg[1]), fmaxf(lg[2], lg[3])));
        float p[4], l = 0.f;
#pragma unroll
        for (int c = 0; c < 4; ++c) { p[c] = __expf(lg[c] - mx); l += p[c]; }
        l = wave_sum(l); const float il = 1.0f / l;
#pragma unroll
        for (int c = 0; c < 4; ++c) pb[lane + 64 * c] = p[c] * il;
        LDS_WAIT(); __builtin_amdgcn_wave_barrier();
        float o0 = 0.f, o1 = 0.f;
#pragma unroll 8
        for (int k4 = 0; k4 < 64; ++k4) { const f32x4 pv = *(const LAS f32x4*)(pb + 4 * k4);
#pragma unroll
            for (int c = 0; c < 4; ++c) { const unsigned vw = *(const LAS unsigned*)(lds + MA_LDS_V + (4 * k4 + c) * 256 + 4 * lane); o0 += pv[c] * bflo(vw); o1 += pv[c] * bfhi(vw); } }
        *(unsigned*)(Y + (size_t)r * 1536 + 1024 + h * 128 + 2 * lane) = pk2(o0, o1);
        LDS_WAIT(); __builtin_amdgcn_wave_barrier();
    }
}

__device__ __forceinline__ void rstdh_phase(const Params& P, int bid, int nblk) {
    const float* HSQ = (const float*)(P.ws + WS_HSQ); float* R = (float*)(P.ws + WS_RSTDH);
    for (int r = bid * NT + tid_opaque(); r < S_; r += nblk * NT) { float s = 0.f;
#pragma unroll
        for (int i = 0; i < 16; ++i) s += HSQ[(size_t)r * 16 + i];
        R[r] = 1.0f / sqrtf(s * (1.0f / 1024.0f) + NORM_EPS); }
}
#define BUBBLE16(v, ix, x, c) do { if ((x) > v[15]) { v[15] = (x); ix[15] = (c); _Pragma("unroll") for (int _p = 15; _p > 0; --_p) { \
        const bool _sw = v[_p] > v[_p - 1]; const float _a = v[_p], _b = v[_p - 1]; const int _ia = ix[_p], _ib = ix[_p - 1]; \
        v[_p] = _sw ? _b : _a; v[_p - 1] = _sw ? _a : _b; ix[_p] = _sw ? _ib : _ia; ix[_p - 1] = _sw ? _ia : _ib; } } } while (0)
__device__ __forceinline__ void peer_topk_phase(const Params& P, LAS unsigned char* lds, int h, int bid, int nblk) {
    const float* SC = (const float*)(P.ws + WS_SC); int* EIDX = (int*)(P.ws + WS_EIDX); float* EG = (float*)(P.ws + WS_EGATE);
    LAS float* sv = (LAS float*)lds; LAS int* sx = (LAS int*)(lds + 256 * 2 * 16 * 4);
    const int tid = tid_opaque(), rl = tid >> 1, half = tid & 1;
    for (int r0 = bid * 256; r0 < S_; r0 += nblk * 256) {
        const int row = r0 + rl;
        float v[16]; int ix[16];
#pragma unroll
        for (int p = 0; p < 16; ++p) { v[p] = -INFINITY; ix[p] = 0; }
        const f32x4* sp = (const f32x4*)(SC + (size_t)row * 256 + half * 128);
        for (int c4 = 0; c4 < 32; ++c4) { const f32x4 x = sp[c4];
#pragma unroll
            for (int j = 0; j < 4; ++j) { const float xv = x[j]; const int cc = 4 * c4 + j; BUBBLE16(v, ix, xv, cc); } }
#pragma unroll
        for (int p = 0; p < 16; ++p) { sv[(rl * 2 + half) * 16 + p] = v[p]; sx[(rl * 2 + half) * 16 + p] = ix[p]; }
        __syncthreads();
        if (half == 0) {
            float cv[16]; int ci[16];
#pragma unroll
            for (int p = 0; p < 16; ++p) { cv[p] = -INFINITY; ci[p] = 0; }
            for (int i = 0; i < 16; ++i) { const float a = sv[(rl * 2) * 16 + i];
                for (int j = 0; j < 16; ++j) { const float s = a + sv[(rl * 2 + 1) * 16 + j]; const int f = i * 16 + j; BUBBLE16(cv, ci, s, f); } }
            float l = 0.f, pe[16];
#pragma unroll
            for (int p = 0; p < 16; ++p) { pe[p] = __expf(cv[p] - cv[0]); l += pe[p]; }
            const float il = 1.0f / l;
#pragma unroll
            for (int p = 0; p < 16; ++p) { const int e1 = sx[(rl * 2) * 16 + (ci[p] >> 4)], e2 = sx[(rl * 2 + 1) * 16 + (ci[p] & 15)];
                EIDX[(size_t)row * 128 + h * 16 + p] = e1 * 128 + e2; EG[(size_t)row * 128 + h * 16 + p] = pe[p] * il; }
        }
        __syncthreads();
    }
}
__device__ __forceinline__ void peer_expert_phase_v1(const Params& P, int bid, int nblk) {
    const int* EIDX = (const int*)(P.ws + WS_EIDX); const float* EG = (const float*)(P.ws + WS_EGATE); const float* HSQ = (const float*)(P.ws + WS_HSQ);
    const float* U = P.in[29]; const float* Vt = P.in[30]; const float* gain = P.in[25];
    const int tid = tid_opaque(), lane = tid & 63, wave = tid >> 6;
    for (int row = bid * NW + wave; row < S_; row += nblk * NW) {
        float* hp = P.out + (size_t)row * 1024; const float rs = rstd_h_row(HSQ, row);
        f32x4 hv[4], xn[4], o[4];
#pragma unroll
        for (int j = 0; j < 4; ++j) { hv[j] = *(const f32x4*)(hp + 4 * lane + 256 * j); xn[j] = hv[j] * rs * *(const f32x4*)(gain + 4 * lane + 256 * j); o[j] = (f32x4){0.f, 0.f, 0.f, 0.f}; }
        const int e_lo = EIDX[(size_t)row * 128 + lane], e_hi = EIDX[(size_t)row * 128 + 64 + lane];
        const float g_lo = EG[(size_t)row * 128 + lane], g_hi = EG[(size_t)row * 128 + 64 + lane];
        for (int e = 0; e < 128; ++e) {
            const int idx = __shfl((e < 64) ? e_lo : e_hi, e & 63); const float gt = __shfl((e < 64) ? g_lo : g_hi, e & 63);
            const float* up = U + (size_t)idx * 1024; float d = 0.f;
#pragma unroll
            for (int j = 0; j < 4; ++j) { const f32x4 uv = *(const f32x4*)(up + 4 * lane + 256 * j); d += (xn[j][0] * uv[0] + xn[j][1] * uv[1]) + (xn[j][2] * uv[2] + xn[j][3] * uv[3]); }
            d = wave_sum(d);
            const float w = gt * 0.5f * d * (1.0f + erff(d * 0.70710678118654752f));
            const float* vp = Vt + (size_t)idx * 1024;
#pragma unroll
            for (int j = 0; j < 4; ++j) o[j] = o[j] + *(const f32x4*)(vp + 4 * lane + 256 * j) * w;
        }
#pragma unroll
        for (int j = 0; j < 4; ++j) *(f32x4*)(hp + 4 * lane + 256 * j) = hv[j] + o[j];
    }
}
struct EpiPQ {
    half_t* PQ; const float* HSQ;
    __device__ __forceinline__ void operator()(AccRef acc, const pg8::Unit& u, int wr, int wc, int fr, int fq) const {
#pragma unroll
        for (int ai = 0; ai < 2; ++ai)
#pragma unroll
            for (int m = 0; m < 4; ++m) { const int row = u.pm * 256 + ai * 128 + wr * 64 + m * 16 + fr;
                const f32x4* hp = (const f32x4*)(HSQ + (size_t)row * 16); const f32x4 a = hp[0], b = hp[1], c = hp[2], d = hp[3];
                const float s = ((a[0] + a[1]) + (a[2] + a[3])) + ((b[0] + b[1]) + (b[2] + b[3])) + ((c[0] + c[1]) + (c[2] + c[3])) + ((d[0] + d[1]) + (d[2] + d[3]));
                const float rs = 1.0f / sqrtf(s * (1.0f / 1024.0f) + NORM_EPS);
                half_t* dst = PQ + (size_t)row * 2048 + u.pn * 256 + 32 * wc + 4 * fq;
#pragma unroll
                for (int bj = 0; bj < 2; ++bj)
#pragma unroll
                    for (int n = 0; n < 2; ++n) st_h4(dst + 128 * bj + 16 * n, acc[ai][bj][m][n] * rs); }
    }
};
#define PEER_CAND(I, J) do { if (((I) + 1) * ((J) + 1) <= 16) { const float _s = v1[I] + v2[J]; const int _e = i1[I] * 128 + i2[J]; BUBBLE16(cv, ce, _s, _e); } } while (0)
__device__ __forceinline__ void peer_topk_tile(const float* scr, int pm, int head, int* EIDX, float* EG) {
    const int tid = tid_opaque(), lrow = tid >> 1, kh = tid & 1;
    float v[16]; int ix[16];
#pragma unroll
    for (int p = 0; p < 16; ++p) { v[p] = -INFINITY; ix[p] = 0; }
    const f32x4* sp = (const f32x4*)(scr + (size_t)lrow * 256 + kh * 128);
#pragma unroll 1
    for (int c4 = 0; c4 < 32; ++c4) { const f32x4 x = sp[c4];
#pragma unroll
        for (int j = 0; j < 4; ++j) { const float xv = x[j]; const int cc = 4 * c4 + j; BUBBLE16(v, ix, xv, cc); } }
    float v1[16], v2[16]; int i1[16], i2[16];
#pragma unroll
    for (int p = 0; p < 16; ++p) { const float ov = __shfl_xor(v[p], 1); const int oi = __shfl_xor(ix[p], 1);
        v1[p] = kh ? ov : v[p]; i1[p] = kh ? oi : ix[p]; v2[p] = kh ? v[p] : ov; i2[p] = kh ? ix[p] : oi; }
    float cv[16]; int ce[16];
#pragma unroll
    for (int p = 0; p < 16; ++p) { cv[p] = -INFINITY; ce[p] = 0; }
#pragma unroll
    for (int I = 0; I < 16; ++I) {
#pragma unroll
        for (int J = 0; J < 16; ++J) PEER_CAND(I, J); }
    if (kh == 0) {
        float l = 0.f, pe[16];
#pragma unroll
        for (int p = 0; p < 16; ++p) { pe[p] = __expf(cv[p] - cv[0]); l += pe[p]; }
        const float il = 1.0f / l; const int row = pm * 256 + lrow;
        int* ep = EIDX + (size_t)row * 128 + head * 16; float* gp = EG + (size_t)row * 128 + head * 16;
#pragma unroll
        for (int p4 = 0; p4 < 4; ++p4) { *(f32x4*)(gp + 4 * p4) = (f32x4){pe[4 * p4] * il, pe[4 * p4 + 1] * il, pe[4 * p4 + 2] * il, pe[4 * p4 + 3] * il};
            typedef int i32x4 __attribute__((ext_vector_type(4))); *(i32x4*)(ep + 4 * p4) = (i32x4){ce[4 * p4], ce[4 * p4 + 1], ce[4 * p4 + 2], ce[4 * p4 + 3]}; }
    }
}
struct EpiTile {
    float* scr;
    __device__ __forceinline__ void operator()(AccRef acc, const pg8::Unit& u, int wr, int wc, int fr, int fq) const {
#pragma unroll
        for (int ai = 0; ai < 2; ++ai)
#pragma unroll
            for (int m = 0; m < 4; ++m) { float* dst = scr + (size_t)(ai * 128 + wr * 64 + m * 16 + fr) * 256 + 32 * wc + 4 * fq;
#pragma unroll
                for (int bj = 0; bj < 2; ++bj)
#pragma unroll
                    for (int n = 0; n < 2; ++n) *(f32x4*)(dst + 128 * bj + 16 * n) = acc[ai][bj][m][n]; }
    }
};
typedef _Float16 h8 __attribute__((ext_vector_type(8)));
constexpr int DQ = 16, DCAP = 1024, DSTEP_TILES = 16;
constexpr int DA_CS = 0, DA_CI = DQ * DCAP * 4, DA_CNT = DA_CI + DQ * DCAP * 2, DA_TAU = DA_CNT + 64, DA_HIST = DA_TAU + 64, DA_SELST = DA_HIST + 8 * 256 * 4, DA_END = DA_SELST + 8 * 512;
__device__ __forceinline__ float inv_ordkey(unsigned u) { return __builtin_bit_cast(float, (u & 0x80000000u) ? (u & 0x7fffffffu) : ~u); }

__device__ __forceinline__ void dsa_compact(LAS unsigned char* lds, int q, int lane, int wave) {
    LAS float* cs = (LAS float*)(lds + DA_CS) + q * DCAP; LAS u16* ci = (LAS u16*)(lds + DA_CI) + q * DCAP;
    LAS unsigned* cnt = (LAS unsigned*)(lds + DA_CNT); LAS float* tau = (LAS float*)(lds + DA_TAU); LAS unsigned* hist = (LAS unsigned*)(lds + DA_HIST) + wave * 256;
    const int n = (int)cnt[q];
    if (n <= 256) return;
    unsigned hi[16], lo[16]; unsigned alive = 0u, valid = 0u;
#pragma unroll
    for (int k = 0; k < 16; ++k) { const int e = lane + 64 * k; const bool v = e < n; hi[k] = v ? ordkey(cs[e]) : 0u; lo[k] = v ? (0xFFFFu - (unsigned)ci[e]) : 0u; if (v) { alive |= 1u << k; valid |= 1u << k; } }
    unsigned krem = 256u, Thi = 0u, Tlo = 0u;
#pragma unroll 1
    for (int pass = 5; pass >= 0; --pass) {
        *(LAS u32x4*)(hist + 4 * lane) = (u32x4){0u, 0u, 0u, 0u};
        const int sh = (pass >= 2) ? 8 * (pass - 2) : 8 * pass;
        unsigned dg[16];
#pragma unroll
        for (int k = 0; k < 16; ++k) { dg[k] = (((pass >= 2) ? hi[k] : lo[k]) >> sh) & 255u; if (alive & (1u << k)) atomicAdd((unsigned*)&hist[dg[k]], 1u); }
        LDS_WAIT();
        const u32x4 h4 = *(const LAS u32x4*)(hist + 4 * lane);
        unsigned suf = h4.x + h4.y + h4.z + h4.w;
#pragma unroll
        for (int o = 1; o < 64; o <<= 1) { const unsigned v = __shfl_down(suf, o); suf += (lane + o < 64) ? v : 0u; }
        const unsigned S0 = suf, S1 = suf - h4.x, S2 = S1 - h4.y, S3 = S2 - h4.z;
        const int nge = __popcll(__ballot(S0 >= krem)) + __popcll(__ballot(S1 >= krem)) + __popcll(__ballot(S2 >= krem)) + __popcll(__ballot(S3 >= krem));
        const int d = nge - 1;
        const unsigned Sd0 = __shfl(S0, d >> 2), Sd1 = __shfl(S1, d >> 2), Sd2 = __shfl(S2, d >> 2), Sd3 = __shfl(S3, d >> 2);
        const unsigned Sd = ((d & 3) == 0) ? Sd0 : ((d & 3) == 1) ? Sd1 : ((d & 3) == 2) ? Sd2 : Sd3;
        const unsigned hd = hist[d];
        krem -= (Sd - hd);
        if (pass >= 2) Thi |= (unsigned)d << sh; else Tlo |= (unsigned)d << sh;
#pragma unroll
        for (int k = 0; k < 16; ++k) if (dg[k] != (unsigned)d) alive &= ~(1u << k);
        LDS_WAIT();
    }
    unsigned base = 0u;
#pragma unroll
    for (int k = 0; k < 16; ++k) { const bool keep = ((valid >> k) & 1u) && (hi[k] > Thi || (hi[k] == Thi && lo[k] >= Tlo));
        const unsigned long long b = __ballot(keep);
        if (keep) { const unsigned pos = base + (unsigned)__popcll(b & ((1ull << lane) - 1ull)); cs[pos] = inv_ordkey(hi[k]); ci[pos] = (u16)(0xFFFFu - lo[k]); }
        base += (unsigned)__popcll(b); }
    if (lane == 0) { cnt[q] = 256u; tau[q] = inv_ordkey(Thi); }
}

__device__ __forceinline__ void dsa_index_item(const Params& P, LAS unsigned char* lds, int item) {
    const half_t* IQ = (const half_t*)(P.ws + WS_IQ); const half_t* IK = (const half_t*)(P.ws + WS_IK); const float* IW = (const float*)(P.ws + WS_IW); u16* SEL = (u16*)(P.ws + WS_SEL);
    LAS float* cs = (LAS float*)(lds + DA_CS); LAS u16* ci = (LAS u16*)(lds + DA_CI); LAS unsigned* cnt = (LAS unsigned*)(lds + DA_CNT); LAS float* tau = (LAS float*)(lds + DA_TAU);
    const int tid = tid_opaque(), lane = tid & 63, wave = __builtin_amdgcn_readfirstlane(tid >> 6), qq = lane & 15, kg = lane >> 4;
    const int q0 = item * DQ, t = q0 + qq, ntiles = item + 1;
    h8 bq[4][2]; float w[4];
#pragma unroll
    for (int h = 0; h < 4; ++h) { w[h] = IW[(size_t)t * 4 + h] * 0.0625f;
#pragma unroll
        for (int ks = 0; ks < 2; ++ks) bq[h][ks] = *(const h8*)(IQ + (size_t)t * 256 + h * 64 + ks * 32 + kg * 8); }
    if (tid < DQ) { cnt[tid] = 0u; tau[tid] = -INFINITY; }
    __syncthreads();
    float tq = -INFINITY;
    for (int base = 0; base < ntiles; base += DSTEP_TILES) {
#pragma unroll
        for (int g = 0; g < 2; ++g) { const int tile = base + g * 8 + wave;
            if (tile < ntiles) { const int s0 = tile * 16;
                const h8 a0 = *(const h8*)(IK + (size_t)(s0 + qq) * 64 + kg * 8), a1 = *(const h8*)(IK + (size_t)(s0 + qq) * 64 + 32 + kg * 8);
                float sc[4] = {0.f, 0.f, 0.f, 0.f};
#pragma unroll
                for (int h = 0; h < 4; ++h) { f32x4 acc = {0.f, 0.f, 0.f, 0.f};
                    acc = __builtin_amdgcn_mfma_f32_16x16x32_f16(a0, bq[h][0], acc, 0, 0, 0); acc = __builtin_amdgcn_mfma_f32_16x16x32_f16(a1, bq[h][1], acc, 0, 0, 0);
#pragma unroll
                    for (int r = 0; r < 4; ++r) sc[r] += w[h] * fmaxf(acc[r], 0.f); }
#pragma unroll
                for (int r = 0; r < 4; ++r) { const float v = sc[r] + 0.0f; const int s = s0 + 4 * kg + r;
                    if (v > tq && s <= t) { const unsigned pos = atomicAdd((unsigned*)&cnt[qq], 1u); cs[qq * DCAP + pos] = v; ci[qq * DCAP + pos] = (u16)s; } } } }
        __syncthreads();
        unsigned mx = 0u;
        { const u32x4 c0 = *(const LAS u32x4*)(cnt), c1 = *(const LAS u32x4*)(cnt + 4), c2 = *(const LAS u32x4*)(cnt + 8), c3 = *(const LAS u32x4*)(cnt + 12);
          mx = max(max(max(c0.x, c0.y), max(c0.z, c0.w)), max(max(c1.x, c1.y), max(c1.z, c1.w))); mx = max(mx, max(max(max(c2.x, c2.y), max(c2.z, c2.w)), max(max(c3.x, c3.y), max(c3.z, c3.w)))); }
        if (mx > (unsigned)(DCAP - 256)) {
            dsa_compact(lds, 2 * wave, lane, wave); dsa_compact(lds, 2 * wave + 1, lane, wave);
            __syncthreads();
            tq = tau[qq];
        }
    }
    LAS u16* st = (LAS u16*)(lds + DA_SELST) + wave * 256;
#pragma unroll 1
    for (int j = 0; j < 2; ++j) { const int q = 2 * wave + j;
        dsa_compact(lds, q, lane, wave);
        LDS_WAIT();
        const int m = (int)cnt[q]; const LAS u16* cq = ci + q * DCAP;
        unsigned id[4], rk[4];
#pragma unroll
        for (int k = 0; k < 4; ++k) { const int e = lane + 64 * k; id[k] = (e < m) ? (unsigned)cq[e] : 0xFFFFu; rk[k] = 0u; }
        *(LAS u32x2*)(st + 4 * lane) = (u32x2){0xFFFFFFFFu, 0xFFFFFFFFu};
        for (int e = 0; e < m; ++e) { const unsigned x = (unsigned)cq[e];
#pragma unroll
            for (int k = 0; k < 4; ++k) rk[k] += (x < id[k]) ? 1u : 0u; }
        LDS_WAIT();
#pragma unroll
        for (int k = 0; k < 4; ++k) if (id[k] != 0xFFFFu) st[rk[k]] = (u16)id[k];
        LDS_WAIT();
        *(u32x2*)(SEL + (size_t)(q0 + q) * 256 + 4 * lane) = *(const LAS u32x2*)(st + 4 * lane);
        LDS_WAIT();
    }
    __syncthreads();
}

__device__ __forceinline__ void dsa_index_phase(const Params& P, LAS unsigned char* lds, int bid, int nblk) {
    constexpr int NITEMS = S_ / DQ;
    for (int r = 0;; ++r) { const int k = r * nblk + ((r & 1) ? (nblk - 1 - bid) : bid); if (k >= NITEMS) break; dsa_index_item(P, lds, NITEMS - 1 - k); }
}

__device__ __forceinline__ void dsa_attn_phase(const Params& P, LAS unsigned char* lds, int bid, int nblk) {
    const bf16* Q = (const bf16*)(P.ws + WS_Q); const bf16* Kh = (const bf16*)(P.ws + WS_K); const bf16* Vh = (const bf16*)(P.ws + WS_V); const u16* SEL = (const u16*)(P.ws + WS_SEL); bf16* Y = (bf16*)(P.ws + WS_Y);
    const int tid = tid_opaque(), lane = tid & 63, wave = __builtin_amdgcn_readfirstlane(tid >> 6), g = lane >> 3, c8 = (lane & 7) * 8;
    const int h = bid & 7, rank = bid >> 3, nr = nblk >> 3;
    LAS u16* sl = (LAS u16*)lds + wave * 256;
    const bf16* Kb = Kh + (size_t)h * S_ * 64 + c8; const bf16* Vb = Vh + (size_t)h * S_ * 64 + c8;
    for (int t = rank * 8 + wave; t < S_; t += nr * 8) {
        *(LAS u32x2*)(sl + 4 * lane) = *(const u32x2*)(SEL + (size_t)t * 256 + 4 * lane);
        const u32x4 qw = *(const u32x4*)(Q + (size_t)t * 512 + h * 64 + c8);
        const float q0 = bflo(qw.x) * 0.125f, q1 = bfhi(qw.x) * 0.125f, q2 = bflo(qw.y) * 0.125f, q3 = bfhi(qw.y) * 0.125f, q4 = bflo(qw.z) * 0.125f, q5 = bfhi(qw.z) * 0.125f, q6 = bflo(qw.w) * 0.125f, q7 = bfhi(qw.w) * 0.125f;
        LDS_WAIT(); __builtin_amdgcn_wave_barrier();
        float lg[32]; float mx = -INFINITY;
#pragma unroll
        for (int i0 = 0; i0 < 32; i0 += 8) {
            u32x4 kw[8]; unsigned id[8];
#pragma unroll
            for (int i = 0; i < 8; ++i) { id[i] = sl[(i0 + i) * 8 + g]; kw[i] = (u32x4){0u, 0u, 0u, 0u}; if (id[i] != 0xFFFFu) kw[i] = *(const u32x4*)(Kb + (size_t)id[i] * 64); }
#pragma unroll
            for (int i = 0; i < 8; ++i) { float d = q0 * bflo(kw[i].x) + q1 * bfhi(kw[i].x) + q2 * bflo(kw[i].y) + q3 * bfhi(kw[i].y) + q4 * bflo(kw[i].z) + q5 * bfhi(kw[i].z) + q6 * bflo(kw[i].w) + q7 * bfhi(kw[i].w);
                d += __shfl_xor(d, 1); d += __shfl_xor(d, 2); d += __shfl_xor(d, 4);
                d = (id[i] != 0xFFFFu) ? d : -INFINITY; lg[i0 + i] = d; mx = fmaxf(mx, d); } }
        mx = fmaxf(mx, __shfl_xor(mx, 8)); mx = fmaxf(mx, __shfl_xor(mx, 16)); mx = fmaxf(mx, __shfl_xor(mx, 32));
        float l = 0.f, o[8];
#pragma unroll
        for (int c = 0; c < 8; ++c) o[c] = 0.f;
#pragma unroll
        for (int i0 = 0; i0 < 32; i0 += 8) {
            u32x4 vw[8]; float p[8];
#pragma unroll
            for (int i = 0; i < 8; ++i) { const unsigned id = sl[(i0 + i) * 8 + g]; vw[i] = (u32x4){0u, 0u, 0u, 0u}; p[i] = 0.f; if (id != 0xFFFFu) { vw[i] = *(const u32x4*)(Vb + (size_t)id * 64); p[i] = __expf(lg[i0 + i] - mx); } }
#pragma unroll
            for (int i = 0; i < 8; ++i) { l += p[i];
                o[0] += p[i] * bflo(vw[i].x); o[1] += p[i] * bfhi(vw[i].x); o[2] += p[i] * bflo(vw[i].y); o[3] += p[i] * bfhi(vw[i].y);
                o[4] += p[i] * bflo(vw[i].z); o[5] += p[i] * bfhi(vw[i].z); o[6] += p[i] * bflo(vw[i].w); o[7] += p[i] * bfhi(vw[i].w); } }
        l += __shfl_xor(l, 8); l += __shfl_xor(l, 16); l += __shfl_xor(l, 32);
#pragma unroll
        for (int c = 0; c < 8; ++c) { o[c] += __shfl_xor(o[c], 8); o[c] += __shfl_xor(o[c], 16); o[c] += __shfl_xor(o[c], 32); }
        const float il = 1.0f / l;
        if (g == 0) { u32x4 w4; w4.x = pk2(o[0] * il, o[1] * il); w4.y = pk2(o[2] * il, o[3] * il); w4.z = pk2(o[4] * il, o[5] * il); w4.w = pk2(o[6] * il, o[7] * il);
            *(u32x4*)(Y + (size_t)t * 1536 + h * 64 + c8) = w4; }
        LDS_WAIT(); __builtin_amdgcn_wave_barrier();
    }
}
constexpr int RC = 64, RLD = 72, RARR = 64 * RLD * 2;
constexpr int RO_AT = 0, RO_ATT = RARR, RO_RT = 2 * RARR, RO_BT = 3 * RARR, RO_KT = 4 * RARR, RO_VT = 5 * RARR, RO_WT = 6 * RARR, RO_P1 = 7 * RARR, RO_P2 = 8 * RARR, RO_P3 = 9 * RARR, RO_P4 = 10 * RARR,
              RO_S0 = 11 * RARR, RO_F1 = 12 * RARR, RO_F2 = RO_F1 + 16384, RO_END = RO_F2 + 16384;
typedef short s16x8 __attribute__((ext_vector_type(8)));

__device__ __forceinline__ f32x4 mm16(const LAS bf16* A, const LAS bf16* B, int tr, int tc, int l15, int kg, f32x4 acc) {
#pragma unroll
    for (int ks = 0; ks < 2; ++ks) { const s16x8 a = *(const LAS s16x8*)(A + (16 * tr + l15) * RLD + 32 * ks + 8 * kg); const s16x8 b = *(const LAS s16x8*)(B + (16 * tc + l15) * RLD + 32 * ks + 8 * kg);
        acc = __builtin_amdgcn_mfma_f32_16x16x32_bf16(a, b, acc, 0, 0, 0); }
    return acc;
}
template <int MASK> __device__ __forceinline__ void st_tile(LAS bf16* Out, int tr, int tc, int l15, int kg, f32x4 acc) {
    const int col = 16 * tc + l15, row0 = 16 * tr + 4 * kg;
#pragma unroll
    for (int r = 0; r < 4; ++r) { const int row = row0 + r; bool keep = true; if (MASK == 1) keep = col < row; if (MASK == 2) keep = row < col; if (MASK == 3) keep = row <= col; if (!keep) acc[r] = 0.f; }
    u32x2 w; w.x = pk2(acc[0], acc[1]); w.y = pk2(acc[2], acc[3]);
    *(LAS u32x2*)(Out + col * RLD + row0) = w;
}
__device__ __forceinline__ void ld8(const bf16* p, float* o) { const u32x4 w = *(const u32x4*)p; o[0] = bflo(w.x); o[1] = bfhi(w.x); o[2] = bflo(w.y); o[3] = bfhi(w.y); o[4] = bflo(w.z); o[5] = bfhi(w.z); o[6] = bflo(w.w); o[7] = bfhi(w.w); }
__device__ __forceinline__ void ldf8(const float* p, float* o) { const f32x4 a = *(const f32x4*)p, b = *(const f32x4*)(p + 4); o[0] = a[0]; o[1] = a[1]; o[2] = a[2]; o[3] = a[3]; o[4] = b[0]; o[5] = b[1]; o[6] = b[2]; o[7] = b[3]; }
__device__ __forceinline__ u32x4 pk8(const float* v) { u32x4 w; w.x = pk2(v[0], v[1]); w.y = pk2(v[2], v[3]); w.z = pk2(v[4], v[5]); w.w = pk2(v[6], v[7]); return w; }

struct RwBufs { const bf16* RWP; const bf16* Eb; const bf16* Ab; const bf16* Gb; bf16* MT; bf16* Nn; bf16* S0; bf16* Y; };
__device__ __forceinline__ RwBufs rw_bufs(const Params& P) {
    RwBufs b; unsigned char* dob = (unsigned char*)P.out;
    b.RWP = (const bf16*)(P.ws + WS_RWP); b.Eb = (const bf16*)(dob + DO_E); b.Ab = (const bf16*)(dob + DO_A); b.Gb = (const bf16*)(dob + DO_G);
    b.MT = (bf16*)(dob + DO_LIN); b.Nn = (bf16*)(P.ws + WS_XB); b.S0 = (bf16*)(P.ws + WS_MEMQ); b.Y = (bf16*)(P.ws + WS_Y); return b;
}

template <bool PH3> __device__ __forceinline__ void rw_unit(const Params& P, const RwBufs& B, LAS unsigned char* lds, int h, int c) {
    const float* mu = P.in[12]; const float* k_k = P.in[18]; const float* k_a = P.in[19]; const float* r_k = P.in[20]; const float* ln_w = P.in[21]; const float* ln_b = P.in[22];
    LAS bf16* sAT = (LAS bf16*)(lds + RO_AT); LAS bf16* sATT = (LAS bf16*)(lds + RO_ATT); LAS bf16* sRT = (LAS bf16*)(lds + RO_RT); LAS bf16* sBT = (LAS bf16*)(lds + RO_BT); LAS bf16* sKT = (LAS bf16*)(lds + RO_KT);
    LAS bf16* sVT = (LAS bf16*)(lds + RO_VT); LAS bf16* sWT = (LAS bf16*)(lds + RO_WT); LAS bf16* sP1 = (LAS bf16*)(lds + RO_P1); LAS bf16* sP2 = (LAS bf16*)(lds + RO_P2); LAS bf16* sP3 = (LAS bf16*)(lds + RO_P3);
    LAS bf16* sP4 = (LAS bf16*)(lds + RO_P4); LAS bf16* sS0 = (LAS bf16*)(lds + RO_S0); LAS float* sL = (LAS float*)(lds + RO_F1); LAS float* sF2 = (LAS float*)(lds + RO_F2);
    const int tid = tid_opaque(), lane = tid & 63, wave = __builtin_amdgcn_readfirstlane(tid >> 6), l15 = lane & 15, kg = lane >> 4;
    const int t = tid >> 3, jc = (tid & 7) * 8, tg = c * RC + t, hc = h * 64 + jc;
    const size_t unit = (size_t)h * 256 + c;
    float rr[8], kk[8], vv[8], al[8], ee[8], bb[8], aa[8];
    {
        float p[8], q[8], m8[8];
        ld8(B.RWP + (size_t)tg * RW_IN + hc, p); if (tg > 0) ld8(B.RWP + (size_t)(tg - 1) * RW_IN + hc, q); else { for (int i = 0; i < 8; ++i) q[i] = 0.f; } ldf8(mu + hc, m8);
#pragma unroll
        for (int i = 0; i < 8; ++i) rr[i] = p[i] + (q[i] - p[i]) * m8[i];
        ld8(B.RWP + (size_t)tg * RW_IN + 512 + hc, p); if (tg > 0) ld8(B.RWP + (size_t)(tg - 1) * RW_IN + 512 + hc, q); ldf8(mu + 512 + hc, m8);
#pragma unroll
        for (int i = 0; i < 8; ++i) kk[i] = p[i] + (q[i] - p[i]) * m8[i];
        ld8(B.RWP + (size_t)tg * RW_IN + 1024 + hc, p); if (tg > 0) ld8(B.RWP + (size_t)(tg - 1) * RW_IN + 1024 + hc, q); ldf8(mu + 1024 + hc, m8);
#pragma unroll
        for (int i = 0; i < 8; ++i) vv[i] = p[i] + (q[i] - p[i]) * m8[i];
        ld8(B.Ab + (size_t)tg * 512 + hc, al); ld8(B.Eb + (size_t)tg * 512 + hc, ee);
        float kn[8], kkc[8], kac[8], ss = 0.f; ldf8(k_k + hc, kkc); ldf8(k_a + hc, kac);
#pragma unroll
        for (int i = 0; i < 8; ++i) { kn[i] = kk[i] * kkc[i]; ss += kn[i] * kn[i]; }
        ss += __shfl_xor(ss, 1); ss += __shfl_xor(ss, 2); ss += __shfl_xor(ss, 4);
        const float inv = 1.0f / fmaxf(sqrtf(ss), 1e-12f);
#pragma unroll
        for (int i = 0; i < 8; ++i) { kn[i] *= inv; aa[i] = -kn[i]; bb[i] = kn[i] * al[i]; kk[i] = kk[i] * (1.0f + (al[i] - 1.0f) * kac[i]); }
        *(LAS f32x4*)(sL + t * 64 + jc) = (f32x4){ee[0], ee[1], ee[2], ee[3]}; *(LAS f32x4*)(sL + t * 64 + jc + 4) = (f32x4){ee[4], ee[5], ee[6], ee[7]};
    }
    float bonus = 0.f, gg[8];
    if (PH3) { float rk8[8]; ldf8(r_k + hc, rk8);
#pragma unroll
        for (int i = 0; i < 8; ++i) bonus += rr[i] * kk[i] * rk8[i];
        bonus += __shfl_xor(bonus, 1); bonus += __shfl_xor(bonus, 2); bonus += __shfl_xor(bonus, 4);
        ld8(B.Gb + (size_t)tg * 512 + hc, gg);
        const u32x4 sw = *(const u32x4*)(B.S0 + unit * 4096 + (size_t)t * 64 + jc); *(LAS u32x4*)(sS0 + t * RLD + jc) = sw; }
    __syncthreads();
    if (wave == 0) { float run = 0.f;
#pragma unroll 8
        for (int u = 0; u < 64; ++u) { run += sL[u * 64 + lane]; sL[u * 64 + lane] = run; } }
    __syncthreads();
    {
        float Lt[8], Lp[8], Le[8];
        { const f32x4 a = *(const LAS f32x4*)(sL + t * 64 + jc), b = *(const LAS f32x4*)(sL + t * 64 + jc + 4); Lt[0] = a[0]; Lt[1] = a[1]; Lt[2] = a[2]; Lt[3] = a[3]; Lt[4] = b[0]; Lt[5] = b[1]; Lt[6] = b[2]; Lt[7] = b[3]; }
        if (t > 0) { const f32x4 a = *(const LAS f32x4*)(sL + (t - 1) * 64 + jc), b = *(const LAS f32x4*)(sL + (t - 1) * 64 + jc + 4); Lp[0] = a[0]; Lp[1] = a[1]; Lp[2] = a[2]; Lp[3] = a[3]; Lp[4] = b[0]; Lp[5] = b[1]; Lp[6] = b[2]; Lp[7] = b[3]; }
        else { for (int i = 0; i < 8; ++i) Lp[i] = 0.f; }
        { const f32x4 a = *(const LAS f32x4*)(sL + 63 * 64 + jc), b = *(const LAS f32x4*)(sL + 63 * 64 + jc + 4); Le[0] = a[0]; Le[1] = a[1]; Le[2] = a[2]; Le[3] = a[3]; Le[4] = b[0]; Le[5] = b[1]; Le[6] = b[2]; Le[7] = b[3]; }
        float at[8], rt[8], bt[8], kt[8];
#pragma unroll
        for (int i = 0; i < 8; ++i) { const float ep = __expf(Lt[i]); at[i] = aa[i] * __expf(-Lp[i]); rt[i] = rr[i] * __expf(-Lt[i]); bt[i] = bb[i] * ep; kt[i] = kk[i] * ep; }
        *(LAS u32x4*)(sAT + t * RLD + jc) = pk8(at); *(LAS u32x4*)(sBT + t * RLD + jc) = pk8(bt); *(LAS u32x4*)(sKT + t * RLD + jc) = pk8(kt);
        if (PH3) *(LAS u32x4*)(sRT + t * RLD + jc) = pk8(rt);
#pragma unroll
        for (int i = 0; i < 8; ++i) sVT[(jc + i) * RLD + t] = (bf16)f2bf(vv[i]);
        if (!PH3) {
#pragma unroll
            for (int i = 0; i < 8; ++i) sATT[(jc + i) * RLD + t] = (bf16)f2bf(at[i]);
            float bp[8], kp[8];
#pragma unroll
            for (int i = 0; i < 8; ++i) { const float ed = __expf(-(Le[i] - Lt[i])); bp[i] = bb[i] * ed; kp[i] = kk[i] * ed; }
            *(LAS f32x4*)(sF2 + t * 64 + jc) = (f32x4){bp[0], bp[1], bp[2], bp[3]}; *(LAS f32x4*)(sF2 + t * 64 + jc + 4) = (f32x4){bp[4], bp[5], bp[6], bp[7]};
            *(LAS u32x4*)(sP4 + t * RLD + jc) = pk8(kp);
        }
    }
    __syncthreads();
    const int tr = wave >> 1, tc0 = 2 * (wave & 1);
    const f32x4 z4 = {0.f, 0.f, 0.f, 0.f};
    if (!PH3) {
#pragma unroll
        for (int x = 0; x < 2; ++x) { st_tile<1>(sP1, tr, tc0 + x, l15, kg, mm16(sAT, sBT, tr, tc0 + x, l15, kg, z4)); st_tile<1>(sP2, tr, tc0 + x, l15, kg, mm16(sAT, sKT, tr, tc0 + x, l15, kg, z4)); }
        __syncthreads();
        if (wave == 0) {
#pragma unroll 1
            for (int bt = 7; bt >= 0; --bt) {
                float acc[8];
#pragma unroll
                for (int k2 = 0; k2 < 8; ++k2) acc[k2] = sF2[(8 * bt + k2) * 64 + lane];
#pragma unroll 1
                for (int u8 = bt + 1; u8 < 8; ++u8) { float w8[8];
#pragma unroll
                    for (int x = 0; x < 8; ++x) w8[x] = sF2[(8 * u8 + x) * 64 + lane];
#pragma unroll
                    for (int k2 = 0; k2 < 8; ++k2) { const u32x4 aw = *(const LAS u32x4*)(sP1 + (8 * bt + k2) * RLD + 8 * u8);
                        acc[k2] += bflo(aw.x) * w8[0] + bfhi(aw.x) * w8[1] + bflo(aw.y) * w8[2] + bfhi(aw.y) * w8[3] + bflo(aw.z) * w8[4] + bfhi(aw.z) * w8[5] + bflo(aw.w) * w8[6] + bfhi(aw.w) * w8[7]; } }
#pragma unroll
                for (int k2 = 7; k2 >= 0; --k2) { const u32x4 aw = *(const LAS u32x4*)(sP1 + (8 * bt + k2) * RLD + 8 * bt); const float a8[8] = {bflo(aw.x), bfhi(aw.x), bflo(aw.y), bfhi(aw.y), bflo(aw.z), bfhi(aw.z), bflo(aw.w), bfhi(aw.w)};
#pragma unroll
                    for (int x = k2 + 1; x < 8; ++x) acc[k2] += a8[x] * acc[x]; }
#pragma unroll
                for (int k2 = 0; k2 < 8; ++k2) sF2[(8 * bt + k2) * 64 + lane] = acc[k2];
                *(LAS u32x4*)(sWT + lane * RLD + 8 * bt) = pk8(acc);
            }
        }
        __syncthreads();
#pragma unroll
        for (int x = 0; x < 2; ++x) { const int tc = tc0 + x;
            f32x4 zi; { const int col = 16 * tc + l15;
#pragma unroll
                for (int r = 0; r < 4; ++r) zi[r] = bf2f(sP4[(16 * tr + 4 * kg + r) * RLD + col]); }
            st_tile<0>(sP3, tr, tc, l15, kg, mm16(sP2, sWT, tr, tc, l15, kg, zi));
            f32x4 m = mm16(sATT, sWT, tr, tc, l15, kg, z4);
            { const int col = 16 * tc + l15, row0 = 16 * tr + 4 * kg; const float pc = __expf(-sL[63 * 64 + col]);
#pragma unroll
                for (int r = 0; r < 4; ++r) if (row0 + r == col) m[r] += pc;
                u32x2 w; w.x = pk2(m[0], m[1]); w.y = pk2(m[2], m[3]); *(u32x2*)(B.MT + unit * 4096 + (size_t)col * 64 + row0) = w; } }
        __syncthreads();
#pragma unroll
        for (int x = 0; x < 2; ++x) { const int tc = tc0 + x; const f32x4 nacc = mm16(sP3, sVT, tr, tc, l15, kg, z4);
            u32x2 w; w.x = pk2(nacc[0], nacc[1]); w.y = pk2(nacc[2], nacc[3]); *(u32x2*)(B.Nn + unit * 4096 + (size_t)(16 * tc + l15) * 64 + 16 * tr + 4 * kg) = w; }
        __syncthreads();
    } else {
#pragma unroll
        for (int x = 0; x < 2; ++x) { const int tc = tc0 + x;
            st_tile<2>(sP1, tr, tc, l15, kg, mm16(sBT, sAT, tr, tc, l15, kg, z4)); st_tile<2>(sP2, tr, tc, l15, kg, mm16(sKT, sAT, tr, tc, l15, kg, z4));
            st_tile<3>(sP3, tr, tc, l15, kg, mm16(sBT, sRT, tr, tc, l15, kg, z4)); st_tile<3>(sP4, tr, tc, l15, kg, mm16(sKT, sRT, tr, tc, l15, kg, z4)); }
        __syncthreads();
#pragma unroll
        for (int x = 0; x < 2; ++x) { const int tc = tc0 + x; f32x4 xa = mm16(sAT, sS0, tr, tc, l15, kg, z4); xa = mm16(sP2, sVT, tr, tc, l15, kg, xa);
#pragma unroll
            for (int r = 0; r < 4; ++r) sF2[(16 * tr + 4 * kg + r) * 64 + 16 * tc + l15] = xa[r]; }
        __syncthreads();
        if (wave == 0) {
#pragma unroll 1
            for (int bt = 0; bt < 8; ++bt) {
                float acc[8];
#pragma unroll
                for (int k2 = 0; k2 < 8; ++k2) acc[k2] = sF2[(8 * bt + k2) * 64 + lane];
#pragma unroll 1
                for (int u8 = 0; u8 < bt; ++u8) { float w8[8];
#pragma unroll
                    for (int x = 0; x < 8; ++x) w8[x] = sF2[(8 * u8 + x) * 64 + lane];
#pragma unroll
                    for (int k2 = 0; k2 < 8; ++k2) { const u32x4 aw = *(const LAS u32x4*)(sP1 + (8 * bt + k2) * RLD + 8 * u8);
                        acc[k2] += bflo(aw.x) * w8[0] + bfhi(aw.x) * w8[1] + bflo(aw.y) * w8[2] + bfhi(aw.y) * w8[3] + bflo(aw.z) * w8[4] + bfhi(aw.z) * w8[5] + bflo(aw.w) * w8[6] + bfhi(aw.w) * w8[7]; } }
#pragma unroll
                for (int k2 = 0; k2 < 8; ++k2) { const u32x4 aw = *(const LAS u32x4*)(sP1 + (8 * bt + k2) * RLD + 8 * bt); const float a8[8] = {bflo(aw.x), bfhi(aw.x), bflo(aw.y), bfhi(aw.y), bflo(aw.z), bfhi(aw.z), bflo(aw.w), bfhi(aw.w)};
#pragma unroll
                    for (int x = 0; x < k2; ++x) acc[k2] += a8[x] * acc[x]; }
#pragma unroll
                for (int k2 = 0; k2 < 8; ++k2) sF2[(8 * bt + k2) * 64 + lane] = acc[k2];
                *(LAS u32x4*)(sWT + lane * RLD + 8 * bt) = pk8(acc);
            }
        }
        __syncthreads();
#pragma unroll
        for (int x = 0; x < 2; ++x) { const int tc = tc0 + x; f32x4 ya = mm16(sRT, sS0, tr, tc, l15, kg, z4); ya = mm16(sP3, sWT, tr, tc, l15, kg, ya); ya = mm16(sP4, sVT, tr, tc, l15, kg, ya);
#pragma unroll
            for (int r = 0; r < 4; ++r) sF2[(16 * tr + 4 * kg + r) * 64 + 16 * tc + l15] = ya[r]; }
        __syncthreads();
        {
            float y8[8], s1 = 0.f;
            { const f32x4 a = *(const LAS f32x4*)(sF2 + t * 64 + jc), b = *(const LAS f32x4*)(sF2 + t * 64 + jc + 4); y8[0] = a[0]; y8[1] = a[1]; y8[2] = a[2]; y8[3] = a[3]; y8[4] = b[0]; y8[5] = b[1]; y8[6] = b[2]; y8[7] = b[3]; }
#pragma unroll
            for (int i = 0; i < 8; ++i) s1 += y8[i];
            s1 += __shfl_xor(s1, 1); s1 += __shfl_xor(s1, 2); s1 += __shfl_xor(s1, 4);
            const float mean = s1 * (1.0f / 64.0f); float s2 = 0.f;
#pragma unroll
            for (int i = 0; i < 8; ++i) { const float d = y8[i] - mean; s2 += d * d; }
            s2 += __shfl_xor(s2, 1); s2 += __shfl_xor(s2, 2); s2 += __shfl_xor(s2, 4);
            const float rstd = 1.0f / sqrtf(s2 * (1.0f / 64.0f) + GN_EPS);
            float lw[8], lb[8], o8[8]; ldf8(ln_w + hc, lw); ldf8(ln_b + hc, lb);
#pragma unroll
            for (int i = 0; i < 8; ++i) o8[i] = ((y8[i] - mean) * rstd * lw[i] + lb[i] + bonus * vv[i]) * gg[i];
            *(u32x4*)(B.Y + (size_t)tg * 1536 + 512 + hc) = pk8(o8);
        }
        __syncthreads();
    }
}

__device__ __forceinline__ void rw_scan_phase(const Params& P, LAS unsigned char* lds, int h) {
    const RwBufs B = rw_bufs(P);
    const int tid = tid_opaque(), lane = tid & 63, wave = __builtin_amdgcn_readfirstlane(tid >> 6), l15 = lane & 15, kg = lane >> 4;
    const int tr = wave >> 1, tc0 = 2 * (wave & 1);
    LAS bf16* sS[2] = {(LAS bf16*)lds, (LAS bf16*)(lds + RARR)};
    for (int i = tid; i < 2 * RARR / 4; i += NT) ((LAS unsigned*)lds)[i] = 0u;
    __syncthreads();
    const int trow = tid >> 3, tcol = (tid & 7) * 8;
    s16x8 ma[2]; u32x2 nw[2];
    { const bf16* mt = B.MT + ((size_t)h * 256) * 4096; const bf16* nn = B.Nn + ((size_t)h * 256) * 4096;
#pragma unroll
        for (int ks = 0; ks < 2; ++ks) ma[ks] = *(const s16x8*)(mt + (size_t)(16 * tr + l15) * 64 + 32 * ks + 8 * kg);
#pragma unroll
        for (int x = 0; x < 2; ++x) nw[x] = *(const u32x2*)(nn + (size_t)(16 * (tc0 + x) + l15) * 64 + 16 * tr + 4 * kg); }
    for (int c = 0; c < 256; ++c) {
        const LAS bf16* cur = sS[c & 1]; LAS bf16* nxt = sS[(c + 1) & 1];
        const size_t unit = (size_t)h * 256 + c;
        *(u32x4*)(B.S0 + unit * 4096 + (size_t)trow * 64 + tcol) = *(const LAS u32x4*)(cur + trow * RLD + tcol);
        s16x8 ma_n[2]; u32x2 nw_n[2];
        if (c + 1 < 256) { const bf16* mt = B.MT + (unit + 1) * 4096; const bf16* nn = B.Nn + (unit + 1) * 4096;
#pragma unroll
            for (int ks = 0; ks < 2; ++ks) ma_n[ks] = *(const s16x8*)(mt + (size_t)(16 * tr + l15) * 64 + 32 * ks + 8 * kg);
#pragma unroll
            for (int x = 0; x < 2; ++x) nw_n[x] = *(const u32x2*)(nn + (size_t)(16 * (tc0 + x) + l15) * 64 + 16 * tr + 4 * kg); }
        else { ma_n[0] = ma[0]; ma_n[1] = ma[1]; nw_n[0] = nw[0]; nw_n[1] = nw[1]; }
#pragma unroll
        for (int x = 0; x < 2; ++x) { const int tc = tc0 + x;
            f32x4 acc = {bflo(nw[x].x), bfhi(nw[x].x), bflo(nw[x].y), bfhi(nw[x].y)};
#pragma unroll
            for (int ks = 0; ks < 2; ++ks) { const s16x8 b = *(const LAS s16x8*)(cur + (16 * tc + l15) * RLD + 32 * ks + 8 * kg); acc = __builtin_amdgcn_mfma_f32_16x16x32_bf16(ma[ks], b, acc, 0, 0, 0); }
            u32x2 w; w.x = pk2(acc[0], acc[1]); w.y = pk2(acc[2], acc[3]); *(LAS u32x2*)(nxt + (16 * tc + l15) * RLD + 16 * tr + 4 * kg) = w; }
        ma[0] = ma_n[0]; ma[1] = ma_n[1]; nw[0] = nw_n[0]; nw[1] = nw_n[1];
        __syncthreads();
    }
}
template <bool PH3> __device__ __forceinline__ void rw_units_phase(const Params& P, LAS unsigned char* lds, int bid, int nblk) {
    const RwBufs B = rw_bufs(P);
    for (int u = bid; u < 8 * 256; u += nblk) rw_unit<PH3>(P, B, lds, u >> 8, u & 255);
}

__device__ __forceinline__ void xb_phase(const Params& P, int bid, int nblk) {
    const int tid = tid_opaque(), lane = tid & 63, wave = tid >> 6;
    for (int r = bid * NW + wave; r < S_; r += nblk * NW) {
        const f32x4* xr = (const f32x4*)(P.in[0] + (size_t)r * D_) + lane; unsigned long long* o8 = (unsigned long long*)((bf16*)(P.ws + WS_XB) + (size_t)r * D_) + lane;
#pragma unroll
        for (int j = 0; j < 4; ++j) { const f32x4 v = xr[64 * j]; o8[64 * j] = (unsigned long long)pk2(v.x, v.y) | ((unsigned long long)pk2(v.z, v.w) << 32); }
    }
}
constexpr size_t WS_UBS = 192 * MiB, WS_VBS = 224 * MiB, WS_PART = 64 * MiB, WS_EW = 48 * MiB;
__device__ __forceinline__ void peer_conv_phase(const Params& P, int bid, int nblk) {
    const int gt = bid * NT + tid_opaque(), NGT = nblk * NT;
    for (int i = gt; i < 2 * NEXP * 128; i += NGT) { const int tab = i / (NEXP * 128), r = i % (NEXP * 128), e = r >> 7, l = r & 127;
        const float* src = (tab ? P.in[30] : P.in[29]) + (size_t)e * 1024 + 8 * l; const f32x4 a = *(const f32x4*)src, b = *(const f32x4*)(src + 4);
        u32x4 w; w.x = pk2(a[0], a[1]); w.y = pk2(a[2], a[3]); w.z = pk2(b[0], b[1]); w.w = pk2(b[2], b[3]);
        *(u32x4*)((bf16*)(P.ws + (tab ? WS_VBS : WS_UBS)) + ((size_t)(l >> 3) * NEXP + e) * 64 + (l & 7) * 8) = w; }
}
__device__ __forceinline__ void peer_e1_phase(const Params& P, LAS unsigned char* lds, int bid, int nblk) {
    const int* EIDX = (const int*)(P.ws + WS_EIDX); const float* HSQ = (const float*)(P.ws + WS_HSQ); const float* gain = P.in[25]; float* PART = (float*)(P.ws + WS_PART);
    const int tid = tid_opaque(), lane = tid & 63, wave = __builtin_amdgcn_readfirstlane(tid >> 6), g = lane >> 3, c8 = (lane & 7) * 8;
    const int x = bid & 7, rank = bid >> 3, nr = nblk >> 3;
    LAS float* pb = (LAS float*)lds + wave * 128;
#pragma unroll 1
    for (int pass = 0; pass < 2; ++pass) { const int s = x + 8 * pass; const bf16* tab = (const bf16*)(P.ws + WS_UBS) + (size_t)s * NEXP * 64 + c8;
        float gn[8]; ldf8(gain + 64 * s + c8, gn);
        for (int t = rank * 8 + wave; t < S_; t += nr * 8) {
            const float rs = rstd_h_row(HSQ, t); float xn[8]; ldf8(P.out + (size_t)t * 1024 + 64 * s + c8, xn);
#pragma unroll
            for (int i = 0; i < 8; ++i) xn[i] *= rs * gn[i];
            const int e_lo = EIDX[(size_t)t * 128 + lane], e_hi = EIDX[(size_t)t * 128 + 64 + lane];
            u32x4 uw[16];
#pragma unroll
            for (int i = 0; i < 16; ++i) { const int e = __shfl((i < 8) ? e_lo : e_hi, (8 * i + g) & 63); uw[i] = *(const u32x4*)(tab + (size_t)e * 64); }
#pragma unroll
            for (int i = 0; i < 16; ++i) { float d = xn[0] * bflo(uw[i].x) + xn[1] * bfhi(uw[i].x) + xn[2] * bflo(uw[i].y) + xn[3] * bfhi(uw[i].y) + xn[4] * bflo(uw[i].z) + xn[5] * bfhi(uw[i].z) + xn[6] * bflo(uw[i].w) + xn[7] * bfhi(uw[i].w);
                d += __shfl_xor(d, 1); d += __shfl_xor(d, 2); d += __shfl_xor(d, 4);
                if ((lane & 7) == 0) pb[8 * i + g] = d; }
            LDS_WAIT(); __builtin_amdgcn_wave_barrier();
            float p_lo = pb[lane], p_hi = pb[64 + lane];
            float* dst = PART + ((size_t)t * 8 + x) * 128;
            if (pass) { p_lo += dst[lane]; p_hi += dst[64 + lane]; }
            dst[lane] = p_lo; dst[64 + lane] = p_hi;
            LDS_WAIT(); __builtin_amdgcn_wave_barrier();
        }
    }
}
__device__ __forceinline__ void peer_w_phase(const Params& P, int bid, int nblk) {
    const float* PART = (const float*)(P.ws + WS_PART); const float* EG = (const float*)(P.ws + WS_EGATE); float* EW = (float*)(P.ws + WS_EW);
    const int gt = bid * NT + tid_opaque(), NGT = nblk * NT;
    for (int i = gt; i < S_ * 128; i += NGT) { const int t = i >> 7, k = i & 127; float d = 0.f;
#pragma unroll
        for (int x = 0; x < 8; ++x) d += PART[((size_t)t * 8 + x) * 128 + k];
        EW[i] = EG[i] * 0.5f * d * (1.0f + erff(d * 0.70710678118654752f)); }
}
__device__ __forceinline__ void peer_e2_phase(const Params& P, int bid, int nblk) {
    const int* EIDX = (const int*)(P.ws + WS_EIDX); const float* EW = (const float*)(P.ws + WS_EW);
    const int tid = tid_opaque(), lane = tid & 63, wave = __builtin_amdgcn_readfirstlane(tid >> 6), g = lane >> 3, c8 = (lane & 7) * 8;
    const int x = bid & 7, rank = bid >> 3, nr = nblk >> 3;
#pragma unroll 1
    for (int pass = 0; pass < 2; ++pass) { const int s = x + 8 * pass; const bf16* tab = (const bf16*)(P.ws + WS_VBS) + (size_t)s * NEXP * 64 + c8;
        for (int t = rank * 8 + wave; t < S_; t += nr * 8) {
            const int e_lo = EIDX[(size_t)t * 128 + lane], e_hi = EIDX[(size_t)t * 128 + 64 + lane];
            const float w_lo = EW[(size_t)t * 128 + lane], w_hi = EW[(size_t)t * 128 + 64 + lane];
            u32x4 vw[16]; float wk[16];
#pragma unroll
            for (int i = 0; i < 16; ++i) { const int e = __shfl((i < 8) ? e_lo : e_hi, (8 * i + g) & 63); wk[i] = __shfl((i < 8) ? w_lo : w_hi, (8 * i + g) & 63); vw[i] = *(const u32x4*)(tab + (size_t)e * 64); }
            float o[8];
#pragma unroll
            for (int c = 0; c < 8; ++c) o[c] = 0.f;
#pragma unroll
            for (int i = 0; i < 16; ++i) { o[0] += wk[i] * bflo(vw[i].x); o[1] += wk[i] * bfhi(vw[i].x); o[2] += wk[i] * bflo(vw[i].y); o[3] += wk[i] * bfhi(vw[i].y);
                o[4] += wk[i] * bflo(vw[i].z); o[5] += wk[i] * bfhi(vw[i].z); o[6] += wk[i] * bflo(vw[i].w); o[7] += wk[i] * bfhi(vw[i].w); }
#pragma unroll
            for (int c = 0; c < 8; ++c) { o[c] += __shfl_xor(o[c], 8); o[c] += __shfl_xor(o[c], 16); o[c] += __shfl_xor(o[c], 32); }
            if (g == 0) { float* hp = P.out + (size_t)t * 1024 + 64 * s + c8; const f32x4 a = *(const f32x4*)hp, b = *(const f32x4*)(hp + 4);
                *(f32x4*)hp = (f32x4){a[0] + o[0], a[1] + o[1], a[2] + o[2], a[3] + o[3]}; *(f32x4*)(hp + 4) = (f32x4){b[0] + o[4], b[1] + o[5], b[2] + o[6], b[3] + o[7]}; }
        }
    }
}
#include <hip/hip_cooperative_groups.h>
namespace cg = cooperative_groups;
extern __shared__ __attribute__((aligned(16))) unsigned char dyn_lds[];
#define LDSP ((LAS unsigned char*)dyn_lds)
constexpr int LDS_BYTES = 150 * 1024;
static_assert(MA_LDS_END <= LDS_BYTES && DA_END <= LDS_BYTES && RO_END <= LDS_BYTES && 131072 <= LDS_BYTES, "LDS budget");

typedef const __attribute__((address_space(4))) Params* KargPtr;
__device__ __forceinline__ Params load_params() {
    Params r;
#if defined(__HIP_DEVICE_COMPILE__)
    KargPtr kp = (KargPtr)__builtin_amdgcn_kernarg_segment_ptr(); asm volatile("" : "+s"(kp));
#pragma unroll
    for (int i = 0; i < 31; ++i) r.in[i] = kp->in[i];
    r.out = kp->out; r.ws = kp->ws;
#endif
    return r;
}
__global__ void __launch_bounds__(NT, 2) mega(Params P_unused) {
    cg::grid_group grid = cg::this_grid();
    const int bid = blockIdx.x, nb = gridDim.x;
#define PH_BEGIN const Params P = load_params(); unsigned char* ws = P.ws; unsigned char* dob = (unsigned char*)P.out; (void)ws; (void)dob;
    { PH_BEGIN prologue_phase(P, LDSP, bid, nb); }
    grid.sync();
    { PH_BEGIN
        pg8::Gemm g{(const bf16*)(ws + WS_MB), (const bf16*)(ws + WS_WMEM), 256, 1024, 1024, 1024, 1024, 0, 256 * 1024};
        pg8::StaticOrder S; S.init(g.M, g.N, nb, bid);
        EpiF32 E{(float*)(ws + WS_KMVM), 1024, (const float*)(ws + WS_RSTDM)};
        pg8::gemm_phase<false>(LDSP, g, S, E);
    }
    { PH_BEGIN
        pg8::Gemm g{(const bf16*)(ws + WS_XB), (const bf16*)(ws + WS_WIN), S_, P1_N, 1024, 1024, 1024, 0, 256 * 1024};
        pg8::StaticOrder S; S.init(g.M, g.N, nb, bid);
        EpiP1 E{(const float*)(ws + WS_RSTDX), (const float*)(ws + WS_COS), (const float*)(ws + WS_SIN), P.in[6], P.in[7],
                (bf16*)(ws + WS_Q), (bf16*)(ws + WS_K), (bf16*)(ws + WS_V), (bf16*)(ws + WS_RWP), (bf16*)(ws + WS_MEMQ), (half_t*)(ws + WS_IQ), (half_t*)(ws + WS_IK), (float*)(ws + WS_IW)};
        pg8::gemm_phase<false>(LDSP, g, S, E);
    }
    grid.sync();
    { PH_BEGIN lora_in_phase(P, bid, nb); }
    grid.sync();
    { PH_BEGIN
        pg8::Gemm g{(const bf16*)(dob + DO_LIN), (const bf16*)(ws + WS_WLORA), S_, 1536, 256, 256, 256, 0, 256 * 256};
        pg8::StaticOrder S; S.init(g.M, g.N, nb, bid);
        EpiLora E{(bf16*)(dob + DO_E), (bf16*)(dob + DO_A), (bf16*)(dob + DO_G), P.in[13], P.in[15]};
        pg8::gemm_phase<false>(LDSP, g, S, E);
    }
    grid.sync();
    { PH_BEGIN dsa_index_phase(P, LDSP, bid, nb); }
    { PH_BEGIN mem_attn_phase(P, LDSP, bid, nb); }
    __syncthreads();
    { PH_BEGIN rw_units_phase<false>(P, LDSP, bid, nb); }
    grid.sync();
    if (bid >= nb - 8) { PH_BEGIN rw_scan_phase(P, LDSP, bid - (nb - 8)); }
    __syncthreads();
    { PH_BEGIN dsa_attn_phase(P, LDSP, bid, nb); }
    grid.sync();
    { PH_BEGIN rw_units_phase<true>(P, LDSP, bid, nb); }
    { PH_BEGIN xb_phase(P, bid, nb); }
    grid.sync();
    { PH_BEGIN
        pg8::Gemm g{(const bf16*)(ws + WS_XB), (const bf16*)(ws + WS_WG), S_, 3072, 1024, 1024, 1024, 0, 256 * 1024};
        pg8::PanelOrder S; S.init(S_, nb, bid, 3);
        EpiGate E{(bf16*)(ws + WS_GATES), (const float*)(ws + WS_RSTDX), P.in[5]};
        pg8::gemm_phase<false>(LDSP, g, S, E);
    }
    for (int c = 0; c < 3; ++c) { PH_BEGIN
        pg8::Gemm g{(const bf16*)(ws + WS_Y) + c * 512, (const bf16*)(ws + WS_WUP) + (size_t)c * 1024 * 512, S_, 1024, 512, 1536, 512, 0, 256 * 512};
        pg8::StaticOrder S; S.init(g.M, g.N, nb, bid);
        EpiMerge E{(const bf16*)(ws + WS_GATES), P.out, (bf16*)(ws + WS_MERGED), c};
        pg8::gemm_phase<false>(LDSP, g, S, E);
    }
    grid.sync();
    { PH_BEGIN peer_conv_phase(P, bid, nb); }
    { PH_BEGIN
        pg8::Gemm g{(const bf16*)(ws + WS_MERGED), (const bf16*)(ws + WS_WOUT), S_, 1024, 1024, 1024, 1024, 0, 256 * 1024};
        pg8::StaticOrder S; S.init(g.M, g.N, nb, bid);
        EpiOut E{P.in[0], P.out, (bf16*)(ws + WS_XB), (float*)(ws + WS_HSQ)};
        pg8::gemm_phase<false>(LDSP, g, S, E);
    }
    grid.sync();
    { PH_BEGIN
        pg8::Gemm g{(const bf16*)(ws + WS_XB), (const bf16*)(ws + WS_WQ), S_, 2048, 1024, 1024, 1024, 0, 256 * 1024};
        pg8::StaticOrder S; S.init(g.M, g.N, nb, bid);
        EpiPQ E{(half_t*)(ws + WS_PQ), (const float*)(ws + WS_HSQ)};
        pg8::gemm_phase<true>(LDSP, g, S, E);
    }
    grid.sync();
    { PH_BEGIN
        pg8::Gemm g{(const bf16*)(ws + WS_PQ), (const bf16*)(ws + WS_KEYBD), S_, 2048, 256, 2048, 256, 256, 0};
        pg8::StaticOrder S; S.init(g.M, g.N, nb, bid);
        float* scr = (float*)(ws + WS_SC) + (size_t)bid * 65536;
        pg8::Unit u;
        for (int i = 0; S.next(i, u); ++i) {
            pg8::OneUnit O{u}; EpiTile E{scr};
            pg8::gemm_phase<true>(LDSP, g, O, E);
            __syncthreads();
            peer_topk_tile(scr, u.pm, u.pn, (int*)(ws + WS_EIDX), (float*)(ws + WS_EGATE));
            __syncthreads();
        }
    }
    grid.sync();
    { PH_BEGIN peer_e1_phase(P, LDSP, bid, nb); }
    grid.sync();
    { PH_BEGIN peer_w_phase(P, bid, nb); }
    grid.sync();
    { PH_BEGIN peer_e2_phase(P, bid, nb); }
#undef PH_BEGIN
}

extern "C" void kernel_launch(void* const* d_in, const int* in_sizes, int n_in, void* d_out, int out_size, void* d_ws, size_t ws_size, hipStream_t stream) {
    static int grid = 0;
    if (grid == 0) {
        if (n_in != 31 || out_size != S_ * D_ || ws_size < WS_END) { fprintf(stderr, "kernel_launch: unexpected problem (n_in %d out %d ws %zu)\n", n_in, out_size, ws_size); grid = -1; return; }
        int dev = 0, cus = 0, per_cu = 0;
        if (hipGetDevice(&dev) != hipSuccess || hipDeviceGetAttribute(&cus, hipDeviceAttributeMultiprocessorCount, dev) != hipSuccess) { grid = -1; return; }
        if (hipFuncSetAttribute((const void*)mega, hipFuncAttributeMaxDynamicSharedMemorySize, LDS_BYTES) != hipSuccess) { fprintf(stderr, "kernel_launch: hipFuncSetAttribute failed\n"); grid = -1; return; }
        if (hipOccupancyMaxActiveBlocksPerMultiprocessor(&per_cu, (const void*)mega, NT, LDS_BYTES) != hipSuccess || per_cu < 1) { fprintf(stderr, "kernel_launch: occupancy query failed (%d)\n", per_cu); grid = -1; return; }
        grid = cus;
        if (grid != 256) { fprintf(stderr, "kernel_launch: built for 256 CUs, device has %d\n", cus); grid = -1; return; }
    }
    if (grid < 0) return;
    Params P{};
    for (int i = 0; i < 31; ++i) P.in[i] = (const float*)d_in[i];
    P.out = (float*)d_out; P.ws = (unsigned char*)d_ws;
    void* args[] = {&P};
    hipError_t e = hipLaunchCooperativeKernel((const void*)mega, dim3(grid), dim3(NT), args, LDS_BYTES, stream);
    if (e != hipSuccess) fprintf(stderr, "kernel_launch: cooperative launch failed: %s\n", hipGetErrorString(e));
}
```

```cpp
#include <hip/hip_runtime.h>
#include <cstdio>
#include <cstdint>

typedef unsigned short bf16;
typedef unsigned short u16;
typedef float f32x4 __attribute__((ext_vector_type(4)));
typedef float f32x2 __attribute__((ext_vector_type(2)));
typedef unsigned u32x4 __attribute__((ext_vector_type(4)));
typedef unsigned u32x2 __attribute__((ext_vector_type(2)));
typedef _Float16 half_t;
typedef _Float16 half4 __attribute__((ext_vector_type(4)));
typedef _Float16 half8 __attribute__((ext_vector_type(8)));

constexpr int S_ = 16384, D_ = 1024;
constexpr int NMEM = 256;
constexpr int ATT_W = 512, RW_W = 512, MEM_W = 512;
constexpr int RW_IN = 1792;
constexpr int WIN_COLS = 7236;
constexpr int COL_Q = 0, COL_K = 512, COL_V = 1024, COL_IQ = 1536, COL_IK = 1792, COL_IW = 1856, COL_RW = 1860, COL_MEMQ = 3652, COL_GATE = 4164;
constexpr int P1_TILES = 17, P1_N = P1_TILES * 256;
constexpr float NORM_EPS = 1e-6f, GN_EPS = 64e-5f;
constexpr int NEXP = 16384;

constexpr size_t MiB = 1u << 20;
constexpr size_t WS_CTL = 0;
constexpr size_t WS_RSTDX = 1 * MiB;
constexpr size_t WS_COS = WS_RSTDX + 64 * 1024;
constexpr size_t WS_SIN = WS_COS + 512 * 1024;
constexpr size_t WS_IW = WS_SIN + 512 * 1024;
constexpr size_t WS_RSTDM = WS_IW + 256 * 1024;
constexpr size_t WS_RSTDH = WS_RSTDM + 4096;
constexpr size_t WS_HSQ = 3 * MiB;
constexpr size_t WS_WIN = 4 * MiB;
constexpr size_t WS_WG = WS_WIN + (size_t)P1_N * 1024 * 2;
constexpr size_t WS_WUP = WS_WG + 6 * MiB;
constexpr size_t WS_WOUT = WS_WUP + 3 * MiB;
constexpr size_t WS_WQ = WS_WOUT + 2 * MiB;
constexpr size_t WS_WMEM = WS_WQ + 4 * MiB;
constexpr size_t WS_KEYBD = WS_WMEM + 2 * MiB;
constexpr size_t WS_WLORA = WS_KEYBD + 128 * 1024;
static_assert(WS_WLORA + 768 * 1024 <= 30 * MiB + 512 * 1024, "weights region");
constexpr size_t WS_KMVM = 30 * MiB + 512 * 1024;
constexpr size_t WS_MB = 31 * MiB + 512 * 1024;
constexpr size_t WS_XB = 32 * MiB;
constexpr size_t WS_Q = 64 * MiB, WS_K = 80 * MiB, WS_V = 96 * MiB;
constexpr size_t WS_IQ = 112 * MiB;
constexpr size_t WS_IK = 120 * MiB;
constexpr size_t WS_MEMQ = 122 * MiB;
constexpr size_t WS_RWP = 138 * MiB;
constexpr size_t WS_Y = 194 * MiB;
constexpr size_t WS_SEL = 242 * MiB;
constexpr size_t DO_E = 0, DO_A = 16 * MiB, DO_G = 32 * MiB, DO_LIN = 48 * MiB;
constexpr size_t WS_GATES = 64 * MiB;
constexpr size_t WS_MERGED = 160 * MiB;
constexpr size_t WS_PQ = 64 * MiB;
constexpr size_t WS_SC = 128 * MiB;
constexpr size_t WS_EIDX = 32 * MiB;
constexpr size_t WS_EGATE = 40 * MiB;
constexpr size_t WS_END = 256 * MiB;

__device__ __forceinline__ unsigned f2bf(float f) { unsigned u = __builtin_bit_cast(unsigned, f); return (u + 0x7fffu + ((u >> 16) & 1u)) >> 16; }
__device__ __forceinline__ unsigned pk2(float lo, float hi) { return f2bf(lo) | (f2bf(hi) << 16); }
__device__ __forceinline__ unsigned pk2h(float lo, float hi) { typedef _Float16 h2 __attribute__((ext_vector_type(2))); h2 v; v[0] = (_Float16)lo; v[1] = (_Float16)hi; return __builtin_bit_cast(unsigned, v); }
__device__ __forceinline__ float bf2f(unsigned short b) { return __builtin_bit_cast(float, ((unsigned)b) << 16); }
__device__ __forceinline__ float bflo(unsigned w) { return __builtin_bit_cast(float, w << 16); }
__device__ __forceinline__ float bfhi(unsigned w) { return __builtin_bit_cast(float, w & 0xffff0000u); }
#ifndef XL_FALLBACK
#define XL_FALLBACK 0
#endif
template <int CTRL> __device__ __forceinline__ float dppf(float x) { return __builtin_bit_cast(float, __builtin_amdgcn_update_dpp(0, __builtin_bit_cast(int, x), CTRL, 0xf, 0xf, true)); }
template <int CTRL> __device__ __forceinline__ unsigned dppu(unsigned x) { return (unsigned)__builtin_amdgcn_update_dpp(0, (int)x, CTRL, 0xf, 0xf, true); }
typedef unsigned u32x2_ __attribute__((ext_vector_type(2)));
__device__ __forceinline__ void pl16(unsigned x, unsigned& a, unsigned& b) { a = x; b = x; asm volatile("s_nop 1\n\tv_permlane16_swap_b32 %0, %1" : "+v"(a), "+v"(b)); }
__device__ __forceinline__ void pl32(unsigned x, unsigned& a, unsigned& b) { a = x; b = x; asm volatile("s_nop 1\n\tv_permlane32_swap_b32 %0, %1" : "+v"(a), "+v"(b)); }
#define PLF(fn, x, fa, fb) unsigned _a, _b; fn(__builtin_bit_cast(unsigned, x), _a, _b); const float fa = __builtin_bit_cast(float, _a), fb = __builtin_bit_cast(float, _b)
__device__ __forceinline__ float xor16f(float x) { PLF(pl16, x, a, b); return ((threadIdx.x & 16) ? a : b); }
__device__ __forceinline__ float xor32f(float x) { PLF(pl32, x, a, b); return ((threadIdx.x & 32) ? a : b); }
#if XL_FALLBACK
__device__ __forceinline__ float sum_x16(float x) { return x + __shfl_xor(x, 16); }
__device__ __forceinline__ float sum_x32(float x) { return x + __shfl_xor(x, 32); }
__device__ __forceinline__ float max_x16(float x) { return fmaxf(x, __shfl_xor(x, 16)); }
__device__ __forceinline__ float max_x32(float x) { return fmaxf(x, __shfl_xor(x, 32)); }
__device__ __forceinline__ float sum8(float x) { x += __shfl_xor(x, 1); x += __shfl_xor(x, 2); x += __shfl_xor(x, 4); return x; }
__device__ __forceinline__ float sum16(float x) { x = sum8(x); x += __shfl_xor(x, 8); return x; }
__device__ __forceinline__ float max16(float x) { x = fmaxf(x, __shfl_xor(x, 1)); x = fmaxf(x, __shfl_xor(x, 2)); x = fmaxf(x, __shfl_xor(x, 4)); x = fmaxf(x, __shfl_xor(x, 8)); return x; }
#else
__device__ __forceinline__ float sum_x16(float x) { PLF(pl16, x, a, b); return a + b; }
__device__ __forceinline__ float sum_x32(float x) { PLF(pl32, x, a, b); return a + b; }
__device__ __forceinline__ float max_x16(float x) { PLF(pl16, x, a, b); return fmaxf(a, b); }
__device__ __forceinline__ float max_x32(float x) { PLF(pl32, x, a, b); return fmaxf(a, b); }
__device__ __forceinline__ float sum8(float x) { x += dppf<0xB1>(x); x += dppf<0x4E>(x); x += dppf<0x141>(x); return x; }
__device__ __forceinline__ float sum16(float x) { x = sum8(x); x += dppf<0x140>(x); return x; }
__device__ __forceinline__ float max16(float x) { x = fmaxf(x, dppf<0xB1>(x)); x = fmaxf(x, dppf<0x4E>(x)); x = fmaxf(x, dppf<0x141>(x)); x = fmaxf(x, dppf<0x140>(x)); return x; }
#endif
__device__ __forceinline__ float wave_sum(float v) { v = sum16(v); v = sum_x16(v); return sum_x32(v); }
__device__ __forceinline__ float wave_max(float v) { v = max16(v); v = max_x16(v); return max_x32(v); }
__device__ __forceinline__ int tid_opaque() { int t = threadIdx.x; asm volatile("" : "+v"(t)); return t; }

#ifndef PROBE_ID
#define PROBE_ID 0
#endif
#ifndef PROBE_BLK
#define PROBE_BLK 0
#endif
#define PROBE_LDS_OFF (150 * 1024 - 32)
#if PROBE_ID
#define PROBE_T0(id, ldsb) unsigned long long _pt0_##id = 0; if ((id) == PROBE_ID && blockIdx.x == PROBE_BLK && threadIdx.x == 0) _pt0_##id = __builtin_amdgcn_s_memrealtime();
#define PROBE_T1(id, ldsb) if ((id) == PROBE_ID && blockIdx.x == PROBE_BLK && threadIdx.x == 0) { *(LAS_ unsigned*)((ldsb) + PROBE_LDS_OFF) += (unsigned)(__builtin_amdgcn_s_memrealtime() - _pt0_##id); }
#else
#define PROBE_T0(id, ldsb)
#define PROBE_T1(id, ldsb)
#endif
#define LAS_ __attribute__((address_space(3)))
#if PROBE_ID
#define PROBE_SEG_INIT(ldsb) unsigned long long _pseg = 0; if (blockIdx.x == PROBE_BLK && threadIdx.x == 0) _pseg = __builtin_amdgcn_s_memrealtime();
#define PROBE_SEG(id, ldsb) if (blockIdx.x == PROBE_BLK && threadIdx.x == 0) { const unsigned long long _n = __builtin_amdgcn_s_memrealtime(); if ((id) == PROBE_ID) *(LAS_ unsigned*)((ldsb) + PROBE_LDS_OFF) += (unsigned)(_n - _pseg); _pseg = _n; }
#else
#define PROBE_SEG_INIT(ldsb)
#define PROBE_SEG(id, ldsb)
#endif
namespace pg8 {
#define PG8_LAS __attribute__((address_space(3)))
typedef unsigned short bf16_t;
typedef short bf16x8 __attribute__((ext_vector_type(8)));
typedef float f32x4 __attribute__((ext_vector_type(4)));
typedef unsigned u32x4 __attribute__((ext_vector_type(4)));
typedef unsigned u32x2 __attribute__((ext_vector_type(2)));
constexpr int BM = 256, BK = 64, HALF = 128, HTB = HALF * BK * 2, STAGE_BYTES = 8 * HTB, NXCD = 8, WGM = 8;

__host__ __device__ __forceinline__ int lds_byte(int r, int c) { const int st = (r >> 4) * 2 + (c >> 5), rr = r & 15, cc = c & 31, ob = rr * 64 + cc * 2; return st * 1024 + (ob ^ (((ob >> 9) & 1) << 5)); }
__host__ __device__ __forceinline__ void stage_rc(int b, int& R, int& C) { const int st = b / 1024, sb = b % 1024, swz = sb ^ (((sb >> 9) & 1) << 5); R = (st >> 1) * 16 + swz / 64; C = (st & 1) * 32 + (swz % 64) / 2; }

struct Unit { int pm, pn; };
struct Gemm { const bf16_t* A; const bf16_t* Bt; int M, N, K; int lda, ldb; long a_pn_step, b_pn_step; };

struct StaticOrder {
    int nM, nN, nwg, G, c;
    __host__ __device__ __forceinline__ void init(int M, int N, int G_, int c_) { nM = M / BM; nN = N / BM; nwg = nM * nN; G = G_; c = c_; }
    __host__ __device__ __forceinline__ bool next(int i, Unit& u) const {
        const long L = (long)i * G + c; if (L >= nwg) return false;
        int wgid = (int)L; { const int q = nwg / NXCD, r = nwg % NXCD, xcd = wgid % NXCD, off = wgid / NXCD; wgid = (xcd < r ? xcd * (q + 1) : r * (q + 1) + (xcd - r) * q) + off; }
        const int nig = WGM * nN, gid = wgid / nig, fm = gid * WGM, gsz = (nM - fm) < WGM ? (nM - fm) : WGM;
        u.pm = fm + ((wgid % nig) % gsz); u.pn = (wgid % nig) / gsz; return true;
    }
};

__device__ __forceinline__ unsigned cvt_pk_bf16(float lo, float hi) { unsigned r; asm volatile("v_cvt_pk_bf16_f32 %0, %1, %2" : "=v"(r) : "v"(lo), "v"(hi)); return r; }

typedef _Float16 f16x8 __attribute__((ext_vector_type(8)));
template <bool F16> __device__ __forceinline__ f32x4 mma16(bf16x8 a, bf16x8 b, f32x4 c) {
    if constexpr (F16) return __builtin_amdgcn_mfma_f32_16x16x32_f16(__builtin_bit_cast(f16x8, a), __builtin_bit_cast(f16x8, b), c, 0, 0, 0);
    else return __builtin_amdgcn_mfma_f32_16x16x32_bf16(a, b, c, 0, 0, 0);
}
struct PanelOrder {
    int pm0, pn0, nsteps, valid;
    __host__ __device__ __forceinline__ void init(int M, int G_, int c_, int nsteps_) { StaticOrder S; S.init(M, 1024, G_, c_); Unit u; valid = S.next(0, u) ? 1 : 0; pm0 = u.pm; pn0 = u.pn; nsteps = nsteps_; }
    __host__ __device__ __forceinline__ bool next(int i, Unit& u) const { if (!valid || i >= nsteps) return false; u.pm = pm0; u.pn = pn0 + 4 * i; return true; }
};
struct OneUnit { Unit u0; __host__ __device__ __forceinline__ bool next(int i, Unit& u) const { if (i != 0) return false; u = u0; return true; } };
template <bool F16, class Sched, class Epi>
__device__ __forceinline__ void gemm_phase(PG8_LAS unsigned char* lds, const Gemm g, const Sched& S, const Epi& E) {
    int tid = threadIdx.x; asm volatile("" : "+v"(tid));
    const int wid = __builtin_amdgcn_readfirstlane(tid >> 6), lane = tid & 63, wr = wid >> 2, wc = wid & 3, fr = lane & 15, fq = lane >> 4;
    const int K = g.K, nt = K / BK;
    unsigned voffA[2], voffB[2];
#pragma unroll
    for (int i = 0; i < 2; ++i) { int R, C; stage_rc(tid * 16 + i * 8192, R, C);
        voffA[i] = (unsigned)(R * g.lda + C) * 2u; voffB[i] = (unsigned)(R * g.ldb + C) * 2u; }
    const size_t kstep = (size_t)(BK * 2);
    const size_t hstepA = (size_t)HALF * g.lda * 2, hstepB = (size_t)HALF * g.ldb * 2;
    const size_t tstepA = 2 * hstepA;
    const unsigned ldsw = (unsigned)wid * 1024u;
    const int aoff = lds_byte(wr * 64 + fr, fq * 8), boff = lds_byte(wc * 32 + fr, fq * 8);
#define PG8_SA(b, h) (((b) * 2 + (h)) * HTB)
#define PG8_SB(b, h) ((4 + (b) * 2 + (h)) * HTB)
#define PG8_STAGE(bufoff, gbase, voff) do { _Pragma("unroll") for (int _i = 0; _i < 2; ++_i) \
        __builtin_amdgcn_global_load_lds((const unsigned*)((const char*)(gbase) + (voff)[_i]), (PG8_LAS unsigned*)(lds + (bufoff) + ldsw + _i * 8192), 16, 0, 0); } while (0)
#define PG8_LDA(dst, b, h) do { _Pragma("unroll") for (int m = 0; m < 4; ++m) _Pragma("unroll") for (int k = 0; k < 2; ++k) dst[m][k] = *(const PG8_LAS bf16x8*)(lds + PG8_SA(b, h) + aoff + m * 2048 + k * 1024); } while (0)
#define PG8_LDB(dst, b, h) do { _Pragma("unroll") for (int n = 0; n < 2; ++n) _Pragma("unroll") for (int k = 0; k < 2; ++k) dst[n][k] = *(const PG8_LAS bf16x8*)(lds + PG8_SB(b, h) + boff + n * 2048 + k * 1024); } while (0)
#define PG8_MMA(ai, bj, At, Bt) do { __builtin_amdgcn_s_setprio(1); _Pragma("unroll") for (int m = 0; m < 4; ++m) _Pragma("unroll") for (int n = 0; n < 2; ++n) _Pragma("unroll") for (int k = 0; k < 2; ++k) \
        acc[ai][bj][m][n] = mma16<F16>(Bt[n][k], At[m][k], acc[ai][bj][m][n]); __builtin_amdgcn_s_setprio(0); } while (0)
#define PG8_WAIT_V(n) asm volatile("s_waitcnt vmcnt(" #n ")" ::: "memory")
#define PG8_WAIT_L(n) asm volatile("s_waitcnt lgkmcnt(" #n ")" ::: "memory")
#define PG8_BAR __builtin_amdgcn_s_barrier()
#define PG8_SCHED __builtin_amdgcn_sched_barrier(0)
    Unit cur, nxt; int ui = 0;
    if (!S.next(0, cur)) return;
    f32x4 acc[2][2][4][2];
#pragma unroll
    for (int a = 0; a < 2; ++a)
#pragma unroll
        for (int b = 0; b < 2; ++b)
#pragma unroll
            for (int m = 0; m < 4; ++m)
#pragma unroll
                for (int n = 0; n < 2; ++n) acc[a][b][m][n] = (f32x4){0.f, 0.f, 0.f, 0.f};
    bf16x8 At[4][2], B0[2][2], B1[2][2];
    const char* cA = (const char*)g.A + (size_t)cur.pm * tstepA + (size_t)cur.pn * g.a_pn_step * 2; const char* cB = (const char*)g.Bt + (size_t)cur.pn * g.b_pn_step * 2;
    PG8_STAGE(PG8_SB(0, 0), cB, voffB); PG8_STAGE(PG8_SA(0, 0), cA, voffA); PG8_STAGE(PG8_SB(0, 1), cB + hstepB, voffB); PG8_STAGE(PG8_SA(0, 1), cA + hstepA, voffA);
    if (wr == 1) PG8_BAR;
    PG8_WAIT_V(4); PG8_BAR;
    PG8_STAGE(PG8_SB(1, 0), cB + kstep, voffB); PG8_STAGE(PG8_SA(1, 0), cA + kstep, voffA); PG8_STAGE(PG8_SB(1, 1), cB + hstepB + kstep, voffB);
    PG8_WAIT_V(6); PG8_BAR;
    for (;;) {
        const bool has_next = S.next(ui + 1, nxt);
        const char* nA = has_next ? (const char*)g.A + (size_t)nxt.pm * tstepA + (size_t)nxt.pn * g.a_pn_step * 2 : cA; const char* nB = has_next ? (const char*)g.Bt + (size_t)nxt.pn * g.b_pn_step * 2 : cB;
        for (int t = 0; t < nt; t += 2) {
            const bool last = (t == nt - 2);
            const char* a1 = cA + (size_t)(t + 1) * kstep;
            const char* a2 = last ? nA : cA + (size_t)(t + 2) * kstep; const char* b2 = last ? nB : cB + (size_t)(t + 2) * kstep;
            const char* a3 = a2 + kstep; const char* b3 = b2 + kstep;
            PG8_LDB(B0, 0, 0); PG8_SCHED; PG8_LDA(At, 0, 0); PG8_STAGE(PG8_SA(1, 1), a1 + hstepA, voffA);
            PG8_WAIT_L(8); PG8_BAR; PG8_WAIT_L(0); PG8_MMA(0, 0, At, B0); PG8_BAR; PG8_SCHED;
            PG8_LDB(B1, 0, 1); PG8_STAGE(PG8_SB(0, 0), b2, voffB);
            PG8_BAR; PG8_WAIT_L(0); PG8_MMA(0, 1, At, B1); PG8_BAR;
            PG8_LDA(At, 0, 1); PG8_STAGE(PG8_SA(0, 0), a2, voffA);
            PG8_BAR; PG8_WAIT_L(0); PG8_MMA(1, 0, At, B0); PG8_BAR; PG8_SCHED;
            PG8_STAGE(PG8_SB(0, 1), b2 + hstepB, voffB);
            PG8_WAIT_V(6); PG8_BAR; PG8_MMA(1, 1, At, B1); PG8_BAR;
            PG8_LDB(B0, 1, 0); PG8_SCHED; PG8_LDA(At, 1, 0); PG8_STAGE(PG8_SA(0, 1), a2 + hstepA, voffA);
            PG8_WAIT_L(8); PG8_BAR; PG8_WAIT_L(0); PG8_MMA(0, 0, At, B0); PG8_BAR; PG8_SCHED;
            PG8_LDB(B1, 1, 1); PG8_STAGE(PG8_SB(1, 0), b3, voffB);
            PG8_BAR; PG8_WAIT_L(0); PG8_MMA(0, 1, At, B1); PG8_BAR;
            PG8_LDA(At, 1, 1); PG8_STAGE(PG8_SA(1, 0), a3, voffA);
            PG8_BAR; PG8_WAIT_L(0); PG8_MMA(1, 0, At, B0); PG8_BAR; PG8_SCHED;
            PG8_STAGE(PG8_SB(1, 1), b3 + hstepB, voffB);
            PG8_WAIT_V(6); PG8_BAR; PG8_MMA(1, 1, At, B1); PG8_BAR;
        }
        { int fr_ = fr, fq_ = fq; asm volatile("" : "+v"(fr_), "+v"(fq_)); E(acc, cur, wr, wc, fr_, fq_); }
        if (!has_next) break;
#pragma unroll
        for (int a = 0; a < 2; ++a)
#pragma unroll
            for (int b = 0; b < 2; ++b)
#pragma unroll
                for (int m = 0; m < 4; ++m)
#pragma unroll
                    for (int n = 0; n < 2; ++n) acc[a][b][m][n] = (f32x4){0.f, 0.f, 0.f, 0.f};
        cur = nxt; cA = nA; cB = nB; ++ui;
    }
    PG8_WAIT_V(0);
    if (wr == 0) PG8_BAR;
    PG8_BAR;
#undef PG8_SA
#undef PG8_SB
#undef PG8_STAGE
#undef PG8_LDA
#undef PG8_LDB
#undef PG8_MMA
#undef PG8_WAIT_V
#undef PG8_WAIT_L
#undef PG8_BAR
#undef PG8_SCHED
}
}
#define LAS __attribute__((address_space(3)))
#define LDS_WAIT() asm volatile("s_waitcnt lgkmcnt(0)" ::: "memory")
constexpr int NT = 512, NW = 8;

struct Params {
    const float* in[31];
    float* out;
    unsigned char* ws;
};

__device__ __forceinline__ void tr_item(const float* W, int ldw, bf16* WT, int K, int k0, int nphys0, int lbase, int cnt, const float* kg, LAS float* scr, int lane, bool f16 = false) {
    const int c = lane & 31;
#pragma unroll 8
    for (int i = 0; i < 32; ++i) { const int kk = 2 * i + (lane >> 5); float v = 0.f;
        if (c < cnt) { v = W[(size_t)(k0 + kk) * ldw + lbase + c]; if (kg) v *= kg[k0 + kk]; }
        scr[kk * 33 + c] = v; }
    LDS_WAIT();
    const int c8 = lane & 7;
#pragma unroll
    for (int j = 0; j < 4; ++j) { const int n = (lane >> 3) + 8 * j; const LAS float* s = scr + (8 * c8) * 33 + n;
        u32x4 o;
        if (f16) { o.x = pk2h(s[0 * 33], s[1 * 33]); o.y = pk2h(s[2 * 33], s[3 * 33]); o.z = pk2h(s[4 * 33], s[5 * 33]); o.w = pk2h(s[6 * 33], s[7 * 33]); }
        else { o.x = pk2(s[0 * 33], s[1 * 33]); o.y = pk2(s[2 * 33], s[3 * 33]); o.z = pk2(s[4 * 33], s[5 * 33]); o.w = pk2(s[6 * 33], s[7 * 33]); }
        *(u32x4*)(WT + (size_t)(nphys0 + n) * K + k0 + 8 * c8) = o; }
    LDS_WAIT();
}
__device__ __forceinline__ void p1_group(int g, int& lbase, int& cnt) {
    const int tile = g >> 3, gi = g & 7, bj = gi >> 2, wc = gi & 3; cnt = 32;
    if (tile < 2) lbase = COL_Q + (4 * tile + wc) * 64 + 32 * bj;
    else if (tile < 4) lbase = COL_K + (4 * (tile - 2) + wc) * 64 + 32 * bj;
    else if (tile < 6) lbase = COL_V + (tile - 4) * 256 + 32 * gi;
    else if (tile == 6) lbase = COL_IQ + wc * 64 + 32 * bj;
    else if (tile == 7) { if (wc == 0) lbase = COL_IK + 32 * bj; else if (gi == 1) { lbase = COL_IW; cnt = 4; } else { lbase = 0; cnt = 0; } }
    else if (tile < 15) lbase = COL_RW + (tile - 8) * 256 + 32 * gi;
    else lbase = COL_MEMQ + (tile - 15) * 256 + 32 * gi;
}

__device__ __forceinline__ void prologue_phase(const Params& P, LAS unsigned char* lds, int bid, int nblk) {
    const int tid = tid_opaque(), lane = tid & 63, wave = tid >> 6;
    const int gw = bid * NW + wave, NGW = nblk * NW;
    unsigned char* ws = P.ws;
    LAS float* scr = (LAS float*)(lds + wave * 16384);
    constexpr int I_P1 = 16 * (P1_N / 32), I_WG = 16 * 96, I_UP = 8 * 32, I_OUT = 16 * 32, I_WQ = 16 * 64, I_MEM = 16 * 32;
    constexpr int NITEMS = I_P1 + I_WG + 3 * I_UP + I_OUT + I_WQ + I_MEM;
    for (int it = gw; it < I_P1 + I_MEM; it += NGW) {
        int r = it;
        if (r < I_P1) { const int ng = P1_N / 32, kb = r / ng, g = r % ng; int lb, cnt; p1_group(g, lb, cnt);
            tr_item(P.in[4], WIN_COLS, (bf16*)(ws + WS_WIN), 1024, 64 * kb, 32 * g, lb, cnt, P.in[3], scr, lane); continue; } r -= I_P1;
        { const int kb = r / 32, g = r % 32;
            tr_item(P.in[9], 1024, (bf16*)(ws + WS_WMEM), 1024, 64 * kb, 32 * g, 32 * g, 32, P.in[8], scr, lane); }
    }
    for (int m = gw; m < S_ + NMEM; m += NGW) {
        const bool isx = m < S_; const int r = isx ? m : m - S_;
        const f32x4* xr = (const f32x4*)((isx ? P.in[0] : P.in[1]) + (size_t)r * D_) + lane;
        f32x4 v[4]; float s = 0.f;
#pragma unroll
        for (int j = 0; j < 4; ++j) { v[j] = xr[64 * j]; s += (v[j].x * v[j].x + v[j].y * v[j].y) + (v[j].z * v[j].z + v[j].w * v[j].w); }
        s = wave_sum(s);
        const float rstd = 1.0f / sqrtf(s * (1.0f / D_) + NORM_EPS);
        if (lane == 0) ((float*)(ws + (isx ? WS_RSTDX : WS_RSTDM)))[r] = rstd;
        unsigned long long* o8 = (unsigned long long*)((bf16*)(ws + (isx ? WS_XB : WS_MB)) + (size_t)r * D_) + lane;
#pragma unroll
        for (int j = 0; j < 4; ++j) o8[64 * j] = (unsigned long long)pk2(v[j].x, v[j].y) | ((unsigned long long)pk2(v[j].z, v[j].w) << 32);
    }
    const int gt = bid * NT + tid, NGT = nblk * NT;
    for (int i = gt; i < S_ * 8; i += NGT) { const int t = i >> 3, f = i & 7;
        const double inv = pow(500000.0, -(double)f / 8.0); const double ang = (double)((const int*)P.in[2])[t] * inv;
        ((float*)(ws + WS_COS))[i] = (float)cos(ang); ((float*)(ws + WS_SIN))[i] = (float)sin(ang); }
    for (int i = gt; i < 256 * 256; i += NGT) { const int n = i >> 8, k = i & 255; float v = 0.f;
        if (n < 128) { if (k < 128) v = P.in[27][n * 128 + k]; } else { if (k >= 128) v = P.in[28][(n - 128) * 128 + (k - 128)]; }
        ((half_t*)(ws + WS_KEYBD))[i] = (half_t)v; }
    for (int i = gt; i < 1536 * 256; i += NGT) { const int n = i >> 8, k = i & 255; float v = 0.f;
        if (n < 512) { if (k < 64) v = P.in[14][k * 512 + n]; }
        else if (n < 1024) { if (k >= 64 && k < 128) v = P.in[16][(k - 64) * 512 + (n - 512)]; }
        else { if (k >= 128) v = P.in[17][(k - 128) * 512 + (n - 1024)]; }
        ((bf16*)(ws + WS_WLORA))[i] = (bf16)f2bf(v); }
}

__device__ __forceinline__ void prologue_rest_phase(const Params& P, LAS unsigned char* lds, int bid, int nblk) {
    const int tid = tid_opaque(), lane = tid & 63, wave = tid >> 6;
    const int gw = bid * NW + wave, NGW = nblk * NW;
    unsigned char* ws = P.ws;
    LAS float* scr = (LAS float*)(lds + wave * 16384);
    constexpr int I_WG = 16 * 96, I_UP = 8 * 32, I_OUT = 16 * 32, I_WQ = 16 * 64;
    constexpr int NREST = I_WG + 3 * I_UP + I_OUT + I_WQ;
    for (int it = gw; it < NREST; it += NGW) {
        int r = it;
        if (r < I_WG) { const int kb = r / 96, g = r % 96;
            tr_item(P.in[4], WIN_COLS, (bf16*)(ws + WS_WG), 1024, 64 * kb, 32 * g, COL_GATE + 32 * g, 32, P.in[3], scr, lane); continue; } r -= I_WG;
        if (r < 3 * I_UP) { const int c = r / I_UP, rr = r % I_UP, kb = rr / 32, g = rr % 32;
            tr_item(P.in[23] + (size_t)c * 512 * 1024, 1024, (bf16*)(ws + WS_WUP) + (size_t)c * 1024 * 512, 512, 64 * kb, 32 * g, 32 * g, 32, nullptr, scr, lane); continue; } r -= 3 * I_UP;
        if (r < I_OUT) { const int kb = r / 32, g = r % 32;
            tr_item(P.in[24], 1024, (bf16*)(ws + WS_WOUT), 1024, 64 * kb, 32 * g, 32 * g, 32, nullptr, scr, lane); continue; } r -= I_OUT;
        { const int kb = r / 64, g = r % 64;
            tr_item(P.in[26], 2048, (bf16*)(ws + WS_WQ), 1024, 64 * kb, 32 * g, 32 * g, 32, P.in[25], scr, lane, true); }
    }
}

typedef const f32x4 (&AccRef)[2][2][4][2];
__device__ __forceinline__ void st_bf4(bf16* p, f32x4 v) { u32x2 w; w.x = pk2(v[0], v[1]); w.y = pk2(v[2], v[3]); *(u32x2*)p = w; }
__device__ __forceinline__ void st_h4(half_t* p, f32x4 v) { half4 h; h[0] = (half_t)v[0]; h[1] = (half_t)v[1]; h[2] = (half_t)v[2]; h[3] = (half_t)v[3]; *(half4*)p = h; }

__device__ __forceinline__ void st_f8x4(unsigned char* p, f32x4 v) { int w = __builtin_amdgcn_cvt_pk_fp8_f32(v[0], v[1], 0, false); w = __builtin_amdgcn_cvt_pk_fp8_f32(v[2], v[3], w, true); *(int*)p = w; }
__device__ __forceinline__ f32x4 rope4(f32x4 v, int fq, const float* cs, const float* sn) {
    f32x4 o;
#pragma unroll
    for (int j = 0; j < 4; ++j) { const float p = xor32f(v[j]); const int i = 4 * (fq & 1) + j; const float c = cs[i], s = sn[i];
        o[j] = (fq < 2) ? (v[j] * c - p * s) : (v[j] * c + p * s); }
    return o;
}

struct EpiP1 {
    const float* rstd; const float* cs; const float* sn; const float* qgain; const float* kgain;
    bf16 *Q, *K, *V, *RWP, *MEMQ; half_t *IQ, *IK; float* IW;
    __device__ __forceinline__ void operator()(AccRef acc, const pg8::Unit& u, int wr, int wc, int fr, int fq) const {
        const int pn = u.pn;
#pragma unroll
        for (int ai = 0; ai < 2; ++ai)
#pragma unroll
            for (int m = 0; m < 4; ++m) {
                const int row = u.pm * 256 + ai * 128 + wr * 64 + m * 16 + fr; const float rs = rstd[row];
                f32x4 v[2][2];
#pragma unroll
                for (int bj = 0; bj < 2; ++bj)
#pragma unroll
                    for (int n = 0; n < 2; ++n) v[bj][n] = acc[ai][bj][m][n] * rs;
                if (pn < 4) {
                    float ss = 0.f;
#pragma unroll
                    for (int bj = 0; bj < 2; ++bj)
#pragma unroll
                        for (int n = 0; n < 2; ++n) ss += (v[bj][n][0] * v[bj][n][0] + v[bj][n][1] * v[bj][n][1]) + (v[bj][n][2] * v[bj][n][2] + v[bj][n][3] * v[bj][n][3]);
                    ss = sum_x16(ss); ss = sum_x32(ss);
                    const float rh = 1.0f / sqrtf(ss * (1.0f / 64.0f) + NORM_EPS);
                    const float* gn = (pn < 2) ? qgain : kgain;
#pragma unroll
                    for (int bj = 0; bj < 2; ++bj)
#pragma unroll
                        for (int n = 0; n < 2; ++n) { const f32x4 gv = *(const f32x4*)(gn + 32 * bj + 16 * n + 4 * fq); v[bj][n] = v[bj][n] * rh * gv; }
                    v[0][0] = rope4(v[0][0], fq, cs + row * 8, sn + row * 8);
                    const int head = (pn & 1) * 4 + wc;
                    if (pn < 2) { bf16* dst = Q + (size_t)row * 512 + head * 64 + 4 * fq;
#pragma unroll
                        for (int bj = 0; bj < 2; ++bj)
#pragma unroll
                            for (int n = 0; n < 2; ++n) st_bf4(dst + 32 * bj + 16 * n, v[bj][n]);
                    } else { half_t* dst = (half_t*)K + ((size_t)head * S_ + row) * 64 + 4 * fq;
#pragma unroll
                        for (int bj = 0; bj < 2; ++bj)
#pragma unroll
                            for (int n = 0; n < 2; ++n) st_h4(dst + 32 * bj + 16 * n, v[bj][n]); }
                } else if (pn < 6) {
#pragma unroll
                    for (int bj = 0; bj < 2; ++bj)
#pragma unroll
                        for (int n = 0; n < 2; ++n) { const int head = (pn - 4) * 4 + 2 * bj + (wc >> 1);
                            st_h4((half_t*)V + ((size_t)head * S_ + row) * 64 + 32 * (wc & 1) + 16 * n + 4 * fq, v[bj][n]); }
                } else if (pn == 6) {
                    v[0][0] = rope4(v[0][0], fq, cs + row * 8, sn + row * 8);
                    half_t* dst = IQ + (size_t)row * 256 + wc * 64 + 4 * fq;
#pragma unroll
                    for (int bj = 0; bj < 2; ++bj)
#pragma unroll
                        for (int n = 0; n < 2; ++n) st_h4(dst + 32 * bj + 16 * n, v[bj][n]);
                } else if (pn == 7) {
                    if (wc == 0) {
                        v[0][0] = rope4(v[0][0], fq, cs + row * 8, sn + row * 8);
#pragma unroll
                        for (int bj = 0; bj < 2; ++bj)
#pragma unroll
                            for (int n = 0; n < 2; ++n) st_h4(IK + ((size_t)((row >> 4) * 2 + bj) * 64 + (2 * n + (fq >> 1)) * 16 + (row & 15)) * 8 + 4 * (fq & 1), v[bj][n]);
                    } else if (wc == 1) { if (fq == 0) *(f32x4*)(IW + (size_t)row * 4) = v[0][0]; }
                } else if (pn < 15) {
                    bf16* dst = RWP + (size_t)row * RW_IN + (pn - 8) * 256 + 32 * wc + 4 * fq;
#pragma unroll
                    for (int bj = 0; bj < 2; ++bj)
#pragma unroll
                        for (int n = 0; n < 2; ++n) st_bf4(dst + 128 * bj + 16 * n, v[bj][n]);
                } else {
                    bf16* dst = MEMQ + (size_t)row * 512 + (pn - 15) * 256 + 32 * wc + 4 * fq;
#pragma unroll
                    for (int bj = 0; bj < 2; ++bj)
#pragma unroll
                        for (int n = 0; n < 2; ++n) st_bf4(dst + 128 * bj + 16 * n, v[bj][n]);
                }
            }
    }
};

struct EpiF32 {
    float* C; int ldc; const float* rstd;
    __device__ __forceinline__ void operator()(AccRef acc, const pg8::Unit& u, int wr, int wc, int fr, int fq) const {
#pragma unroll
        for (int ai = 0; ai < 2; ++ai)
#pragma unroll
            for (int m = 0; m < 4; ++m) { const int row = u.pm * 256 + ai * 128 + wr * 64 + m * 16 + fr; const float rs = rstd ? rstd[row] : 1.0f;
                float* dst = C + (size_t)row * ldc + u.pn * 256 + 32 * wc + 4 * fq;
#pragma unroll
                for (int bj = 0; bj < 2; ++bj)
#pragma unroll
                    for (int n = 0; n < 2; ++n) *(f32x4*)(dst + 128 * bj + 16 * n) = acc[ai][bj][m][n] * rs; }
    }
};
struct EpiBf {
    bf16* C; int ldc; const float* rstd;
    __device__ __forceinline__ void operator()(AccRef acc, const pg8::Unit& u, int wr, int wc, int fr, int fq) const {
#pragma unroll
        for (int ai = 0; ai < 2; ++ai)
#pragma unroll
            for (int m = 0; m < 4; ++m) { const int row = u.pm * 256 + ai * 128 + wr * 64 + m * 16 + fr; const float rs = rstd ? rstd[row] : 1.0f;
                bf16* dst = C + (size_t)row * ldc + u.pn * 256 + 32 * wc + 4 * fq;
#pragma unroll
                for (int bj = 0; bj < 2; ++bj)
#pragma unroll
                    for (int n = 0; n < 2; ++n) st_bf4(dst + 128 * bj + 16 * n, acc[ai][bj][m][n] * rs); }
    }
};
__device__ __forceinline__ float sigmoidf_(float x) { return 1.0f / (1.0f + __expf(-x)); }
struct EpiLora {
    bf16 *E, *A, *G; const float* w0; const float* a0;
    __device__ __forceinline__ void operator()(AccRef acc, const pg8::Unit& u, int wr, int wc, int fr, int fq) const {
        const int kind = u.pn >> 1;
#pragma unroll
        for (int ai = 0; ai < 2; ++ai)
#pragma unroll
            for (int m = 0; m < 4; ++m) { const int row = u.pm * 256 + ai * 128 + wr * 64 + m * 16 + fr;
#pragma unroll
                for (int bj = 0; bj < 2; ++bj)
#pragma unroll
                    for (int n = 0; n < 2; ++n) { const int c = (u.pn & 1) * 256 + 128 * bj + 32 * wc + 16 * n + 4 * fq; f32x4 v = acc[ai][bj][m][n];
                        if (kind == 0) { const f32x4 b = *(const f32x4*)(w0 + c);
#pragma unroll
                            for (int j = 0; j < 4; ++j) { const float z = v[j] + b[j]; const float sp = fmaxf(-z, 0.f) + __logf(1.0f + __expf(-fabsf(z))); v[j] = __expf(-sp - 0.5f); }
                            st_bf4(E + (size_t)row * 512 + c, v);
                        } else if (kind == 1) { const f32x4 b = *(const f32x4*)(a0 + c);
#pragma unroll
                            for (int j = 0; j < 4; ++j) v[j] = sigmoidf_(v[j] + b[j]);
                            st_bf4(A + (size_t)row * 512 + c, v);
                        } else st_bf4(G + (size_t)row * 512 + c, v); } }
    }
};
struct EpiGate {
    bf16* Gt; const float* rstd; const float* bias;
    __device__ __forceinline__ void operator()(AccRef acc, const pg8::Unit& u, int wr, int wc, int fr, int fq) const {
#pragma unroll
        for (int ai = 0; ai < 2; ++ai)
#pragma unroll
            for (int m = 0; m < 4; ++m) { const int row = u.pm * 256 + ai * 128 + wr * 64 + m * 16 + fr; const float rs = rstd[row];
#pragma unroll
                for (int bj = 0; bj < 2; ++bj)
#pragma unroll
                    for (int n = 0; n < 2; ++n) { const int c = u.pn * 256 + 128 * bj + 32 * wc + 16 * n + 4 * fq; const f32x4 b = *(const f32x4*)(bias + c); f32x4 v = acc[ai][bj][m][n] * rs + b;
#pragma unroll
                        for (int j = 0; j < 4; ++j) v[j] = sigmoidf_(v[j]);
                        st_bf4(Gt + (size_t)row * 3072 + c, v); } }
    }
};
struct EpiMerge {
    const bf16* Gt; float* accf; bf16* merged; int c;
    __device__ __forceinline__ void operator()(AccRef acc, const pg8::Unit& u, int wr, int wc, int fr, int fq) const {
        const int row0 = u.pm * 256 + wr * 64 + fr, col0 = u.pn * 256 + 32 * wc + 4 * fq;
#pragma unroll
        for (int ai = 0; ai < 2; ++ai)
#pragma unroll
            for (int bj = 0; bj < 2; ++bj) {
                u32x2 gw[4][2]; f32x4 old[4][2];
#pragma unroll
                for (int m = 0; m < 4; ++m)
#pragma unroll
                    for (int n = 0; n < 2; ++n) { const size_t r = (size_t)(row0 + ai * 128 + m * 16); const int cc = col0 + 128 * bj + 16 * n;
                        gw[m][n] = *(const u32x2*)(Gt + r * 3072 + c * 1024 + cc); old[m][n] = (f32x4){0.f, 0.f, 0.f, 0.f}; if (c > 0) old[m][n] = *(const f32x4*)(accf + r * 1024 + cc); }
#pragma unroll
                for (int m = 0; m < 4; ++m)
#pragma unroll
                    for (int n = 0; n < 2; ++n) { const u32x2 g2 = gw[m][n]; f32x4 a = acc[ai][bj][m][n]; const f32x4 od = old[m][n];
                        a[0] = a[0] * bflo(g2.x) + od[0]; a[1] = a[1] * bfhi(g2.x) + od[1]; a[2] = a[2] * bflo(g2.y) + od[2]; a[3] = a[3] * bfhi(g2.y) + od[3];
                        const size_t o = (size_t)(row0 + ai * 128 + m * 16) * 1024 + col0 + 128 * bj + 16 * n;
                        if (c < 2) *(f32x4*)(accf + o) = a; else st_bf4(merged + o, a); }
            }
    }
};
struct EpiOut {
    const float* x; float* out; bf16* HB; float* HSQ;
    __device__ __forceinline__ void operator()(AccRef acc, const pg8::Unit& u, int wr, int wc, int fr, int fq) const {
#pragma unroll
        for (int ai = 0; ai < 2; ++ai)
#pragma unroll
            for (int m = 0; m < 4; ++m) { const int row = u.pm * 256 + ai * 128 + wr * 64 + m * 16 + fr; float ss = 0.f;
#pragma unroll
                for (int bj = 0; bj < 2; ++bj)
#pragma unroll
                    for (int n = 0; n < 2; ++n) { const size_t o = (size_t)row * 1024 + u.pn * 256 + 128 * bj + 32 * wc + 16 * n + 4 * fq;
                        const f32x4 v = acc[ai][bj][m][n] + *(const f32x4*)(x + o); *(f32x4*)(out + o) = v; st_h4((half_t*)HB + o, v);
                        ss += (v[0] * v[0] + v[1] * v[1]) + (v[2] * v[2] + v[3] * v[3]); }
                ss = sum_x16(ss); ss = sum_x32(ss);
                if (fq == 0) HSQ[(size_t)row * 16 + u.pn * 4 + wc] = ss; }
    }
};

__device__ __forceinline__ float rstd_h_row(const float* HSQ, int row) {
    const f32x4* hp = (const f32x4*)(HSQ + (size_t)row * 16); const f32x4 a = hp[0], b = hp[1], c = hp[2], d = hp[3];
    const float s = ((a[0] + a[1]) + (a[2] + a[3])) + ((b[0] + b[1]) + (b[2] + b[3])) + ((c[0] + c[1]) + (c[2] + c[3])) + ((d[0] + d[1]) + (d[2] + d[3]));
    return 1.0f / sqrtf(s * (1.0f / 1024.0f) + NORM_EPS);
}
__device__ __forceinline__ void lora_in_phase(const Params& P, int bid, int nblk) {
    const bf16* RWP = (const bf16*)(P.ws + WS_RWP); bf16* LIN = (bf16*)((unsigned char*)P.out + DO_LIN); const float* mu = P.in[12];
    const int gt = bid * NT + tid_opaque(), NGT = nblk * NT;
    for (int i = gt; i < S_ * 64; i += NGT) { const int t = i >> 6, c4 = (i & 63) * 4;
        const u32x2 pw = *(const u32x2*)(RWP + (size_t)t * RW_IN + 1536 + c4);
        u32x2 qw; qw.x = 0u; qw.y = 0u; if (t > 0) qw = *(const u32x2*)(RWP + (size_t)(t - 1) * RW_IN + 1536 + c4);
        const f32x4 m4 = *(const f32x4*)(mu + 1536 + c4);
        f32x4 p = {bflo(pw.x), bfhi(pw.x), bflo(pw.y), bfhi(pw.y)}, q = {bflo(qw.x), bfhi(qw.x), bflo(qw.y), bfhi(qw.y)};
        f32x4 s = p + (q - p) * m4;
        if (c4 < 64) { for (int j = 0; j < 4; ++j) s[j] = tanhf(s[j]); }
        else if (c4 >= 128) { for (int j = 0; j < 4; ++j) s[j] = sigmoidf_(s[j]); }
        st_bf4(LIN + (size_t)t * 256 + c4, s); }
}

constexpr int TC = 32;
__device__ __forceinline__ float shift3(const bf16* RWP, const float* mu, int t, int col) {
    const float p = bf2f(RWP[(size_t)t * RW_IN + col]); const float q = t > 0 ? bf2f(RWP[(size_t)(t - 1) * RW_IN + col]) : 0.f;
    return p + (q - p) * mu[col];
}
__device__ __forceinline__ void rwkv_scan_v1(const Params& P, LAS unsigned char* lds, int h) {
    const bf16* RWP = (const bf16*)(P.ws + WS_RWP);
    const bf16* Eb = (const bf16*)((unsigned char*)P.out + DO_E); const bf16* Ab = (const bf16*)((unsigned char*)P.out + DO_A); const bf16* Gb = (const bf16*)((unsigned char*)P.out + DO_G);
    bf16* Y = (bf16*)(P.ws + WS_Y);
    const float* mu = P.in[12]; const float* k_k = P.in[18]; const float* k_a = P.in[19]; const float* r_k = P.in[20]; const float* ln_w = P.in[21]; const float* ln_b = P.in[22];
    LAS float* sR = (LAS float*)lds; LAS float* sW = sR + TC * 64; LAS float* sK = sW + TC * 64; LAS float* sV = sK + TC * 64;
    LAS float* sA = sV + TC * 64; LAS float* sB = sA + TC * 64; LAS float* sY = sB + TC * 64; LAS float* sG = sY + TC * 64;
    const int tid = tid_opaque();
    const int tok = tid >> 4, j0 = (tid & 15) * 4;
    const int si = tid >> 3, jg = tid & 7;
    float S[8];
#pragma unroll
    for (int c = 0; c < 8; ++c) S[c] = 0.f;
    for (int t0 = 0; t0 < S_; t0 += TC) {
        {
            const int t = t0 + tok; float kkv[4], ss = 0.f, rr[4], kk_[4], vv[4], aa[4], ee[4], gg[4];
#pragma unroll
            for (int j = 0; j < 4; ++j) { const int c = h * 64 + j0 + j;
                rr[j] = shift3(RWP, mu, t, c); kk_[j] = shift3(RWP, mu, t, 512 + c); vv[j] = shift3(RWP, mu, t, 1024 + c);
                aa[j] = bf2f(Ab[(size_t)t * 512 + c]); ee[j] = bf2f(Eb[(size_t)t * 512 + c]); gg[j] = bf2f(Gb[(size_t)t * 512 + c]);
                kkv[j] = kk_[j] * k_k[c]; ss += kkv[j] * kkv[j]; }
            ss += __shfl_xor(ss, 1); ss += __shfl_xor(ss, 2); ss += __shfl_xor(ss, 4); ss += __shfl_xor(ss, 8);
            const float inv = 1.0f / fmaxf(sqrtf(ss), 1e-12f);
#pragma unroll
            for (int j = 0; j < 4; ++j) { const int c = h * 64 + j0 + j; const int o = tok * 64 + j0 + j; const float kn = kkv[j] * inv;
                sR[o] = rr[j]; sW[o] = __expf(-ee[j]); sK[o] = kk_[j] * (1.0f + (aa[j] - 1.0f) * k_a[c]); sV[o] = vv[j]; sA[o] = -kn; sB[o] = kn * aa[j]; sG[o] = gg[j]; }
        }
        __syncthreads();
        for (int tt = 0; tt < TC; ++tt) {
            const LAS float* pa = sA + tt * 64 + 8 * jg; const LAS float* pb = sB + tt * 64 + 8 * jg; const LAS float* pw = sW + tt * 64 + 8 * jg;
            const LAS float* pk = sK + tt * 64 + 8 * jg; const LAS float* pr = sR + tt * 64 + 8 * jg;
            const float vi = sV[tt * 64 + si];
            float sa = 0.f;
#pragma unroll
            for (int c = 0; c < 8; ++c) sa += S[c] * pa[c];
            sa += __shfl_xor(sa, 1); sa += __shfl_xor(sa, 2); sa += __shfl_xor(sa, 4);
            float y = 0.f;
#pragma unroll
            for (int c = 0; c < 8; ++c) { S[c] = S[c] * pw[c] + sa * pb[c] + vi * pk[c]; y += S[c] * pr[c]; }
            y += __shfl_xor(y, 1); y += __shfl_xor(y, 2); y += __shfl_xor(y, 4);
            if (jg == 0) sY[tt * 64 + si] = y;
        }
        __syncthreads();
        {
            const int t = t0 + tok; float y4[4], s1 = 0.f, bon = 0.f;
#pragma unroll
            for (int j = 0; j < 4; ++j) { const int o = tok * 64 + j0 + j; y4[j] = sY[o]; s1 += y4[j]; bon += sR[o] * sK[o] * r_k[h * 64 + j0 + j]; }
            s1 += __shfl_xor(s1, 1); s1 += __shfl_xor(s1, 2); s1 += __shfl_xor(s1, 4); s1 += __shfl_xor(s1, 8);
            bon += __shfl_xor(bon, 1); bon += __shfl_xor(bon, 2); bon += __shfl_xor(bon, 4); bon += __shfl_xor(bon, 8);
            const float mean = s1 * (1.0f / 64.0f); float s2 = 0.f;
#pragma unroll
            for (int j = 0; j < 4; ++j) { const float d = y4[j] - mean; s2 += d * d; }
            s2 += __shfl_xor(s2, 1); s2 += __shfl_xor(s2, 2); s2 += __shfl_xor(s2, 4); s2 += __shfl_xor(s2, 8);
            const float rstd = 1.0f / sqrtf(s2 * (1.0f / 64.0f) + GN_EPS);
            f32x4 o4;
#pragma unroll
            for (int j = 0; j < 4; ++j) { const int c = h * 64 + j0 + j; const int o = tok * 64 + j0 + j;
                o4[j] = ((y4[j] - mean) * rstd * ln_w[c] + ln_b[c] + bon * sV[o]) * sG[o]; }
            st_bf4(Y + (size_t)t * 1536 + 512 + h * 64 + j0, o4);
        }
        __syncthreads();
    }
}

__device__ __forceinline__ float inv_ordkey(unsigned u) { return __builtin_bit_cast(float, (u & 0x80000000u) ? (u & 0x7fffffffu) : ~u); }
__device__ __forceinline__ unsigned ordkey(float f) { const unsigned u = __builtin_bit_cast(unsigned, f); return (u & 0x80000000u) ? ~u : (u | 0x80000000u); }
constexpr int DSA_LDS_SCORES = 0, DSA_LDS_IQ = 65536, DSA_LDS_HIST = DSA_LDS_IQ + 1024, DSA_LDS_MISC = DSA_LDS_HIST + 1024, DSA_LDS_SEL = DSA_LDS_MISC + 256,
              DSA_LDS_O = DSA_LDS_SEL + 1024, DSA_LDS_ML = DSA_LDS_O + 8 * 512 * 4, DSA_LDS_END = DSA_LDS_ML + 8 * 8 * 2 * 4;
__device__ __forceinline__ void dsa_query_v1(const Params& P, LAS unsigned char* lds, int t) {
    const half_t* IQ = (const half_t*)(P.ws + WS_IQ); const half_t* IK = (const half_t*)(P.ws + WS_IK); const float* IW = (const float*)(P.ws + WS_IW);
    const bf16* Q = (const bf16*)(P.ws + WS_Q); const bf16* Kb = (const bf16*)(P.ws + WS_K); const bf16* Vb = (const bf16*)(P.ws + WS_V);
    bf16* Y = (bf16*)(P.ws + WS_Y);
    LAS float* sc = (LAS float*)(lds + DSA_LDS_SCORES); LAS float* siq = (LAS float*)(lds + DSA_LDS_IQ); LAS unsigned* hist = (LAS unsigned*)(lds + DSA_LDS_HIST);
    LAS unsigned* misc = (LAS unsigned*)(lds + DSA_LDS_MISC); LAS unsigned* sel = (LAS unsigned*)(lds + DSA_LDS_SEL);
    LAS float* so = (LAS float*)(lds + DSA_LDS_O); LAS float* sml = (LAS float*)(lds + DSA_LDS_ML);
    const int tid = tid_opaque(), lane = tid & 63, wave = tid >> 6;
    const int n = t + 1;
    if (tid < 256) siq[tid] = (float)IQ[(size_t)t * 256 + tid];
    if (tid < 256) sel[tid] = 0xFFFFu;
    __syncthreads();
    float w4[4];
#pragma unroll
    for (int hh = 0; hh < 4; ++hh) w4[hh] = IW[(size_t)t * 4 + hh] * 0.0625f;
    for (int s = tid; s < n; s += NT) {
        const half8* kp = (const half8*)(IK + (size_t)s * 64);
        float d0 = 0.f, d1 = 0.f, d2 = 0.f, d3 = 0.f;
#pragma unroll
        for (int c = 0; c < 8; ++c) { const half8 kv = kp[c];
#pragma unroll
            for (int j = 0; j < 8; ++j) { const float kf = (float)kv[j]; const int d = c * 8 + j;
                d0 += siq[d] * kf; d1 += siq[64 + d] * kf; d2 += siq[128 + d] * kf; d3 += siq[192 + d] * kf; } }
        float v = w4[0] * fmaxf(d0, 0.f) + w4[1] * fmaxf(d1, 0.f) + w4[2] * fmaxf(d2, 0.f) + w4[3] * fmaxf(d3, 0.f);
        sc[s] = v + 0.0f;
    }
    __syncthreads();
    if (n <= 256) { if (tid < n) sel[tid] = (unsigned)tid; __syncthreads(); }
    else {
        unsigned prefix = 0u, krem = 256u;
        for (int pass = 3; pass >= 0; --pass) {
            const int shift = pass * 8;
            if (tid < 256) hist[tid] = 0u;
            __syncthreads();
            for (int s = tid; s < n; s += NT) { const unsigned k = ordkey(sc[s]);
                if (pass == 3 || (k >> (shift + 8)) == (prefix >> (shift + 8))) atomicAdd((unsigned*)&hist[(k >> shift) & 255u], 1u); }
            __syncthreads();
            if (tid == 0) { unsigned cum = 0u; int b = 255; for (; b > 0; --b) { const unsigned hb = hist[b]; if (cum + hb >= krem) break; cum += hb; }
                misc[0] = prefix | ((unsigned)b << shift); misc[1] = krem - cum; }
            __syncthreads();
            prefix = misc[0]; krem = misc[1];
            __syncthreads();
        }
        const unsigned T = prefix; unsigned selbase = 0u, eqbase = 0u;
        for (int c0 = 0; c0 < n; c0 += NT) {
            const int s = c0 + tid; const unsigned k = (s < n) ? ordkey(sc[s]) : 0u; const bool gt = (s < n) && k > T, eq = (s < n) && k == T;
            const unsigned long long beq = __ballot(eq); const unsigned eqpre = __popcll(beq & ((1ull << lane) - 1ull));
            if (lane == 0) misc[8 + wave] = (unsigned)__popcll(beq);
            __syncthreads();
            unsigned eqoff = eqbase, eqtot = 0u;
#pragma unroll
            for (int w = 0; w < 8; ++w) { const unsigned cw = misc[8 + w]; if (w < wave) eqoff += cw; eqtot += cw; }
            const bool take = gt || (eq && (eqoff + eqpre) < krem);
            const unsigned long long bt = __ballot(take); const unsigned tpre = __popcll(bt & ((1ull << lane) - 1ull));
            if (lane == 0) misc[16 + wave] = (unsigned)__popcll(bt);
            __syncthreads();
            unsigned toff = selbase, ttot = 0u;
#pragma unroll
            for (int w = 0; w < 8; ++w) { const unsigned cw = misc[16 + w]; if (w < wave) toff += cw; ttot += cw; }
            if (take && (toff + tpre) < 256u) sel[toff + tpre] = (unsigned)s;
            selbase += ttot; eqbase += eqtot;
            __syncthreads();
        }
    }
    {
        u16* SEL = (u16*)(P.ws + WS_SEL);
        if (tid < 256) SEL[(size_t)t * 256 + tid] = (u16)sel[tid];
        const u32x4 qw = *(const u32x4*)(Q + (size_t)t * 512 + 8 * lane);
        float q[8] = {bflo(qw.x), bfhi(qw.x), bflo(qw.y), bfhi(qw.y), bflo(qw.z), bfhi(qw.z), bflo(qw.w), bfhi(qw.w)};
        float lg[32]; float mx = -INFINITY;
#pragma unroll
        for (int i = 0; i < 32; ++i) { const unsigned id = sel[wave * 32 + i];
            float d = -INFINITY;
            if (id != 0xFFFFu) { const u32x4 kw = *(const u32x4*)(Kb + (size_t)id * 512 + 8 * lane);
                d = q[0] * bflo(kw.x) + q[1] * bfhi(kw.x) + q[2] * bflo(kw.y) + q[3] * bfhi(kw.y) + q[4] * bflo(kw.z) + q[5] * bfhi(kw.z) + q[6] * bflo(kw.w) + q[7] * bfhi(kw.w);
                d += __shfl_xor(d, 1); d += __shfl_xor(d, 2); d += __shfl_xor(d, 4); d *= 0.125f; }
            lg[i] = d; mx = fmaxf(mx, d); }
        float l = 0.f, o[8];
#pragma unroll
        for (int c = 0; c < 8; ++c) o[c] = 0.f;
#pragma unroll
        for (int i = 0; i < 32; ++i) { const unsigned id = sel[wave * 32 + i];
            if (id != 0xFFFFu) { const float p = __expf(lg[i] - mx); l += p;
                const u32x4 vw = *(const u32x4*)(Vb + (size_t)id * 512 + 8 * lane);
                o[0] += p * bflo(vw.x); o[1] += p * bfhi(vw.x); o[2] += p * bflo(vw.y); o[3] += p * bfhi(vw.y); o[4] += p * bflo(vw.z); o[5] += p * bfhi(vw.z); o[6] += p * bflo(vw.w); o[7] += p * bfhi(vw.w); } }
#pragma unroll
        for (int c = 0; c < 8; ++c) so[wave * 512 + 8 * lane + c] = o[c];
        if ((lane & 7) == 0) { sml[(wave * 8 + (lane >> 3)) * 2] = mx; sml[(wave * 8 + (lane >> 3)) * 2 + 1] = l; }
        __syncthreads();
        {
            const int hh = tid >> 6; float M = -INFINITY;
#pragma unroll
            for (int w = 0; w < 8; ++w) M = fmaxf(M, sml[(w * 8 + hh) * 2]);
            float L = 0.f, acc = 0.f;
#pragma unroll
            for (int w = 0; w < 8; ++w) { const float mw = sml[(w * 8 + hh) * 2]; const float f = (mw == -INFINITY) ? 0.f : __expf(mw - M); L += f * sml[(w * 8 + hh) * 2 + 1]; acc += f * so[w * 512 + tid]; }
            Y[(size_t)t * 1536 + tid] = (bf16)f2bf(acc / L);
        }
        __syncthreads();
    }
}

constexpr int MA_KLD = 136, MA_VLD = 260;
constexpr int MA_LDS_K = 0, MA_LDS_V = 256 * MA_KLD * 2, MA_LDS_END = MA_LDS_V + 128 * MA_VLD * 2;
__device__ __forceinline__ void mem_attn_phase(const Params& P, LAS unsigned char* lds, int bid, int nblk) {
    const float* KMVM = (const float*)(P.ws + WS_KMVM); const bf16* MEMQ = (const bf16*)(P.ws + WS_MEMQ); bf16* Y = (bf16*)(P.ws + WS_Y);
    const float* qg = P.in[10]; const float* kg_ = P.in[11];
    const int tid = tid_opaque(), lane = tid & 63, wave = __builtin_amdgcn_readfirstlane(tid >> 6), l15 = lane & 15, kg = lane >> 4;
    const int h = bid & 3, sub = bid >> 2, nsub = nblk >> 2;
    LAS bf16* sK = (LAS bf16*)(lds + MA_LDS_K); LAS bf16* sV = (LAS bf16*)(lds + MA_LDS_V);
    for (int r = wave; r < 256; r += NW) {
        const f32x2 kv = *(const f32x2*)(KMVM + (size_t)r * 1024 + h * 128 + 2 * lane);
        const float ss = wave_sum(kv.x * kv.x + kv.y * kv.y); const float rk = 1.0f / sqrtf(ss * (1.0f / 128.0f) + NORM_EPS);
        *(LAS unsigned*)(sK + r * MA_KLD + 2 * lane) = pk2(kv.x * rk * kg_[2 * lane] * qg[2 * lane], kv.y * rk * kg_[2 * lane + 1] * qg[2 * lane + 1]);
        const f32x2 vv = *(const f32x2*)(KMVM + (size_t)r * 1024 + 512 + h * 128 + 2 * lane);
        sV[(2 * lane) * MA_VLD + r] = (bf16)f2bf(vv.x); sV[(2 * lane + 1) * MA_VLD + r] = (bf16)f2bf(vv.y);
    }
    __syncthreads();
    typedef short s8 __attribute__((ext_vector_type(8)));
    for (int tile = sub * NW + wave; tile < S_ / 16; tile += nsub * NW) {
        const int q = tile * 16 + l15;
        s8 bq[4]; float ss = 0.f;
#pragma unroll
        for (int ks = 0; ks < 4; ++ks) { const u32x4 w = *(const u32x4*)(MEMQ + (size_t)q * 512 + h * 128 + 32 * ks + 8 * kg); bq[ks] = __builtin_bit_cast(s8, w);
            ss += bflo(w.x) * bflo(w.x) + bfhi(w.x) * bfhi(w.x) + bflo(w.y) * bflo(w.y) + bfhi(w.y) * bfhi(w.y) + bflo(w.z) * bflo(w.z) + bfhi(w.z) * bfhi(w.z) + bflo(w.w) * bflo(w.w) + bfhi(w.w) * bfhi(w.w); }
        ss = sum_x16(ss); ss = sum_x32(ss);
        const float rq = 1.0f / sqrtf(ss * (1.0f / 128.0f) + NORM_EPS) * 0.08838834764831845f;
        float lg[16][4]; float mx = -INFINITY;
#pragma unroll
        for (int kt = 0; kt < 16; ++kt) { f32x4 acc = {0.f, 0.f, 0.f, 0.f};
#pragma unroll
            for (int ks = 0; ks < 4; ++ks) { const s8 a = *(const LAS s8*)(sK + (16 * kt + l15) * MA_KLD + 32 * ks + 8 * kg); acc = __builtin_amdgcn_mfma_f32_16x16x32_bf16(a, bq[ks], acc, 0, 0, 0); }
#pragma unroll
            for (int r = 0; r < 4; ++r) { lg[kt][r] = acc[r] * rq; mx = fmaxf(mx, lg[kt][r]); } }
        mx = max_x16(mx); mx = max_x32(mx);
        float l = 0.f;
#pragma unroll
        for (int kt = 0; kt < 16; ++kt)
#pragma unroll
            for (int r = 0; r < 4; ++r) { lg[kt][r] = __expf(lg[kt][r] - mx); l += lg[kt][r]; }
        l = sum_x16(l); l = sum_x32(l);
        const float il = 1.0f / l;
        s8 pb[8];
#pragma unroll
        for (int s = 0; s < 8; ++s) { u32x4 w; w.x = pk2(lg[2 * s][0] * il, lg[2 * s][1] * il); w.y = pk2(lg[2 * s][2] * il, lg[2 * s][3] * il); w.z = pk2(lg[2 * s + 1][0] * il, lg[2 * s + 1][1] * il); w.w = pk2(lg[2 * s + 1][2] * il, lg[2 * s + 1][3] * il);
            pb[s] = __builtin_bit_cast(s8, w); }
#pragma unroll
        for (int dt = 0; dt < 8; ++dt) { f32x4 acc = {0.f, 0.f, 0.f, 0.f};
#pragma unroll
            for (int s = 0; s < 8; ++s) { const LAS bf16* vp = sV + (16 * dt + l15) * MA_VLD + 32 * s + 4 * kg; const u32x2 lo = *(const LAS u32x2*)vp, hi = *(const LAS u32x2*)(vp + 16);
                u32x4 w; w.x = lo.x; w.y = lo.y; w.z = hi.x; w.w = hi.y; acc = __builtin_amdgcn_mfma_f32_16x16x32_bf16(__builtin_bit_cast(s8, w), pb[s], acc, 0, 0, 0); }
            st_bf4(Y + (size_t)q * 1536 + 1024 + h * 128 + 16 * dt + 4 * kg, acc); }
    }
}

__device__ __forceinline__ void rstdh_phase(const Params& P, int bid, int nblk) {
    const float* HSQ = (const float*)(P.ws + WS_HSQ); float* R = (float*)(P.ws + WS_RSTDH);
    for (int r = bid * NT + tid_opaque(); r < S_; r += nblk * NT) { float s = 0.f;
#pragma unroll
        for (int i = 0; i < 16; ++i) s += HSQ[(size_t)r * 16 + i];
        R[r] = 1.0f / sqrtf(s * (1.0f / 1024.0f) + NORM_EPS); }
}
#define BUBBLE16(v, ix, x, c) do { if ((x) > v[15]) { v[15] = (x); ix[15] = (c); _Pragma("unroll") for (int _p = 15; _p > 0; --_p) { \
        const bool _sw = v[_p] > v[_p - 1]; const float _a = v[_p], _b = v[_p - 1]; const int _ia = ix[_p], _ib = ix[_p - 1]; \
        v[_p] = _sw ? _b : _a; v[_p - 1] = _sw ? _a : _b; ix[_p] = _sw ? _ib : _ia; ix[_p - 1] = _sw ? _ia : _ib; } } } while (0)
__device__ __forceinline__ void peer_topk_phase(const Params& P, LAS unsigned char* lds, int h, int bid, int nblk) {
    const float* SC = (const float*)(P.ws + WS_SC); int* EIDX = (int*)(P.ws + WS_EIDX); float* EG = (float*)(P.ws + WS_EGATE);
    LAS float* sv = (LAS float*)lds; LAS int* sx = (LAS int*)(lds + 256 * 2 * 16 * 4);
    const int tid = tid_opaque(), rl = tid >> 1, half = tid & 1;
    for (int r0 = bid * 256; r0 < S_; r0 += nblk * 256) {
        const int row = r0 + rl;
        float v[16]; int ix[16];
#pragma unroll
        for (int p = 0; p < 16; ++p) { v[p] = -INFINITY; ix[p] = 0; }
        const f32x4* sp = (const f32x4*)(SC + (size_t)row * 256 + half * 128);
        for (int c4 = 0; c4 < 32; ++c4) { const f32x4 x = sp[c4];
#pragma unroll
            for (int j = 0; j < 4; ++j) { const float xv = x[j]; const int cc = 4 * c4 + j; BUBBLE16(v, ix, xv, cc); } }
#pragma unroll
        for (int p = 0; p < 16; ++p) { sv[(rl * 2 + half) * 16 + p] = v[p]; sx[(rl * 2 + half) * 16 + p] = ix[p]; }
        __syncthreads();
        if (half == 0) {
            float cv[16]; int ci[16];
#pragma unroll
            for (int p = 0; p < 16; ++p) { cv[p] = -INFINITY; ci[p] = 0; }
            for (int i = 0; i < 16; ++i) { const float a = sv[(rl * 2) * 16 + i];
                for (int j = 0; j < 16; ++j) { const float s = a + sv[(rl * 2 + 1) * 16 + j]; const int f = i * 16 + j; BUBBLE16(cv, ci, s, f); } }
            float l = 0.f, pe[16];
#pragma unroll
            for (int p = 0; p < 16; ++p) { pe[p] = __expf(cv[p] - cv[0]); l += pe[p]; }
            const float il = 1.0f / l;
#pragma unroll
            for (int p = 0; p < 16; ++p) { const int e1 = sx[(rl * 2) * 16 + (ci[p] >> 4)], e2 = sx[(rl * 2 + 1) * 16 + (ci[p] & 15)];
                EIDX[(size_t)row * 128 + h * 16 + p] = e1 * 128 + e2; EG[(size_t)row * 128 + h * 16 + p] = pe[p] * il; }
        }
        __syncthreads();
    }
}
__device__ __forceinline__ void peer_expert_phase_v1(const Params& P, int bid, int nblk) {
    const int* EIDX = (const int*)(P.ws + WS_EIDX); const float* EG = (const float*)(P.ws + WS_EGATE); const float* HSQ = (const float*)(P.ws + WS_HSQ);
    const float* U = P.in[29]; const float* Vt = P.in[30]; const float* gain = P.in[25];
    const int tid = tid_opaque(), lane = tid & 63, wave = tid >> 6;
    for (int row = bid * NW + wave; row < S_; row += nblk * NW) {
        float* hp = P.out + (size_t)row * 1024; const float rs = rstd_h_row(HSQ, row);
        f32x4 hv[4], xn[4], o[4];
#pragma unroll
        for (int j = 0; j < 4; ++j) { hv[j] = *(const f32x4*)(hp + 4 * lane + 256 * j); xn[j] = hv[j] * rs * *(const f32x4*)(gain + 4 * lane + 256 * j); o[j] = (f32x4){0.f, 0.f, 0.f, 0.f}; }
        const int e_lo = EIDX[(size_t)row * 128 + lane], e_hi = EIDX[(size_t)row * 128 + 64 + lane];
        const float g_lo = EG[(size_t)row * 128 + lane], g_hi = EG[(size_t)row * 128 + 64 + lane];
        for (int e = 0; e < 128; ++e) {
            const int idx = __shfl((e < 64) ? e_lo : e_hi, e & 63); const float gt = __shfl((e < 64) ? g_lo : g_hi, e & 63);
            const float* up = U + (size_t)idx * 1024; float d = 0.f;
#pragma unroll
            for (int j = 0; j < 4; ++j) { const f32x4 uv = *(const f32x4*)(up + 4 * lane + 256 * j); d += (xn[j][0] * uv[0] + xn[j][1] * uv[1]) + (xn[j][2] * uv[2] + xn[j][3] * uv[3]); }
            d = wave_sum(d);
            const float w = gt * 0.5f * d * (1.0f + erff(d * 0.70710678118654752f));
            const float* vp = Vt + (size_t)idx * 1024;
#pragma unroll
            for (int j = 0; j < 4; ++j) o[j] = o[j] + *(const f32x4*)(vp + 4 * lane + 256 * j) * w;
        }
#pragma unroll
        for (int j = 0; j < 4; ++j) *(f32x4*)(hp + 4 * lane + 256 * j) = hv[j] + o[j];
    }
}
struct EpiPQ {
    half_t* PQ; const float* HSQ;
    __device__ __forceinline__ void operator()(AccRef acc, const pg8::Unit& u, int wr, int wc, int fr, int fq) const {
#pragma unroll
        for (int ai = 0; ai < 2; ++ai)
#pragma unroll
            for (int m = 0; m < 4; ++m) { const int row = u.pm * 256 + ai * 128 + wr * 64 + m * 16 + fr;
                const f32x4* hp = (const f32x4*)(HSQ + (size_t)row * 16); const f32x4 a = hp[0], b = hp[1], c = hp[2], d = hp[3];
                const float s = ((a[0] + a[1]) + (a[2] + a[3])) + ((b[0] + b[1]) + (b[2] + b[3])) + ((c[0] + c[1]) + (c[2] + c[3])) + ((d[0] + d[1]) + (d[2] + d[3]));
                const float rs = 1.0f / sqrtf(s * (1.0f / 1024.0f) + NORM_EPS);
                half_t* dst = PQ + (size_t)row * 2048 + u.pn * 256 + 32 * wc + 4 * fq;
#pragma unroll
                for (int bj = 0; bj < 2; ++bj)
#pragma unroll
                    for (int n = 0; n < 2; ++n) st_h4(dst + 128 * bj + 16 * n, acc[ai][bj][m][n] * rs); }
    }
};
#define UBUBBLE16(v, x) do { if ((x) > v[15]) { v[15] = (x); _Pragma("unroll") for (int _p = 15; _p > 0; --_p) { const unsigned _a = v[_p], _b = v[_p - 1]; v[_p] = min(_a, _b); v[_p - 1] = max(_a, _b); } } } while (0)
__device__ __forceinline__ void peer_topk_tile(const float* scr, int pm, int head, int* EIDX, float* EG, LAS unsigned* xl) {
    const int tid = tid_opaque(), lrow = tid >> 1, kh = tid & 1;
    unsigned v[16];
#pragma unroll
    for (int p = 0; p < 16; ++p) v[p] = 0u;
    const f32x4* sp = (const f32x4*)(scr + (size_t)lrow * 256 + kh * 128);
#pragma unroll 1
    for (int c4 = 0; c4 < 32; ++c4) { const f32x4 x = sp[c4];
#pragma unroll
        for (int j = 0; j < 4; ++j) { const unsigned ku = (ordkey(x[j]) & ~127u) | (unsigned)(127 - (4 * c4 + j)); UBUBBLE16(v, ku); } }
    unsigned k1[16], k2[16];
#pragma unroll
    for (int p = 0; p < 16; ++p) { const unsigned ov = dppu<0xB1>(v[p]); k1[p] = kh ? ov : v[p]; k2[p] = kh ? v[p] : ov; }
    LAS unsigned* myx = xl + tid * 33;
#pragma unroll
    for (int p = 0; p < 16; ++p) { myx[p] = 127u - (k1[p] & 127u); myx[16 + p] = 127u - (k2[p] & 127u); }
    float f1[16], f2[16];
#pragma unroll
    for (int p = 0; p < 16; ++p) { f1[p] = inv_ordkey(k1[p] & ~127u); f2[p] = inv_ordkey(k2[p] & ~127u); }
    unsigned cv[16];
#pragma unroll
    for (int p = 0; p < 16; ++p) cv[p] = 0u;
#pragma unroll
    for (int I = 0; I < 16; ++I) {
#pragma unroll
        for (int J = 0; J < 16; ++J) if ((I + 1) * (J + 1) <= 16) { const unsigned ku = (ordkey(f1[I] + f2[J]) & ~255u) | (unsigned)(255 - (16 * I + J)); UBUBBLE16(cv, ku); } }
    if (kh == 0) {
        float l = 0.f, pe[16]; const float top = inv_ordkey(cv[0] & ~255u);
#pragma unroll
        for (int p = 0; p < 16; ++p) { pe[p] = __expf(inv_ordkey(cv[p] & ~255u) - top); l += pe[p]; }
        const float il = 1.0f / l; const int row = pm * 256 + lrow;
        int* ep = EIDX + (size_t)row * 128 + head * 16; float* gp = EG + (size_t)row * 128 + head * 16;
        int ce[16];
#pragma unroll
        for (int p = 0; p < 16; ++p) { const unsigned f = 255u - (cv[p] & 255u); ce[p] = (int)(myx[f >> 4] * 128u + myx[16 + (f & 15u)]); }
#pragma unroll
        for (int p4 = 0; p4 < 4; ++p4) { *(f32x4*)(gp + 4 * p4) = (f32x4){pe[4 * p4] * il, pe[4 * p4 + 1] * il, pe[4 * p4 + 2] * il, pe[4 * p4 + 3] * il};
            typedef int i32x4 __attribute__((ext_vector_type(4))); *(i32x4*)(ep + 4 * p4) = (i32x4){ce[4 * p4], ce[4 * p4 + 1], ce[4 * p4 + 2], ce[4 * p4 + 3]}; }
    }
}
struct EpiTile {
    float* scr;
    __device__ __forceinline__ void operator()(AccRef acc, const pg8::Unit& u, int wr, int wc, int fr, int fq) const {
#pragma unroll
        for (int ai = 0; ai < 2; ++ai)
#pragma unroll
            for (int m = 0; m < 4; ++m) { float* dst = scr + (size_t)(ai * 128 + wr * 64 + m * 16 + fr) * 256 + 32 * wc + 4 * fq;
#pragma unroll
                for (int bj = 0; bj < 2; ++bj)
#pragma unroll
                    for (int n = 0; n < 2; ++n) *(f32x4*)(dst + 128 * bj + 16 * n) = acc[ai][bj][m][n]; }
    }
};
typedef _Float16 h8 __attribute__((ext_vector_type(8)));
struct LayoutExact { static constexpr int CAP = 1280, NK = 20, CS = 0, CI = 16 * 1280 * 4, CNT = CI + 16 * 1280 * 2, TAU = CNT + 64, HIST = TAU + 64, SELST = HIST + 8 * 256 * 4; };
struct LayoutFast { static constexpr int CAP = 1024, NK = 16, CS = 0, CI = 16 * 1024 * 4, B = CI + 16 * 1024 * 2, BCAP = 1280, CNT = B + 16 * BCAP * 2, TAU = CNT + 64, CNTB = TAU + 64, FLAG = CNTB + 64, HIST = FLAG + 64, SELST = HIST + 8 * 256 * 4, END = SELST + 8 * 512; };
__device__ __forceinline__ float relu_bits(float x) { return __builtin_bit_cast(float, max(__builtin_bit_cast(int, x), 0)); }
constexpr int DQ = 16, DCAP = 1280, DSTEP_TILES = 32, DNK = DCAP / 64;
constexpr int DA_CS = 0, DA_CI = DQ * DCAP * 4, DA_CNT = DA_CI + DQ * DCAP * 2, DA_TAU = DA_CNT + 64, DA_HIST = DA_TAU + 64, DA_SELST = DA_HIST + 8 * 256 * 4, DA_END = (DA_SELST + 8 * 512 > LayoutFast::END) ? DA_SELST + 8 * 512 : LayoutFast::END;

__device__ __forceinline__ unsigned wave_incl_scan_u32(unsigned v) {
    v += (unsigned)__builtin_amdgcn_update_dpp(0, (int)v, 0x111, 0xf, 0xf, false); v += (unsigned)__builtin_amdgcn_update_dpp(0, (int)v, 0x112, 0xf, 0xf, false);
    v += (unsigned)__builtin_amdgcn_update_dpp(0, (int)v, 0x114, 0xf, 0xf, false); v += (unsigned)__builtin_amdgcn_update_dpp(0, (int)v, 0x118, 0xf, 0xf, false);
    v += (unsigned)__builtin_amdgcn_update_dpp(0, (int)v, 0x142, 0xa, 0xf, false); v += (unsigned)__builtin_amdgcn_update_dpp(0, (int)v, 0x143, 0xc, 0xf, false);
    return v;
}
__device__ __forceinline__ unsigned wave_umin(unsigned x) { x = min(x, dppu<0xB1>(x)); x = min(x, dppu<0x4E>(x)); x = min(x, dppu<0x141>(x)); x = min(x, dppu<0x140>(x));
    unsigned a, b; pl16(x, a, b); x = min(a, b); pl32(x, a, b); return min(a, b); }
__device__ __forceinline__ unsigned wave_umax(unsigned x) { x = max(x, dppu<0xB1>(x)); x = max(x, dppu<0x4E>(x)); x = max(x, dppu<0x141>(x)); x = max(x, dppu<0x140>(x));
    unsigned a, b; pl16(x, a, b); x = max(a, b); pl32(x, a, b); return max(a, b); }
template <int NK> __device__ __forceinline__ unsigned radix_pass(LAS unsigned* hist, const unsigned (&dg)[NK], unsigned& alive, unsigned& krem, unsigned& nd, int lane) {
    *(LAS u32x4*)(hist + 4 * lane) = (u32x4){0u, 0u, 0u, 0u};
#pragma unroll
    for (int k = 0; k < NK; ++k) if (alive & (1u << k)) atomicAdd((unsigned*)&hist[dg[k]], 1u);
    LDS_WAIT();
    const u32x4 h4 = *(const LAS u32x4*)(hist + 252 - 4 * lane);
    const unsigned P = wave_incl_scan_u32(h4.x + h4.y + h4.z + h4.w);
    const unsigned S0 = P, S1 = P - h4.x, S2 = S1 - h4.y, S3 = S2 - h4.z;
    const int nge = __popcll(__ballot(S0 >= krem)) + __popcll(__ballot(S1 >= krem)) + __popcll(__ballot(S2 >= krem)) + __popcll(__ballot(S3 >= krem));
    const int d = nge - 1, ld = (255 - d) >> 2, comp = d & 3;
    const unsigned Sd = (comp == 0) ? __builtin_amdgcn_readlane(S0, ld) : (comp == 1) ? __builtin_amdgcn_readlane(S1, ld) : (comp == 2) ? __builtin_amdgcn_readlane(S2, ld) : __builtin_amdgcn_readlane(S3, ld);
    nd = (comp == 0) ? __builtin_amdgcn_readlane(h4.x, ld) : (comp == 1) ? __builtin_amdgcn_readlane(h4.y, ld) : (comp == 2) ? __builtin_amdgcn_readlane(h4.z, ld) : __builtin_amdgcn_readlane(h4.w, ld);
    krem -= (Sd - nd);
#pragma unroll
    for (int k = 0; k < NK; ++k) if (dg[k] != (unsigned)d) alive &= ~(1u << k);
    LDS_WAIT();
    return (unsigned)d;
}
template <int NK, bool USE_LO> __device__ __forceinline__ void radix_kth(LAS unsigned* hist, const unsigned (&hi)[NK], const unsigned (&lo)[NK], unsigned valid, unsigned K, int n, int lane, unsigned& Thi, unsigned& Tlo) {
    unsigned alive = valid, mn = 0xFFFFFFFFu, mxv = 0u;
#pragma unroll
    for (int k = 0; k < NK; ++k) if ((valid >> k) & 1u) { mn = min(mn, hi[k]); mxv = max(mxv, hi[k]); }
    mn = wave_umin(mn); mxv = wave_umax(mxv);
    unsigned krem = K, nd = (unsigned)n; Thi = mn; Tlo = 0u;
    const unsigned diff = mn ^ mxv;
    if (diff != 0u) {
        const int first = (31 - __builtin_clz(diff)) >> 3;
        Thi = (first == 3) ? 0u : (mn & ~((1u << (8 * (first + 1))) - 1u));
#pragma unroll 1
        for (int byte = first; byte >= 0; --byte) { unsigned dg[NK];
#pragma unroll
            for (int k = 0; k < NK; ++k) dg[k] = (hi[k] >> (8 * byte)) & 255u;
            Thi |= radix_pass<NK>(hist, dg, alive, krem, nd, lane) << (8 * byte); }
    }
    if (USE_LO && nd != krem) {
#pragma unroll 1
        for (int byte = 1; byte >= 0; --byte) { unsigned dg[NK];
#pragma unroll
            for (int k = 0; k < NK; ++k) dg[k] = (lo[k] >> (8 * byte)) & 255u;
            Tlo |= radix_pass<NK>(hist, dg, alive, krem, nd, lane) << (8 * byte); }
    }
}
template <class L> __device__ __forceinline__ void dsa_compact(LAS unsigned char* lds, int q, int lane, int wave) {
    constexpr int DNK = L::NK;
    LAS float* cs = (LAS float*)(lds + L::CS) + q * L::CAP; LAS u16* ci = (LAS u16*)(lds + L::CI) + q * L::CAP;
    LAS unsigned* cnt = (LAS unsigned*)(lds + L::CNT); LAS float* tau = (LAS float*)(lds + L::TAU); LAS unsigned* hist = (LAS unsigned*)(lds + L::HIST) + wave * 256;
    const int n = (int)cnt[q];
    if (n <= 256) return;
    unsigned hi[DNK], lo[DNK]; unsigned valid = 0u;
#pragma unroll
    for (int k = 0; k < DNK; ++k) { const int e = lane + 64 * k; const bool v = e < n; hi[k] = v ? ordkey(cs[e]) : 0u; lo[k] = v ? (0xFFFFu - (unsigned)ci[e]) : 0u; if (v) valid |= 1u << k; }
    unsigned Thi, Tlo; radix_kth<DNK, true>(hist, hi, lo, valid, 256u, n, lane, Thi, Tlo);
    unsigned base = 0u;
#pragma unroll
    for (int k = 0; k < DNK; ++k) { const bool keep = ((valid >> k) & 1u) && (hi[k] > Thi || (hi[k] == Thi && lo[k] >= Tlo));
        const unsigned long long b = __ballot(keep);
        if (keep) { const unsigned pos = base + (unsigned)__popcll(b & ((1ull << lane) - 1ull)); cs[pos] = inv_ordkey(hi[k]); ci[pos] = (u16)(0xFFFFu - lo[k]); }
        base += (unsigned)__popcll(b); }
    if (lane == 0) { cnt[q] = 256u; tau[q] = inv_ordkey(Thi); }
}
template <class L> __device__ __forceinline__ void dsa_emit_sel(LAS unsigned char* lds, u16* SEL, int tq_, int q, int m, int lane, int wave) {
    LAS u16* st = (LAS u16*)(lds + L::SELST) + wave * 256; const LAS u16* cq = (LAS u16*)(lds + L::CI) + q * L::CAP;
    LAS unsigned* bm = (LAS unsigned*)((LAS float*)(lds + L::CS) + q * L::CAP);
    unsigned id[4];
#pragma unroll
    for (int k = 0; k < 4; ++k) { const int e = lane + 64 * k; id[k] = (e < m) ? (unsigned)cq[e] : 0xFFFFu; }
    *(LAS u32x4*)(bm + 8 * lane) = (u32x4){0u, 0u, 0u, 0u}; *(LAS u32x4*)(bm + 8 * lane + 4) = (u32x4){0u, 0u, 0u, 0u};
    *(LAS u32x2*)(st + 4 * lane) = (u32x2){0xFFFFFFFFu, 0xFFFFFFFFu};
    LDS_WAIT();
#pragma unroll
    for (int k = 0; k < 4; ++k) if (id[k] != 0xFFFFu) atomicOr((unsigned*)&bm[id[k] >> 5], 1u << (id[k] & 31u));
    LDS_WAIT();
    const u32x4 w0 = *(const LAS u32x4*)(bm + 8 * lane), w1 = *(const LAS u32x4*)(bm + 8 * lane + 4);
    unsigned wd[8] = {w0.x, w0.y, w0.z, w0.w, w1.x, w1.y, w1.z, w1.w};
    unsigned c = 0u;
#pragma unroll
    for (int j = 0; j < 8; ++j) c += (unsigned)__popc(wd[j]);
    unsigned pos = wave_incl_scan_u32(c) - c;
#pragma unroll
    for (int j = 0; j < 8; ++j) { unsigned wv = wd[j];
        while (wv) { const unsigned b = (unsigned)__builtin_ctz(wv); st[pos++] = (u16)(256u * (unsigned)lane + 32u * (unsigned)j + b); wv &= wv - 1u; } }
    LDS_WAIT();
    *(u32x2*)(SEL + (size_t)tq_ * 256 + 4 * lane) = *(const LAS u32x2*)(st + 4 * lane);
    LDS_WAIT();
}

__device__ __forceinline__ void dsa_index_item_exact(const Params& P, LAS unsigned char* lds, int item) {
    const half_t* IQ = (const half_t*)(P.ws + WS_IQ); const half_t* IK = (const half_t*)(P.ws + WS_IK); const float* IW = (const float*)(P.ws + WS_IW); u16* SEL = (u16*)(P.ws + WS_SEL);
    LAS float* cs = (LAS float*)(lds + DA_CS); LAS u16* ci = (LAS u16*)(lds + DA_CI); LAS unsigned* cnt = (LAS unsigned*)(lds + DA_CNT); LAS float* tau = (LAS float*)(lds + DA_TAU);
    const int tid = tid_opaque(), lane = tid & 63, wave = __builtin_amdgcn_readfirstlane(tid >> 6), qq = lane & 15, kg = lane >> 4;
    const int q0 = item * DQ, t = q0 + qq, ntiles = item + 1;
    h8 bq[4][2]; float w[4];
#pragma unroll
    for (int h = 0; h < 4; ++h) { w[h] = IW[(size_t)t * 4 + h] * 0.0625f;
#pragma unroll
        for (int ks = 0; ks < 2; ++ks) bq[h][ks] = *(const h8*)(IQ + (size_t)t * 256 + h * 64 + ks * 32 + kg * 8); }
    if (tid < DQ) { cnt[tid] = 0u; tau[tid] = -INFINITY; }
    __syncthreads();
    float tq = -INFINITY;
    h8 a0[4], a1[4];
#pragma unroll
    for (int g = 0; g < 4; ++g) { const int tile = min(g * 8 + wave, ntiles - 1); const half_t* kp = IK + (size_t)(tile) * 1024 + lane * 8; a0[g] = *(const h8*)kp; a1[g] = *(const h8*)(kp + 512); }
    for (int base = 0; base < ntiles; base += DSTEP_TILES) {
        PROBE_T0(2, lds)
        h8 n0[4], n1[4];
#pragma unroll
        for (int g = 0; g < 4; ++g) { const int tile = min(base + DSTEP_TILES + g * 8 + wave, ntiles - 1); const half_t* kp = IK + (size_t)(tile) * 1024 + lane * 8; n0[g] = *(const h8*)kp; n1[g] = *(const h8*)(kp + 512); }
        float sc[4][4]; unsigned pb = 0u;
#pragma unroll
        for (int g = 0; g < 4; ++g) { const int tile = base + g * 8 + wave; const int s0 = tile * 16;
#pragma unroll
            for (int r = 0; r < 4; ++r) sc[g][r] = 0.f;
#pragma unroll
            for (int h = 0; h < 4; ++h) { f32x4 acc = {0.f, 0.f, 0.f, 0.f};
                acc = __builtin_amdgcn_mfma_f32_16x16x32_f16(a0[g], bq[h][0], acc, 0, 0, 0); acc = __builtin_amdgcn_mfma_f32_16x16x32_f16(a1[g], bq[h][1], acc, 0, 0, 0);
#pragma unroll
                for (int r = 0; r < 4; ++r) sc[g][r] += w[h] * fmaxf(acc[r], 0.f); }
#pragma unroll
            for (int r = 0; r < 4; ++r) { sc[g][r] += 0.0f; if (tile < ntiles && sc[g][r] > tq && s0 + 4 * kg + r <= t) pb |= 1u << (4 * g + r); } }
        if (__ballot(pb != 0u) != 0ull) {
            unsigned pos = 0u; if (pb) pos = atomicAdd((unsigned*)&cnt[qq], (unsigned)__popc(pb));
#pragma unroll
            for (int g = 0; g < 4; ++g)
#pragma unroll
                for (int r = 0; r < 4; ++r) if (pb & (1u << (4 * g + r))) { cs[qq * DCAP + pos] = sc[g][r]; ci[qq * DCAP + pos] = (u16)((base + g * 8 + wave) * 16 + 4 * kg + r); ++pos; } }
#pragma unroll
        for (int g = 0; g < 4; ++g) { a0[g] = n0[g]; a1[g] = n1[g]; }
        __syncthreads();
        PROBE_T1(2, lds)
        unsigned mx = 0u;
        { const u32x4 c0 = *(const LAS u32x4*)(cnt), c1 = *(const LAS u32x4*)(cnt + 4), c2 = *(const LAS u32x4*)(cnt + 8), c3 = *(const LAS u32x4*)(cnt + 12);
          mx = max(max(max(c0.x, c0.y), max(c0.z, c0.w)), max(max(c1.x, c1.y), max(c1.z, c1.w))); mx = max(mx, max(max(max(c2.x, c2.y), max(c2.z, c2.w)), max(max(c3.x, c3.y), max(c3.z, c3.w)))); }
        if (mx > (unsigned)(DCAP - 512)) {
            PROBE_T0(1, lds)
            dsa_compact<LayoutExact>(lds, 2 * wave, lane, wave); dsa_compact<LayoutExact>(lds, 2 * wave + 1, lane, wave);
            __syncthreads();
            tq = tau[qq];
            PROBE_T1(1, lds)
        }
    }
    PROBE_T0(3, lds)
#pragma unroll 1
    for (int j = 0; j < 2; ++j) { const int q = 2 * wave + j;
        dsa_compact<LayoutExact>(lds, q, lane, wave);
        LDS_WAIT();
        dsa_emit_sel<LayoutExact>(lds, SEL, q0 + q, q, (int)cnt[q], lane, wave); }
    __syncthreads();
    PROBE_T1(3, lds)
}

constexpr int DFA_CAP = LayoutFast::CAP, DFB_CAP = LayoutFast::BCAP, DF_STRIDE = 8, DF_OFF = 5, DF_KS = 72, DF_MIN_TILES = 128;
__device__ __forceinline__ LAS u16* dfb_slot(LAS unsigned char* lds, int q, unsigned p) {
    return (LAS u16*)(lds + LayoutFast::B) + q * LayoutFast::BCAP + p;
}
__device__ __forceinline__ int ptile(int tile, int ntiles, int rot) { int p = min(tile, ntiles - 1) + rot; return p - ((p >= ntiles) ? ntiles : 0); }
__device__ __forceinline__ void dsa_index_item(const Params& P, LAS unsigned char* lds, int item) {
    if (item + 1 < DF_MIN_TILES) { dsa_index_item_exact(P, lds, item); return; }
    const half_t* IQ = (const half_t*)(P.ws + WS_IQ); const half_t* IK = (const half_t*)(P.ws + WS_IK); const float* IW = (const float*)(P.ws + WS_IW); u16* SEL = (u16*)(P.ws + WS_SEL);
    typedef LayoutFast L; constexpr int DCAP = L::CAP, DNK = L::NK;
    LAS float* cs = (LAS float*)(lds + L::CS); LAS u16* ci = (LAS u16*)(lds + L::CI); LAS unsigned* cnt = (LAS unsigned*)(lds + L::CNT); LAS float* tau = (LAS float*)(lds + L::TAU);
    LAS unsigned* cntb = (LAS unsigned*)(lds + L::CNTB); LAS unsigned* flag = (LAS unsigned*)(lds + L::FLAG); LAS unsigned* hist = (LAS unsigned*)(lds + L::HIST);
    const int tid = tid_opaque(), lane = tid & 63, wave = __builtin_amdgcn_readfirstlane(tid >> 6), qq = lane & 15, kg = lane >> 4;
    const int q0 = item * DQ, t = q0 + qq, ntiles = item + 1;
    h8 bq[4][2]; float w[4];
#pragma unroll
    for (int h = 0; h < 4; ++h) { w[h] = IW[(size_t)t * 4 + h] * 0.0625f;
#pragma unroll
        for (int ks = 0; ks < 2; ++ks) bq[h][ks] = *(const h8*)(IQ + (size_t)t * 256 + h * 64 + ks * 32 + kg * 8); }
    if (tid < DQ) { cnt[tid] = 0u; cntb[tid] = 0u; } if (tid == 0) flag[0] = 0u;
    __syncthreads();
    PROBE_T0(4, lds)
    for (int ts = DF_OFF + DF_STRIDE * wave; ts < item; ts += DF_STRIDE * NW) {
        const half_t* kp = IK + (size_t)(ts) * 1024 + lane * 8; const h8 a0 = *(const h8*)kp, a1 = *(const h8*)(kp + 512);
        float sc[4] = {0.f, 0.f, 0.f, 0.f};
#pragma unroll
        for (int h = 0; h < 4; ++h) { f32x4 acc = {0.f, 0.f, 0.f, 0.f};
            acc = __builtin_amdgcn_mfma_f32_16x16x32_f16(a0, bq[h][0], acc, 0, 0, 0); acc = __builtin_amdgcn_mfma_f32_16x16x32_f16(a1, bq[h][1], acc, 0, 0, 0);
#pragma unroll
            for (int r = 0; r < 4; ++r) sc[r] += w[h] * fmaxf(acc[r], 0.f); }
        const unsigned pos = atomicAdd((unsigned*)&cnt[qq], 4u);
        *(LAS u32x2*)((LAS u16*)(cs + qq * DCAP) + pos) = (u32x2){pk2(sc[0] + 0.0f, sc[1] + 0.0f), pk2(sc[2] + 0.0f, sc[3] + 0.0f)};
    }
    __syncthreads();
#pragma unroll 1
    for (int j = 0; j < 2; ++j) { const int q = 2 * wave + j; const int n = (int)cnt[q];
        unsigned hi[32], lo[32]; unsigned valid = 0u; const LAS u16* sq = (const LAS u16*)(cs + q * DCAP);
#pragma unroll
        for (int k2 = 0; k2 < 32; ++k2) { const int e = lane + 64 * k2; const bool v = e < n; hi[k2] = v ? (ordkey(bf2f(sq[v ? e : 0])) >> 16) : 0u; lo[k2] = 0u; if (v) valid |= 1u << k2; }
        unsigned Thi, Tlo; radix_kth<32, false>(hist + wave * 256, hi, lo, valid, (unsigned)DF_KS, n, lane, Thi, Tlo);
        Thi <<= 16;
        if (lane == 0) tau[q] = inv_ordkey(Thi); }
    __syncthreads();
    if (tid < DQ) cnt[tid] = 0u;
    const float tq = tau[qq];
    __syncthreads();
    PROBE_T1(4, lds)
    PROBE_T0(5, lds)
    {
        constexpr int DFG = 6;
        h8 a0[DFG], a1[DFG];
        const int rot = (int)(((unsigned)blockIdx.x * 2654435761u >> 8) % (unsigned)ntiles);
#pragma unroll
        for (int g = 0; g < DFG; ++g) { int tile = min(g * 8 + wave, ntiles - 1) + rot; tile -= (tile >= ntiles) ? ntiles : 0; const half_t* kp = IK + (size_t)(tile) * 1024 + lane * 8; a0[g] = *(const h8*)kp; a1[g] = *(const h8*)(kp + 512); }
        for (int base = 0; base < ntiles; base += 8 * DFG) {
            h8 n0[DFG], n1[DFG];
#pragma unroll
            for (int g = 0; g < DFG; ++g) { int tile = min(base + 8 * DFG + g * 8 + wave, ntiles - 1) + rot; tile -= (tile >= ntiles) ? ntiles : 0; const half_t* kp = IK + (size_t)(tile) * 1024 + lane * 8; n0[g] = *(const h8*)kp; n1[g] = *(const h8*)(kp + 512); }
            float sc[DFG][4]; unsigned pa = 0u, pb = 0u;
#pragma unroll
            for (int g = 0; g < DFG; ++g) { const int tile = base + g * 8 + wave; int pt = min(tile, ntiles - 1) + rot; pt -= (pt >= ntiles) ? ntiles : 0; const int s0 = pt * 16;
#pragma unroll
                for (int r = 0; r < 4; ++r) sc[g][r] = 0.f;
#pragma unroll
                for (int h = 0; h < 4; ++h) { f32x4 acc = {0.f, 0.f, 0.f, 0.f};
                    acc = __builtin_amdgcn_mfma_f32_16x16x32_f16(a0[g], bq[h][0], acc, 0, 0, 0); acc = __builtin_amdgcn_mfma_f32_16x16x32_f16(a1[g], bq[h][1], acc, 0, 0, 0);
#pragma unroll
                    for (int r = 0; r < 4; ++r) sc[g][r] += w[h] * relu_bits(acc[r]); }
#pragma unroll
                for (int r = 0; r < 4; ++r) { sc[g][r] += 0.0f; const bool ok = tile < ntiles && s0 + 4 * kg + r <= t;
                    if (ok && sc[g][r] > tq) pa |= 1u << (4 * g + r); if (ok && sc[g][r] == tq) pb |= 1u << (4 * g + r); } }
            if (__ballot((pa | pb) != 0u) != 0ull) {
                if (pa) { unsigned pos = atomicAdd((unsigned*)&cnt[qq], (unsigned)__popc(pa));
                    if (pos + (unsigned)__popc(pa) > (unsigned)DFA_CAP) atomicOr((unsigned*)&flag[0], 1u);
                    else {
#pragma unroll
                        for (int g = 0; g < DFG; ++g)
#pragma unroll
                            for (int r = 0; r < 4; ++r) if (pa & (1u << (4 * g + r))) { cs[qq * DCAP + pos] = sc[g][r]; ci[qq * DCAP + pos] = (u16)(ptile(base + g * 8 + wave, ntiles, rot) * 16 + 4 * kg + r); ++pos; } } }
                if (pb) { unsigned pos = atomicAdd((unsigned*)&cntb[qq], (unsigned)__popc(pb));
                    if (pos + (unsigned)__popc(pb) > (unsigned)DFB_CAP) atomicOr((unsigned*)&flag[0], 2u);
                    else {
#pragma unroll
                        for (int g = 0; g < DFG; ++g)
#pragma unroll
                            for (int r = 0; r < 4; ++r) if (pb & (1u << (4 * g + r))) { *dfb_slot(lds, qq, pos) = (u16)(ptile(base + g * 8 + wave, ntiles, rot) * 16 + 4 * kg + r); ++pos; } } }
            }
#pragma unroll
            for (int g = 0; g < DFG; ++g) { a0[g] = n0[g]; a1[g] = n1[g]; }
        }
    }
    __syncthreads();
    PROBE_T1(5, lds)
    bool bad = flag[0] != 0u;
#pragma unroll
    for (int q = 0; q < DQ; ++q) { const unsigned na = cnt[q], nb2 = cntb[q]; if (na < 256u && na + nb2 < 256u) bad = true; }
    if (bad) { PROBE_T0(7, lds) __syncthreads(); dsa_index_item_exact(P, lds, item); PROBE_T1(7, lds) return; }
    PROBE_T0(6, lds)
#pragma unroll 1
    for (int j = 0; j < 2; ++j) { const int q = 2 * wave + j; const int na = (int)cnt[q];
        int m = 256;
        if (na >= 256) { dsa_compact<LayoutFast>(lds, q, lane, wave); }
        else {
            const int nb2 = (int)cntb[q]; const unsigned need = (unsigned)(256 - na);
            unsigned hi[20], lo[20]; unsigned valid = 0u;
#pragma unroll
            for (int k2 = 0; k2 < 20; ++k2) { const int e = lane + 64 * k2; const bool v = e < nb2; hi[k2] = v ? (0xFFFFu - (unsigned)*dfb_slot(lds, q, (unsigned)(v ? e : 0))) : 0u; lo[k2] = 0u; if (v) valid |= 1u << k2; }
            unsigned Thi, Tlo; radix_kth<20, false>(hist + wave * 256, hi, lo, valid, need, nb2, lane, Thi, Tlo);
            unsigned base = (unsigned)na;
#pragma unroll
            for (int k2 = 0; k2 < 20; ++k2) { const bool keep = ((valid >> k2) & 1u) && hi[k2] >= Thi; const unsigned long long b = __ballot(keep);
                if (keep) ci[q * DCAP + base + (unsigned)__popcll(b & ((1ull << lane) - 1ull))] = (u16)(0xFFFFu - hi[k2]);
                base += (unsigned)__popcll(b); }
        }
        LDS_WAIT();
        dsa_emit_sel<LayoutFast>(lds, SEL, q0 + q, q, m, lane, wave); }
    __syncthreads();
    PROBE_T1(6, lds)
}

__device__ __forceinline__ void dsa_index_phase(const Params& P, LAS unsigned char* lds, int bid, int nblk) {
    constexpr int NITEMS = S_ / DQ;
    for (int r = 0;; ++r) { const int k = r * nblk + ((r & 1) ? (nblk - 1 - bid) : bid); if (k >= NITEMS) break; dsa_index_item(P, lds, NITEMS - 1 - k); }
}

typedef _Float16 hh2 __attribute__((ext_vector_type(2)));
__device__ __forceinline__ hh2 as_h2(unsigned u) { return __builtin_bit_cast(hh2, u); }
__device__ __forceinline__ float dot8h(const u32x4 a, const u32x4 b, float c) {
    c = __builtin_amdgcn_fdot2(as_h2(a.x), as_h2(b.x), c, false); c = __builtin_amdgcn_fdot2(as_h2(a.y), as_h2(b.y), c, false);
    c = __builtin_amdgcn_fdot2(as_h2(a.z), as_h2(b.z), c, false); c = __builtin_amdgcn_fdot2(as_h2(a.w), as_h2(b.w), c, false); return c; }
__device__ __forceinline__ void attn_issue(const half_t* Kb, const half_t* Vb, const LAS u16* sl, int qt, int g, u32x4 (&kq)[8], u32x4 (&vq)[8]) {
#pragma unroll
    for (int i = 0; i < 8; ++i) { const unsigned id = sl[(8 * qt + i) * 8 + g]; kq[i] = (u32x4){0u, 0u, 0u, 0u}; vq[i] = (u32x4){0u, 0u, 0u, 0u};
        if (id != 0xFFFFu) { kq[i] = *(const u32x4*)(Kb + (size_t)id * 64); vq[i] = *(const u32x4*)(Vb + (size_t)id * 64); } }
}
__device__ __forceinline__ void attn_consume(const LAS u16* sl, int qt, int g, const u32x4 qh, const u32x4 (&kq)[8], const u32x4 (&vq)[8], float& m, float& l, hh2 (&o2)[4]) {
    float lg[8]; float mx = m;
#pragma unroll
    for (int i = 0; i < 8; ++i) { float d = sum8(dot8h(kq[i], qh, 0.f)); d = (sl[(8 * qt + i) * 8 + g] != 0xFFFFu) ? d : -INFINITY; lg[i] = d; mx = fmaxf(mx, d); }
    if (mx != -INFINITY) {
        const float r = (m == -INFINITY) ? 0.f : __expf(m - mx); l *= r; const _Float16 rh = (_Float16)r; const hh2 r2 = {rh, rh};
#pragma unroll
        for (int c = 0; c < 4; ++c) o2[c] = o2[c] * r2;
#pragma unroll
        for (int i = 0; i < 8; ++i) { const float p = (lg[i] == -INFINITY) ? 0.f : __expf(lg[i] - mx); l += p; const _Float16 ph = (_Float16)p; const hh2 p2 = {ph, ph};
            o2[0] = __builtin_elementwise_fma(p2, as_h2(vq[i].x), o2[0]); o2[1] = __builtin_elementwise_fma(p2, as_h2(vq[i].y), o2[1]);
            o2[2] = __builtin_elementwise_fma(p2, as_h2(vq[i].z), o2[2]); o2[3] = __builtin_elementwise_fma(p2, as_h2(vq[i].w), o2[3]); }
        m = mx; }
}
__device__ __forceinline__ void dsa_attn_phase(const Params& P, LAS unsigned char* lds, int bid, int nblk) {
    const bf16* Q = (const bf16*)(P.ws + WS_Q); const half_t* Kh = (const half_t*)(P.ws + WS_K); const half_t* Vh = (const half_t*)(P.ws + WS_V); const u16* SEL = (const u16*)(P.ws + WS_SEL); bf16* Y = (bf16*)(P.ws + WS_Y);
    const int tid = tid_opaque(), lane = tid & 63, wave = __builtin_amdgcn_readfirstlane(tid >> 6), g = lane >> 3, c8 = (lane & 7) * 8;
    const int h = bid & 7, rank = bid >> 3, nr = (nblk >> 3) - 1, tstep = nr * 8;
    LAS u16* slb = (LAS u16*)lds + wave * 512;
    const half_t* Kb = Kh + (size_t)h * S_ * 64 + c8; const half_t* Vb = Vh + (size_t)h * S_ * 64 + c8;
    const int t0 = rank * 8 + wave;
    if (t0 >= S_) return;
    u32x4 kA[8], vA[8], kB[8], vB[8];
    *(LAS u32x2*)(slb + 4 * lane) = *(const u32x2*)(SEL + (size_t)t0 * 256 + 4 * lane);
    u32x4 qw = *(const u32x4*)(Q + (size_t)t0 * 512 + h * 64 + c8);
    LDS_WAIT(); __builtin_amdgcn_wave_barrier();
    attn_issue(Kb, Vb, slb, 0, g, kA, vA); attn_issue(Kb, Vb, slb, 1, g, kB, vB);
    int cur = 0;
    for (int t = t0; t < S_; t += tstep) {
        const LAS u16* sl = slb + cur * 256; LAS u16* sn = slb + (cur ^ 1) * 256;
        const int tn = (t + tstep < S_) ? t + tstep : t;
        u32x4 qh; qh.x = pk2h(bflo(qw.x) * 0.125f, bfhi(qw.x) * 0.125f); qh.y = pk2h(bflo(qw.y) * 0.125f, bfhi(qw.y) * 0.125f); qh.z = pk2h(bflo(qw.z) * 0.125f, bfhi(qw.z) * 0.125f); qh.w = pk2h(bflo(qw.w) * 0.125f, bfhi(qw.w) * 0.125f);
        const u32x2 selw = *(const u32x2*)(SEL + (size_t)tn * 256 + 4 * lane); qw = *(const u32x4*)(Q + (size_t)tn * 512 + h * 64 + c8);
        float m = -INFINITY, l = 0.f; hh2 o2[4];
#pragma unroll
        for (int c = 0; c < 4; ++c) o2[c] = (hh2){(_Float16)0.f, (_Float16)0.f};
        attn_consume(sl, 0, g, qh, kA, vA, m, l, o2); attn_issue(Kb, Vb, sl, 2, g, kA, vA);
        *(LAS u32x2*)(sn + 4 * lane) = selw;
        attn_consume(sl, 1, g, qh, kB, vB, m, l, o2); attn_issue(Kb, Vb, sl, 3, g, kB, vB);
        LDS_WAIT(); __builtin_amdgcn_wave_barrier();
        attn_consume(sl, 2, g, qh, kA, vA, m, l, o2); attn_issue(Kb, Vb, sn, 0, g, kA, vA);
        attn_consume(sl, 3, g, qh, kB, vB, m, l, o2); attn_issue(Kb, Vb, sn, 1, g, kB, vB);
        float M = fmaxf(m, dppf<0x128>(m)); M = max_x16(M); M = max_x32(M);
        const float f = (m == -INFINITY) ? 0.f : __expf(m - M);
        float o[8];
#pragma unroll
        for (int c = 0; c < 4; ++c) { o[2 * c] = (float)o2[c].x * f; o[2 * c + 1] = (float)o2[c].y * f; }
        l *= f; l += dppf<0x128>(l); l = sum_x16(l); l = sum_x32(l);
#pragma unroll
        for (int c = 0; c < 8; ++c) { o[c] += dppf<0x128>(o[c]); o[c] = sum_x16(o[c]); o[c] = sum_x32(o[c]); }
        const float il = 1.0f / l;
        if (g == 0) { u32x4 w4; w4.x = pk2(o[0] * il, o[1] * il); w4.y = pk2(o[2] * il, o[3] * il); w4.z = pk2(o[4] * il, o[5] * il); w4.w = pk2(o[6] * il, o[7] * il);
            *(u32x4*)(Y + (size_t)t * 1536 + h * 64 + c8) = w4; }
        cur ^= 1;
    }
}
constexpr int RC = 64, RLD = 72, RARR = 64 * RLD * 2;
constexpr int RO_AT = 0, RO_ATT = RARR, RO_RT = 2 * RARR, RO_BT = 3 * RARR, RO_KT = 4 * RARR, RO_VT = 5 * RARR, RO_WT = 6 * RARR, RO_P1 = 7 * RARR, RO_P2 = 8 * RARR, RO_P3 = 9 * RARR, RO_P4 = 10 * RARR,
              RO_S0 = 11 * RARR, RO_F1 = 12 * RARR, RO_F2 = RO_F1 + 16384, RO_END = RO_F2 + 16384;
typedef short s16x8 __attribute__((ext_vector_type(8)));

__device__ __forceinline__ f32x4 mm16(const LAS bf16* A, const LAS bf16* B, int tr, int tc, int l15, int kg, f32x4 acc) {
#pragma unroll
    for (int ks = 0; ks < 2; ++ks) { const s16x8 a = *(const LAS s16x8*)(A + (16 * tr + l15) * RLD + 32 * ks + 8 * kg); const s16x8 b = *(const LAS s16x8*)(B + (16 * tc + l15) * RLD + 32 * ks + 8 * kg);
        acc = __builtin_amdgcn_mfma_f32_16x16x32_bf16(a, b, acc, 0, 0, 0); }
    return acc;
}
template <int MASK> __device__ __forceinline__ void st_tile(LAS bf16* Out, int tr, int tc, int l15, int kg, f32x4 acc) {
    const int col = 16 * tc + l15, row0 = 16 * tr + 4 * kg;
#pragma unroll
    for (int r = 0; r < 4; ++r) { const int row = row0 + r; bool keep = true; if (MASK == 1) keep = col < row; if (MASK == 2) keep = row < col; if (MASK == 3) keep = row <= col; if (!keep) acc[r] = 0.f; }
    u32x2 w; w.x = pk2(acc[0], acc[1]); w.y = pk2(acc[2], acc[3]);
    *(LAS u32x2*)(Out + col * RLD + row0) = w;
}
__device__ __forceinline__ void ld8(const bf16* p, float* o) { const u32x4 w = *(const u32x4*)p; o[0] = bflo(w.x); o[1] = bfhi(w.x); o[2] = bflo(w.y); o[3] = bfhi(w.y); o[4] = bflo(w.z); o[5] = bfhi(w.z); o[6] = bflo(w.w); o[7] = bfhi(w.w); }
__device__ __forceinline__ void ldf8(const float* p, float* o) { const f32x4 a = *(const f32x4*)p, b = *(const f32x4*)(p + 4); o[0] = a[0]; o[1] = a[1]; o[2] = a[2]; o[3] = a[3]; o[4] = b[0]; o[5] = b[1]; o[6] = b[2]; o[7] = b[3]; }
__device__ __forceinline__ u32x4 pk8(const float* v) { u32x4 w; w.x = pk2(v[0], v[1]); w.y = pk2(v[2], v[3]); w.z = pk2(v[4], v[5]); w.w = pk2(v[6], v[7]); return w; }

struct RwBufs { const bf16* RWP; const bf16* Eb; const bf16* Ab; const bf16* Gb; bf16* MT; bf16* Nn; bf16* S0; bf16* Y; };
__device__ __forceinline__ RwBufs rw_bufs(const Params& P) {
    RwBufs b; unsigned char* dob = (unsigned char*)P.out;
    b.RWP = (const bf16*)(P.ws + WS_RWP); b.Eb = (const bf16*)(dob + DO_E); b.Ab = (const bf16*)(dob + DO_A); b.Gb = (const bf16*)(dob + DO_G);
    b.MT = (bf16*)(dob + DO_LIN); b.Nn = (bf16*)(P.ws + WS_XB); b.S0 = (bf16*)(P.ws + WS_MEMQ); b.Y = (bf16*)(P.ws + WS_Y); return b;
}

template <bool PH3> __device__ __forceinline__ void rw_unit(const Params& P, const RwBufs& B, LAS unsigned char* lds, int h, int c) {
    const float* mu = P.in[12]; const float* k_k = P.in[18]; const float* k_a = P.in[19]; const float* r_k = P.in[20]; const float* ln_w = P.in[21]; const float* ln_b = P.in[22];
    LAS bf16* sAT = (LAS bf16*)(lds + RO_AT); LAS bf16* sATT = (LAS bf16*)(lds + RO_ATT); LAS bf16* sRT = (LAS bf16*)(lds + RO_RT); LAS bf16* sBT = (LAS bf16*)(lds + RO_BT); LAS bf16* sKT = (LAS bf16*)(lds + RO_KT);
    LAS bf16* sVT = (LAS bf16*)(lds + RO_VT); LAS bf16* sWT = (LAS bf16*)(lds + RO_WT); LAS bf16* sP1 = (LAS bf16*)(lds + RO_P1); LAS bf16* sP2 = (LAS bf16*)(lds + RO_P2); LAS bf16* sP3 = (LAS bf16*)(lds + RO_P3);
    LAS bf16* sP4 = (LAS bf16*)(lds + RO_P4); LAS bf16* sS0 = (LAS bf16*)(lds + RO_S0); LAS float* sL = (LAS float*)(lds + RO_F1); LAS float* sF2 = (LAS float*)(lds + RO_F2);
    const int tid = tid_opaque(), lane = tid & 63, wave = __builtin_amdgcn_readfirstlane(tid >> 6), l15 = lane & 15, kg = lane >> 4;
    const int t = tid >> 3, jc = (tid & 7) * 8, tg = c * RC + t, hc = h * 64 + jc;
    const size_t unit = (size_t)h * 256 + c;
    PROBE_T0(32, lds)
    float rr[8], kk[8], vv[8], al[8], ee[8], bb[8], aa[8];
    {
        float p[8], q[8], m8[8];
        ld8(B.RWP + (size_t)tg * RW_IN + hc, p); if (tg > 0) ld8(B.RWP + (size_t)(tg - 1) * RW_IN + hc, q); else { for (int i = 0; i < 8; ++i) q[i] = 0.f; } ldf8(mu + hc, m8);
#pragma unroll
        for (int i = 0; i < 8; ++i) rr[i] = p[i] + (q[i] - p[i]) * m8[i];
        ld8(B.RWP + (size_t)tg * RW_IN + 512 + hc, p); if (tg > 0) ld8(B.RWP + (size_t)(tg - 1) * RW_IN + 512 + hc, q); ldf8(mu + 512 + hc, m8);
#pragma unroll
        for (int i = 0; i < 8; ++i) kk[i] = p[i] + (q[i] - p[i]) * m8[i];
        ld8(B.RWP + (size_t)tg * RW_IN + 1024 + hc, p); if (tg > 0) ld8(B.RWP + (size_t)(tg - 1) * RW_IN + 1024 + hc, q); ldf8(mu + 1024 + hc, m8);
#pragma unroll
        for (int i = 0; i < 8; ++i) vv[i] = p[i] + (q[i] - p[i]) * m8[i];
        ld8(B.Ab + (size_t)tg * 512 + hc, al); ld8(B.Eb + (size_t)tg * 512 + hc, ee);
        float kn[8], kkc[8], kac[8], ss = 0.f; ldf8(k_k + hc, kkc); ldf8(k_a + hc, kac);
#pragma unroll
        for (int i = 0; i < 8; ++i) { kn[i] = kk[i] * kkc[i]; ss += kn[i] * kn[i]; }
        ss = sum8(ss);
        const float inv = 1.0f / fmaxf(sqrtf(ss), 1e-12f);
#pragma unroll
        for (int i = 0; i < 8; ++i) { kn[i] *= inv; aa[i] = -kn[i]; bb[i] = kn[i] * al[i]; kk[i] = kk[i] * (1.0f + (al[i] - 1.0f) * kac[i]); }
        *(LAS f32x4*)(sL + t * 64 + jc) = (f32x4){ee[0], ee[1], ee[2], ee[3]}; *(LAS f32x4*)(sL + t * 64 + jc + 4) = (f32x4){ee[4], ee[5], ee[6], ee[7]};
    }
    float bonus = 0.f, gg[8];
    if (PH3) { float rk8[8]; ldf8(r_k + hc, rk8);
#pragma unroll
        for (int i = 0; i < 8; ++i) bonus += rr[i] * kk[i] * rk8[i];
        bonus = sum8(bonus);
        ld8(B.Gb + (size_t)tg * 512 + hc, gg);
        const u32x4 sw = *(const u32x4*)(B.S0 + unit * 4096 + (size_t)t * 64 + jc); *(LAS u32x4*)(sS0 + t * RLD + jc) = sw; }
    __syncthreads();
    if (wave == 0) { float ev[64];
#pragma unroll
        for (int u = 0; u < 64; ++u) ev[u] = sL[u * 64 + lane];
        float run = 0.f;
#pragma unroll
        for (int u = 0; u < 64; ++u) { run += ev[u]; sL[u * 64 + lane] = run; } }
    __syncthreads();
    {
        float Lt[8], Lp[8], Le[8];
        { const f32x4 a = *(const LAS f32x4*)(sL + t * 64 + jc), b = *(const LAS f32x4*)(sL + t * 64 + jc + 4); Lt[0] = a[0]; Lt[1] = a[1]; Lt[2] = a[2]; Lt[3] = a[3]; Lt[4] = b[0]; Lt[5] = b[1]; Lt[6] = b[2]; Lt[7] = b[3]; }
        if (t > 0) { const f32x4 a = *(const LAS f32x4*)(sL + (t - 1) * 64 + jc), b = *(const LAS f32x4*)(sL + (t - 1) * 64 + jc + 4); Lp[0] = a[0]; Lp[1] = a[1]; Lp[2] = a[2]; Lp[3] = a[3]; Lp[4] = b[0]; Lp[5] = b[1]; Lp[6] = b[2]; Lp[7] = b[3]; }
        else { for (int i = 0; i < 8; ++i) Lp[i] = 0.f; }
        { const f32x4 a = *(const LAS f32x4*)(sL + 63 * 64 + jc), b = *(const LAS f32x4*)(sL + 63 * 64 + jc + 4); Le[0] = a[0]; Le[1] = a[1]; Le[2] = a[2]; Le[3] = a[3]; Le[4] = b[0]; Le[5] = b[1]; Le[6] = b[2]; Le[7] = b[3]; }
        float at[8], rt[8], bt[8], kt[8];
#pragma unroll
        for (int i = 0; i < 8; ++i) { const float ep = __expf(Lt[i]); at[i] = aa[i] * __expf(-Lp[i]); rt[i] = rr[i] * __expf(-Lt[i]); bt[i] = bb[i] * ep; kt[i] = kk[i] * ep; }
        *(LAS u32x4*)(sAT + t * RLD + jc) = pk8(at); *(LAS u32x4*)(sBT + t * RLD + jc) = pk8(bt); *(LAS u32x4*)(sKT + t * RLD + jc) = pk8(kt);
        if (PH3) *(LAS u32x4*)(sRT + t * RLD + jc) = pk8(rt);
#pragma unroll
        for (int i = 0; i < 8; ++i) sVT[(jc + i) * RLD + t] = (bf16)f2bf(vv[i]);
        if (!PH3) {
#pragma unroll
            for (int i = 0; i < 8; ++i) sATT[(jc + i) * RLD + t] = (bf16)f2bf(at[i]);
            float bp[8], kp[8];
#pragma unroll
            for (int i = 0; i < 8; ++i) { const float ed = __expf(-(Le[i] - Lt[i])); bp[i] = bb[i] * ed; kp[i] = kk[i] * ed; }
            *(LAS f32x4*)(sF2 + t * 64 + jc) = (f32x4){bp[0], bp[1], bp[2], bp[3]}; *(LAS f32x4*)(sF2 + t * 64 + jc + 4) = (f32x4){bp[4], bp[5], bp[6], bp[7]};
            *(LAS u32x4*)(sP4 + t * RLD + jc) = pk8(kp);
        }
    }
    __syncthreads();
    PROBE_T1(32, lds)
    const int tr = wave >> 1, tc0 = 2 * (wave & 1);
    const f32x4 z4 = {0.f, 0.f, 0.f, 0.f};
    if (!PH3) {
#pragma unroll
        for (int x = 0; x < 2; ++x) { st_tile<1>(sP1, tr, tc0 + x, l15, kg, mm16(sAT, sBT, tr, tc0 + x, l15, kg, z4)); st_tile<1>(sP2, tr, tc0 + x, l15, kg, mm16(sAT, sKT, tr, tc0 + x, l15, kg, z4)); }
        __syncthreads();
        PROBE_T0(33, lds)
        for (int i = tid; i < RARR / 4; i += NT) ((LAS unsigned*)sWT)[i] = 0u;
        __syncthreads();
#pragma unroll 1
        for (int bt = 3; bt >= 0; --bt) {
            if (wave < 4) { f32x4 xi;
#pragma unroll
                for (int r = 0; r < 4; ++r) xi[r] = sF2[(16 * bt + 4 * kg + r) * 64 + 16 * wave + l15];
                xi = mm16(sP1, sWT, bt, wave, l15, kg, xi);
#pragma unroll
                for (int r = 0; r < 4; ++r) sF2[(16 * bt + 4 * kg + r) * 64 + 16 * wave + l15] = xi[r]; }
            __syncthreads();
            if (wave == 0) { float wv[16];
#pragma unroll
                for (int r = 15; r >= 0; --r) { float acc = sF2[(16 * bt + r) * 64 + lane];
                    const u32x4 a0 = *(const LAS u32x4*)(sP1 + (16 * bt + r) * RLD + 16 * bt), a1 = *(const LAS u32x4*)(sP1 + (16 * bt + r) * RLD + 16 * bt + 8);
                    const float a16[16] = {bflo(a0.x), bfhi(a0.x), bflo(a0.y), bfhi(a0.y), bflo(a0.z), bfhi(a0.z), bflo(a0.w), bfhi(a0.w), bflo(a1.x), bfhi(a1.x), bflo(a1.y), bfhi(a1.y), bflo(a1.z), bfhi(a1.z), bflo(a1.w), bfhi(a1.w)};
#pragma unroll
                    for (int x = r + 1; x < 16; ++x) acc += a16[x] * wv[x];
                    wv[r] = acc; }
                *(LAS u32x4*)(sWT + lane * RLD + 16 * bt) = pk8(wv); *(LAS u32x4*)(sWT + lane * RLD + 16 * bt + 8) = pk8(wv + 8); }
            __syncthreads();
        }
        __syncthreads();
        PROBE_T1(33, lds)
#pragma unroll
        for (int x = 0; x < 2; ++x) { const int tc = tc0 + x;
            f32x4 zi; { const int col = 16 * tc + l15;
#pragma unroll
                for (int r = 0; r < 4; ++r) zi[r] = bf2f(sP4[(16 * tr + 4 * kg + r) * RLD + col]); }
            st_tile<0>(sP3, tr, tc, l15, kg, mm16(sP2, sWT, tr, tc, l15, kg, zi));
            f32x4 m = mm16(sATT, sWT, tr, tc, l15, kg, z4);
            { const int col = 16 * tc + l15, row0 = 16 * tr + 4 * kg; const float pc = __expf(-sL[63 * 64 + col]);
#pragma unroll
                for (int r = 0; r < 4; ++r) if (row0 + r == col) m[r] += pc;
                u32x2 w; w.x = pk2(m[0], m[1]); w.y = pk2(m[2], m[3]); *(u32x2*)(B.MT + unit * 4096 + (size_t)col * 64 + row0) = w; } }
        __syncthreads();
#pragma unroll
        for (int x = 0; x < 2; ++x) { const int tc = tc0 + x; const f32x4 nacc = mm16(sP3, sVT, tr, tc, l15, kg, z4);
            u32x2 w; w.x = pk2(nacc[0], nacc[1]); w.y = pk2(nacc[2], nacc[3]); *(u32x2*)(B.Nn + unit * 4096 + (size_t)(16 * tc + l15) * 64 + 16 * tr + 4 * kg) = w; }
        __syncthreads();
    } else {
#pragma unroll
        for (int x = 0; x < 2; ++x) { const int tc = tc0 + x;
            st_tile<2>(sP1, tr, tc, l15, kg, mm16(sBT, sAT, tr, tc, l15, kg, z4)); st_tile<2>(sP2, tr, tc, l15, kg, mm16(sKT, sAT, tr, tc, l15, kg, z4));
            st_tile<3>(sP3, tr, tc, l15, kg, mm16(sBT, sRT, tr, tc, l15, kg, z4)); st_tile<3>(sP4, tr, tc, l15, kg, mm16(sKT, sRT, tr, tc, l15, kg, z4)); }
        __syncthreads();
#pragma unroll
        for (int x = 0; x < 2; ++x) { const int tc = tc0 + x; f32x4 xa = mm16(sAT, sS0, tr, tc, l15, kg, z4); xa = mm16(sP2, sVT, tr, tc, l15, kg, xa);
#pragma unroll
            for (int r = 0; r < 4; ++r) sF2[(16 * tr + 4 * kg + r) * 64 + 16 * tc + l15] = xa[r]; }
        __syncthreads();
        for (int i = tid; i < RARR / 4; i += NT) ((LAS unsigned*)sWT)[i] = 0u;
        __syncthreads();
#pragma unroll 1
        for (int bt = 0; bt < 4; ++bt) {
            if (wave < 4) { f32x4 xi;
#pragma unroll
                for (int r = 0; r < 4; ++r) xi[r] = sF2[(16 * bt + 4 * kg + r) * 64 + 16 * wave + l15];
                xi = mm16(sP1, sWT, bt, wave, l15, kg, xi);
#pragma unroll
                for (int r = 0; r < 4; ++r) sF2[(16 * bt + 4 * kg + r) * 64 + 16 * wave + l15] = xi[r]; }
            __syncthreads();
            if (wave == 0) { float uv[16];
#pragma unroll
                for (int r = 0; r < 16; ++r) { float acc = sF2[(16 * bt + r) * 64 + lane];
                    const u32x4 a0 = *(const LAS u32x4*)(sP1 + (16 * bt + r) * RLD + 16 * bt), a1 = *(const LAS u32x4*)(sP1 + (16 * bt + r) * RLD + 16 * bt + 8);
                    const float a16[16] = {bflo(a0.x), bfhi(a0.x), bflo(a0.y), bfhi(a0.y), bflo(a0.z), bfhi(a0.z), bflo(a0.w), bfhi(a0.w), bflo(a1.x), bfhi(a1.x), bflo(a1.y), bfhi(a1.y), bflo(a1.z), bfhi(a1.z), bflo(a1.w), bfhi(a1.w)};
#pragma unroll
                    for (int x = 0; x < r; ++x) acc += a16[x] * uv[x];
                    uv[r] = acc; }
                *(LAS u32x4*)(sWT + lane * RLD + 16 * bt) = pk8(uv); *(LAS u32x4*)(sWT + lane * RLD + 16 * bt + 8) = pk8(uv + 8); }
            __syncthreads();
        }
        __syncthreads();
#pragma unroll
        for (int x = 0; x < 2; ++x) { const int tc = tc0 + x; f32x4 ya = mm16(sRT, sS0, tr, tc, l15, kg, z4); ya = mm16(sP3, sWT, tr, tc, l15, kg, ya); ya = mm16(sP4, sVT, tr, tc, l15, kg, ya);
#pragma unroll
            for (int r = 0; r < 4; ++r) sF2[(16 * tr + 4 * kg + r) * 64 + 16 * tc + l15] = ya[r]; }
        __syncthreads();
        {
            float y8[8], s1 = 0.f;
            { const f32x4 a = *(const LAS f32x4*)(sF2 + t * 64 + jc), b = *(const LAS f32x4*)(sF2 + t * 64 + jc + 4); y8[0] = a[0]; y8[1] = a[1]; y8[2] = a[2]; y8[3] = a[3]; y8[4] = b[0]; y8[5] = b[1]; y8[6] = b[2]; y8[7] = b[3]; }
#pragma unroll
            for (int i = 0; i < 8; ++i) s1 += y8[i];
            s1 = sum8(s1);
            const float mean = s1 * (1.0f / 64.0f); float s2 = 0.f;
#pragma unroll
            for (int i = 0; i < 8; ++i) { const float d = y8[i] - mean; s2 += d * d; }
            s2 = sum8(s2);
            const float rstd = 1.0f / sqrtf(s2 * (1.0f / 64.0f) + GN_EPS);
            float lw[8], lb[8], o8[8]; ldf8(ln_w + hc, lw); ldf8(ln_b + hc, lb);
#pragma unroll
            for (int i = 0; i < 8; ++i) o8[i] = ((y8[i] - mean) * rstd * lw[i] + lb[i] + bonus * vv[i]) * gg[i];
            *(u32x4*)(B.Y + (size_t)tg * 1536 + 512 + hc) = pk8(o8);
        }
        __syncthreads();
    }
}

__device__ __forceinline__ void rw_scan_phase(const Params& P, LAS unsigned char* lds, int h) {
    const RwBufs B = rw_bufs(P);
    const int tid = tid_opaque(), lane = tid & 63, wave = __builtin_amdgcn_readfirstlane(tid >> 6), l15 = lane & 15, kg = lane >> 4;
    const int tr = wave >> 1, tc0 = 2 * (wave & 1);
    LAS bf16* sS[2] = {(LAS bf16*)lds, (LAS bf16*)(lds + RARR)};
    for (int i = tid; i < 2 * RARR / 4; i += NT) ((LAS unsigned*)lds)[i] = 0u;
    __syncthreads();
    const int trow = tid >> 3, tcol = (tid & 7) * 8;
    s16x8 ma[2]; u32x2 nw[2];
    { const bf16* mt = B.MT + ((size_t)h * 256) * 4096; const bf16* nn = B.Nn + ((size_t)h * 256) * 4096;
#pragma unroll
        for (int ks = 0; ks < 2; ++ks) ma[ks] = *(const s16x8*)(mt + (size_t)(16 * tr + l15) * 64 + 32 * ks + 8 * kg);
#pragma unroll
        for (int x = 0; x < 2; ++x) nw[x] = *(const u32x2*)(nn + (size_t)(16 * (tc0 + x) + l15) * 64 + 16 * tr + 4 * kg); }
    for (int c = 0; c < 256; ++c) {
        const LAS bf16* cur = sS[c & 1]; LAS bf16* nxt = sS[(c + 1) & 1];
        const size_t unit = (size_t)h * 256 + c;
        *(u32x4*)(B.S0 + unit * 4096 + (size_t)trow * 64 + tcol) = *(const LAS u32x4*)(cur + trow * RLD + tcol);
        s16x8 ma_n[2]; u32x2 nw_n[2];
        if (c + 1 < 256) { const bf16* mt = B.MT + (unit + 1) * 4096; const bf16* nn = B.Nn + (unit + 1) * 4096;
#pragma unroll
            for (int ks = 0; ks < 2; ++ks) ma_n[ks] = *(const s16x8*)(mt + (size_t)(16 * tr + l15) * 64 + 32 * ks + 8 * kg);
#pragma unroll
            for (int x = 0; x < 2; ++x) nw_n[x] = *(const u32x2*)(nn + (size_t)(16 * (tc0 + x) + l15) * 64 + 16 * tr + 4 * kg); }
        else { ma_n[0] = ma[0]; ma_n[1] = ma[1]; nw_n[0] = nw[0]; nw_n[1] = nw[1]; }
#pragma unroll
        for (int x = 0; x < 2; ++x) { const int tc = tc0 + x;
            f32x4 acc = {bflo(nw[x].x), bfhi(nw[x].x), bflo(nw[x].y), bfhi(nw[x].y)};
#pragma unroll
            for (int ks = 0; ks < 2; ++ks) { const s16x8 b = *(const LAS s16x8*)(cur + (16 * tc + l15) * RLD + 32 * ks + 8 * kg); acc = __builtin_amdgcn_mfma_f32_16x16x32_bf16(ma[ks], b, acc, 0, 0, 0); }
            u32x2 w; w.x = pk2(acc[0], acc[1]); w.y = pk2(acc[2], acc[3]); *(LAS u32x2*)(nxt + (16 * tc + l15) * RLD + 16 * tr + 4 * kg) = w; }
        ma[0] = ma_n[0]; ma[1] = ma_n[1]; nw[0] = nw_n[0]; nw[1] = nw_n[1];
        __syncthreads();
    }
}
__device__ __forceinline__ void rw_lora_chunk(const Params& P, const RwBufs& B, LAS unsigned char* lds, int c) {
    constexpr int LLD = 264; LAS bf16* sLIN = (LAS bf16*)lds;
    const float* mu = P.in[12]; const float* w0 = P.in[13]; const float* a0 = P.in[15]; const bf16* WL = (const bf16*)(P.ws + WS_WLORA);
    const int tid = tid_opaque(), lane = tid & 63, h = __builtin_amdgcn_readfirstlane(tid >> 6), l15 = lane & 15, kg = lane >> 4;
    { const int t = tid >> 3, part = tid & 7, tg = c * RC + t, c0 = 1536 + 32 * part; float pv[32];
#pragma unroll
      for (int q4 = 0; q4 < 4; ++q4) { float p[8], q[8], m8[8]; ld8(B.RWP + (size_t)tg * RW_IN + c0 + 8 * q4, p);
          if (tg > 0) ld8(B.RWP + (size_t)(tg - 1) * RW_IN + c0 + 8 * q4, q); else { for (int i = 0; i < 8; ++i) q[i] = 0.f; }
          ldf8(mu + c0 + 8 * q4, m8);
#pragma unroll
          for (int i = 0; i < 8; ++i) { float s = p[i] + (q[i] - p[i]) * m8[i]; if (part < 2) s = 1.0f - 2.0f / (1.0f + __expf(2.0f * s)); else if (part >= 4) s = sigmoidf_(s); pv[8 * q4 + i] = s; } }
#pragma unroll
      for (int q4 = 0; q4 < 4; ++q4) *(LAS u32x4*)(sLIN + t * LLD + 32 * part + 8 * q4) = pk8(pv + 8 * q4); }
    __syncthreads();
#pragma unroll 1
    for (int jt = 0; jt < 4; ++jt) { const int j0 = h * 64 + 16 * jt;
        s16x8 we[2], wa[2], wg[4];
#pragma unroll
        for (int ks = 0; ks < 2; ++ks) { we[ks] = *(const s16x8*)(WL + (size_t)(j0 + l15) * 256 + 32 * ks + 8 * kg); wa[ks] = *(const s16x8*)(WL + (size_t)(512 + j0 + l15) * 256 + 64 + 32 * ks + 8 * kg); }
#pragma unroll
        for (int ks = 0; ks < 4; ++ks) wg[ks] = *(const s16x8*)(WL + (size_t)(1024 + j0 + l15) * 256 + 128 + 32 * ks + 8 * kg);
        const f32x4 w04 = *(const f32x4*)(w0 + j0 + 4 * kg), a04 = *(const f32x4*)(a0 + j0 + 4 * kg);
#pragma unroll
        for (int tt = 0; tt < 4; ++tt) { const LAS bf16* lp = sLIN + (16 * tt + l15) * LLD + 8 * kg;
            f32x4 ae = {0.f, 0.f, 0.f, 0.f}, aa = {0.f, 0.f, 0.f, 0.f}, ag = {0.f, 0.f, 0.f, 0.f};
#pragma unroll
            for (int ks = 0; ks < 2; ++ks) { ae = __builtin_amdgcn_mfma_f32_16x16x32_bf16(we[ks], *(const LAS s16x8*)(lp + 32 * ks), ae, 0, 0, 0); aa = __builtin_amdgcn_mfma_f32_16x16x32_bf16(wa[ks], *(const LAS s16x8*)(lp + 64 + 32 * ks), aa, 0, 0, 0); }
#pragma unroll
            for (int ks = 0; ks < 4; ++ks) ag = __builtin_amdgcn_mfma_f32_16x16x32_bf16(wg[ks], *(const LAS s16x8*)(lp + 128 + 32 * ks), ag, 0, 0, 0);
            f32x4 ev, av;
#pragma unroll
            for (int r = 0; r < 4; ++r) { const float z = ae[r] + w04[r]; const float sp = fmaxf(-z, 0.f) + __logf(1.0f + __expf(-fabsf(z))); ev[r] = __expf(-sp - 0.5f); av[r] = sigmoidf_(aa[r] + a04[r]); }
            const size_t o = (size_t)(c * RC + 16 * tt + l15) * 512 + j0 + 4 * kg;
            st_bf4((bf16*)B.Eb + o, ev); st_bf4((bf16*)B.Ab + o, av); st_bf4((bf16*)B.Gb + o, ag); } }
    __syncthreads();
}
template <bool PH3> __device__ __forceinline__ void rw_units_phase(const Params& P, LAS unsigned char* lds, int bid, int nblk) {
    const RwBufs B = rw_bufs(P);
    if (!PH3) rw_lora_chunk(P, B, lds, bid & 255);
    for (int u = bid; u < 8 * 256; u += nblk) rw_unit<PH3>(P, B, lds, u >> 8, u & 255);
}

__device__ __forceinline__ void xb_phase(const Params& P, int bid, int nblk) {
    const int tid = tid_opaque(), lane = tid & 63, wave = tid >> 6;
    for (int r = bid * NW + wave; r < S_; r += nblk * NW) {
        const f32x4* xr = (const f32x4*)(P.in[0] + (size_t)r * D_) + lane; unsigned long long* o8 = (unsigned long long*)((bf16*)(P.ws + WS_XB) + (size_t)r * D_) + lane;
#pragma unroll
        for (int j = 0; j < 4; ++j) { const f32x4 v = xr[64 * j]; o8[64 * j] = (unsigned long long)pk2(v.x, v.y) | ((unsigned long long)pk2(v.z, v.w) << 32); }
    }
}
constexpr size_t WS_UBS = 192 * MiB, WS_VBS = 224 * MiB, WS_PART = 64 * MiB, WS_EW = 48 * MiB;
typedef float f32x2_ __attribute__((ext_vector_type(2)));
__device__ __forceinline__ void f8x16(const u32x4 w, float* x) {
    const f32x2_ a0 = __builtin_amdgcn_cvt_pk_f32_fp8((int)w.x, false), a1 = __builtin_amdgcn_cvt_pk_f32_fp8((int)w.x, true), b0 = __builtin_amdgcn_cvt_pk_f32_fp8((int)w.y, false), b1 = __builtin_amdgcn_cvt_pk_f32_fp8((int)w.y, true);
    const f32x2_ c0 = __builtin_amdgcn_cvt_pk_f32_fp8((int)w.z, false), c1 = __builtin_amdgcn_cvt_pk_f32_fp8((int)w.z, true), d0 = __builtin_amdgcn_cvt_pk_f32_fp8((int)w.w, false), d1 = __builtin_amdgcn_cvt_pk_f32_fp8((int)w.w, true);
    x[0] = a0.x; x[1] = a0.y; x[2] = a1.x; x[3] = a1.y; x[4] = b0.x; x[5] = b0.y; x[6] = b1.x; x[7] = b1.y; x[8] = c0.x; x[9] = c0.y; x[10] = c1.x; x[11] = c1.y; x[12] = d0.x; x[13] = d0.y; x[14] = d1.x; x[15] = d1.y;
}
__device__ __forceinline__ unsigned pk4f8(f32x4 v, float s) { int w = __builtin_amdgcn_cvt_pk_fp8_f32(v[0] * s, v[1] * s, 0, false); w = __builtin_amdgcn_cvt_pk_fp8_f32(v[2] * s, v[3] * s, w, true); return (unsigned)w; }
constexpr float PEER_USCALE = 32.0f, PEER_VSCALE = 4.0f;
__device__ __forceinline__ void peer_conv_phase(const Params& P, int bid, int nblk) {
    const int gt = bid * NT + tid_opaque(), NGT = nblk * NT;
    for (int i = gt; i < 2 * NEXP * 64; i += NGT) { const int tab = i / (NEXP * 64), r = i % (NEXP * 64), e = r >> 6, l = r & 63;
        const float* src = (tab ? P.in[30] : P.in[29]) + (size_t)e * 1024 + 16 * l; const float s = tab ? PEER_VSCALE : PEER_USCALE;
        u32x4 w; w.x = pk4f8(*(const f32x4*)src, s); w.y = pk4f8(*(const f32x4*)(src + 4), s); w.z = pk4f8(*(const f32x4*)(src + 8), s); w.w = pk4f8(*(const f32x4*)(src + 12), s);
        *(u32x4*)(P.ws + (tab ? WS_VBS : WS_UBS) + ((size_t)(l >> 3) * NEXP + e) * 128 + (l & 7) * 16) = w; }
}
__device__ __forceinline__ void peer_e1_phase(const Params& P, LAS unsigned char* lds, int bid, int nblk) {
    const int* EIDX = (const int*)(P.ws + WS_EIDX); const float* HSQ = (const float*)(P.ws + WS_HSQ); const float* gain = P.in[25]; float* PART = (float*)(P.ws + WS_PART);
    const int tid = tid_opaque(), lane = tid & 63, wave = __builtin_amdgcn_readfirstlane(tid >> 6), g = lane >> 3, c16 = (lane & 7) * 16;
    const int x = bid & 7, rank = bid >> 3, nr = nblk >> 3, tstep = nr * 8;
    LAS float* pb = (LAS float*)lds + wave * 256;
    const unsigned char* tab = P.ws + WS_UBS + (size_t)x * NEXP * 128 + c16;
    float gn[16]; ldf8(gain + 128 * x + c16, gn); ldf8(gain + 128 * x + c16 + 8, gn + 8);
    for (int t0 = rank * 8 + wave; t0 < S_; t0 += 2 * tstep) {
        int tt[2] = {t0, (t0 + tstep < S_) ? t0 + tstep : t0};
        int e_lo[2], e_hi[2]; float xn[2][16];
#pragma unroll
        for (int z = 0; z < 2; ++z) { e_lo[z] = EIDX[(size_t)tt[z] * 128 + lane]; e_hi[z] = EIDX[(size_t)tt[z] * 128 + 64 + lane];
            ldf8(P.out + (size_t)tt[z] * 1024 + 128 * x + c16, xn[z]); ldf8(P.out + (size_t)tt[z] * 1024 + 128 * x + c16 + 8, xn[z] + 8); }
        u32x4 uw[2][16];
#pragma unroll
        for (int z = 0; z < 2; ++z)
#pragma unroll
            for (int i = 0; i < 16; ++i) { const int e = __shfl((i < 8) ? e_lo[z] : e_hi[z], (8 * i + g) & 63); uw[z][i] = *(const u32x4*)(tab + (size_t)e * 128); }
#pragma unroll
        for (int z = 0; z < 2; ++z) { const float rs = rstd_h_row(HSQ, tt[z]) * (1.0f / PEER_USCALE);
#pragma unroll
            for (int j = 0; j < 16; ++j) xn[z][j] *= rs * gn[j];
#pragma unroll
            for (int i = 0; i < 16; ++i) { float u16[16]; f8x16(uw[z][i], u16); float d = 0.f;
#pragma unroll
                for (int j = 0; j < 16; ++j) d += xn[z][j] * u16[j];
                d = sum8(d);
                if ((lane & 7) == 0) pb[z * 128 + 8 * i + g] = d; } }
        LDS_WAIT(); __builtin_amdgcn_wave_barrier();
#pragma unroll
        for (int z = 0; z < 2; ++z) if (z == 0 || tt[1] != tt[0]) { float* dst = PART + ((size_t)tt[z] * 8 + x) * 128; dst[lane] = pb[z * 128 + lane]; dst[64 + lane] = pb[z * 128 + 64 + lane]; }
        LDS_WAIT(); __builtin_amdgcn_wave_barrier();
    }
}
__device__ __forceinline__ void peer_w_phase(const Params& P, int bid, int nblk) {
    const float* PART = (const float*)(P.ws + WS_PART); const float* EG = (const float*)(P.ws + WS_EGATE); float* EW = (float*)(P.ws + WS_EW);
    const int gt = bid * NT + tid_opaque(), NGT = nblk * NT;
    for (int i = gt; i < S_ * 128; i += NGT) { const int t = i >> 7, k = i & 127; float d = 0.f;
#pragma unroll
        for (int x = 0; x < 8; ++x) d += PART[((size_t)t * 8 + x) * 128 + k];
        EW[i] = EG[i] * 0.5f * d * (1.0f + erff(d * 0.70710678118654752f)); }
}
__device__ __forceinline__ void peer_e2_phase(const Params& P, int bid, int nblk) {
    const int* EIDX = (const int*)(P.ws + WS_EIDX); const float* EW = (const float*)(P.ws + WS_EW);
    const int tid = tid_opaque(), lane = tid & 63, wave = __builtin_amdgcn_readfirstlane(tid >> 6), g = lane >> 3, c16 = (lane & 7) * 16;
    const int x = bid & 7, rank = bid >> 3, nr = nblk >> 3, tstep = nr * 8;
    const unsigned char* tab = P.ws + WS_VBS + (size_t)x * NEXP * 128 + c16;
    for (int t0 = rank * 8 + wave; t0 < S_; t0 += 2 * tstep) {
        int tt[2] = {t0, (t0 + tstep < S_) ? t0 + tstep : t0};
        int e_lo[2], e_hi[2]; float w_lo[2], w_hi[2];
#pragma unroll
        for (int z = 0; z < 2; ++z) { e_lo[z] = EIDX[(size_t)tt[z] * 128 + lane]; e_hi[z] = EIDX[(size_t)tt[z] * 128 + 64 + lane]; w_lo[z] = EW[(size_t)tt[z] * 128 + lane]; w_hi[z] = EW[(size_t)tt[z] * 128 + 64 + lane]; }
        u32x4 vw[2][16]; float wk[2][16];
#pragma unroll
        for (int z = 0; z < 2; ++z)
#pragma unroll
            for (int i = 0; i < 16; ++i) { const int e = __shfl((i < 8) ? e_lo[z] : e_hi[z], (8 * i + g) & 63); wk[z][i] = __shfl((i < 8) ? w_lo[z] : w_hi[z], (8 * i + g) & 63); vw[z][i] = *(const u32x4*)(tab + (size_t)e * 128); }
#pragma unroll
        for (int z = 0; z < 2; ++z) { float o[16];
#pragma unroll
            for (int c = 0; c < 16; ++c) o[c] = 0.f;
#pragma unroll
            for (int i = 0; i < 16; ++i) { float v16[16]; f8x16(vw[z][i], v16); const float wv = wk[z][i];
#pragma unroll
                for (int j = 0; j < 16; ++j) o[j] += wv * v16[j]; }
#pragma unroll
            for (int c = 0; c < 16; ++c) { o[c] += dppf<0x128>(o[c]); o[c] = sum_x16(o[c]); o[c] = sum_x32(o[c]); }
            if (g == 0 && (z == 0 || tt[1] != tt[0])) { float* hp = P.out + (size_t)tt[z] * 1024 + 128 * x + c16;
#pragma unroll
                for (int c4 = 0; c4 < 4; ++c4) { const f32x4 a = *(const f32x4*)(hp + 4 * c4);
                    *(f32x4*)(hp + 4 * c4) = (f32x4){a[0] + o[4 * c4] * (1.0f / PEER_VSCALE), a[1] + o[4 * c4 + 1] * (1.0f / PEER_VSCALE), a[2] + o[4 * c4 + 2] * (1.0f / PEER_VSCALE), a[3] + o[4 * c4 + 3] * (1.0f / PEER_VSCALE)}; } } }
    }
}
#define XB_TMO      128
#define XB_XCNT(j)  (256  + 64 * (j))
#define XB_XSUB(j)  (1280 + 64 * (j))
#define XB_XGEN(j)  (2304 + 64 * (j))
#define XB_TOP      3328
#define XB_TOPGEN   3392
#define XCD_BAR_WORDS 3456
#define XB_SPIN_CAP (1u << 18)

__device__ __forceinline__ unsigned xb_ld(unsigned* p)              { return __hip_atomic_load(p, __ATOMIC_RELAXED, __HIP_MEMORY_SCOPE_AGENT); }
__device__ __forceinline__ unsigned xb_add(unsigned* p, unsigned v) { return __hip_atomic_fetch_add(p, v, __ATOMIC_RELAXED, __HIP_MEMORY_SCOPE_AGENT); }
__device__ __forceinline__ unsigned xb_xcc_id() { return (unsigned)__builtin_amdgcn_s_getreg((3 << 11) | 20) & 0xFu; }
#define XB_SPIN(cond, bar) do { unsigned _sp = 0; while (cond) { __builtin_amdgcn_s_sleep(1); \
    if ((++_sp & 255u) == 0u) { if (xb_ld(&(bar)[XB_TMO])) break; if (_sp > XB_SPIN_CAP) { atomicAdd(&(bar)[XB_TMO], 1u); break; } } } } while (0)

struct XcdBarrier {
    unsigned* bar; unsigned x;
    volatile LAS unsigned* st;
};

__device__ __forceinline__ XcdBarrier xcd_barrier_post(unsigned* bar, volatile LAS unsigned* st) {
    XcdBarrier b; b.bar = bar; b.x = xb_xcc_id(); b.st = st;
    if (threadIdx.x == 0) (void)xb_add(&bar[XB_XCNT(b.x)], 1u);
    return b;
}
__device__ __forceinline__ void xcd_barrier_complete(unsigned* bar, unsigned x, unsigned& nloc, unsigned& nx) {
    const unsigned G = gridDim.x * gridDim.y * gridDim.z;
    unsigned sum, cnt, mine, sp = 0u;
    for (;;) {
        sum = 0u; cnt = 0u; mine = 0u;
#pragma unroll
        for (unsigned j = 0; j < 16; ++j) { const unsigned c = xb_ld(&bar[XB_XCNT(j)]); sum += c; cnt += (c > 0u) ? 1u : 0u; mine = (j == x) ? c : mine; }
        if (sum == G) break;
        __builtin_amdgcn_s_sleep(1);
        if ((++sp & 255u) == 0u) { if (xb_ld(&bar[XB_TMO])) break; if (sp > XB_SPIN_CAP) { atomicAdd(&bar[XB_TMO], 1u); break; } }
    }
    nloc = mine > 0u ? mine : 1u; nx = cnt > 0u ? cnt : 1u;
}

__device__ __forceinline__ void xcd_barrier(const XcdBarrier& b) {
    asm volatile("s_waitcnt vmcnt(0)" ::: "memory");
    __syncthreads();
    if (threadIdx.x == 0) {
        unsigned* bar = b.bar;
        __builtin_amdgcn_s_waitcnt(0);
        unsigned nloc = b.st[0], nx = b.st[1];
        if (nloc == 0u) { xcd_barrier_complete(bar, b.x, nloc, nx); b.st[0] = nloc; b.st[1] = nx; }
        const unsigned old = xb_add(&bar[XB_XSUB(b.x)], 1u);
        const unsigned gen = old / nloc;
        if (old + 1u == (gen + 1u) * nloc) {
            __builtin_amdgcn_fence(__ATOMIC_RELEASE, "agent");
            asm volatile("s_waitcnt vmcnt(0)" ::: "memory");
            const unsigned og = xb_add(&bar[XB_TOP], 1u);
            const unsigned tg = og / nx;
            if (og + 1u == (tg + 1u) * nx) xb_add(&bar[XB_TOPGEN], 1u);
            else XB_SPIN(xb_ld(&bar[XB_TOPGEN]) == tg, bar);
            __builtin_amdgcn_fence(__ATOMIC_ACQUIRE, "agent");
            xb_add(&bar[XB_XGEN(b.x)], 1u);
            asm volatile("s_waitcnt vmcnt(0)" ::: "memory");
        } else {
            XB_SPIN(xb_ld(&bar[XB_XGEN(b.x)]) == gen, bar);
            __builtin_amdgcn_fence(__ATOMIC_ACQUIRE, "agent");
            asm volatile("s_waitcnt vmcnt(0)" ::: "memory");
        }
    }
    __syncthreads();
}

#include <hip/hip_cooperative_groups.h>
namespace cg = cooperative_groups;
extern __shared__ __attribute__((aligned(16))) unsigned char dyn_lds[];
#define LDSP ((LAS unsigned char*)dyn_lds)
constexpr int LDS_BYTES = 150 * 1024;
#ifndef REP_P1
#define REP_P1 1
#endif
#ifndef REP_RW
#define REP_RW 1
#endif
#ifndef REP_P4
#define REP_P4 1
#endif
#ifndef REP_P7
#define REP_P7 1
#endif
#ifndef REP_ATTN
#define REP_ATTN 1
#endif
#ifndef REP_IDX
#define REP_IDX 1
#endif
#ifndef REP_MEM
#define REP_MEM 1
#endif
#ifndef REP_E1
#define REP_E1 1
#endif
static_assert(MA_LDS_END <= LDS_BYTES - 64 && DA_END <= LDS_BYTES && RO_END <= LDS_BYTES && 131072 <= LDS_BYTES, "LDS budget");

typedef const __attribute__((address_space(4))) Params* KargPtr;
__device__ __forceinline__ Params load_params() {
    Params r;
#if defined(__HIP_DEVICE_COMPILE__)
    KargPtr kp = (KargPtr)__builtin_amdgcn_kernarg_segment_ptr(); asm volatile("" : "+s"(kp));
#pragma unroll
    for (int i = 0; i < 31; ++i) r.in[i] = kp->in[i];
    r.out = kp->out; r.ws = kp->ws;
#endif
    return r;
}
__global__ void __launch_bounds__(NT, 2) mega(Params P_unused) {
    cg::grid_group grid = cg::this_grid();
    const int bid = blockIdx.x, nb = gridDim.x;
#define PH_BEGIN const Params P = load_params(); unsigned char* ws = P.ws; unsigned char* dob = (unsigned char*)P.out; (void)ws; (void)dob;
#define GRID_BAR() do { PH_BEGIN XcdBarrier b_; b_.bar = (unsigned*)(ws + WS_CTL); b_.x = xb_xcc_id(); b_.st = (volatile LAS unsigned*)(LDSP + LDS_BYTES - 64); xcd_barrier(b_); } while (0)
    if (threadIdx.x < 16) ((LAS unsigned*)(LDSP + LDS_BYTES - 64))[threadIdx.x] = 0u;
    __syncthreads();
    { PH_BEGIN (void)xcd_barrier_post((unsigned*)(ws + WS_CTL), (volatile LAS unsigned*)(LDSP + LDS_BYTES - 64)); }
    PROBE_SEG_INIT(LDSP)
    { PROBE_T0(10, LDSP)
    { PH_BEGIN prologue_phase(P, LDSP, bid, nb); }
    PROBE_T1(10, LDSP) }
    grid.sync();
    PROBE_SEG(40, LDSP)
    PROBE_T0(11, LDSP)
    { PH_BEGIN
        pg8::Gemm g{(const bf16*)(ws + WS_MB), (const bf16*)(ws + WS_WMEM), 256, 1024, 1024, 1024, 1024, 0, 256 * 1024};
        pg8::StaticOrder S; S.init(g.M, g.N, nb, bid);
        EpiF32 E{(float*)(ws + WS_KMVM), 1024, (const float*)(ws + WS_RSTDM)};
        pg8::gemm_phase<false>(LDSP, g, S, E);
    }
    for (int rep = 0; rep < REP_P1; ++rep) { PH_BEGIN
        pg8::Gemm g{(const bf16*)(ws + WS_XB), (const bf16*)(ws + WS_WIN), S_, P1_N, 1024, 1024, 1024, 0, 256 * 1024};
        pg8::StaticOrder S; S.init(g.M, g.N, nb, bid);
        EpiP1 E{(const float*)(ws + WS_RSTDX), (const float*)(ws + WS_COS), (const float*)(ws + WS_SIN), P.in[6], P.in[7],
                (bf16*)(ws + WS_Q), (bf16*)(ws + WS_K), (bf16*)(ws + WS_V), (bf16*)(ws + WS_RWP), (bf16*)(ws + WS_MEMQ), (half_t*)(ws + WS_IQ), (half_t*)(ws + WS_IK), (float*)(ws + WS_IW)};
        pg8::gemm_phase<false>(LDSP, g, S, E);
    }
    if (bid >= 64) { PH_BEGIN prologue_rest_phase(P, LDSP, bid - 64, nb - 64); }
    PROBE_T1(11, LDSP)
    GRID_BAR();
    PROBE_SEG(41, LDSP)
    PROBE_T0(35, LDSP)
    { PROBE_T0(13, LDSP)
    { PH_BEGIN dsa_index_phase(P, LDSP, bid, nb); }
    PROBE_T1(13, LDSP) }
    { PROBE_T0(14, LDSP)
    { PH_BEGIN mem_attn_phase(P, LDSP, bid, nb); }
    PROBE_T1(14, LDSP) }
    __syncthreads();
    { PROBE_T0(15, LDSP)
    { PH_BEGIN rw_units_phase<false>(P, LDSP, bid, nb); }
    PROBE_T1(15, LDSP) }
    PROBE_T1(35, LDSP)
    GRID_BAR();
    PROBE_SEG(44, LDSP)
    if (bid >= nb - 8) { PROBE_T0(30, LDSP) { PH_BEGIN rw_scan_phase(P, LDSP, bid - (nb - 8)); } PROBE_T1(30, LDSP) }
    else    { PROBE_T0(16, LDSP)
    for (int rep = 0; rep < REP_ATTN; ++rep) { PH_BEGIN dsa_attn_phase(P, LDSP, bid, nb); }
    PROBE_T1(16, LDSP) }
    GRID_BAR();
    PROBE_SEG(45, LDSP)
    { PROBE_T0(17, LDSP)
    for (int rep = 0; rep < REP_RW; ++rep) { PH_BEGIN rw_units_phase<true>(P, LDSP, bid, nb); }
    PROBE_T1(17, LDSP) }
    { PH_BEGIN xb_phase(P, bid, nb); }
    GRID_BAR();
    PROBE_SEG(46, LDSP)
    PROBE_T0(18, LDSP)
    for (int rep4 = 0; rep4 < REP_P4; ++rep4) {
    { PH_BEGIN
        pg8::Gemm g{(const bf16*)(ws + WS_XB), (const bf16*)(ws + WS_WG), S_, 3072, 1024, 1024, 1024, 0, 256 * 1024};
        pg8::PanelOrder S; S.init(S_, nb, bid, 3);
        EpiGate E{(bf16*)(ws + WS_GATES), (const float*)(ws + WS_RSTDX), P.in[5]};
        PROBE_T0(31, LDSP)
        pg8::gemm_phase<false>(LDSP, g, S, E);
        PROBE_T1(31, LDSP)
    }
    for (int c = 0; c < 3; ++c) { PH_BEGIN
        pg8::Gemm g{(const bf16*)(ws + WS_Y) + c * 512, (const bf16*)(ws + WS_WUP) + (size_t)c * 1024 * 512, S_, 1024, 512, 1536, 512, 0, 256 * 512};
        pg8::StaticOrder S; S.init(g.M, g.N, nb, bid);
        EpiMerge E{(const bf16*)(ws + WS_GATES), P.out, (bf16*)(ws + WS_MERGED), c};
        pg8::gemm_phase<false>(LDSP, g, S, E);
    }
    }
    PROBE_T1(18, LDSP)
    GRID_BAR();
    PROBE_SEG(47, LDSP)
    { PROBE_T0(19, LDSP)
    { PH_BEGIN peer_conv_phase(P, bid, nb); }
    PROBE_T1(19, LDSP) }
    PROBE_T0(20, LDSP)
    { PH_BEGIN
        pg8::Gemm g{(const bf16*)(ws + WS_MERGED), (const bf16*)(ws + WS_WOUT), S_, 1024, 1024, 1024, 1024, 0, 256 * 1024};
        pg8::StaticOrder S; S.init(g.M, g.N, nb, bid);
        EpiOut E{P.in[0], P.out, (bf16*)(ws + WS_XB), (float*)(ws + WS_HSQ)};
        pg8::gemm_phase<false>(LDSP, g, S, E);
    }
    PROBE_T1(20, LDSP)
    GRID_BAR();
    PROBE_SEG(48, LDSP)
    PROBE_T0(21, LDSP)
    { PH_BEGIN
        pg8::Gemm g{(const bf16*)(ws + WS_XB), (const bf16*)(ws + WS_WQ), S_, 2048, 1024, 1024, 1024, 0, 256 * 1024};
        pg8::StaticOrder S; S.init(g.M, g.N, nb, bid);
        EpiPQ E{(half_t*)(ws + WS_PQ), (const float*)(ws + WS_HSQ)};
        pg8::gemm_phase<true>(LDSP, g, S, E);
    }
    PROBE_T1(21, LDSP)
    GRID_BAR();
    PROBE_SEG(49, LDSP)
    PROBE_T0(25, LDSP)
    for (int rep = 0; rep < REP_P7; ++rep) { PH_BEGIN
        pg8::Gemm g{(const bf16*)(ws + WS_PQ), (const bf16*)(ws + WS_KEYBD), S_, 2048, 256, 2048, 256, 256, 0};
        pg8::StaticOrder S; S.init(g.M, g.N, nb, bid);
        float* scr = (float*)(ws + WS_SC) + (size_t)bid * 65536;
        pg8::Unit u;
        for (int i = 0; S.next(i, u); ++i) {
            pg8::OneUnit O{u}; EpiTile E{scr};
            pg8::gemm_phase<true>(LDSP, g, O, E);
            __syncthreads();
            peer_topk_tile(scr, u.pm, u.pn, (int*)(ws + WS_EIDX), (float*)(ws + WS_EGATE), (LAS unsigned*)LDSP);
            __syncthreads();
        }
    }
    PROBE_T1(25, LDSP)
    GRID_BAR();
    PROBE_SEG(50, LDSP)
    { PROBE_T0(22, LDSP)
    for (int rep = 0; rep < REP_E1; ++rep) { PH_BEGIN peer_e1_phase(P, LDSP, bid, nb); }
    PROBE_T1(22, LDSP) }
    GRID_BAR();
    PROBE_SEG(51, LDSP)
    { PROBE_T0(23, LDSP)
    { PH_BEGIN peer_w_phase(P, bid, nb); }
    PROBE_T1(23, LDSP) }
    GRID_BAR();
    PROBE_SEG(52, LDSP)
    { PROBE_T0(24, LDSP)
    { PH_BEGIN peer_e2_phase(P, bid, nb); }
    PROBE_T1(24, LDSP) }
#if PROBE_ID
    GRID_BAR();
    if (bid == PROBE_BLK && threadIdx.x == 0) { PH_BEGIN P.out[0] += 1.0f + (float)(*(LAS unsigned*)(LDSP + PROBE_LDS_OFF)) * 1e-3f; }
#endif
#undef GRID_BAR
#undef PH_BEGIN
}

extern "C" void kernel_launch(void* const* d_in, const int* in_sizes, int n_in, void* d_out, int out_size, void* d_ws, size_t ws_size, hipStream_t stream) {
    static int grid = 0;
    if (grid == 0) {
        if (n_in != 31 || out_size != S_ * D_ || ws_size < WS_END) { fprintf(stderr, "kernel_launch: unexpected problem (n_in %d out %d ws %zu)\n", n_in, out_size, ws_size); grid = -1; return; }
        int dev = 0, cus = 0, per_cu = 0;
        if (hipGetDevice(&dev) != hipSuccess || hipDeviceGetAttribute(&cus, hipDeviceAttributeMultiprocessorCount, dev) != hipSuccess) { grid = -1; return; }
        if (hipFuncSetAttribute((const void*)mega, hipFuncAttributeMaxDynamicSharedMemorySize, LDS_BYTES) != hipSuccess) { fprintf(stderr, "kernel_launch: hipFuncSetAttribute failed\n"); grid = -1; return; }
        if (hipOccupancyMaxActiveBlocksPerMultiprocessor(&per_cu, (const void*)mega, NT, LDS_BYTES) != hipSuccess || per_cu < 1) { fprintf(stderr, "kernel_launch: occupancy query failed (%d)\n", per_cu); grid = -1; return; }
        grid = cus;
        if (grid != 256) { fprintf(stderr, "kernel_launch: built for 256 CUs, device has %d\n", cus); grid = -1; return; }
    }
    if (grid < 0) return;
    Params P{};
    for (int i = 0; i < 31; ++i) P.in[i] = (const float*)d_in[i];
    P.out = (float*)d_out; P.ws = (unsigned char*)d_ws;
    if (hipMemsetAsync(d_ws, 0, 16384, stream) != hipSuccess) { fprintf(stderr, "kernel_launch: memset of the barrier words failed\n"); return; }
    void* args[] = {&P};
    hipError_t e = hipLaunchCooperativeKernel((const void*)mega, dim3(grid), dim3(NT), args, LDS_BYTES, stream);
    if (e != hipSuccess) fprintf(stderr, "kernel_launch: cooperative launch failed: %s\n", hipGetErrorString(e));
}
```

```cpp
#include <hip/hip_runtime.h>
#include <cstdio>
#include <cstdint>

typedef unsigned short bf16;
typedef unsigned short u16;
typedef float f32x4 __attribute__((ext_vector_type(4)));
typedef float f32x2 __attribute__((ext_vector_type(2)));
typedef unsigned u32x4 __attribute__((ext_vector_type(4)));
typedef unsigned u32x2 __attribute__((ext_vector_type(2)));
typedef _Float16 half_t;
typedef _Float16 half4 __attribute__((ext_vector_type(4)));
typedef _Float16 half8 __attribute__((ext_vector_type(8)));

constexpr int S_ = 16384, D_ = 1024;
constexpr int NMEM = 256;
constexpr int ATT_W = 512, RW_W = 512, MEM_W = 512;
constexpr int RW_IN = 1792;
constexpr int WIN_COLS = 7236;
constexpr int COL_Q = 0, COL_K = 512, COL_V = 1024, COL_IQ = 1536, COL_IK = 1792, COL_IW = 1856, COL_RW = 1860, COL_MEMQ = 3652, COL_GATE = 4164;
constexpr int P1_TILES = 17, P1_N = P1_TILES * 256;
constexpr float NORM_EPS = 1e-6f, GN_EPS = 64e-5f;
constexpr int NEXP = 16384;

constexpr size_t MiB = 1u << 20;
constexpr size_t WS_CTL = 0;
constexpr size_t WS_RSTDX = 1 * MiB;
constexpr size_t WS_COS = WS_RSTDX + 64 * 1024;
constexpr size_t WS_SIN = WS_COS + 512 * 1024;
constexpr size_t WS_IW = WS_SIN + 512 * 1024;
constexpr size_t WS_RSTDM = WS_IW + 256 * 1024;
constexpr size_t WS_RSTDH = WS_RSTDM + 4096;
constexpr size_t WS_HSQ = 3 * MiB;
constexpr size_t WS_WIN = 4 * MiB;
constexpr size_t WS_WG = WS_WIN + (size_t)P1_N * 1024 * 2;
constexpr size_t WS_WUP = WS_WG + 6 * MiB;
constexpr size_t WS_WOUT = WS_WUP + 3 * MiB;
constexpr size_t WS_WQ = WS_WOUT + 2 * MiB;
constexpr size_t WS_WMEM = WS_WQ + 4 * MiB;
constexpr size_t WS_KEYBD = WS_WMEM + 2 * MiB;
constexpr size_t WS_WLORA = WS_KEYBD + 128 * 1024;
static_assert(WS_WLORA + 768 * 1024 <= 30 * MiB + 512 * 1024, "weights region");
constexpr size_t WS_KMVM = 30 * MiB + 512 * 1024;
constexpr size_t WS_MB = 31 * MiB + 512 * 1024;
constexpr size_t WS_XB = 32 * MiB;
constexpr size_t WS_Q = 64 * MiB, WS_K = 80 * MiB, WS_V = 96 * MiB;
constexpr size_t WS_IQ = 112 * MiB;
constexpr size_t WS_IK = 120 * MiB;
constexpr size_t WS_MEMQ = 122 * MiB;
constexpr size_t WS_RWP = 138 * MiB;
constexpr size_t WS_Y = 194 * MiB;
constexpr size_t WS_SEL = 242 * MiB;
constexpr size_t DO_E = 0, DO_A = 16 * MiB, DO_G = 32 * MiB, DO_LIN = 48 * MiB;
constexpr size_t WS_GATES = 64 * MiB;
constexpr size_t WS_MERGED = 160 * MiB;
constexpr size_t WS_PQ = 64 * MiB;
constexpr size_t WS_SC = 128 * MiB;
constexpr size_t WS_EIDX = 32 * MiB;
constexpr size_t WS_EGATE = 40 * MiB;
constexpr size_t WS_END = 256 * MiB;

__device__ __forceinline__ unsigned f2bf(float f) { unsigned u = __builtin_bit_cast(unsigned, f); return (u + 0x7fffu + ((u >> 16) & 1u)) >> 16; }
__device__ __forceinline__ unsigned pk2(float lo, float hi) { return f2bf(lo) | (f2bf(hi) << 16); }
__device__ __forceinline__ unsigned pk2h(float lo, float hi) { typedef _Float16 h2 __attribute__((ext_vector_type(2))); h2 v; v[0] = (_Float16)lo; v[1] = (_Float16)hi; return __builtin_bit_cast(unsigned, v); }
__device__ __forceinline__ float bf2f(unsigned short b) { return __builtin_bit_cast(float, ((unsigned)b) << 16); }
__device__ __forceinline__ float bflo(unsigned w) { return __builtin_bit_cast(float, w << 16); }
__device__ __forceinline__ float bfhi(unsigned w) { return __builtin_bit_cast(float, w & 0xffff0000u); }
#ifndef XL_FALLBACK
#define XL_FALLBACK 0
#endif
template <int CTRL> __device__ __forceinline__ float dppf(float x) { return __builtin_bit_cast(float, __builtin_amdgcn_update_dpp(0, __builtin_bit_cast(int, x), CTRL, 0xf, 0xf, true)); }
template <int CTRL> __device__ __forceinline__ unsigned dppu(unsigned x) { return (unsigned)__builtin_amdgcn_update_dpp(0, (int)x, CTRL, 0xf, 0xf, true); }
typedef unsigned u32x2_ __attribute__((ext_vector_type(2)));
__device__ __forceinline__ void pl16(unsigned x, unsigned& a, unsigned& b) { a = x; b = x; asm volatile("s_nop 1\n\tv_permlane16_swap_b32 %0, %1" : "+v"(a), "+v"(b)); }
__device__ __forceinline__ void pl32(unsigned x, unsigned& a, unsigned& b) { a = x; b = x; asm volatile("s_nop 1\n\tv_permlane32_swap_b32 %0, %1" : "+v"(a), "+v"(b)); }
#define PLF(fn, x, fa, fb) unsigned _a, _b; fn(__builtin_bit_cast(unsigned, x), _a, _b); const float fa = __builtin_bit_cast(float, _a), fb = __builtin_bit_cast(float, _b)
__device__ __forceinline__ float xor16f(float x) { PLF(pl16, x, a, b); return ((threadIdx.x & 16) ? a : b); }
__device__ __forceinline__ float xor32f(float x) { PLF(pl32, x, a, b); return ((threadIdx.x & 32) ? a : b); }
#if XL_FALLBACK
__device__ __forceinline__ float sum_x16(float x) { return x + __shfl_xor(x, 16); }
__device__ __forceinline__ float sum_x32(float x) { return x + __shfl_xor(x, 32); }
__device__ __forceinline__ float max_x16(float x) { return fmaxf(x, __shfl_xor(x, 16)); }
__device__ __forceinline__ float max_x32(float x) { return fmaxf(x, __shfl_xor(x, 32)); }
__device__ __forceinline__ float sum8(float x) { x += __shfl_xor(x, 1); x += __shfl_xor(x, 2); x += __shfl_xor(x, 4); return x; }
__device__ __forceinline__ float sum16(float x) { x = sum8(x); x += __shfl_xor(x, 8); return x; }
__device__ __forceinline__ float max16(float x) { x = fmaxf(x, __shfl_xor(x, 1)); x = fmaxf(x, __shfl_xor(x, 2)); x = fmaxf(x, __shfl_xor(x, 4)); x = fmaxf(x, __shfl_xor(x, 8)); return x; }
#else
__device__ __forceinline__ float sum_x16(float x) { PLF(pl16, x, a, b); return a + b; }
__device__ __forceinline__ float sum_x32(float x) { PLF(pl32, x, a, b); return a + b; }
__device__ __forceinline__ float max_x16(float x) { PLF(pl16, x, a, b); return fmaxf(a, b); }
__device__ __forceinline__ float max_x32(float x) { PLF(pl32, x, a, b); return fmaxf(a, b); }
__device__ __forceinline__ float sum8(float x) { x += dppf<0xB1>(x); x += dppf<0x4E>(x); x += dppf<0x141>(x); return x; }
__device__ __forceinline__ float sum16(float x) { x = sum8(x); x += dppf<0x140>(x); return x; }
__device__ __forceinline__ float max16(float x) { x = fmaxf(x, dppf<0xB1>(x)); x = fmaxf(x, dppf<0x4E>(x)); x = fmaxf(x, dppf<0x141>(x)); x = fmaxf(x, dppf<0x140>(x)); return x; }
#endif
__device__ __forceinline__ float wave_sum(float v) { v = sum16(v); v = sum_x16(v); return sum_x32(v); }
__device__ __forceinline__ float wave_max(float v) { v = max16(v); v = max_x16(v); return max_x32(v); }
__device__ __forceinline__ int tid_opaque() { int t = threadIdx.x; asm volatile("" : "+v"(t)); return t; }

#ifndef PROBE_ID
#define PROBE_ID 0
#endif
#ifndef PROBE_BLK
#define PROBE_BLK 0
#endif
#define PROBE_LDS_OFF (150 * 1024 - 32)
#if PROBE_ID
#define PROBE_T0(id, ldsb) unsigned long long _pt0_##id = 0; if ((id) == PROBE_ID && blockIdx.x == PROBE_BLK && threadIdx.x == 0) _pt0_##id = __builtin_amdgcn_s_memrealtime();
#define PROBE_T1(id, ldsb) if ((id) == PROBE_ID && blockIdx.x == PROBE_BLK && threadIdx.x == 0) { *(LAS_ unsigned*)((ldsb) + PROBE_LDS_OFF) += (unsigned)(__builtin_amdgcn_s_memrealtime() - _pt0_##id); }
#else
#define PROBE_T0(id, ldsb)
#define PROBE_T1(id, ldsb)
#endif
#define LAS_ __attribute__((address_space(3)))
#if PROBE_ID
#define PROBE_SEG_INIT(ldsb) unsigned long long _pseg = 0; if (blockIdx.x == PROBE_BLK && threadIdx.x == 0) _pseg = __builtin_amdgcn_s_memrealtime();
#define PROBE_SEG(id, ldsb) if (blockIdx.x == PROBE_BLK && threadIdx.x == 0) { const unsigned long long _n = __builtin_amdgcn_s_memrealtime(); if ((id) == PROBE_ID) *(LAS_ unsigned*)((ldsb) + PROBE_LDS_OFF) += (unsigned)(_n - _pseg); _pseg = _n; }
#else
#define PROBE_SEG_INIT(ldsb)
#define PROBE_SEG(id, ldsb)
#endif
namespace pg8 {
#define PG8_LAS __attribute__((address_space(3)))
typedef unsigned short bf16_t;
typedef short bf16x8 __attribute__((ext_vector_type(8)));
typedef float f32x4 __attribute__((ext_vector_type(4)));
typedef unsigned u32x4 __attribute__((ext_vector_type(4)));
typedef unsigned u32x2 __attribute__((ext_vector_type(2)));
constexpr int BM = 256, BK = 64, HALF = 128, HTB = HALF * BK * 2, STAGE_BYTES = 8 * HTB, NXCD = 8, WGM = 8;

__host__ __device__ __forceinline__ int lds_byte(int r, int c) { const int st = (r >> 4) * 2 + (c >> 5), rr = r & 15, cc = c & 31, ob = rr * 64 + cc * 2; return st * 1024 + (ob ^ (((ob >> 9) & 1) << 5)); }
__host__ __device__ __forceinline__ void stage_rc(int b, int& R, int& C) { const int st = b / 1024, sb = b % 1024, swz = sb ^ (((sb >> 9) & 1) << 5); R = (st >> 1) * 16 + swz / 64; C = (st & 1) * 32 + (swz % 64) / 2; }

struct Unit { int pm, pn; };
struct Gemm { const bf16_t* A; const bf16_t* Bt; int M, N, K; int lda, ldb; long a_pn_step, b_pn_step; };

struct StaticOrder {
    int nM, nN, nwg, G, c;
    __host__ __device__ __forceinline__ void init(int M, int N, int G_, int c_) { nM = M / BM; nN = N / BM; nwg = nM * nN; G = G_; c = c_; }
    __host__ __device__ __forceinline__ bool next(int i, Unit& u) const {
        const long L = (long)i * G + c; if (L >= nwg) return false;
        int wgid = (int)L; { const int q = nwg / NXCD, r = nwg % NXCD, xcd = wgid % NXCD, off = wgid / NXCD; wgid = (xcd < r ? xcd * (q + 1) : r * (q + 1) + (xcd - r) * q) + off; }
        const int nig = WGM * nN, gid = wgid / nig, fm = gid * WGM, gsz = (nM - fm) < WGM ? (nM - fm) : WGM;
        u.pm = fm + ((wgid % nig) % gsz); u.pn = (wgid % nig) / gsz; return true;
    }
};

__device__ __forceinline__ unsigned cvt_pk_bf16(float lo, float hi) { unsigned r; asm volatile("v_cvt_pk_bf16_f32 %0, %1, %2" : "=v"(r) : "v"(lo), "v"(hi)); return r; }

typedef _Float16 f16x8 __attribute__((ext_vector_type(8)));
template <bool F16> __device__ __forceinline__ f32x4 mma16(bf16x8 a, bf16x8 b, f32x4 c) {
    if constexpr (F16) return __builtin_amdgcn_mfma_f32_16x16x32_f16(__builtin_bit_cast(f16x8, a), __builtin_bit_cast(f16x8, b), c, 0, 0, 0);
    else return __builtin_amdgcn_mfma_f32_16x16x32_bf16(a, b, c, 0, 0, 0);
}
struct PanelOrder {
    int pm0, pn0, nsteps, valid;
    __host__ __device__ __forceinline__ void init(int M, int G_, int c_, int nsteps_) { StaticOrder S; S.init(M, 1024, G_, c_); Unit u; valid = S.next(0, u) ? 1 : 0; pm0 = u.pm; pn0 = u.pn; nsteps = nsteps_; }
    __host__ __device__ __forceinline__ bool next(int i, Unit& u) const { if (!valid || i >= nsteps) return false; u.pm = pm0; u.pn = pn0 + 4 * i; return true; }
};
struct OneUnit { Unit u0; __host__ __device__ __forceinline__ bool next(int i, Unit& u) const { if (i != 0) return false; u = u0; return true; } };
template <bool F16, class Sched, class Epi>
__device__ __forceinline__ void gemm_phase(PG8_LAS unsigned char* lds, const Gemm g, const Sched& S, const Epi& E) {
    int tid = threadIdx.x; asm volatile("" : "+v"(tid));
    const int wid = __builtin_amdgcn_readfirstlane(tid >> 6), lane = tid & 63, wr = wid >> 2, wc = wid & 3, fr = lane & 15, fq = lane >> 4;
    const int K = g.K, nt = K / BK;
    unsigned voffA[2], voffB[2];
#pragma unroll
    for (int i = 0; i < 2; ++i) { int R, C; stage_rc(tid * 16 + i * 8192, R, C);
        voffA[i] = (unsigned)(R * g.lda + C) * 2u; voffB[i] = (unsigned)(R * g.ldb + C) * 2u; }
    const size_t kstep = (size_t)(BK * 2);
    const size_t hstepA = (size_t)HALF * g.lda * 2, hstepB = (size_t)HALF * g.ldb * 2;
    const size_t tstepA = 2 * hstepA;
    const unsigned ldsw = (unsigned)wid * 1024u;
    const int aoff = lds_byte(wr * 64 + fr, fq * 8), boff = lds_byte(wc * 32 + fr, fq * 8);
#define PG8_SA(b, h) (((b) * 2 + (h)) * HTB)
#define PG8_SB(b, h) ((4 + (b) * 2 + (h)) * HTB)
#define PG8_STAGE(bufoff, gbase, voff) do { _Pragma("unroll") for (int _i = 0; _i < 2; ++_i) \
        __builtin_amdgcn_global_load_lds((const unsigned*)((const char*)(gbase) + (voff)[_i]), (PG8_LAS unsigned*)(lds + (bufoff) + ldsw + _i * 8192), 16, 0, 0); } while (0)
#define PG8_LDA(dst, b, h) do { _Pragma("unroll") for (int m = 0; m < 4; ++m) _Pragma("unroll") for (int k = 0; k < 2; ++k) dst[m][k] = *(const PG8_LAS bf16x8*)(lds + PG8_SA(b, h) + aoff + m * 2048 + k * 1024); } while (0)
#define PG8_LDB(dst, b, h) do { _Pragma("unroll") for (int n = 0; n < 2; ++n) _Pragma("unroll") for (int k = 0; k < 2; ++k) dst[n][k] = *(const PG8_LAS bf16x8*)(lds + PG8_SB(b, h) + boff + n * 2048 + k * 1024); } while (0)
#define PG8_MMA(ai, bj, At, Bt) do { __builtin_amdgcn_s_setprio(1); _Pragma("unroll") for (int m = 0; m < 4; ++m) _Pragma("unroll") for (int n = 0; n < 2; ++n) _Pragma("unroll") for (int k = 0; k < 2; ++k) \
        acc[ai][bj][m][n] = mma16<F16>(Bt[n][k], At[m][k], acc[ai][bj][m][n]); __builtin_amdgcn_s_setprio(0); } while (0)
#define PG8_WAIT_V(n) asm volatile("s_waitcnt vmcnt(" #n ")" ::: "memory")
#define PG8_WAIT_L(n) asm volatile("s_waitcnt lgkmcnt(" #n ")" ::: "memory")
#define PG8_BAR __builtin_amdgcn_s_barrier()
#define PG8_SCHED __builtin_amdgcn_sched_barrier(0)
    Unit cur, nxt; int ui = 0;
    if (!S.next(0, cur)) return;
    f32x4 acc[2][2][4][2];
#pragma unroll
    for (int a = 0; a < 2; ++a)
#pragma unroll
        for (int b = 0; b < 2; ++b)
#pragma unroll
            for (int m = 0; m < 4; ++m)
#pragma unroll
                for (int n = 0; n < 2; ++n) acc[a][b][m][n] = (f32x4){0.f, 0.f, 0.f, 0.f};
    bf16x8 At[4][2], B0[2][2], B1[2][2];
    const char* cA = (const char*)g.A + (size_t)cur.pm * tstepA + (size_t)cur.pn * g.a_pn_step * 2; const char* cB = (const char*)g.Bt + (size_t)cur.pn * g.b_pn_step * 2;
    PG8_STAGE(PG8_SB(0, 0), cB, voffB); PG8_STAGE(PG8_SA(0, 0), cA, voffA); PG8_STAGE(PG8_SB(0, 1), cB + hstepB, voffB); PG8_STAGE(PG8_SA(0, 1), cA + hstepA, voffA);
    if (wr == 1) PG8_BAR;
    PG8_WAIT_V(4); PG8_BAR;
    PG8_STAGE(PG8_SB(1, 0), cB + kstep, voffB); PG8_STAGE(PG8_SA(1, 0), cA + kstep, voffA); PG8_STAGE(PG8_SB(1, 1), cB + hstepB + kstep, voffB);
    PG8_WAIT_V(6); PG8_BAR;
    for (;;) {
        const bool has_next = S.next(ui + 1, nxt);
        const char* nA = has_next ? (const char*)g.A + (size_t)nxt.pm * tstepA + (size_t)nxt.pn * g.a_pn_step * 2 : cA; const char* nB = has_next ? (const char*)g.Bt + (size_t)nxt.pn * g.b_pn_step * 2 : cB;
        for (int t = 0; t < nt; t += 2) {
            const bool last = (t == nt - 2);
            const char* a1 = cA + (size_t)(t + 1) * kstep;
            const char* a2 = last ? nA : cA + (size_t)(t + 2) * kstep; const char* b2 = last ? nB : cB + (size_t)(t + 2) * kstep;
            const char* a3 = a2 + kstep; const char* b3 = b2 + kstep;
            PG8_LDB(B0, 0, 0); PG8_SCHED; PG8_LDA(At, 0, 0); PG8_STAGE(PG8_SA(1, 1), a1 + hstepA, voffA);
            PG8_WAIT_L(8); PG8_BAR; PG8_WAIT_L(0); PG8_MMA(0, 0, At, B0); PG8_BAR; PG8_SCHED;
            PG8_LDB(B1, 0, 1); PG8_STAGE(PG8_SB(0, 0), b2, voffB);
            PG8_BAR; PG8_WAIT_L(0); PG8_MMA(0, 1, At, B1); PG8_BAR;
            PG8_LDA(At, 0, 1); PG8_STAGE(PG8_SA(0, 0), a2, voffA);
            PG8_BAR; PG8_WAIT_L(0); PG8_MMA(1, 0, At, B0); PG8_BAR; PG8_SCHED;
            PG8_STAGE(PG8_SB(0, 1), b2 + hstepB, voffB);
            PG8_WAIT_V(6); PG8_BAR; PG8_MMA(1, 1, At, B1); PG8_BAR;
            PG8_LDB(B0, 1, 0); PG8_SCHED; PG8_LDA(At, 1, 0); PG8_STAGE(PG8_SA(0, 1), a2 + hstepA, voffA);
            PG8_WAIT_L(8); PG8_BAR; PG8_WAIT_L(0); PG8_MMA(0, 0, At, B0); PG8_BAR; PG8_SCHED;
            PG8_LDB(B1, 1, 1); PG8_STAGE(PG8_SB(1, 0), b3, voffB);
            PG8_BAR; PG8_WAIT_L(0); PG8_MMA(0, 1, At, B1); PG8_BAR;
            PG8_LDA(At, 1, 1); PG8_STAGE(PG8_SA(1, 0), a3, voffA);
            PG8_BAR; PG8_WAIT_L(0); PG8_MMA(1, 0, At, B0); PG8_BAR; PG8_SCHED;
            PG8_STAGE(PG8_SB(1, 1), b3 + hstepB, voffB);
            PG8_WAIT_V(6); PG8_BAR; PG8_MMA(1, 1, At, B1); PG8_BAR;
        }
        { int fr_ = fr, fq_ = fq; asm volatile("" : "+v"(fr_), "+v"(fq_)); E(acc, cur, wr, wc, fr_, fq_); }
        if (!has_next) break;
#pragma unroll
        for (int a = 0; a < 2; ++a)
#pragma unroll
            for (int b = 0; b < 2; ++b)
#pragma unroll
                for (int m = 0; m < 4; ++m)
#pragma unroll
                    for (int n = 0; n < 2; ++n) acc[a][b][m][n] = (f32x4){0.f, 0.f, 0.f, 0.f};
        cur = nxt; cA = nA; cB = nB; ++ui;
    }
    PG8_WAIT_V(0);
    if (wr == 0) PG8_BAR;
    PG8_BAR;
#undef PG8_SA
#undef PG8_SB
#undef PG8_STAGE
#undef PG8_LDA
#undef PG8_LDB
#undef PG8_MMA
#undef PG8_WAIT_V
#undef PG8_WAIT_L
#undef PG8_BAR
#undef PG8_SCHED
}
}
#define LAS __attribute__((address_space(3)))
#define LDS_WAIT() asm volatile("s_waitcnt lgkmcnt(0)" ::: "memory")
constexpr int NT = 512, NW = 8;

struct Params {
    const float* in[31];
    float* out;
    unsigned char* ws;
};

__device__ __forceinline__ void tr_item(const float* W, int ldw, bf16* WT, int K, int k0, int nphys0, int lbase, int cnt, const float* kg, LAS float* scr, int lane, bool f16 = false) {
    const int c = lane & 31;
#pragma unroll 8
    for (int i = 0; i < 32; ++i) { const int kk = 2 * i + (lane >> 5); float v = 0.f;
        if (c < cnt) { v = W[(size_t)(k0 + kk) * ldw + lbase + c]; if (kg) v *= kg[k0 + kk]; }
        scr[kk * 33 + c] = v; }
    LDS_WAIT();
    const int c8 = lane & 7;
#pragma unroll
    for (int j = 0; j < 4; ++j) { const int n = (lane >> 3) + 8 * j; const LAS float* s = scr + (8 * c8) * 33 + n;
        u32x4 o;
        if (f16) { o.x = pk2h(s[0 * 33], s[1 * 33]); o.y = pk2h(s[2 * 33], s[3 * 33]); o.z = pk2h(s[4 * 33], s[5 * 33]); o.w = pk2h(s[6 * 33], s[7 * 33]); }
        else { o.x = pk2(s[0 * 33], s[1 * 33]); o.y = pk2(s[2 * 33], s[3 * 33]); o.z = pk2(s[4 * 33], s[5 * 33]); o.w = pk2(s[6 * 33], s[7 * 33]); }
        *(u32x4*)(WT + (size_t)(nphys0 + n) * K + k0 + 8 * c8) = o; }
    LDS_WAIT();
}
__device__ __forceinline__ void p1_group(int g, int& lbase, int& cnt) {
    const int tile = g >> 3, gi = g & 7, bj = gi >> 2, wc = gi & 3; cnt = 32;
    if (tile < 2) lbase = COL_Q + (4 * tile + wc) * 64 + 32 * bj;
    else if (tile < 4) lbase = COL_K + (4 * (tile - 2) + wc) * 64 + 32 * bj;
    else if (tile < 6) lbase = COL_V + (tile - 4) * 256 + 32 * gi;
    else if (tile == 6) lbase = COL_IQ + wc * 64 + 32 * bj;
    else if (tile == 7) { if (wc == 0) lbase = COL_IK + 32 * bj; else if (gi == 1) { lbase = COL_IW; cnt = 4; } else { lbase = 0; cnt = 0; } }
    else if (tile < 15) lbase = COL_RW + (tile - 8) * 256 + 32 * gi;
    else lbase = COL_MEMQ + (tile - 15) * 256 + 32 * gi;
}

__device__ __forceinline__ void prologue_phase(const Params& P, LAS unsigned char* lds, int bid, int nblk) {
    const int tid = tid_opaque(), lane = tid & 63, wave = tid >> 6;
    const int gw = bid * NW + wave, NGW = nblk * NW;
    unsigned char* ws = P.ws;
    LAS float* scr = (LAS float*)(lds + wave * 16384);
    constexpr int I_P1 = 16 * (P1_N / 32), I_WG = 16 * 96, I_UP = 8 * 32, I_OUT = 16 * 32, I_WQ = 16 * 64, I_MEM = 16 * 32;
    constexpr int NITEMS = I_P1 + I_WG + 3 * I_UP + I_OUT + I_WQ + I_MEM;
    for (int it = gw; it < I_P1 + I_MEM; it += NGW) {
        int r = it;
        if (r < I_P1) { const int ng = P1_N / 32, kb = r / ng, g = r % ng; int lb, cnt; p1_group(g, lb, cnt);
            tr_item(P.in[4], WIN_COLS, (bf16*)(ws + WS_WIN), 1024, 64 * kb, 32 * g, lb, cnt, P.in[3], scr, lane); continue; } r -= I_P1;
        { const int kb = r / 32, g = r % 32;
            tr_item(P.in[9], 1024, (bf16*)(ws + WS_WMEM), 1024, 64 * kb, 32 * g, 32 * g, 32, P.in[8], scr, lane); }
    }
    for (int m = gw; m < S_ + NMEM; m += NGW) {
        const bool isx = m < S_; const int r = isx ? m : m - S_;
        const f32x4* xr = (const f32x4*)((isx ? P.in[0] : P.in[1]) + (size_t)r * D_) + lane;
        f32x4 v[4]; float s = 0.f;
#pragma unroll
        for (int j = 0; j < 4; ++j) { v[j] = xr[64 * j]; s += (v[j].x * v[j].x + v[j].y * v[j].y) + (v[j].z * v[j].z + v[j].w * v[j].w); }
        s = wave_sum(s);
        const float rstd = 1.0f / sqrtf(s * (1.0f / D_) + NORM_EPS);
        if (lane == 0) ((float*)(ws + (isx ? WS_RSTDX : WS_RSTDM)))[r] = rstd;
        unsigned long long* o8 = (unsigned long long*)((bf16*)(ws + (isx ? WS_XB : WS_MB)) + (size_t)r * D_) + lane;
#pragma unroll
        for (int j = 0; j < 4; ++j) o8[64 * j] = (unsigned long long)pk2(v[j].x, v[j].y) | ((unsigned long long)pk2(v[j].z, v[j].w) << 32);
    }
    const int gt = bid * NT + tid, NGT = nblk * NT;
    for (int i = gt; i < S_ * 8; i += NGT) { const int t = i >> 3, f = i & 7;
        const double inv = pow(500000.0, -(double)f / 8.0); const double ang = (double)((const int*)P.in[2])[t] * inv;
        ((float*)(ws + WS_COS))[i] = (float)cos(ang); ((float*)(ws + WS_SIN))[i] = (float)sin(ang); }
    for (int i = gt; i < 256 * 256; i += NGT) { const int n = i >> 8, k = i & 255; float v = 0.f;
        if (n < 128) { if (k < 128) v = P.in[27][n * 128 + k]; } else { if (k >= 128) v = P.in[28][(n - 128) * 128 + (k - 128)]; }
        ((half_t*)(ws + WS_KEYBD))[i] = (half_t)v; }
    for (int i = gt; i < 1536 * 256; i += NGT) { const int n = i >> 8, k = i & 255; float v = 0.f;
        if (n < 512) { if (k < 64) v = P.in[14][k * 512 + n]; }
        else if (n < 1024) { if (k >= 64 && k < 128) v = P.in[16][(k - 64) * 512 + (n - 512)]; }
        else { if (k >= 128) v = P.in[17][(k - 128) * 512 + (n - 1024)]; }
        ((bf16*)(ws + WS_WLORA))[i] = (bf16)f2bf(v); }
}

__device__ __forceinline__ void prologue_rest_phase(const Params& P, LAS unsigned char* lds, int bid, int nblk) {
    const int tid = tid_opaque(), lane = tid & 63, wave = tid >> 6;
    const int gw = bid * NW + wave, NGW = nblk * NW;
    unsigned char* ws = P.ws;
    LAS float* scr = (LAS float*)(lds + wave * 16384);
    constexpr int I_WG = 16 * 96, I_UP = 8 * 32, I_OUT = 16 * 32, I_WQ = 16 * 64;
    constexpr int NREST = I_WG + 3 * I_UP + I_OUT + I_WQ;
    for (int it = gw; it < NREST; it += NGW) {
        int r = it;
        if (r < I_WG) { const int kb = r / 96, g = r % 96;
            tr_item(P.in[4], WIN_COLS, (bf16*)(ws + WS_WG), 1024, 64 * kb, 32 * g, COL_GATE + 32 * g, 32, P.in[3], scr, lane); continue; } r -= I_WG;
        if (r < 3 * I_UP) { const int c = r / I_UP, rr = r % I_UP, kb = rr / 32, g = rr % 32;
            tr_item(P.in[23] + (size_t)c * 512 * 1024, 1024, (bf16*)(ws + WS_WUP) + (size_t)c * 1024 * 512, 512, 64 * kb, 32 * g, 32 * g, 32, nullptr, scr, lane); continue; } r -= 3 * I_UP;
        if (r < I_OUT) { const int kb = r / 32, g = r % 32;
            tr_item(P.in[24], 1024, (bf16*)(ws + WS_WOUT), 1024, 64 * kb, 32 * g, 32 * g, 32, nullptr, scr, lane); continue; } r -= I_OUT;
        { const int kb = r / 64, g = r % 64;
            tr_item(P.in[26], 2048, (bf16*)(ws + WS_WQ), 1024, 64 * kb, 32 * g, 32 * g, 32, P.in[25], scr, lane, true); }
    }
}

typedef const f32x4 (&AccRef)[2][2][4][2];
__device__ __forceinline__ void st_bf4(bf16* p, f32x4 v) { u32x2 w; w.x = pk2(v[0], v[1]); w.y = pk2(v[2], v[3]); *(u32x2*)p = w; }
__device__ __forceinline__ void st_h4(half_t* p, f32x4 v) { half4 h; h[0] = (half_t)v[0]; h[1] = (half_t)v[1]; h[2] = (half_t)v[2]; h[3] = (half_t)v[3]; *(half4*)p = h; }

__device__ __forceinline__ void st_f8x4(unsigned char* p, f32x4 v) { int w = __builtin_amdgcn_cvt_pk_fp8_f32(v[0], v[1], 0, false); w = __builtin_amdgcn_cvt_pk_fp8_f32(v[2], v[3], w, true); *(int*)p = w; }
__device__ __forceinline__ f32x4 rope4(f32x4 v, int fq, const float* cs, const float* sn) {
    f32x4 o;
#pragma unroll
    for (int j = 0; j < 4; ++j) { const float p = xor32f(v[j]); const int i = 4 * (fq & 1) + j; const float c = cs[i], s = sn[i];
        o[j] = (fq < 2) ? (v[j] * c - p * s) : (v[j] * c + p * s); }
    return o;
}

struct EpiP1 {
    const float* rstd; const float* cs; const float* sn; const float* qgain; const float* kgain;
    bf16 *Q, *K, *V, *RWP, *MEMQ; half_t *IQ, *IK; float* IW;
    __device__ __forceinline__ void operator()(AccRef acc, const pg8::Unit& u, int wr, int wc, int fr, int fq) const {
        const int pn = u.pn;
#pragma unroll
        for (int ai = 0; ai < 2; ++ai)
#pragma unroll
            for (int m = 0; m < 4; ++m) {
                const int row = u.pm * 256 + ai * 128 + wr * 64 + m * 16 + fr; const float rs = rstd[row];
                f32x4 v[2][2];
#pragma unroll
                for (int bj = 0; bj < 2; ++bj)
#pragma unroll
                    for (int n = 0; n < 2; ++n) v[bj][n] = acc[ai][bj][m][n] * rs;
                if (pn < 4) {
                    float ss = 0.f;
#pragma unroll
                    for (int bj = 0; bj < 2; ++bj)
#pragma unroll
                        for (int n = 0; n < 2; ++n) ss += (v[bj][n][0] * v[bj][n][0] + v[bj][n][1] * v[bj][n][1]) + (v[bj][n][2] * v[bj][n][2] + v[bj][n][3] * v[bj][n][3]);
                    ss = sum_x16(ss); ss = sum_x32(ss);
                    const float rh = 1.0f / sqrtf(ss * (1.0f / 64.0f) + NORM_EPS);
                    const float* gn = (pn < 2) ? qgain : kgain;
#pragma unroll
                    for (int bj = 0; bj < 2; ++bj)
#pragma unroll
                        for (int n = 0; n < 2; ++n) { const f32x4 gv = *(const f32x4*)(gn + 32 * bj + 16 * n + 4 * fq); v[bj][n] = v[bj][n] * rh * gv; }
                    v[0][0] = rope4(v[0][0], fq, cs + row * 8, sn + row * 8);
                    const int head = (pn & 1) * 4 + wc;
                    if (pn < 2) { bf16* dst = Q + (size_t)row * 512 + head * 64 + 4 * fq;
#pragma unroll
                        for (int bj = 0; bj < 2; ++bj)
#pragma unroll
                            for (int n = 0; n < 2; ++n) st_bf4(dst + 32 * bj + 16 * n, v[bj][n]);
                    } else { half_t* dst = (half_t*)K + ((size_t)head * S_ + row) * 64 + 4 * fq;
#pragma unroll
                        for (int bj = 0; bj < 2; ++bj)
#pragma unroll
                            for (int n = 0; n < 2; ++n) st_h4(dst + 32 * bj + 16 * n, v[bj][n]); }
                } else if (pn < 6) {
#pragma unroll
                    for (int bj = 0; bj < 2; ++bj)
#pragma unroll
                        for (int n = 0; n < 2; ++n) { const int head = (pn - 4) * 4 + 2 * bj + (wc >> 1);
                            st_h4((half_t*)V + ((size_t)head * S_ + row) * 64 + 32 * (wc & 1) + 16 * n + 4 * fq, v[bj][n]); }
                } else if (pn == 6) {
                    v[0][0] = rope4(v[0][0], fq, cs + row * 8, sn + row * 8);
                    half_t* dst = IQ + (size_t)row * 256 + wc * 64 + 4 * fq;
#pragma unroll
                    for (int bj = 0; bj < 2; ++bj)
#pragma unroll
                        for (int n = 0; n < 2; ++n) st_h4(dst + 32 * bj + 16 * n, v[bj][n]);
                } else if (pn == 7) {
                    if (wc == 0) {
                        v[0][0] = rope4(v[0][0], fq, cs + row * 8, sn + row * 8);
#pragma unroll
                        for (int bj = 0; bj < 2; ++bj)
#pragma unroll
                            for (int n = 0; n < 2; ++n) st_h4(IK + ((size_t)((row >> 4) * 2 + bj) * 64 + (2 * n + (fq >> 1)) * 16 + (row & 15)) * 8 + 4 * (fq & 1), v[bj][n]);
                    } else if (wc == 1) { if (fq == 0) *(f32x4*)(IW + (size_t)row * 4) = v[0][0]; }
                } else if (pn < 15) {
                    bf16* dst = RWP + (size_t)row * RW_IN + (pn - 8) * 256 + 32 * wc + 4 * fq;
#pragma unroll
                    for (int bj = 0; bj < 2; ++bj)
#pragma unroll
                        for (int n = 0; n < 2; ++n) st_bf4(dst + 128 * bj + 16 * n, v[bj][n]);
                } else {
                    bf16* dst = MEMQ + (size_t)row * 512 + (pn - 15) * 256 + 32 * wc + 4 * fq;
#pragma unroll
                    for (int bj = 0; bj < 2; ++bj)
#pragma unroll
                        for (int n = 0; n < 2; ++n) st_bf4(dst + 128 * bj + 16 * n, v[bj][n]);
                }
            }
    }
};

struct EpiF32 {
    float* C; int ldc; const float* rstd;
    __device__ __forceinline__ void operator()(AccRef acc, const pg8::Unit& u, int wr, int wc, int fr, int fq) const {
#pragma unroll
        for (int ai = 0; ai < 2; ++ai)
#pragma unroll
            for (int m = 0; m < 4; ++m) { const int row = u.pm * 256 + ai * 128 + wr * 64 + m * 16 + fr; const float rs = rstd ? rstd[row] : 1.0f;
                float* dst = C + (size_t)row * ldc + u.pn * 256 + 32 * wc + 4 * fq;
#pragma unroll
                for (int bj = 0; bj < 2; ++bj)
#pragma unroll
                    for (int n = 0; n < 2; ++n) *(f32x4*)(dst + 128 * bj + 16 * n) = acc[ai][bj][m][n] * rs; }
    }
};
struct EpiBf {
    bf16* C; int ldc; const float* rstd;
    __device__ __forceinline__ void operator()(AccRef acc, const pg8::Unit& u, int wr, int wc, int fr, int fq) const {
#pragma unroll
        for (int ai = 0; ai < 2; ++ai)
#pragma unroll
            for (int m = 0; m < 4; ++m) { const int row = u.pm * 256 + ai * 128 + wr * 64 + m * 16 + fr; const float rs = rstd ? rstd[row] : 1.0f;
                bf16* dst = C + (size_t)row * ldc + u.pn * 256 + 32 * wc + 4 * fq;
#pragma unroll
                for (int bj = 0; bj < 2; ++bj)
#pragma unroll
                    for (int n = 0; n < 2; ++n) st_bf4(dst + 128 * bj + 16 * n, acc[ai][bj][m][n] * rs); }
    }
};
__device__ __forceinline__ float sigmoidf_(float x) { return 1.0f / (1.0f + __expf(-x)); }
struct EpiLora {
    bf16 *E, *A, *G; const float* w0; const float* a0;
    __device__ __forceinline__ void operator()(AccRef acc, const pg8::Unit& u, int wr, int wc, int fr, int fq) const {
        const int kind = u.pn >> 1;
#pragma unroll
        for (int ai = 0; ai < 2; ++ai)
#pragma unroll
            for (int m = 0; m < 4; ++m) { const int row = u.pm * 256 + ai * 128 + wr * 64 + m * 16 + fr;
#pragma unroll
                for (int bj = 0; bj < 2; ++bj)
#pragma unroll
                    for (int n = 0; n < 2; ++n) { const int c = (u.pn & 1) * 256 + 128 * bj + 32 * wc + 16 * n + 4 * fq; f32x4 v = acc[ai][bj][m][n];
                        if (kind == 0) { const f32x4 b = *(const f32x4*)(w0 + c);
#pragma unroll
                            for (int j = 0; j < 4; ++j) { const float z = v[j] + b[j]; const float sp = fmaxf(-z, 0.f) + __logf(1.0f + __expf(-fabsf(z))); v[j] = __expf(-sp - 0.5f); }
                            st_bf4(E + (size_t)row * 512 + c, v);
                        } else if (kind == 1) { const f32x4 b = *(const f32x4*)(a0 + c);
#pragma unroll
                            for (int j = 0; j < 4; ++j) v[j] = sigmoidf_(v[j] + b[j]);
                            st_bf4(A + (size_t)row * 512 + c, v);
                        } else st_bf4(G + (size_t)row * 512 + c, v); } }
    }
};
struct EpiGate {
    bf16* Gt; const float* rstd; const float* bias;
    __device__ __forceinline__ void operator()(AccRef acc, const pg8::Unit& u, int wr, int wc, int fr, int fq) const {
#pragma unroll
        for (int ai = 0; ai < 2; ++ai)
#pragma unroll
            for (int m = 0; m < 4; ++m) { const int row = u.pm * 256 + ai * 128 + wr * 64 + m * 16 + fr; const float rs = rstd[row];
#pragma unroll
                for (int bj = 0; bj < 2; ++bj)
#pragma unroll
                    for (int n = 0; n < 2; ++n) { const int c = u.pn * 256 + 128 * bj + 32 * wc + 16 * n + 4 * fq; const f32x4 b = *(const f32x4*)(bias + c); f32x4 v = acc[ai][bj][m][n] * rs + b;
#pragma unroll
                        for (int j = 0; j < 4; ++j) v[j] = sigmoidf_(v[j]);
                        st_bf4(Gt + (size_t)row * 3072 + c, v); } }
    }
};
struct EpiMerge {
    const bf16* Gt; float* accf; bf16* merged; int c;
    __device__ __forceinline__ void operator()(AccRef acc, const pg8::Unit& u, int wr, int wc, int fr, int fq) const {
        const int row0 = u.pm * 256 + wr * 64 + fr, col0 = u.pn * 256 + 32 * wc + 4 * fq;
#pragma unroll
        for (int ai = 0; ai < 2; ++ai)
#pragma unroll
            for (int bj = 0; bj < 2; ++bj) {
                u32x2 gw[4][2]; f32x4 old[4][2];
#pragma unroll
                for (int m = 0; m < 4; ++m)
#pragma unroll
                    for (int n = 0; n < 2; ++n) { const size_t r = (size_t)(row0 + ai * 128 + m * 16); const int cc = col0 + 128 * bj + 16 * n;
                        gw[m][n] = *(const u32x2*)(Gt + r * 3072 + c * 1024 + cc); old[m][n] = (f32x4){0.f, 0.f, 0.f, 0.f}; if (c > 0) old[m][n] = *(const f32x4*)(accf + r * 1024 + cc); }
#pragma unroll
                for (int m = 0; m < 4; ++m)
#pragma unroll
                    for (int n = 0; n < 2; ++n) { const u32x2 g2 = gw[m][n]; f32x4 a = acc[ai][bj][m][n]; const f32x4 od = old[m][n];
                        a[0] = a[0] * bflo(g2.x) + od[0]; a[1] = a[1] * bfhi(g2.x) + od[1]; a[2] = a[2] * bflo(g2.y) + od[2]; a[3] = a[3] * bfhi(g2.y) + od[3];
                        const size_t o = (size_t)(row0 + ai * 128 + m * 16) * 1024 + col0 + 128 * bj + 16 * n;
                        if (c < 2) *(f32x4*)(accf + o) = a; else st_bf4(merged + o, a); }
            }
    }
};
struct EpiOut {
    const float* x; float* out; bf16* HB; float* HSQ;
    __device__ __forceinline__ void operator()(AccRef acc, const pg8::Unit& u, int wr, int wc, int fr, int fq) const {
#pragma unroll
        for (int ai = 0; ai < 2; ++ai)
#pragma unroll
            for (int m = 0; m < 4; ++m) { const int row = u.pm * 256 + ai * 128 + wr * 64 + m * 16 + fr; float ss = 0.f;
#pragma unroll
                for (int bj = 0; bj < 2; ++bj)
#pragma unroll
                    for (int n = 0; n < 2; ++n) { const size_t o = (size_t)row * 1024 + u.pn * 256 + 128 * bj + 32 * wc + 16 * n + 4 * fq;
                        const f32x4 v = acc[ai][bj][m][n] + *(const f32x4*)(x + o); *(f32x4*)(out + o) = v; st_h4((half_t*)HB + o, v);
                        ss += (v[0] * v[0] + v[1] * v[1]) + (v[2] * v[2] + v[3] * v[3]); }
                ss = sum_x16(ss); ss = sum_x32(ss);
                if (fq == 0) HSQ[(size_t)row * 16 + u.pn * 4 + wc] = ss; }
    }
};

__device__ __forceinline__ float rstd_h_row(const float* HSQ, int row) {
    const f32x4* hp = (const f32x4*)(HSQ + (size_t)row * 16); const f32x4 a = hp[0], b = hp[1], c = hp[2], d = hp[3];
    const float s = ((a[0] + a[1]) + (a[2] + a[3])) + ((b[0] + b[1]) + (b[2] + b[3])) + ((c[0] + c[1]) + (c[2] + c[3])) + ((d[0] + d[1]) + (d[2] + d[3]));
    return 1.0f / sqrtf(s * (1.0f / 1024.0f) + NORM_EPS);
}
__device__ __forceinline__ void lora_in_phase(const Params& P, int bid, int nblk) {
    const bf16* RWP = (const bf16*)(P.ws + WS_RWP); bf16* LIN = (bf16*)((unsigned char*)P.out + DO_LIN); const float* mu = P.in[12];
    const int gt = bid * NT + tid_opaque(), NGT = nblk * NT;
    for (int i = gt; i < S_ * 64; i += NGT) { const int t = i >> 6, c4 = (i & 63) * 4;
        const u32x2 pw = *(const u32x2*)(RWP + (size_t)t * RW_IN + 1536 + c4);
        u32x2 qw; qw.x = 0u; qw.y = 0u; if (t > 0) qw = *(const u32x2*)(RWP + (size_t)(t - 1) * RW_IN + 1536 + c4);
        const f32x4 m4 = *(const f32x4*)(mu + 1536 + c4);
        f32x4 p = {bflo(pw.x), bfhi(pw.x), bflo(pw.y), bfhi(pw.y)}, q = {bflo(qw.x), bfhi(qw.x), bflo(qw.y), bfhi(qw.y)};
        f32x4 s = p + (q - p) * m4;
        if (c4 < 64) { for (int j = 0; j < 4; ++j) s[j] = tanhf(s[j]); }
        else if (c4 >= 128) { for (int j = 0; j < 4; ++j) s[j] = sigmoidf_(s[j]); }
        st_bf4(LIN + (size_t)t * 256 + c4, s); }
}

constexpr int TC = 32;
__device__ __forceinline__ float shift3(const bf16* RWP, const float* mu, int t, int col) {
    const float p = bf2f(RWP[(size_t)t * RW_IN + col]); const float q = t > 0 ? bf2f(RWP[(size_t)(t - 1) * RW_IN + col]) : 0.f;
    return p + (q - p) * mu[col];
}
__device__ __forceinline__ void rwkv_scan_v1(const Params& P, LAS unsigned char* lds, int h) {
    const bf16* RWP = (const bf16*)(P.ws + WS_RWP);
    const bf16* Eb = (const bf16*)((unsigned char*)P.out + DO_E); const bf16* Ab = (const bf16*)((unsigned char*)P.out + DO_A); const bf16* Gb = (const bf16*)((unsigned char*)P.out + DO_G);
    bf16* Y = (bf16*)(P.ws + WS_Y);
    const float* mu = P.in[12]; const float* k_k = P.in[18]; const float* k_a = P.in[19]; const float* r_k = P.in[20]; const float* ln_w = P.in[21]; const float* ln_b = P.in[22];
    LAS float* sR = (LAS float*)lds; LAS float* sW = sR + TC * 64; LAS float* sK = sW + TC * 64; LAS float* sV = sK + TC * 64;
    LAS float* sA = sV + TC * 64; LAS float* sB = sA + TC * 64; LAS float* sY = sB + TC * 64; LAS float* sG = sY + TC * 64;
    const int tid = tid_opaque();
    const int tok = tid >> 4, j0 = (tid & 15) * 4;
    const int si = tid >> 3, jg = tid & 7;
    float S[8];
#pragma unroll
    for (int c = 0; c < 8; ++c) S[c] = 0.f;
    for (int t0 = 0; t0 < S_; t0 += TC) {
        {
            const int t = t0 + tok; float kkv[4], ss = 0.f, rr[4], kk_[4], vv[4], aa[4], ee[4], gg[4];
#pragma unroll
            for (int j = 0; j < 4; ++j) { const int c = h * 64 + j0 + j;
                rr[j] = shift3(RWP, mu, t, c); kk_[j] = shift3(RWP, mu, t, 512 + c); vv[j] = shift3(RWP, mu, t, 1024 + c);
                aa[j] = bf2f(Ab[(size_t)t * 512 + c]); ee[j] = bf2f(Eb[(size_t)t * 512 + c]); gg[j] = bf2f(Gb[(size_t)t * 512 + c]);
                kkv[j] = kk_[j] * k_k[c]; ss += kkv[j] * kkv[j]; }
            ss += __shfl_xor(ss, 1); ss += __shfl_xor(ss, 2); ss += __shfl_xor(ss, 4); ss += __shfl_xor(ss, 8);
            const float inv = 1.0f / fmaxf(sqrtf(ss), 1e-12f);
#pragma unroll
            for (int j = 0; j < 4; ++j) { const int c = h * 64 + j0 + j; const int o = tok * 64 + j0 + j; const float kn = kkv[j] * inv;
                sR[o] = rr[j]; sW[o] = __expf(-ee[j]); sK[o] = kk_[j] * (1.0f + (aa[j] - 1.0f) * k_a[c]); sV[o] = vv[j]; sA[o] = -kn; sB[o] = kn * aa[j]; sG[o] = gg[j]; }
        }
        __syncthreads();
        for (int tt = 0; tt < TC; ++tt) {
            const LAS float* pa = sA + tt * 64 + 8 * jg; const LAS float* pb = sB + tt * 64 + 8 * jg; const LAS float* pw = sW + tt * 64 + 8 * jg;
            const LAS float* pk = sK + tt * 64 + 8 * jg; const LAS float* pr = sR + tt * 64 + 8 * jg;
            const float vi = sV[tt * 64 + si];
            float sa = 0.f;
#pragma unroll
            for (int c = 0; c < 8; ++c) sa += S[c] * pa[c];
            sa += __shfl_xor(sa, 1); sa += __shfl_xor(sa, 2); sa += __shfl_xor(sa, 4);
            float y = 0.f;
#pragma unroll
            for (int c = 0; c < 8; ++c) { S[c] = S[c] * pw[c] + sa * pb[c] + vi * pk[c]; y += S[c] * pr[c]; }
            y += __shfl_xor(y, 1); y += __shfl_xor(y, 2); y += __shfl_xor(y, 4);
            if (jg == 0) sY[tt * 64 + si] = y;
        }
        __syncthreads();
        {
            const int t = t0 + tok; float y4[4], s1 = 0.f, bon = 0.f;
#pragma unroll
            for (int j = 0; j < 4; ++j) { const int o = tok * 64 + j0 + j; y4[j] = sY[o]; s1 += y4[j]; bon += sR[o] * sK[o] * r_k[h * 64 + j0 + j]; }
            s1 += __shfl_xor(s1, 1); s1 += __shfl_xor(s1, 2); s1 += __shfl_xor(s1, 4); s1 += __shfl_xor(s1, 8);
            bon += __shfl_xor(bon, 1); bon += __shfl_xor(bon, 2); bon += __shfl_xor(bon, 4); bon += __shfl_xor(bon, 8);
            const float mean = s1 * (1.0f / 64.0f); float s2 = 0.f;
#pragma unroll
            for (int j = 0; j < 4; ++j) { const float d = y4[j] - mean; s2 += d * d; }
            s2 += __shfl_xor(s2, 1); s2 += __shfl_xor(s2, 2); s2 += __shfl_xor(s2, 4); s2 += __shfl_xor(s2, 8);
            const float rstd = 1.0f / sqrtf(s2 * (1.0f / 64.0f) + GN_EPS);
            f32x4 o4;
#pragma unroll
            for (int j = 0; j < 4; ++j) { const int c = h * 64 + j0 + j; const int o = tok * 64 + j0 + j;
                o4[j] = ((y4[j] - mean) * rstd * ln_w[c] + ln_b[c] + bon * sV[o]) * sG[o]; }
            st_bf4(Y + (size_t)t * 1536 + 512 + h * 64 + j0, o4);
        }
        __syncthreads();
    }
}

__device__ __forceinline__ float inv_ordkey(unsigned u) { return __builtin_bit_cast(float, (u & 0x80000000u) ? (u & 0x7fffffffu) : ~u); }
__device__ __forceinline__ unsigned ordkey(float f) { const unsigned u = __builtin_bit_cast(unsigned, f); return (u & 0x80000000u) ? ~u : (u | 0x80000000u); }
constexpr int DSA_LDS_SCORES = 0, DSA_LDS_IQ = 65536, DSA_LDS_HIST = DSA_LDS_IQ + 1024, DSA_LDS_MISC = DSA_LDS_HIST + 1024, DSA_LDS_SEL = DSA_LDS_MISC + 256,
              DSA_LDS_O = DSA_LDS_SEL + 1024, DSA_LDS_ML = DSA_LDS_O + 8 * 512 * 4, DSA_LDS_END = DSA_LDS_ML + 8 * 8 * 2 * 4;
__device__ __forceinline__ void dsa_query_v1(const Params& P, LAS unsigned char* lds, int t) {
    const half_t* IQ = (const half_t*)(P.ws + WS_IQ); const half_t* IK = (const half_t*)(P.ws + WS_IK); const float* IW = (const float*)(P.ws + WS_IW);
    const bf16* Q = (const bf16*)(P.ws + WS_Q); const bf16* Kb = (const bf16*)(P.ws + WS_K); const bf16* Vb = (const bf16*)(P.ws + WS_V);
    bf16* Y = (bf16*)(P.ws + WS_Y);
    LAS float* sc = (LAS float*)(lds + DSA_LDS_SCORES); LAS float* siq = (LAS float*)(lds + DSA_LDS_IQ); LAS unsigned* hist = (LAS unsigned*)(lds + DSA_LDS_HIST);
    LAS unsigned* misc = (LAS unsigned*)(lds + DSA_LDS_MISC); LAS unsigned* sel = (LAS unsigned*)(lds + DSA_LDS_SEL);
    LAS float* so = (LAS float*)(lds + DSA_LDS_O); LAS float* sml = (LAS float*)(lds + DSA_LDS_ML);
    const int tid = tid_opaque(), lane = tid & 63, wave = tid >> 6;
    const int n = t + 1;
    if (tid < 256) siq[tid] = (float)IQ[(size_t)t * 256 + tid];
    if (tid < 256) sel[tid] = 0xFFFFu;
    __syncthreads();
    float w4[4];
#pragma unroll
    for (int hh = 0; hh < 4; ++hh) w4[hh] = IW[(size_t)t * 4 + hh] * 0.0625f;
    for (int s = tid; s < n; s += NT) {
        const half8* kp = (const half8*)(IK + (size_t)s * 64);
        float d0 = 0.f, d1 = 0.f, d2 = 0.f, d3 = 0.f;
#pragma unroll
        for (int c = 0; c < 8; ++c) { const half8 kv = kp[c];
#pragma unroll
            for (int j = 0; j < 8; ++j) { const float kf = (float)kv[j]; const int d = c * 8 + j;
                d0 += siq[d] * kf; d1 += siq[64 + d] * kf; d2 += siq[128 + d] * kf; d3 += siq[192 + d] * kf; } }
        float v = w4[0] * fmaxf(d0, 0.f) + w4[1] * fmaxf(d1, 0.f) + w4[2] * fmaxf(d2, 0.f) + w4[3] * fmaxf(d3, 0.f);
        sc[s] = v + 0.0f;
    }
    __syncthreads();
    if (n <= 256) { if (tid < n) sel[tid] = (unsigned)tid; __syncthreads(); }
    else {
        unsigned prefix = 0u, krem = 256u;
        for (int pass = 3; pass >= 0; --pass) {
            const int shift = pass * 8;
            if (tid < 256) hist[tid] = 0u;
            __syncthreads();
            for (int s = tid; s < n; s += NT) { const unsigned k = ordkey(sc[s]);
                if (pass == 3 || (k >> (shift + 8)) == (prefix >> (shift + 8))) atomicAdd((unsigned*)&hist[(k >> shift) & 255u], 1u); }
            __syncthreads();
            if (tid == 0) { unsigned cum = 0u; int b = 255; for (; b > 0; --b) { const unsigned hb = hist[b]; if (cum + hb >= krem) break; cum += hb; }
                misc[0] = prefix | ((unsigned)b << shift); misc[1] = krem - cum; }
            __syncthreads();
            prefix = misc[0]; krem = misc[1];
            __syncthreads();
        }
        const unsigned T = prefix; unsigned selbase = 0u, eqbase = 0u;
        for (int c0 = 0; c0 < n; c0 += NT) {
            const int s = c0 + tid; const unsigned k = (s < n) ? ordkey(sc[s]) : 0u; const bool gt = (s < n) && k > T, eq = (s < n) && k == T;
            const unsigned long long beq = __ballot(eq); const unsigned eqpre = __popcll(beq & ((1ull << lane) - 1ull));
            if (lane == 0) misc[8 + wave] = (unsigned)__popcll(beq);
            __syncthreads();
            unsigned eqoff = eqbase, eqtot = 0u;
#pragma unroll
            for (int w = 0; w < 8; ++w) { const unsigned cw = misc[8 + w]; if (w < wave) eqoff += cw; eqtot += cw; }
            const bool take = gt || (eq && (eqoff + eqpre) < krem);
            const unsigned long long bt = __ballot(take); const unsigned tpre = __popcll(bt & ((1ull << lane) - 1ull));
            if (lane == 0) misc[16 + wave] = (unsigned)__popcll(bt);
            __syncthreads();
            unsigned toff = selbase, ttot = 0u;
#pragma unroll
            for (int w = 0; w < 8; ++w) { const unsigned cw = misc[16 + w]; if (w < wave) toff += cw; ttot += cw; }
            if (take && (toff + tpre) < 256u) sel[toff + tpre] = (unsigned)s;
            selbase += ttot; eqbase += eqtot;
            __syncthreads();
        }
    }
    {
        u16* SEL = (u16*)(P.ws + WS_SEL);
        if (tid < 256) SEL[(size_t)t * 256 + tid] = (u16)sel[tid];
        const u32x4 qw = *(const u32x4*)(Q + (size_t)t * 512 + 8 * lane);
        float q[8] = {bflo(qw.x), bfhi(qw.x), bflo(qw.y), bfhi(qw.y), bflo(qw.z), bfhi(qw.z), bflo(qw.w), bfhi(qw.w)};
        float lg[32]; float mx = -INFINITY;
#pragma unroll
        for (int i = 0; i < 32; ++i) { const unsigned id = sel[wave * 32 + i];
            float d = -INFINITY;
            if (id != 0xFFFFu) { const u32x4 kw = *(const u32x4*)(Kb + (size_t)id * 512 + 8 * lane);
                d = q[0] * bflo(kw.x) + q[1] * bfhi(kw.x) + q[2] * bflo(kw.y) + q[3] * bfhi(kw.y) + q[4] * bflo(kw.z) + q[5] * bfhi(kw.z) + q[6] * bflo(kw.w) + q[7] * bfhi(kw.w);
                d += __shfl_xor(d, 1); d += __shfl_xor(d, 2); d += __shfl_xor(d, 4); d *= 0.125f; }
            lg[i] = d; mx = fmaxf(mx, d); }
        float l = 0.f, o[8];
#pragma unroll
        for (int c = 0; c < 8; ++c) o[c] = 0.f;
#pragma unroll
        for (int i = 0; i < 32; ++i) { const unsigned id = sel[wave * 32 + i];
            if (id != 0xFFFFu) { const float p = __expf(lg[i] - mx); l += p;
                const u32x4 vw = *(const u32x4*)(Vb + (size_t)id * 512 + 8 * lane);
                o[0] += p * bflo(vw.x); o[1] += p * bfhi(vw.x); o[2] += p * bflo(vw.y); o[3] += p * bfhi(vw.y); o[4] += p * bflo(vw.z); o[5] += p * bfhi(vw.z); o[6] += p * bflo(vw.w); o[7] += p * bfhi(vw.w); } }
#pragma unroll
        for (int c = 0; c < 8; ++c) so[wave * 512 + 8 * lane + c] = o[c];
        if ((lane & 7) == 0) { sml[(wave * 8 + (lane >> 3)) * 2] = mx; sml[(wave * 8 + (lane >> 3)) * 2 + 1] = l; }
        __syncthreads();
        {
            const int hh = tid >> 6; float M = -INFINITY;
#pragma unroll
            for (int w = 0; w < 8; ++w) M = fmaxf(M, sml[(w * 8 + hh) * 2]);
            float L = 0.f, acc = 0.f;
#pragma unroll
            for (int w = 0; w < 8; ++w) { const float mw = sml[(w * 8 + hh) * 2]; const float f = (mw == -INFINITY) ? 0.f : __expf(mw - M); L += f * sml[(w * 8 + hh) * 2 + 1]; acc += f * so[w * 512 + tid]; }
            Y[(size_t)t * 1536 + tid] = (bf16)f2bf(acc / L);
        }
        __syncthreads();
    }
}

constexpr int MA_KLD = 136, MA_VLD = 260;
constexpr int MA_LDS_K = 0, MA_LDS_V = 256 * MA_KLD * 2, MA_LDS_END = MA_LDS_V + 128 * MA_VLD * 2;
__device__ __forceinline__ void mem_attn_phase(const Params& P, LAS unsigned char* lds, int bid, int nblk) {
    const float* KMVM = (const float*)(P.ws + WS_KMVM); const bf16* MEMQ = (const bf16*)(P.ws + WS_MEMQ); bf16* Y = (bf16*)(P.ws + WS_Y);
    const float* qg = P.in[10]; const float* kg_ = P.in[11];
    const int tid = tid_opaque(), lane = tid & 63, wave = __builtin_amdgcn_readfirstlane(tid >> 6), l15 = lane & 15, kg = lane >> 4;
    const int h = bid & 3, sub = bid >> 2, nsub = nblk >> 2;
    LAS bf16* sK = (LAS bf16*)(lds + MA_LDS_K); LAS bf16* sV = (LAS bf16*)(lds + MA_LDS_V);
    for (int r = wave; r < 256; r += NW) {
        const f32x2 kv = *(const f32x2*)(KMVM + (size_t)r * 1024 + h * 128 + 2 * lane);
        const float ss = wave_sum(kv.x * kv.x + kv.y * kv.y); const float rk = 1.0f / sqrtf(ss * (1.0f / 128.0f) + NORM_EPS);
        *(LAS unsigned*)(sK + r * MA_KLD + 2 * lane) = pk2(kv.x * rk * kg_[2 * lane] * qg[2 * lane], kv.y * rk * kg_[2 * lane + 1] * qg[2 * lane + 1]);
        const f32x2 vv = *(const f32x2*)(KMVM + (size_t)r * 1024 + 512 + h * 128 + 2 * lane);
        sV[(2 * lane) * MA_VLD + r] = (bf16)f2bf(vv.x); sV[(2 * lane + 1) * MA_VLD + r] = (bf16)f2bf(vv.y);
    }
    __syncthreads();
    typedef short s8 __attribute__((ext_vector_type(8)));
    for (int tile = sub * NW + wave; tile < S_ / 16; tile += nsub * NW) {
        const int q = tile * 16 + l15;
        s8 bq[4]; float ss = 0.f;
#pragma unroll
        for (int ks = 0; ks < 4; ++ks) { const u32x4 w = *(const u32x4*)(MEMQ + (size_t)q * 512 + h * 128 + 32 * ks + 8 * kg); bq[ks] = __builtin_bit_cast(s8, w);
            ss += bflo(w.x) * bflo(w.x) + bfhi(w.x) * bfhi(w.x) + bflo(w.y) * bflo(w.y) + bfhi(w.y) * bfhi(w.y) + bflo(w.z) * bflo(w.z) + bfhi(w.z) * bfhi(w.z) + bflo(w.w) * bflo(w.w) + bfhi(w.w) * bfhi(w.w); }
        ss = sum_x16(ss); ss = sum_x32(ss);
        const float rq = 1.0f / sqrtf(ss * (1.0f / 128.0f) + NORM_EPS) * 0.08838834764831845f;
        float lg[16][4]; float mx = -INFINITY;
#pragma unroll
        for (int kt = 0; kt < 16; ++kt) { f32x4 acc = {0.f, 0.f, 0.f, 0.f};
#pragma unroll
            for (int ks = 0; ks < 4; ++ks) { const s8 a = *(const LAS s8*)(sK + (16 * kt + l15) * MA_KLD + 32 * ks + 8 * kg); acc = __builtin_amdgcn_mfma_f32_16x16x32_bf16(a, bq[ks], acc, 0, 0, 0); }
#pragma unroll
            for (int r = 0; r < 4; ++r) { lg[kt][r] = acc[r] * rq; mx = fmaxf(mx, lg[kt][r]); } }
        mx = max_x16(mx); mx = max_x32(mx);
        float l = 0.f;
#pragma unroll
        for (int kt = 0; kt < 16; ++kt)
#pragma unroll
            for (int r = 0; r < 4; ++r) { lg[kt][r] = __expf(lg[kt][r] - mx); l += lg[kt][r]; }
        l = sum_x16(l); l = sum_x32(l);
        const float il = 1.0f / l;
        s8 pb[8];
#pragma unroll
        for (int s = 0; s < 8; ++s) { u32x4 w; w.x = pk2(lg[2 * s][0] * il, lg[2 * s][1] * il); w.y = pk2(lg[2 * s][2] * il, lg[2 * s][3] * il); w.z = pk2(lg[2 * s + 1][0] * il, lg[2 * s + 1][1] * il); w.w = pk2(lg[2 * s + 1][2] * il, lg[2 * s + 1][3] * il);
            pb[s] = __builtin_bit_cast(s8, w); }
#pragma unroll
        for (int dt = 0; dt < 8; ++dt) { f32x4 acc = {0.f, 0.f, 0.f, 0.f};
#pragma unroll
            for (int s = 0; s < 8; ++s) { const LAS bf16* vp = sV + (16 * dt + l15) * MA_VLD + 32 * s + 4 * kg; const u32x2 lo = *(const LAS u32x2*)vp, hi = *(const LAS u32x2*)(vp + 16);
                u32x4 w; w.x = lo.x; w.y = lo.y; w.z = hi.x; w.w = hi.y; acc = __builtin_amdgcn_mfma_f32_16x16x32_bf16(__builtin_bit_cast(s8, w), pb[s], acc, 0, 0, 0); }
            st_bf4(Y + (size_t)q * 1536 + 1024 + h * 128 + 16 * dt + 4 * kg, acc); }
    }
}

__device__ __forceinline__ void rstdh_phase(const Params& P, int bid, int nblk) {
    const float* HSQ = (const float*)(P.ws + WS_HSQ); float* R = (float*)(P.ws + WS_RSTDH);
    for (int r = bid * NT + tid_opaque(); r < S_; r += nblk * NT) { float s = 0.f;
#pragma unroll
        for (int i = 0; i < 16; ++i) s += HSQ[(size_t)r * 16 + i];
        R[r] = 1.0f / sqrtf(s * (1.0f / 1024.0f) + NORM_EPS); }
}
#define BUBBLE16(v, ix, x, c) do { if ((x) > v[15]) { v[15] = (x); ix[15] = (c); _Pragma("unroll") for (int _p = 15; _p > 0; --_p) { \
        const bool _sw = v[_p] > v[_p - 1]; const float _a = v[_p], _b = v[_p - 1]; const int _ia = ix[_p], _ib = ix[_p - 1]; \
        v[_p] = _sw ? _b : _a; v[_p - 1] = _sw ? _a : _b; ix[_p] = _sw ? _ib : _ia; ix[_p - 1] = _sw ? _ia : _ib; } } } while (0)
__device__ __forceinline__ void peer_topk_phase(const Params& P, LAS unsigned char* lds, int h, int bid, int nblk) {
    const float* SC = (const float*)(P.ws + WS_SC); int* EIDX = (int*)(P.ws + WS_EIDX); float* EG = (float*)(P.ws + WS_EGATE);
    LAS float* sv = (LAS float*)lds; LAS int* sx = (LAS int*)(lds + 256 * 2 * 16 * 4);
    const int tid = tid_opaque(), rl = tid >> 1, half = tid & 1;
    for (int r0 = bid * 256; r0 < S_; r0 += nblk * 256) {
        const int row = r0 + rl;
        float v[16]; int ix[16];
#pragma unroll
        for (int p = 0; p < 16; ++p) { v[p] = -INFINITY; ix[p] = 0; }
        const f32x4* sp = (const f32x4*)(SC + (size_t)row * 256 + half * 128);
        for (int c4 = 0; c4 < 32; ++c4) { const f32x4 x = sp[c4];
#pragma unroll
            for (int j = 0; j < 4; ++j) { const float xv = x[j]; const int cc = 4 * c4 + j; BUBBLE16(v, ix, xv, cc); } }
#pragma unroll
        for (int p = 0; p < 16; ++p) { sv[(rl * 2 + half) * 16 + p] = v[p]; sx[(rl * 2 + half) * 16 + p] = ix[p]; }
        __syncthreads();
        if (half == 0) {
            float cv[16]; int ci[16];
#pragma unroll
            for (int p = 0; p < 16; ++p) { cv[p] = -INFINITY; ci[p] = 0; }
            for (int i = 0; i < 16; ++i) { const float a = sv[(rl * 2) * 16 + i];
                for (int j = 0; j < 16; ++j) { const float s = a + sv[(rl * 2 + 1) * 16 + j]; const int f = i * 16 + j; BUBBLE16(cv, ci, s, f); } }
            float l = 0.f, pe[16];
#pragma unroll
            for (int p = 0; p < 16; ++p) { pe[p] = __expf(cv[p] - cv[0]); l += pe[p]; }
            const float il = 1.0f / l;
#pragma unroll
            for (int p = 0; p < 16; ++p) { const int e1 = sx[(rl * 2) * 16 + (ci[p] >> 4)], e2 = sx[(rl * 2 + 1) * 16 + (ci[p] & 15)];
                EIDX[(size_t)row * 128 + h * 16 + p] = e1 * 128 + e2; EG[(size_t)row * 128 + h * 16 + p] = pe[p] * il; }
        }
        __syncthreads();
    }
}
__device__ __forceinline__ void peer_expert_phase_v1(const Params& P, int bid, int nblk) {
    const int* EIDX = (const int*)(P.ws + WS_EIDX); const float* EG = (const float*)(P.ws + WS_EGATE); const float* HSQ = (const float*)(P.ws + WS_HSQ);
    const float* U = P.in[29]; const float* Vt = P.in[30]; const float* gain = P.in[25];
    const int tid = tid_opaque(), lane = tid & 63, wave = tid >> 6;
    for (int row = bid * NW + wave; row < S_; row += nblk * NW) {
        float* hp = P.out + (size_t)row * 1024; const float rs = rstd_h_row(HSQ, row);
        f32x4 hv[4], xn[4], o[4];
#pragma unroll
        for (int j = 0; j < 4; ++j) { hv[j] = *(const f32x4*)(hp + 4 * lane + 256 * j); xn[j] = hv[j] * rs * *(const f32x4*)(gain + 4 * lane + 256 * j); o[j] = (f32x4){0.f, 0.f, 0.f, 0.f}; }
        const int e_lo = EIDX[(size_t)row * 128 + lane], e_hi = EIDX[(size_t)row * 128 + 64 + lane];
        const float g_lo = EG[(size_t)row * 128 + lane], g_hi = EG[(size_t)row * 128 + 64 + lane];
        for (int e = 0; e < 128; ++e) {
            const int idx = __shfl((e < 64) ? e_lo : e_hi, e & 63); const float gt = __shfl((e < 64) ? g_lo : g_hi, e & 63);
            const float* up = U + (size_t)idx * 1024; float d = 0.f;
#pragma unroll
            for (int j = 0; j < 4; ++j) { const f32x4 uv = *(const f32x4*)(up + 4 * lane + 256 * j); d += (xn[j][0] * uv[0] + xn[j][1] * uv[1]) + (xn[j][2] * uv[2] + xn[j][3] * uv[3]); }
            d = wave_sum(d);
            const float w = gt * 0.5f * d * (1.0f + erff(d * 0.70710678118654752f));
            const float* vp = Vt + (size_t)idx * 1024;
#pragma unroll
            for (int j = 0; j < 4; ++j) o[j] = o[j] + *(const f32x4*)(vp + 4 * lane + 256 * j) * w;
        }
#pragma unroll
        for (int j = 0; j < 4; ++j) *(f32x4*)(hp + 4 * lane + 256 * j) = hv[j] + o[j];
    }
}
struct EpiPQ {
    half_t* PQ; const float* HSQ;
    __device__ __forceinline__ void operator()(AccRef acc, const pg8::Unit& u, int wr, int wc, int fr, int fq) const {
#pragma unroll
        for (int ai = 0; ai < 2; ++ai)
#pragma unroll
            for (int m = 0; m < 4; ++m) { const int row = u.pm * 256 + ai * 128 + wr * 64 + m * 16 + fr;
                const f32x4* hp = (const f32x4*)(HSQ + (size_t)row * 16); const f32x4 a = hp[0], b = hp[1], c = hp[2], d = hp[3];
                const float s = ((a[0] + a[1]) + (a[2] + a[3])) + ((b[0] + b[1]) + (b[2] + b[3])) + ((c[0] + c[1]) + (c[2] + c[3])) + ((d[0] + d[1]) + (d[2] + d[3]));
                const float rs = 1.0f / sqrtf(s * (1.0f / 1024.0f) + NORM_EPS);
                half_t* dst = PQ + (size_t)row * 2048 + u.pn * 256 + 32 * wc + 4 * fq;
#pragma unroll
                for (int bj = 0; bj < 2; ++bj)
#pragma unroll
                    for (int n = 0; n < 2; ++n) st_h4(dst + 128 * bj + 16 * n, acc[ai][bj][m][n] * rs); }
    }
};
#define UBUBBLE16(v, x) do { if ((x) > v[15]) { v[15] = (x); _Pragma("unroll") for (int _p = 15; _p > 0; --_p) { const unsigned _a = v[_p], _b = v[_p - 1]; v[_p] = min(_a, _b); v[_p - 1] = max(_a, _b); } } } while (0)
__device__ __forceinline__ void peer_topk_tile(const float* scr, int pm, int head, int* EIDX, float* EG, LAS unsigned* xl) {
    const int tid = tid_opaque(), lrow = tid >> 1, kh = tid & 1;
    unsigned v[16];
#pragma unroll
    for (int p = 0; p < 16; ++p) v[p] = 0u;
    const f32x4* sp = (const f32x4*)(scr + (size_t)lrow * 256 + kh * 128);
#pragma unroll 1
    for (int c4 = 0; c4 < 32; ++c4) { const f32x4 x = sp[c4];
#pragma unroll
        for (int j = 0; j < 4; ++j) { const unsigned ku = (ordkey(x[j]) & ~127u) | (unsigned)(127 - (4 * c4 + j)); UBUBBLE16(v, ku); } }
    unsigned k1[16], k2[16];
#pragma unroll
    for (int p = 0; p < 16; ++p) { const unsigned ov = dppu<0xB1>(v[p]); k1[p] = kh ? ov : v[p]; k2[p] = kh ? v[p] : ov; }
    LAS unsigned* myx = xl + tid * 33;
#pragma unroll
    for (int p = 0; p < 16; ++p) { myx[p] = 127u - (k1[p] & 127u); myx[16 + p] = 127u - (k2[p] & 127u); }
    float f1[16], f2[16];
#pragma unroll
    for (int p = 0; p < 16; ++p) { f1[p] = inv_ordkey(k1[p] & ~127u); f2[p] = inv_ordkey(k2[p] & ~127u); }
    unsigned cv[16];
#pragma unroll
    for (int p = 0; p < 16; ++p) cv[p] = 0u;
#pragma unroll
    for (int I = 0; I < 16; ++I) {
#pragma unroll
        for (int J = 0; J < 16; ++J) if ((I + 1) * (J + 1) <= 16) { const unsigned ku = (ordkey(f1[I] + f2[J]) & ~255u) | (unsigned)(255 - (16 * I + J)); UBUBBLE16(cv, ku); } }
    if (kh == 0) {
        float l = 0.f, pe[16]; const float top = inv_ordkey(cv[0] & ~255u);
#pragma unroll
        for (int p = 0; p < 16; ++p) { pe[p] = __expf(inv_ordkey(cv[p] & ~255u) - top); l += pe[p]; }
        const float il = 1.0f / l; const int row = pm * 256 + lrow;
        int* ep = EIDX + (size_t)row * 128 + head * 16; float* gp = EG + (size_t)row * 128 + head * 16;
        int ce[16];
#pragma unroll
        for (int p = 0; p < 16; ++p) { const unsigned f = 255u - (cv[p] & 255u); ce[p] = (int)(myx[f >> 4] * 128u + myx[16 + (f & 15u)]); }
#pragma unroll
        for (int p4 = 0; p4 < 4; ++p4) { *(f32x4*)(gp + 4 * p4) = (f32x4){pe[4 * p4] * il, pe[4 * p4 + 1] * il, pe[4 * p4 + 2] * il, pe[4 * p4 + 3] * il};
            typedef int i32x4 __attribute__((ext_vector_type(4))); *(i32x4*)(ep + 4 * p4) = (i32x4){ce[4 * p4], ce[4 * p4 + 1], ce[4 * p4 + 2], ce[4 * p4 + 3]}; }
    }
}
struct EpiTile {
    float* scr;
    __device__ __forceinline__ void operator()(AccRef acc, const pg8::Unit& u, int wr, int wc, int fr, int fq) const {
#pragma unroll
        for (int ai = 0; ai < 2; ++ai)
#pragma unroll
            for (int m = 0; m < 4; ++m) { float* dst = scr + (size_t)(ai * 128 + wr * 64 + m * 16 + fr) * 256 + 32 * wc + 4 * fq;
#pragma unroll
                for (int bj = 0; bj < 2; ++bj)
#pragma unroll
                    for (int n = 0; n < 2; ++n) *(f32x4*)(dst + 128 * bj + 16 * n) = acc[ai][bj][m][n]; }
    }
};
typedef _Float16 h8 __attribute__((ext_vector_type(8)));
struct LayoutExact { static constexpr int CAP = 1280, NK = 20, CS = 0, CI = 16 * 1280 * 4, CNT = CI + 16 * 1280 * 2, TAU = CNT + 64, HIST = TAU + 64, SELST = HIST + 8 * 256 * 4; };
struct LayoutFast { static constexpr int CAP = 1024, NK = 16, CS = 0, CI = 16 * 1024 * 4, B = CI + 16 * 1024 * 2, BCAP = 1280, CNT = B + 16 * BCAP * 2, TAU = CNT + 64, CNTB = TAU + 64, FLAG = CNTB + 64, CUT = FLAG + 64, HIST = CUT + 64, SELST = HIST + 8 * 256 * 4, END = SELST + 8 * 512; };
__device__ __forceinline__ float relu_bits(float x) { return __builtin_bit_cast(float, max(__builtin_bit_cast(int, x), 0)); }
constexpr int DQ = 16, DCAP = 1280, DSTEP_TILES = 32, DNK = DCAP / 64;
constexpr int DA_CS = 0, DA_CI = DQ * DCAP * 4, DA_CNT = DA_CI + DQ * DCAP * 2, DA_TAU = DA_CNT + 64, DA_HIST = DA_TAU + 64, DA_SELST = DA_HIST + 8 * 256 * 4, DA_END = (DA_SELST + 8 * 512 > LayoutFast::END) ? DA_SELST + 8 * 512 : LayoutFast::END;

__device__ __forceinline__ unsigned wave_incl_scan_u32(unsigned v) {
    v += (unsigned)__builtin_amdgcn_update_dpp(0, (int)v, 0x111, 0xf, 0xf, false); v += (unsigned)__builtin_amdgcn_update_dpp(0, (int)v, 0x112, 0xf, 0xf, false);
    v += (unsigned)__builtin_amdgcn_update_dpp(0, (int)v, 0x114, 0xf, 0xf, false); v += (unsigned)__builtin_amdgcn_update_dpp(0, (int)v, 0x118, 0xf, 0xf, false);
    v += (unsigned)__builtin_amdgcn_update_dpp(0, (int)v, 0x142, 0xa, 0xf, false); v += (unsigned)__builtin_amdgcn_update_dpp(0, (int)v, 0x143, 0xc, 0xf, false);
    return v;
}
__device__ __forceinline__ unsigned wave_umin(unsigned x) { x = min(x, dppu<0xB1>(x)); x = min(x, dppu<0x4E>(x)); x = min(x, dppu<0x141>(x)); x = min(x, dppu<0x140>(x));
    unsigned a, b; pl16(x, a, b); x = min(a, b); pl32(x, a, b); return min(a, b); }
__device__ __forceinline__ unsigned wave_umax(unsigned x) { x = max(x, dppu<0xB1>(x)); x = max(x, dppu<0x4E>(x)); x = max(x, dppu<0x141>(x)); x = max(x, dppu<0x140>(x));
    unsigned a, b; pl16(x, a, b); x = max(a, b); pl32(x, a, b); return max(a, b); }
template <int NK> __device__ __forceinline__ unsigned radix_pass(LAS unsigned* hist, const unsigned (&dg)[NK], unsigned& alive, unsigned& krem, unsigned& nd, int lane) {
    *(LAS u32x4*)(hist + 4 * lane) = (u32x4){0u, 0u, 0u, 0u};
#pragma unroll
    for (int k = 0; k < NK; ++k) if (alive & (1u << k)) atomicAdd((unsigned*)&hist[dg[k]], 1u);
    LDS_WAIT();
    const u32x4 h4 = *(const LAS u32x4*)(hist + 252 - 4 * lane);
    const unsigned P = wave_incl_scan_u32(h4.x + h4.y + h4.z + h4.w);
    const unsigned S0 = P, S1 = P - h4.x, S2 = S1 - h4.y, S3 = S2 - h4.z;
    const int nge = __popcll(__ballot(S0 >= krem)) + __popcll(__ballot(S1 >= krem)) + __popcll(__ballot(S2 >= krem)) + __popcll(__ballot(S3 >= krem));
    const int d = nge - 1, ld = (255 - d) >> 2, comp = d & 3;
    const unsigned Sd = (comp == 0) ? __builtin_amdgcn_readlane(S0, ld) : (comp == 1) ? __builtin_amdgcn_readlane(S1, ld) : (comp == 2) ? __builtin_amdgcn_readlane(S2, ld) : __builtin_amdgcn_readlane(S3, ld);
    nd = (comp == 0) ? __builtin_amdgcn_readlane(h4.x, ld) : (comp == 1) ? __builtin_amdgcn_readlane(h4.y, ld) : (comp == 2) ? __builtin_amdgcn_readlane(h4.z, ld) : __builtin_amdgcn_readlane(h4.w, ld);
    krem -= (Sd - nd);
#pragma unroll
    for (int k = 0; k < NK; ++k) if (dg[k] != (unsigned)d) alive &= ~(1u << k);
    LDS_WAIT();
    return (unsigned)d;
}
template <int NK, bool USE_LO> __device__ __forceinline__ void radix_kth(LAS unsigned* hist, const unsigned (&hi)[NK], const unsigned (&lo)[NK], unsigned valid, unsigned K, int n, int lane, unsigned& Thi, unsigned& Tlo) {
    unsigned alive = valid, mn = 0xFFFFFFFFu, mxv = 0u;
#pragma unroll
    for (int k = 0; k < NK; ++k) if ((valid >> k) & 1u) { mn = min(mn, hi[k]); mxv = max(mxv, hi[k]); }
    mn = wave_umin(mn); mxv = wave_umax(mxv);
    unsigned krem = K, nd = (unsigned)n; Thi = mn; Tlo = 0u;
    const unsigned diff = mn ^ mxv;
    if (diff != 0u) {
        const int first = (31 - __builtin_clz(diff)) >> 3;
        Thi = (first == 3) ? 0u : (mn & ~((1u << (8 * (first + 1))) - 1u));
#pragma unroll 1
        for (int byte = first; byte >= 0; --byte) { unsigned dg[NK];
#pragma unroll
            for (int k = 0; k < NK; ++k) dg[k] = (hi[k] >> (8 * byte)) & 255u;
            Thi |= radix_pass<NK>(hist, dg, alive, krem, nd, lane) << (8 * byte); }
    }
    if (USE_LO && nd != krem) {
#pragma unroll 1
        for (int byte = 1; byte >= 0; --byte) { unsigned dg[NK];
#pragma unroll
            for (int k = 0; k < NK; ++k) dg[k] = (lo[k] >> (8 * byte)) & 255u;
            Tlo |= radix_pass<NK>(hist, dg, alive, krem, nd, lane) << (8 * byte); }
    }
}
template <class L> __device__ __forceinline__ void dsa_compact(LAS unsigned char* lds, int q, int lane, int wave) {
    constexpr int DNK = L::NK;
    LAS float* cs = (LAS float*)(lds + L::CS) + q * L::CAP; LAS u16* ci = (LAS u16*)(lds + L::CI) + q * L::CAP;
    LAS unsigned* cnt = (LAS unsigned*)(lds + L::CNT); LAS float* tau = (LAS float*)(lds + L::TAU); LAS unsigned* hist = (LAS unsigned*)(lds + L::HIST) + wave * 256;
    const int n = (int)cnt[q];
    if (n <= 256) return;
    unsigned hi[DNK], lo[DNK]; unsigned valid = 0u;
#pragma unroll
    for (int k = 0; k < DNK; ++k) { const int e = lane + 64 * k; const bool v = e < n; hi[k] = v ? ordkey(cs[e]) : 0u; lo[k] = v ? (0xFFFFu - (unsigned)ci[e]) : 0u; if (v) valid |= 1u << k; }
    unsigned Thi, Tlo; radix_kth<DNK, true>(hist, hi, lo, valid, 256u, n, lane, Thi, Tlo);
    unsigned base = 0u;
#pragma unroll
    for (int k = 0; k < DNK; ++k) { const bool keep = ((valid >> k) & 1u) && (hi[k] > Thi || (hi[k] == Thi && lo[k] >= Tlo));
        const unsigned long long b = __ballot(keep);
        if (keep) { const unsigned pos = base + (unsigned)__popcll(b & ((1ull << lane) - 1ull)); cs[pos] = inv_ordkey(hi[k]); ci[pos] = (u16)(0xFFFFu - lo[k]); }
        base += (unsigned)__popcll(b); }
    if (lane == 0) { cnt[q] = 256u; tau[q] = inv_ordkey(Thi); }
}
template <class L> __device__ __forceinline__ void dsa_emit_sel(LAS unsigned char* lds, u16* SEL, int tq_, int q, int m, int lane, int wave) {
    LAS u16* st = (LAS u16*)(lds + L::SELST) + wave * 256; const LAS u16* cq = (LAS u16*)(lds + L::CI) + q * L::CAP;
    LAS unsigned* bm = (LAS unsigned*)((LAS float*)(lds + L::CS) + q * L::CAP);
    unsigned id[4];
#pragma unroll
    for (int k = 0; k < 4; ++k) { const int e = lane + 64 * k; id[k] = (e < m) ? (unsigned)cq[e] : 0xFFFFu; }
    *(LAS u32x4*)(bm + 8 * lane) = (u32x4){0u, 0u, 0u, 0u}; *(LAS u32x4*)(bm + 8 * lane + 4) = (u32x4){0u, 0u, 0u, 0u};
    *(LAS u32x2*)(st + 4 * lane) = (u32x2){0xFFFFFFFFu, 0xFFFFFFFFu};
    LDS_WAIT();
#pragma unroll
    for (int k = 0; k < 4; ++k) if (id[k] != 0xFFFFu) atomicOr((unsigned*)&bm[id[k] >> 5], 1u << (id[k] & 31u));
    LDS_WAIT();
    const u32x4 w0 = *(const LAS u32x4*)(bm + 8 * lane), w1 = *(const LAS u32x4*)(bm + 8 * lane + 4);
    unsigned wd[8] = {w0.x, w0.y, w0.z, w0.w, w1.x, w1.y, w1.z, w1.w};
    unsigned c = 0u;
#pragma unroll
    for (int j = 0; j < 8; ++j) c += (unsigned)__popc(wd[j]);
    unsigned pos = wave_incl_scan_u32(c) - c;
#pragma unroll
    for (int j = 0; j < 8; ++j) { unsigned wv = wd[j];
        while (wv) { const unsigned b = (unsigned)__builtin_ctz(wv); st[pos++] = (u16)(256u * (unsigned)lane + 32u * (unsigned)j + b); wv &= wv - 1u; } }
    LDS_WAIT();
    *(u32x2*)(SEL + (size_t)tq_ * 256 + 4 * lane) = *(const LAS u32x2*)(st + 4 * lane);
    LDS_WAIT();
}

__device__ __forceinline__ void dsa_index_item_exact(const Params& P, LAS unsigned char* lds, int item) {
    const half_t* IQ = (const half_t*)(P.ws + WS_IQ); const half_t* IK = (const half_t*)(P.ws + WS_IK); const float* IW = (const float*)(P.ws + WS_IW); u16* SEL = (u16*)(P.ws + WS_SEL);
    LAS float* cs = (LAS float*)(lds + DA_CS); LAS u16* ci = (LAS u16*)(lds + DA_CI); LAS unsigned* cnt = (LAS unsigned*)(lds + DA_CNT); LAS float* tau = (LAS float*)(lds + DA_TAU);
    const int tid = tid_opaque(), lane = tid & 63, wave = __builtin_amdgcn_readfirstlane(tid >> 6), qq = lane & 15, kg = lane >> 4;
    const int q0 = item * DQ, t = q0 + qq, ntiles = item + 1;
    h8 bq[4][2]; float w[4];
#pragma unroll
    for (int h = 0; h < 4; ++h) { w[h] = IW[(size_t)t * 4 + h] * 0.0625f;
#pragma unroll
        for (int ks = 0; ks < 2; ++ks) bq[h][ks] = *(const h8*)(IQ + (size_t)t * 256 + h * 64 + ks * 32 + kg * 8); }
    if (tid < DQ) { cnt[tid] = 0u; tau[tid] = -INFINITY; }
    __syncthreads();
    float tq = -INFINITY;
    h8 a0[4], a1[4];
#pragma unroll
    for (int g = 0; g < 4; ++g) { const int tile = min(g * 8 + wave, ntiles - 1); const half_t* kp = IK + (size_t)(tile) * 1024 + lane * 8; a0[g] = *(const h8*)kp; a1[g] = *(const h8*)(kp + 512); }
    for (int base = 0; base < ntiles; base += DSTEP_TILES) {
        PROBE_T0(2, lds)
        h8 n0[4], n1[4];
#pragma unroll
        for (int g = 0; g < 4; ++g) { const int tile = min(base + DSTEP_TILES + g * 8 + wave, ntiles - 1); const half_t* kp = IK + (size_t)(tile) * 1024 + lane * 8; n0[g] = *(const h8*)kp; n1[g] = *(const h8*)(kp + 512); }
        float sc[4][4]; unsigned pb = 0u;
#pragma unroll
        for (int g = 0; g < 4; ++g) { const int tile = base + g * 8 + wave; const int s0 = tile * 16;
#pragma unroll
            for (int r = 0; r < 4; ++r) sc[g][r] = 0.f;
#pragma unroll
            for (int h = 0; h < 4; ++h) { f32x4 acc = {0.f, 0.f, 0.f, 0.f};
                acc = __builtin_amdgcn_mfma_f32_16x16x32_f16(a0[g], bq[h][0], acc, 0, 0, 0); acc = __builtin_amdgcn_mfma_f32_16x16x32_f16(a1[g], bq[h][1], acc, 0, 0, 0);
#pragma unroll
                for (int r = 0; r < 4; ++r) sc[g][r] += w[h] * fmaxf(acc[r], 0.f); }
#pragma unroll
            for (int r = 0; r < 4; ++r) { sc[g][r] += 0.0f; if (tile < ntiles && sc[g][r] > tq && s0 + 4 * kg + r <= t) pb |= 1u << (4 * g + r); } }
        if (__ballot(pb != 0u) != 0ull) {
            unsigned pos = 0u; if (pb) pos = atomicAdd((unsigned*)&cnt[qq], (unsigned)__popc(pb));
#pragma unroll
            for (int g = 0; g < 4; ++g)
#pragma unroll
                for (int r = 0; r < 4; ++r) if (pb & (1u << (4 * g + r))) { cs[qq * DCAP + pos] = sc[g][r]; ci[qq * DCAP + pos] = (u16)((base + g * 8 + wave) * 16 + 4 * kg + r); ++pos; } }
#pragma unroll
        for (int g = 0; g < 4; ++g) { a0[g] = n0[g]; a1[g] = n1[g]; }
        __syncthreads();
        PROBE_T1(2, lds)
        unsigned mx = 0u;
        { const u32x4 c0 = *(const LAS u32x4*)(cnt), c1 = *(const LAS u32x4*)(cnt + 4), c2 = *(const LAS u32x4*)(cnt + 8), c3 = *(const LAS u32x4*)(cnt + 12);
          mx = max(max(max(c0.x, c0.y), max(c0.z, c0.w)), max(max(c1.x, c1.y), max(c1.z, c1.w))); mx = max(mx, max(max(max(c2.x, c2.y), max(c2.z, c2.w)), max(max(c3.x, c3.y), max(c3.z, c3.w)))); }
        if (mx > (unsigned)(DCAP - 512)) {
            PROBE_T0(1, lds)
            dsa_compact<LayoutExact>(lds, 2 * wave, lane, wave); dsa_compact<LayoutExact>(lds, 2 * wave + 1, lane, wave);
            __syncthreads();
            tq = tau[qq];
            PROBE_T1(1, lds)
        }
    }
    PROBE_T0(3, lds)
#pragma unroll 1
    for (int j = 0; j < 2; ++j) { const int q = 2 * wave + j;
        dsa_compact<LayoutExact>(lds, q, lane, wave);
        LDS_WAIT();
        dsa_emit_sel<LayoutExact>(lds, SEL, q0 + q, q, (int)cnt[q], lane, wave); }
    __syncthreads();
    PROBE_T1(3, lds)
}

constexpr int DFA_CAP = LayoutFast::CAP, DFB_CAP = LayoutFast::BCAP, DF_STRIDE = 8, DF_OFF = 5, DF_KS = 72, DF_MIN_TILES = 128;
__device__ __forceinline__ LAS u16* dfb_slot(LAS unsigned char* lds, int q, unsigned p) {
    return (LAS u16*)(lds + LayoutFast::B) + q * LayoutFast::BCAP + p;
}
__device__ __forceinline__ int ptile(int tile, int ntiles, int rot) { int p = min(tile, ntiles - 1) + rot; return p - ((p >= ntiles) ? ntiles : 0); }
__device__ __forceinline__ void dsa_index_item(const Params& P, LAS unsigned char* lds, int item) {
    if (item + 1 < DF_MIN_TILES) { dsa_index_item_exact(P, lds, item); return; }
    const half_t* IQ = (const half_t*)(P.ws + WS_IQ); const half_t* IK = (const half_t*)(P.ws + WS_IK); const float* IW = (const float*)(P.ws + WS_IW); u16* SEL = (u16*)(P.ws + WS_SEL);
    typedef LayoutFast L; constexpr int DCAP = L::CAP, DNK = L::NK;
    LAS float* cs = (LAS float*)(lds + L::CS); LAS u16* ci = (LAS u16*)(lds + L::CI); LAS unsigned* cnt = (LAS unsigned*)(lds + L::CNT); LAS float* tau = (LAS float*)(lds + L::TAU);
    LAS unsigned* cntb = (LAS unsigned*)(lds + L::CNTB); LAS unsigned* flag = (LAS unsigned*)(lds + L::FLAG); LAS unsigned* hist = (LAS unsigned*)(lds + L::HIST); LAS unsigned* cutq = (LAS unsigned*)(lds + L::CUT);
    const int tid = tid_opaque(), lane = tid & 63, wave = __builtin_amdgcn_readfirstlane(tid >> 6), qq = lane & 15, kg = lane >> 4;
    const int q0 = item * DQ, t = q0 + qq, ntiles = item + 1;
    h8 bq[4][2]; float w[4];
#pragma unroll
    for (int h = 0; h < 4; ++h) { w[h] = IW[(size_t)t * 4 + h] * 0.0625f;
#pragma unroll
        for (int ks = 0; ks < 2; ++ks) bq[h][ks] = *(const h8*)(IQ + (size_t)t * 256 + h * 64 + ks * 32 + kg * 8); }
    if (tid < DQ) { cnt[tid] = 0u; cntb[tid] = 0u; } if (tid == 0) flag[0] = 0u;
    __syncthreads();
    PROBE_T0(4, lds)
    for (int ts = DF_OFF + DF_STRIDE * wave; ts < item; ts += DF_STRIDE * NW) {
        const half_t* kp = IK + (size_t)(ts) * 1024 + lane * 8; const h8 a0 = *(const h8*)kp, a1 = *(const h8*)(kp + 512);
        float sc[4] = {0.f, 0.f, 0.f, 0.f};
#pragma unroll
        for (int h = 0; h < 4; ++h) { f32x4 acc = {0.f, 0.f, 0.f, 0.f};
            acc = __builtin_amdgcn_mfma_f32_16x16x32_f16(a0, bq[h][0], acc, 0, 0, 0); acc = __builtin_amdgcn_mfma_f32_16x16x32_f16(a1, bq[h][1], acc, 0, 0, 0);
#pragma unroll
            for (int r = 0; r < 4; ++r) sc[r] += w[h] * fmaxf(acc[r], 0.f); }
        const unsigned pos = atomicAdd((unsigned*)&cnt[qq], 4u);
        *(LAS u32x2*)((LAS u16*)(cs + qq * DCAP) + pos) = (u32x2){pk2(sc[0] + 0.0f, sc[1] + 0.0f), pk2(sc[2] + 0.0f, sc[3] + 0.0f)};
    }
    __syncthreads();
#pragma unroll 1
    for (int j = 0; j < 2; ++j) { const int q = 2 * wave + j; const int n = (int)cnt[q];
        unsigned hi[32], lo[32]; unsigned valid = 0u; const LAS u16* sq = (const LAS u16*)(cs + q * DCAP);
#pragma unroll
        for (int k2 = 0; k2 < 32; ++k2) { const int e = lane + 64 * k2; const bool v = e < n; hi[k2] = v ? (ordkey(bf2f(sq[v ? e : 0])) >> 16) : 0u; lo[k2] = 0u; if (v) valid |= 1u << k2; }
        unsigned Thi, Tlo; radix_kth<32, false>(hist + wave * 256, hi, lo, valid, (unsigned)DF_KS, n, lane, Thi, Tlo);
        unsigned ceq = 0u;
#pragma unroll
        for (int k2 = 0; k2 < 32; ++k2) ceq += (((valid >> k2) & 1u) && hi[k2] == Thi) ? 1u : 0u;
        ceq = __builtin_amdgcn_readlane(wave_incl_scan_u32(ceq), 63);
        Thi <<= 16;
        if (lane == 0) { tau[q] = inv_ordkey(Thi); const unsigned est = ceq * (unsigned)DF_STRIDE; cutq[q] = (est > 800u) ? (unsigned)(((unsigned long long)ntiles * 16ull * 512ull) / est) : 0x7fffffffu; } }
    __syncthreads();
    if (tid < DQ) cnt[tid] = 0u;
    const float tq = tau[qq]; const int cut = (int)cutq[qq];
    __syncthreads();
    PROBE_T1(4, lds)
    PROBE_T0(5, lds)
    {
        constexpr int DFG = 6;
        h8 a0[DFG], a1[DFG];
        const int rot = (int)(((unsigned)blockIdx.x * 2654435761u >> 8) % (unsigned)ntiles);
#pragma unroll
        for (int g = 0; g < DFG; ++g) { int tile = min(g * 8 + wave, ntiles - 1) + rot; tile -= (tile >= ntiles) ? ntiles : 0; const half_t* kp = IK + (size_t)(tile) * 1024 + lane * 8; a0[g] = *(const h8*)kp; a1[g] = *(const h8*)(kp + 512); }
        for (int base = 0; base < ntiles; base += 8 * DFG) {
            h8 n0[DFG], n1[DFG];
#pragma unroll
            for (int g = 0; g < DFG; ++g) { int tile = min(base + 8 * DFG + g * 8 + wave, ntiles - 1) + rot; tile -= (tile >= ntiles) ? ntiles : 0; const half_t* kp = IK + (size_t)(tile) * 1024 + lane * 8; n0[g] = *(const h8*)kp; n1[g] = *(const h8*)(kp + 512); }
            float sc[DFG][4]; unsigned pa = 0u, pb = 0u;
#pragma unroll
            for (int g = 0; g < DFG; ++g) { const int tile = base + g * 8 + wave; int pt = min(tile, ntiles - 1) + rot; pt -= (pt >= ntiles) ? ntiles : 0; const int s0 = pt * 16;
#pragma unroll
                for (int r = 0; r < 4; ++r) sc[g][r] = 0.f;
#pragma unroll
                for (int h = 0; h < 4; ++h) { f32x4 acc = {0.f, 0.f, 0.f, 0.f};
                    acc = __builtin_amdgcn_mfma_f32_16x16x32_f16(a0[g], bq[h][0], acc, 0, 0, 0); acc = __builtin_amdgcn_mfma_f32_16x16x32_f16(a1[g], bq[h][1], acc, 0, 0, 0);
#pragma unroll
                    for (int r = 0; r < 4; ++r) sc[g][r] += w[h] * relu_bits(acc[r]); }
#pragma unroll
                for (int r = 0; r < 4; ++r) { sc[g][r] += 0.0f; const bool ok = tile < ntiles && s0 + 4 * kg + r <= t;
                    if (ok && sc[g][r] > tq) pa |= 1u << (4 * g + r); if (ok && sc[g][r] == tq && s0 + 4 * kg + r < cut) pb |= 1u << (4 * g + r); } }
            if (__ballot((pa | pb) != 0u) != 0ull) {
                if (pa) { unsigned pos = atomicAdd((unsigned*)&cnt[qq], (unsigned)__popc(pa));
                    if (pos + (unsigned)__popc(pa) > (unsigned)DFA_CAP) atomicOr((unsigned*)&flag[0], 1u);
                    else {
#pragma unroll
                        for (int g = 0; g < DFG; ++g)
#pragma unroll
                            for (int r = 0; r < 4; ++r) if (pa & (1u << (4 * g + r))) { cs[qq * DCAP + pos] = sc[g][r]; ci[qq * DCAP + pos] = (u16)(ptile(base + g * 8 + wave, ntiles, rot) * 16 + 4 * kg + r); ++pos; } } }
                if (pb) { unsigned pos = atomicAdd((unsigned*)&cntb[qq], (unsigned)__popc(pb));
                    if (pos + (unsigned)__popc(pb) > (unsigned)DFB_CAP) atomicOr((unsigned*)&flag[0], 2u);
                    else {
#pragma unroll
                        for (int g = 0; g < DFG; ++g)
#pragma unroll
                            for (int r = 0; r < 4; ++r) if (pb & (1u << (4 * g + r))) { *dfb_slot(lds, qq, pos) = (u16)(ptile(base + g * 8 + wave, ntiles, rot) * 16 + 4 * kg + r); ++pos; } } }
            }
#pragma unroll
            for (int g = 0; g < DFG; ++g) { a0[g] = n0[g]; a1[g] = n1[g]; }
        }
    }
    __syncthreads();
    PROBE_T1(5, lds)
    bool bad = flag[0] != 0u;
#pragma unroll
    for (int q = 0; q < DQ; ++q) { const unsigned na = cnt[q], nb2 = cntb[q]; if (na < 256u && na + nb2 < 256u) bad = true; }
    if (bad) { PROBE_T0(7, lds) __syncthreads(); dsa_index_item_exact(P, lds, item); PROBE_T1(7, lds) return; }
    PROBE_T0(6, lds)
#pragma unroll 1
    for (int j = 0; j < 2; ++j) { const int q = 2 * wave + j; const int na = (int)cnt[q];
        int m = 256;
        if (na >= 256) { dsa_compact<LayoutFast>(lds, q, lane, wave); }
        else {
            const int nb2 = (int)cntb[q]; const unsigned need = (unsigned)(256 - na);
            unsigned hi[20], lo[20]; unsigned valid = 0u;
#pragma unroll
            for (int k2 = 0; k2 < 20; ++k2) { const int e = lane + 64 * k2; const bool v = e < nb2; hi[k2] = v ? (0xFFFFu - (unsigned)*dfb_slot(lds, q, (unsigned)(v ? e : 0))) : 0u; lo[k2] = 0u; if (v) valid |= 1u << k2; }
            unsigned Thi, Tlo; radix_kth<20, false>(hist + wave * 256, hi, lo, valid, need, nb2, lane, Thi, Tlo);
            unsigned base = (unsigned)na;
#pragma unroll
            for (int k2 = 0; k2 < 20; ++k2) { const bool keep = ((valid >> k2) & 1u) && hi[k2] >= Thi; const unsigned long long b = __ballot(keep);
                if (keep) ci[q * DCAP + base + (unsigned)__popcll(b & ((1ull << lane) - 1ull))] = (u16)(0xFFFFu - hi[k2]);
                base += (unsigned)__popcll(b); }
        }
        LDS_WAIT();
        dsa_emit_sel<LayoutFast>(lds, SEL, q0 + q, q, m, lane, wave); }
    __syncthreads();
    PROBE_T1(6, lds)
}

__device__ __forceinline__ void dsa_index_phase(const Params& P, LAS unsigned char* lds, int bid, int nblk) {
    constexpr int NITEMS = S_ / DQ;
    for (int r = 0;; ++r) { const int k = r * nblk + ((r & 1) ? (nblk - 1 - bid) : bid); if (k >= NITEMS) break; dsa_index_item(P, lds, NITEMS - 1 - k); }
}

typedef _Float16 hh2 __attribute__((ext_vector_type(2)));
__device__ __forceinline__ hh2 as_h2(unsigned u) { return __builtin_bit_cast(hh2, u); }
__device__ __forceinline__ float dot8h(const u32x4 a, const u32x4 b, float c) {
    c = __builtin_amdgcn_fdot2(as_h2(a.x), as_h2(b.x), c, false); c = __builtin_amdgcn_fdot2(as_h2(a.y), as_h2(b.y), c, false);
    c = __builtin_amdgcn_fdot2(as_h2(a.z), as_h2(b.z), c, false); c = __builtin_amdgcn_fdot2(as_h2(a.w), as_h2(b.w), c, false); return c; }
__device__ __forceinline__ void attn_issue(const half_t* Kb, const half_t* Vb, const LAS u16* sl, int qt, int g, u32x4 (&kq)[8], u32x4 (&vq)[8]) {
#pragma unroll
    for (int i = 0; i < 8; ++i) { const unsigned id = sl[(8 * qt + i) * 8 + g]; kq[i] = (u32x4){0u, 0u, 0u, 0u}; vq[i] = (u32x4){0u, 0u, 0u, 0u};
        if (id != 0xFFFFu) { kq[i] = *(const u32x4*)(Kb + (size_t)id * 64); vq[i] = *(const u32x4*)(Vb + (size_t)id * 64); } }
}
__device__ __forceinline__ void attn_consume(const LAS u16* sl, int qt, int g, const u32x4 qh, const u32x4 (&kq)[8], const u32x4 (&vq)[8], float& m, float& l, hh2 (&o2)[4]) {
    float lg[8]; float mx = m;
#pragma unroll
    for (int i = 0; i < 8; ++i) { float d = sum8(dot8h(kq[i], qh, 0.f)); d = (sl[(8 * qt + i) * 8 + g] != 0xFFFFu) ? d : -INFINITY; lg[i] = d; mx = fmaxf(mx, d); }
    if (mx != -INFINITY) {
        const float r = (m == -INFINITY) ? 0.f : __expf(m - mx); l *= r; const _Float16 rh = (_Float16)r; const hh2 r2 = {rh, rh};
#pragma unroll
        for (int c = 0; c < 4; ++c) o2[c] = o2[c] * r2;
#pragma unroll
        for (int i = 0; i < 8; ++i) { const float p = (lg[i] == -INFINITY) ? 0.f : __expf(lg[i] - mx); l += p; const _Float16 ph = (_Float16)p; const hh2 p2 = {ph, ph};
            o2[0] = __builtin_elementwise_fma(p2, as_h2(vq[i].x), o2[0]); o2[1] = __builtin_elementwise_fma(p2, as_h2(vq[i].y), o2[1]);
            o2[2] = __builtin_elementwise_fma(p2, as_h2(vq[i].z), o2[2]); o2[3] = __builtin_elementwise_fma(p2, as_h2(vq[i].w), o2[3]); }
        m = mx; }
}
__device__ __forceinline__ void dsa_attn_phase(const Params& P, LAS unsigned char* lds, int bid, int nblk) {
    const bf16* Q = (const bf16*)(P.ws + WS_Q); const half_t* Kh = (const half_t*)(P.ws + WS_K); const half_t* Vh = (const half_t*)(P.ws + WS_V); const u16* SEL = (const u16*)(P.ws + WS_SEL); bf16* Y = (bf16*)(P.ws + WS_Y);
    const int tid = tid_opaque(), lane = tid & 63, wave = __builtin_amdgcn_readfirstlane(tid >> 6), g = lane >> 3, c8 = (lane & 7) * 8;
    const int h = bid & 7, rank = bid >> 3, nr = (nblk >> 3) - 1, tstep = nr * 8;
    LAS u16* slb = (LAS u16*)lds + wave * 512;
    const half_t* Kb = Kh + (size_t)h * S_ * 64 + c8; const half_t* Vb = Vh + (size_t)h * S_ * 64 + c8;
    const int t0 = rank * 8 + wave;
    if (t0 >= S_) return;
    u32x4 kA[8], vA[8], kB[8], vB[8];
    *(LAS u32x2*)(slb + 4 * lane) = *(const u32x2*)(SEL + (size_t)t0 * 256 + 4 * lane);
    u32x4 qw = *(const u32x4*)(Q + (size_t)t0 * 512 + h * 64 + c8);
    LDS_WAIT(); __builtin_amdgcn_wave_barrier();
    attn_issue(Kb, Vb, slb, 0, g, kA, vA); attn_issue(Kb, Vb, slb, 1, g, kB, vB);
    int cur = 0;
    for (int t = t0; t < S_; t += tstep) {
        const LAS u16* sl = slb + cur * 256; LAS u16* sn = slb + (cur ^ 1) * 256;
        const int tn = (t + tstep < S_) ? t + tstep : t;
        u32x4 qh; qh.x = pk2h(bflo(qw.x) * 0.125f, bfhi(qw.x) * 0.125f); qh.y = pk2h(bflo(qw.y) * 0.125f, bfhi(qw.y) * 0.125f); qh.z = pk2h(bflo(qw.z) * 0.125f, bfhi(qw.z) * 0.125f); qh.w = pk2h(bflo(qw.w) * 0.125f, bfhi(qw.w) * 0.125f);
        const u32x2 selw = *(const u32x2*)(SEL + (size_t)tn * 256 + 4 * lane); qw = *(const u32x4*)(Q + (size_t)tn * 512 + h * 64 + c8);
        float m = -INFINITY, l = 0.f; hh2 o2[4];
#pragma unroll
        for (int c = 0; c < 4; ++c) o2[c] = (hh2){(_Float16)0.f, (_Float16)0.f};
        attn_consume(sl, 0, g, qh, kA, vA, m, l, o2); attn_issue(Kb, Vb, sl, 2, g, kA, vA);
        *(LAS u32x2*)(sn + 4 * lane) = selw;
        attn_consume(sl, 1, g, qh, kB, vB, m, l, o2); attn_issue(Kb, Vb, sl, 3, g, kB, vB);
        LDS_WAIT(); __builtin_amdgcn_wave_barrier();
        attn_consume(sl, 2, g, qh, kA, vA, m, l, o2); attn_issue(Kb, Vb, sn, 0, g, kA, vA);
        attn_consume(sl, 3, g, qh, kB, vB, m, l, o2); attn_issue(Kb, Vb, sn, 1, g, kB, vB);
        float M = fmaxf(m, dppf<0x128>(m)); M = max_x16(M); M = max_x32(M);
        const float f = (m == -INFINITY) ? 0.f : __expf(m - M);
        float o[8];
#pragma unroll
        for (int c = 0; c < 4; ++c) { o[2 * c] = (float)o2[c].x * f; o[2 * c + 1] = (float)o2[c].y * f; }
        l *= f; l += dppf<0x128>(l); l = sum_x16(l); l = sum_x32(l);
#pragma unroll
        for (int c = 0; c < 8; ++c) { o[c] += dppf<0x128>(o[c]); o[c] = sum_x16(o[c]); o[c] = sum_x32(o[c]); }
        const float il = 1.0f / l;
        if (g == 0) { u32x4 w4; w4.x = pk2(o[0] * il, o[1] * il); w4.y = pk2(o[2] * il, o[3] * il); w4.z = pk2(o[4] * il, o[5] * il); w4.w = pk2(o[6] * il, o[7] * il);
            *(u32x4*)(Y + (size_t)t * 1536 + h * 64 + c8) = w4; }
        cur ^= 1;
    }
}
constexpr int RC = 64, RLD = 72, RARR = 64 * RLD * 2;
constexpr int RO_AT = 0, RO_ATT = RARR, RO_RT = 2 * RARR, RO_BT = 3 * RARR, RO_KT = 4 * RARR, RO_VT = 5 * RARR, RO_WT = 6 * RARR, RO_P1 = 7 * RARR, RO_P2 = 8 * RARR, RO_P3 = 9 * RARR, RO_P4 = 10 * RARR,
              RO_S0 = 11 * RARR, RO_F1 = 12 * RARR, RO_F2 = RO_F1 + 16384, RO_END = RO_F2 + 16384;
typedef short s16x8 __attribute__((ext_vector_type(8)));

__device__ __forceinline__ f32x4 mm16(const LAS bf16* A, const LAS bf16* B, int tr, int tc, int l15, int kg, f32x4 acc) {
#pragma unroll
    for (int ks = 0; ks < 2; ++ks) { const s16x8 a = *(const LAS s16x8*)(A + (16 * tr + l15) * RLD + 32 * ks + 8 * kg); const s16x8 b = *(const LAS s16x8*)(B + (16 * tc + l15) * RLD + 32 * ks + 8 * kg);
        acc = __builtin_amdgcn_mfma_f32_16x16x32_bf16(a, b, acc, 0, 0, 0); }
    return acc;
}
template <int MASK> __device__ __forceinline__ void st_tile(LAS bf16* Out, int tr, int tc, int l15, int kg, f32x4 acc) {
    const int col = 16 * tc + l15, row0 = 16 * tr + 4 * kg;
#pragma unroll
    for (int r = 0; r < 4; ++r) { const int row = row0 + r; bool keep = true; if (MASK == 1) keep = col < row; if (MASK == 2) keep = row < col; if (MASK == 3) keep = row <= col; if (!keep) acc[r] = 0.f; }
    u32x2 w; w.x = pk2(acc[0], acc[1]); w.y = pk2(acc[2], acc[3]);
    *(LAS u32x2*)(Out + col * RLD + row0) = w;
}
__device__ __forceinline__ void ld8(const bf16* p, float* o) { const u32x4 w = *(const u32x4*)p; o[0] = bflo(w.x); o[1] = bfhi(w.x); o[2] = bflo(w.y); o[3] = bfhi(w.y); o[4] = bflo(w.z); o[5] = bfhi(w.z); o[6] = bflo(w.w); o[7] = bfhi(w.w); }
__device__ __forceinline__ void ldf8(const float* p, float* o) { const f32x4 a = *(const f32x4*)p, b = *(const f32x4*)(p + 4); o[0] = a[0]; o[1] = a[1]; o[2] = a[2]; o[3] = a[3]; o[4] = b[0]; o[5] = b[1]; o[6] = b[2]; o[7] = b[3]; }
__device__ __forceinline__ u32x4 pk8(const float* v) { u32x4 w; w.x = pk2(v[0], v[1]); w.y = pk2(v[2], v[3]); w.z = pk2(v[4], v[5]); w.w = pk2(v[6], v[7]); return w; }

struct RwBufs { const bf16* RWP; const bf16* Eb; const bf16* Ab; const bf16* Gb; bf16* MT; bf16* Nn; bf16* S0; bf16* Y; };
__device__ __forceinline__ RwBufs rw_bufs(const Params& P) {
    RwBufs b; unsigned char* dob = (unsigned char*)P.out;
    b.RWP = (const bf16*)(P.ws + WS_RWP); b.Eb = (const bf16*)(dob + DO_E); b.Ab = (const bf16*)(dob + DO_A); b.Gb = (const bf16*)(dob + DO_G);
    b.MT = (bf16*)(dob + DO_LIN); b.Nn = (bf16*)(P.ws + WS_XB); b.S0 = (bf16*)(P.ws + WS_MEMQ); b.Y = (bf16*)(P.ws + WS_Y); return b;
}

template <bool PH3> __device__ __forceinline__ void rw_unit(const Params& P, const RwBufs& B, LAS unsigned char* lds, int h, int c) {
    const float* mu = P.in[12]; const float* k_k = P.in[18]; const float* k_a = P.in[19]; const float* r_k = P.in[20]; const float* ln_w = P.in[21]; const float* ln_b = P.in[22];
    LAS bf16* sAT = (LAS bf16*)(lds + RO_AT); LAS bf16* sATT = (LAS bf16*)(lds + RO_ATT); LAS bf16* sRT = (LAS bf16*)(lds + RO_RT); LAS bf16* sBT = (LAS bf16*)(lds + RO_BT); LAS bf16* sKT = (LAS bf16*)(lds + RO_KT);
    LAS bf16* sVT = (LAS bf16*)(lds + RO_VT); LAS bf16* sWT = (LAS bf16*)(lds + RO_WT); LAS bf16* sP1 = (LAS bf16*)(lds + RO_P1); LAS bf16* sP2 = (LAS bf16*)(lds + RO_P2); LAS bf16* sP3 = (LAS bf16*)(lds + RO_P3);
    LAS bf16* sP4 = (LAS bf16*)(lds + RO_P4); LAS bf16* sS0 = (LAS bf16*)(lds + RO_S0); LAS float* sL = (LAS float*)(lds + RO_F1); LAS float* sF2 = (LAS float*)(lds + RO_F2);
    const int tid = tid_opaque(), lane = tid & 63, wave = __builtin_amdgcn_readfirstlane(tid >> 6), l15 = lane & 15, kg = lane >> 4;
    const int t = tid >> 3, jc = (tid & 7) * 8, tg = c * RC + t, hc = h * 64 + jc;
    const size_t unit = (size_t)h * 256 + c;
    PROBE_T0(32, lds)
    float rr[8], kk[8], vv[8], al[8], ee[8], bb[8], aa[8];
    {
        float p[8], q[8], m8[8];
        ld8(B.RWP + (size_t)tg * RW_IN + hc, p); if (tg > 0) ld8(B.RWP + (size_t)(tg - 1) * RW_IN + hc, q); else { for (int i = 0; i < 8; ++i) q[i] = 0.f; } ldf8(mu + hc, m8);
#pragma unroll
        for (int i = 0; i < 8; ++i) rr[i] = p[i] + (q[i] - p[i]) * m8[i];
        ld8(B.RWP + (size_t)tg * RW_IN + 512 + hc, p); if (tg > 0) ld8(B.RWP + (size_t)(tg - 1) * RW_IN + 512 + hc, q); ldf8(mu + 512 + hc, m8);
#pragma unroll
        for (int i = 0; i < 8; ++i) kk[i] = p[i] + (q[i] - p[i]) * m8[i];
        ld8(B.RWP + (size_t)tg * RW_IN + 1024 + hc, p); if (tg > 0) ld8(B.RWP + (size_t)(tg - 1) * RW_IN + 1024 + hc, q); ldf8(mu + 1024 + hc, m8);
#pragma unroll
        for (int i = 0; i < 8; ++i) vv[i] = p[i] + (q[i] - p[i]) * m8[i];
        ld8(B.Ab + (size_t)tg * 512 + hc, al); ld8(B.Eb + (size_t)tg * 512 + hc, ee);
        float kn[8], kkc[8], kac[8], ss = 0.f; ldf8(k_k + hc, kkc); ldf8(k_a + hc, kac);
#pragma unroll
        for (int i = 0; i < 8; ++i) { kn[i] = kk[i] * kkc[i]; ss += kn[i] * kn[i]; }
        ss = sum8(ss);
        const float inv = 1.0f / fmaxf(sqrtf(ss), 1e-12f);
#pragma unroll
        for (int i = 0; i < 8; ++i) { kn[i] *= inv; aa[i] = -kn[i]; bb[i] = kn[i] * al[i]; kk[i] = kk[i] * (1.0f + (al[i] - 1.0f) * kac[i]); }
        *(LAS f32x4*)(sL + t * 64 + jc) = (f32x4){ee[0], ee[1], ee[2], ee[3]}; *(LAS f32x4*)(sL + t * 64 + jc + 4) = (f32x4){ee[4], ee[5], ee[6], ee[7]};
    }
    float bonus = 0.f, gg[8];
    if (PH3) { float rk8[8]; ldf8(r_k + hc, rk8);
#pragma unroll
        for (int i = 0; i < 8; ++i) bonus += rr[i] * kk[i] * rk8[i];
        bonus = sum8(bonus);
        ld8(B.Gb + (size_t)tg * 512 + hc, gg);
        const u32x4 sw = *(const u32x4*)(B.S0 + unit * 4096 + (size_t)t * 64 + jc); *(LAS u32x4*)(sS0 + t * RLD + jc) = sw; }
    __syncthreads();
    if (wave == 0) { float ev[64];
#pragma unroll
        for (int u = 0; u < 64; ++u) ev[u] = sL[u * 64 + lane];
        float run = 0.f;
#pragma unroll
        for (int u = 0; u < 64; ++u) { run += ev[u]; sL[u * 64 + lane] = run; } }
    __syncthreads();
    {
        float Lt[8], Lp[8], Le[8];
        { const f32x4 a = *(const LAS f32x4*)(sL + t * 64 + jc), b = *(const LAS f32x4*)(sL + t * 64 + jc + 4); Lt[0] = a[0]; Lt[1] = a[1]; Lt[2] = a[2]; Lt[3] = a[3]; Lt[4] = b[0]; Lt[5] = b[1]; Lt[6] = b[2]; Lt[7] = b[3]; }
        if (t > 0) { const f32x4 a = *(const LAS f32x4*)(sL + (t - 1) * 64 + jc), b = *(const LAS f32x4*)(sL + (t - 1) * 64 + jc + 4); Lp[0] = a[0]; Lp[1] = a[1]; Lp[2] = a[2]; Lp[3] = a[3]; Lp[4] = b[0]; Lp[5] = b[1]; Lp[6] = b[2]; Lp[7] = b[3]; }
        else { for (int i = 0; i < 8; ++i) Lp[i] = 0.f; }
        { const f32x4 a = *(const LAS f32x4*)(sL + 63 * 64 + jc), b = *(const LAS f32x4*)(sL + 63 * 64 + jc + 4); Le[0] = a[0]; Le[1] = a[1]; Le[2] = a[2]; Le[3] = a[3]; Le[4] = b[0]; Le[5] = b[1]; Le[6] = b[2]; Le[7] = b[3]; }
        float at[8], rt[8], bt[8], kt[8];
#pragma unroll
        for (int i = 0; i < 8; ++i) { const float ep = __expf(Lt[i]); at[i] = aa[i] * __expf(-Lp[i]); rt[i] = rr[i] * __expf(-Lt[i]); bt[i] = bb[i] * ep; kt[i] = kk[i] * ep; }
        *(LAS u32x4*)(sAT + t * RLD + jc) = pk8(at); *(LAS u32x4*)(sBT + t * RLD + jc) = pk8(bt); *(LAS u32x4*)(sKT + t * RLD + jc) = pk8(kt);
        if (PH3) *(LAS u32x4*)(sRT + t * RLD + jc) = pk8(rt);
#pragma unroll
        for (int i = 0; i < 8; ++i) sVT[(jc + i) * RLD + t] = (bf16)f2bf(vv[i]);
        if (!PH3) {
#pragma unroll
            for (int i = 0; i < 8; ++i) sATT[(jc + i) * RLD + t] = (bf16)f2bf(at[i]);
            float bp[8], kp[8];
#pragma unroll
            for (int i = 0; i < 8; ++i) { const float ed = __expf(-(Le[i] - Lt[i])); bp[i] = bb[i] * ed; kp[i] = kk[i] * ed; }
            *(LAS f32x4*)(sF2 + t * 64 + jc) = (f32x4){bp[0], bp[1], bp[2], bp[3]}; *(LAS f32x4*)(sF2 + t * 64 + jc + 4) = (f32x4){bp[4], bp[5], bp[6], bp[7]};
            *(LAS u32x4*)(sP4 + t * RLD + jc) = pk8(kp);
        }
    }
    __syncthreads();
    PROBE_T1(32, lds)
    const int tr = wave >> 1, tc0 = 2 * (wave & 1);
    const f32x4 z4 = {0.f, 0.f, 0.f, 0.f};
    if (!PH3) {
#pragma unroll
        for (int x = 0; x < 2; ++x) { st_tile<1>(sP1, tr, tc0 + x, l15, kg, mm16(sAT, sBT, tr, tc0 + x, l15, kg, z4)); st_tile<1>(sP2, tr, tc0 + x, l15, kg, mm16(sAT, sKT, tr, tc0 + x, l15, kg, z4)); }
        __syncthreads();
        PROBE_T0(33, lds)
        for (int i = tid; i < RARR / 4; i += NT) ((LAS unsigned*)sWT)[i] = 0u;
        __syncthreads();
#pragma unroll 1
        for (int bt = 3; bt >= 0; --bt) {
            if (wave < 4) { f32x4 xi;
#pragma unroll
                for (int r = 0; r < 4; ++r) xi[r] = sF2[(16 * bt + 4 * kg + r) * 64 + 16 * wave + l15];
                xi = mm16(sP1, sWT, bt, wave, l15, kg, xi);
#pragma unroll
                for (int r = 0; r < 4; ++r) sF2[(16 * bt + 4 * kg + r) * 64 + 16 * wave + l15] = xi[r]; }
            __syncthreads();
            if (wave == 0) { float wv[16];
#pragma unroll
                for (int r = 15; r >= 0; --r) { float acc = sF2[(16 * bt + r) * 64 + lane];
                    const u32x4 a0 = *(const LAS u32x4*)(sP1 + (16 * bt + r) * RLD + 16 * bt), a1 = *(const LAS u32x4*)(sP1 + (16 * bt + r) * RLD + 16 * bt + 8);
                    const float a16[16] = {bflo(a0.x), bfhi(a0.x), bflo(a0.y), bfhi(a0.y), bflo(a0.z), bfhi(a0.z), bflo(a0.w), bfhi(a0.w), bflo(a1.x), bfhi(a1.x), bflo(a1.y), bfhi(a1.y), bflo(a1.z), bfhi(a1.z), bflo(a1.w), bfhi(a1.w)};
#pragma unroll
                    for (int x = r + 1; x < 16; ++x) acc += a16[x] * wv[x];
                    wv[r] = acc; }
                *(LAS u32x4*)(sWT + lane * RLD + 16 * bt) = pk8(wv); *(LAS u32x4*)(sWT + lane * RLD + 16 * bt + 8) = pk8(wv + 8); }
            __syncthreads();
        }
        __syncthreads();
        PROBE_T1(33, lds)
#pragma unroll
        for (int x = 0; x < 2; ++x) { const int tc = tc0 + x;
            f32x4 zi; { const int col = 16 * tc + l15;
#pragma unroll
                for (int r = 0; r < 4; ++r) zi[r] = bf2f(sP4[(16 * tr + 4 * kg + r) * RLD + col]); }
            st_tile<0>(sP3, tr, tc, l15, kg, mm16(sP2, sWT, tr, tc, l15, kg, zi));
            f32x4 m = mm16(sATT, sWT, tr, tc, l15, kg, z4);
            { const int col = 16 * tc + l15, row0 = 16 * tr + 4 * kg; const float pc = __expf(-sL[63 * 64 + col]);
#pragma unroll
                for (int r = 0; r < 4; ++r) if (row0 + r == col) m[r] += pc;
                u32x2 w; w.x = pk2(m[0], m[1]); w.y = pk2(m[2], m[3]); *(u32x2*)(B.MT + unit * 4096 + (size_t)col * 64 + row0) = w; } }
        __syncthreads();
#pragma unroll
        for (int x = 0; x < 2; ++x) { const int tc = tc0 + x; const f32x4 nacc = mm16(sP3, sVT, tr, tc, l15, kg, z4);
            u32x2 w; w.x = pk2(nacc[0], nacc[1]); w.y = pk2(nacc[2], nacc[3]); *(u32x2*)(B.Nn + unit * 4096 + (size_t)(16 * tc + l15) * 64 + 16 * tr + 4 * kg) = w; }
        __syncthreads();
    } else {
#pragma unroll
        for (int x = 0; x < 2; ++x) { const int tc = tc0 + x;
            st_tile<2>(sP1, tr, tc, l15, kg, mm16(sBT, sAT, tr, tc, l15, kg, z4)); st_tile<2>(sP2, tr, tc, l15, kg, mm16(sKT, sAT, tr, tc, l15, kg, z4));
            st_tile<3>(sP3, tr, tc, l15, kg, mm16(sBT, sRT, tr, tc, l15, kg, z4)); st_tile<3>(sP4, tr, tc, l15, kg, mm16(sKT, sRT, tr, tc, l15, kg, z4)); }
        __syncthreads();
#pragma unroll
        for (int x = 0; x < 2; ++x) { const int tc = tc0 + x; f32x4 xa = mm16(sAT, sS0, tr, tc, l15, kg, z4); xa = mm16(sP2, sVT, tr, tc, l15, kg, xa);
#pragma unroll
            for (int r = 0; r < 4; ++r) sF2[(16 * tr + 4 * kg + r) * 64 + 16 * tc + l15] = xa[r]; }
        __syncthreads();
        for (int i = tid; i < RARR / 4; i += NT) ((LAS unsigned*)sWT)[i] = 0u;
        __syncthreads();
#pragma unroll 1
        for (int bt = 0; bt < 4; ++bt) {
            if (wave < 4) { f32x4 xi;
#pragma unroll
                for (int r = 0; r < 4; ++r) xi[r] = sF2[(16 * bt + 4 * kg + r) * 64 + 16 * wave + l15];
                xi = mm16(sP1, sWT, bt, wave, l15, kg, xi);
#pragma unroll
                for (int r = 0; r < 4; ++r) sF2[(16 * bt + 4 * kg + r) * 64 + 16 * wave + l15] = xi[r]; }
            __syncthreads();
            if (wave == 0) { float uv[16];
#pragma unroll
                for (int r = 0; r < 16; ++r) { float acc = sF2[(16 * bt + r) * 64 + lane];
                    const u32x4 a0 = *(const LAS u32x4*)(sP1 + (16 * bt + r) * RLD + 16 * bt), a1 = *(const LAS u32x4*)(sP1 + (16 * bt + r) * RLD + 16 * bt + 8);
                    const float a16[16] = {bflo(a0.x), bfhi(a0.x), bflo(a0.y), bfhi(a0.y), bflo(a0.z), bfhi(a0.z), bflo(a0.w), bfhi(a0.w), bflo(a1.x), bfhi(a1.x), bflo(a1.y), bfhi(a1.y), bflo(a1.z), bfhi(a1.z), bflo(a1.w), bfhi(a1.w)};
#pragma unroll
                    for (int x = 0; x < r; ++x) acc += a16[x] * uv[x];
                    uv[r] = acc; }
                *(LAS u32x4*)(sWT + lane * RLD + 16 * bt) = pk8(uv); *(LAS u32x4*)(sWT + lane * RLD + 16 * bt + 8) = pk8(uv + 8); }
            __syncthreads();
        }
        __syncthreads();
#pragma unroll
        for (int x = 0; x < 2; ++x) { const int tc = tc0 + x; f32x4 ya = mm16(sRT, sS0, tr, tc, l15, kg, z4); ya = mm16(sP3, sWT, tr, tc, l15, kg, ya); ya = mm16(sP4, sVT, tr, tc, l15, kg, ya);
#pragma unroll
            for (int r = 0; r < 4; ++r) sF2[(16 * tr + 4 * kg + r) * 64 + 16 * tc + l15] = ya[r]; }
        __syncthreads();
        {
            float y8[8], s1 = 0.f;
            { const f32x4 a = *(const LAS f32x4*)(sF2 + t * 64 + jc), b = *(const LAS f32x4*)(sF2 + t * 64 + jc + 4); y8[0] = a[0]; y8[1] = a[1]; y8[2] = a[2]; y8[3] = a[3]; y8[4] = b[0]; y8[5] = b[1]; y8[6] = b[2]; y8[7] = b[3]; }
#pragma unroll
            for (int i = 0; i < 8; ++i) s1 += y8[i];
            s1 = sum8(s1);
            const float mean = s1 * (1.0f / 64.0f); float s2 = 0.f;
#pragma unroll
            for (int i = 0; i < 8; ++i) { const float d = y8[i] - mean; s2 += d * d; }
            s2 = sum8(s2);
            const float rstd = 1.0f / sqrtf(s2 * (1.0f / 64.0f) + GN_EPS);
            float lw[8], lb[8], o8[8]; ldf8(ln_w + hc, lw); ldf8(ln_b + hc, lb);
#pragma unroll
            for (int i = 0; i < 8; ++i) o8[i] = ((y8[i] - mean) * rstd * lw[i] + lb[i] + bonus * vv[i]) * gg[i];
            *(u32x4*)(B.Y + (size_t)tg * 1536 + 512 + hc) = pk8(o8);
        }
        __syncthreads();
    }
}

__device__ __forceinline__ void rw_scan_phase(const Params& P, LAS unsigned char* lds, int h) {
    const RwBufs B = rw_bufs(P);
    const int tid = tid_opaque(), lane = tid & 63, wave = __builtin_amdgcn_readfirstlane(tid >> 6), l15 = lane & 15, kg = lane >> 4;
    const int tr = wave >> 1, tc0 = 2 * (wave & 1);
    LAS bf16* sS[2] = {(LAS bf16*)lds, (LAS bf16*)(lds + RARR)};
    for (int i = tid; i < 2 * RARR / 4; i += NT) ((LAS unsigned*)lds)[i] = 0u;
    __syncthreads();
    const int trow = tid >> 3, tcol = (tid & 7) * 8;
    s16x8 ma[2]; u32x2 nw[2];
    { const bf16* mt = B.MT + ((size_t)h * 256) * 4096; const bf16* nn = B.Nn + ((size_t)h * 256) * 4096;
#pragma unroll
        for (int ks = 0; ks < 2; ++ks) ma[ks] = *(const s16x8*)(mt + (size_t)(16 * tr + l15) * 64 + 32 * ks + 8 * kg);
#pragma unroll
        for (int x = 0; x < 2; ++x) nw[x] = *(const u32x2*)(nn + (size_t)(16 * (tc0 + x) + l15) * 64 + 16 * tr + 4 * kg); }
    for (int c = 0; c < 256; ++c) {
        const LAS bf16* cur = sS[c & 1]; LAS bf16* nxt = sS[(c + 1) & 1];
        const size_t unit = (size_t)h * 256 + c;
        *(u32x4*)(B.S0 + unit * 4096 + (size_t)trow * 64 + tcol) = *(const LAS u32x4*)(cur + trow * RLD + tcol);
        s16x8 ma_n[2]; u32x2 nw_n[2];
        if (c + 1 < 256) { const bf16* mt = B.MT + (unit + 1) * 4096; const bf16* nn = B.Nn + (unit + 1) * 4096;
#pragma unroll
            for (int ks = 0; ks < 2; ++ks) ma_n[ks] = *(const s16x8*)(mt + (size_t)(16 * tr + l15) * 64 + 32 * ks + 8 * kg);
#pragma unroll
            for (int x = 0; x < 2; ++x) nw_n[x] = *(const u32x2*)(nn + (size_t)(16 * (tc0 + x) + l15) * 64 + 16 * tr + 4 * kg); }
        else { ma_n[0] = ma[0]; ma_n[1] = ma[1]; nw_n[0] = nw[0]; nw_n[1] = nw[1]; }
#pragma unroll
        for (int x = 0; x < 2; ++x) { const int tc = tc0 + x;
            f32x4 acc = {bflo(nw[x].x), bfhi(nw[x].x), bflo(nw[x].y), bfhi(nw[x].y)};
#pragma unroll
            for (int ks = 0; ks < 2; ++ks) { const s16x8 b = *(const LAS s16x8*)(cur + (16 * tc + l15) * RLD + 32 * ks + 8 * kg); acc = __builtin_amdgcn_mfma_f32_16x16x32_bf16(ma[ks], b, acc, 0, 0, 0); }
            u32x2 w; w.x = pk2(acc[0], acc[1]); w.y = pk2(acc[2], acc[3]); *(LAS u32x2*)(nxt + (16 * tc + l15) * RLD + 16 * tr + 4 * kg) = w; }
        ma[0] = ma_n[0]; ma[1] = ma_n[1]; nw[0] = nw_n[0]; nw[1] = nw_n[1];
        __syncthreads();
    }
}
__device__ __forceinline__ void rw_lora_chunk(const Params& P, const RwBufs& B, LAS unsigned char* lds, int c) {
    constexpr int LLD = 264; LAS bf16* sLIN = (LAS bf16*)lds;
    const float* mu = P.in[12]; const float* w0 = P.in[13]; const float* a0 = P.in[15]; const bf16* WL = (const bf16*)(P.ws + WS_WLORA);
    const int tid = tid_opaque(), lane = tid & 63, h = __builtin_amdgcn_readfirstlane(tid >> 6), l15 = lane & 15, kg = lane >> 4;
    { const int t = tid >> 3, part = tid & 7, tg = c * RC + t, c0 = 1536 + 32 * part; float pv[32];
#pragma unroll
      for (int q4 = 0; q4 < 4; ++q4) { float p[8], q[8], m8[8]; ld8(B.RWP + (size_t)tg * RW_IN + c0 + 8 * q4, p);
          if (tg > 0) ld8(B.RWP + (size_t)(tg - 1) * RW_IN + c0 + 8 * q4, q); else { for (int i = 0; i < 8; ++i) q[i] = 0.f; }
          ldf8(mu + c0 + 8 * q4, m8);
#pragma unroll
          for (int i = 0; i < 8; ++i) { float s = p[i] + (q[i] - p[i]) * m8[i]; if (part < 2) s = 1.0f - 2.0f / (1.0f + __expf(2.0f * s)); else if (part >= 4) s = sigmoidf_(s); pv[8 * q4 + i] = s; } }
#pragma unroll
      for (int q4 = 0; q4 < 4; ++q4) *(LAS u32x4*)(sLIN + t * LLD + 32 * part + 8 * q4) = pk8(pv + 8 * q4); }
    __syncthreads();
#pragma unroll 1
    for (int jt = 0; jt < 4; ++jt) { const int j0 = h * 64 + 16 * jt;
        s16x8 we[2], wa[2], wg[4];
#pragma unroll
        for (int ks = 0; ks < 2; ++ks) { we[ks] = *(const s16x8*)(WL + (size_t)(j0 + l15) * 256 + 32 * ks + 8 * kg); wa[ks] = *(const s16x8*)(WL + (size_t)(512 + j0 + l15) * 256 + 64 + 32 * ks + 8 * kg); }
#pragma unroll
        for (int ks = 0; ks < 4; ++ks) wg[ks] = *(const s16x8*)(WL + (size_t)(1024 + j0 + l15) * 256 + 128 + 32 * ks + 8 * kg);
        const f32x4 w04 = *(const f32x4*)(w0 + j0 + 4 * kg), a04 = *(const f32x4*)(a0 + j0 + 4 * kg);
#pragma unroll
        for (int tt = 0; tt < 4; ++tt) { const LAS bf16* lp = sLIN + (16 * tt + l15) * LLD + 8 * kg;
            f32x4 ae = {0.f, 0.f, 0.f, 0.f}, aa = {0.f, 0.f, 0.f, 0.f}, ag = {0.f, 0.f, 0.f, 0.f};
#pragma unroll
            for (int ks = 0; ks < 2; ++ks) { ae = __builtin_amdgcn_mfma_f32_16x16x32_bf16(we[ks], *(const LAS s16x8*)(lp + 32 * ks), ae, 0, 0, 0); aa = __builtin_amdgcn_mfma_f32_16x16x32_bf16(wa[ks], *(const LAS s16x8*)(lp + 64 + 32 * ks), aa, 0, 0, 0); }
#pragma unroll
            for (int ks = 0; ks < 4; ++ks) ag = __builtin_amdgcn_mfma_f32_16x16x32_bf16(wg[ks], *(const LAS s16x8*)(lp + 128 + 32 * ks), ag, 0, 0, 0);
            f32x4 ev, av;
#pragma unroll
            for (int r = 0; r < 4; ++r) { const float z = ae[r] + w04[r]; const float sp = fmaxf(-z, 0.f) + __logf(1.0f + __expf(-fabsf(z))); ev[r] = __expf(-sp - 0.5f); av[r] = sigmoidf_(aa[r] + a04[r]); }
            const size_t o = (size_t)(c * RC + 16 * tt + l15) * 512 + j0 + 4 * kg;
            st_bf4((bf16*)B.Eb + o, ev); st_bf4((bf16*)B.Ab + o, av); st_bf4((bf16*)B.Gb + o, ag); } }
    __syncthreads();
}
template <bool PH3> __device__ __forceinline__ void rw_units_phase(const Params& P, LAS unsigned char* lds, int bid, int nblk) {
    const RwBufs B = rw_bufs(P);
    if (!PH3) rw_lora_chunk(P, B, lds, bid & 255);
    for (int u = bid; u < 8 * 256; u += nblk) rw_unit<PH3>(P, B, lds, u >> 8, u & 255);
}

__device__ __forceinline__ void xb_phase(const Params& P, int bid, int nblk) {
    const int tid = tid_opaque(), lane = tid & 63, wave = tid >> 6;
    for (int r = bid * NW + wave; r < S_; r += nblk * NW) {
        const f32x4* xr = (const f32x4*)(P.in[0] + (size_t)r * D_) + lane; unsigned long long* o8 = (unsigned long long*)((bf16*)(P.ws + WS_XB) + (size_t)r * D_) + lane;
#pragma unroll
        for (int j = 0; j < 4; ++j) { const f32x4 v = xr[64 * j]; o8[64 * j] = (unsigned long long)pk2(v.x, v.y) | ((unsigned long long)pk2(v.z, v.w) << 32); }
    }
}
constexpr size_t WS_UBS = 192 * MiB, WS_VBS = 224 * MiB, WS_PART = 64 * MiB, WS_EW = 48 * MiB;
typedef float f32x2_ __attribute__((ext_vector_type(2)));
__device__ __forceinline__ void f8x16(const u32x4 w, float* x) {
    const f32x2_ a0 = __builtin_amdgcn_cvt_pk_f32_fp8((int)w.x, false), a1 = __builtin_amdgcn_cvt_pk_f32_fp8((int)w.x, true), b0 = __builtin_amdgcn_cvt_pk_f32_fp8((int)w.y, false), b1 = __builtin_amdgcn_cvt_pk_f32_fp8((int)w.y, true);
    const f32x2_ c0 = __builtin_amdgcn_cvt_pk_f32_fp8((int)w.z, false), c1 = __builtin_amdgcn_cvt_pk_f32_fp8((int)w.z, true), d0 = __builtin_amdgcn_cvt_pk_f32_fp8((int)w.w, false), d1 = __builtin_amdgcn_cvt_pk_f32_fp8((int)w.w, true);
    x[0] = a0.x; x[1] = a0.y; x[2] = a1.x; x[3] = a1.y; x[4] = b0.x; x[5] = b0.y; x[6] = b1.x; x[7] = b1.y; x[8] = c0.x; x[9] = c0.y; x[10] = c1.x; x[11] = c1.y; x[12] = d0.x; x[13] = d0.y; x[14] = d1.x; x[15] = d1.y;
}
__device__ __forceinline__ unsigned pk4f8(f32x4 v, float s) { int w = __builtin_amdgcn_cvt_pk_fp8_f32(v[0] * s, v[1] * s, 0, false); w = __builtin_amdgcn_cvt_pk_fp8_f32(v[2] * s, v[3] * s, w, true); return (unsigned)w; }
constexpr float PEER_USCALE = 32.0f, PEER_VSCALE = 4.0f;
__device__ __forceinline__ void peer_conv_phase(const Params& P, int bid, int nblk) {
    const int gt = bid * NT + tid_opaque(), NGT = nblk * NT;
    for (int i = gt; i < 2 * NEXP * 64; i += NGT) { const int tab = i / (NEXP * 64), r = i % (NEXP * 64), e = r >> 6, l = r & 63;
        const float* src = (tab ? P.in[30] : P.in[29]) + (size_t)e * 1024 + 16 * l; const float s = tab ? PEER_VSCALE : PEER_USCALE;
        u32x4 w; w.x = pk4f8(*(const f32x4*)src, s); w.y = pk4f8(*(const f32x4*)(src + 4), s); w.z = pk4f8(*(const f32x4*)(src + 8), s); w.w = pk4f8(*(const f32x4*)(src + 12), s);
        *(u32x4*)(P.ws + (tab ? WS_VBS : WS_UBS) + ((size_t)(l >> 3) * NEXP + e) * 128 + (l & 7) * 16) = w; }
}
__device__ __forceinline__ void peer_e1_phase(const Params& P, LAS unsigned char* lds, int bid, int nblk) {
    const int* EIDX = (const int*)(P.ws + WS_EIDX); const float* HSQ = (const float*)(P.ws + WS_HSQ); const float* gain = P.in[25]; float* PART = (float*)(P.ws + WS_PART);
    const int tid = tid_opaque(), lane = tid & 63, wave = __builtin_amdgcn_readfirstlane(tid >> 6), g = lane >> 3, c16 = (lane & 7) * 16;
    const int x = bid & 7, rank = bid >> 3, nr = nblk >> 3, tstep = nr * 8;
    LAS float* pb = (LAS float*)lds + wave * 256;
    const unsigned char* tab = P.ws + WS_UBS + (size_t)x * NEXP * 128 + c16;
    float gn[16]; ldf8(gain + 128 * x + c16, gn); ldf8(gain + 128 * x + c16 + 8, gn + 8);
    for (int t0 = rank * 8 + wave; t0 < S_; t0 += 2 * tstep) {
        int tt[2] = {t0, (t0 + tstep < S_) ? t0 + tstep : t0};
        int e_lo[2], e_hi[2]; float xn[2][16];
#pragma unroll
        for (int z = 0; z < 2; ++z) { e_lo[z] = EIDX[(size_t)tt[z] * 128 + lane]; e_hi[z] = EIDX[(size_t)tt[z] * 128 + 64 + lane];
            ldf8(P.out + (size_t)tt[z] * 1024 + 128 * x + c16, xn[z]); ldf8(P.out + (size_t)tt[z] * 1024 + 128 * x + c16 + 8, xn[z] + 8); }
        u32x4 uw[2][16];
#pragma unroll
        for (int z = 0; z < 2; ++z)
#pragma unroll
            for (int i = 0; i < 16; ++i) { const int e = __shfl((i < 8) ? e_lo[z] : e_hi[z], (8 * i + g) & 63); uw[z][i] = *(const u32x4*)(tab + (size_t)e * 128); }
#pragma unroll
        for (int z = 0; z < 2; ++z) { const float rs = rstd_h_row(HSQ, tt[z]) * (1.0f / PEER_USCALE);
#pragma unroll
            for (int j = 0; j < 16; ++j) xn[z][j] *= rs * gn[j];
#pragma unroll
            for (int i = 0; i < 16; ++i) { float u16[16]; f8x16(uw[z][i], u16); float d = 0.f;
#pragma unroll
                for (int j = 0; j < 16; ++j) d += xn[z][j] * u16[j];
                d = sum8(d);
                if ((lane & 7) == 0) pb[z * 128 + 8 * i + g] = d; } }
        LDS_WAIT(); __builtin_amdgcn_wave_barrier();
#pragma unroll
        for (int z = 0; z < 2; ++z) if (z == 0 || tt[1] != tt[0]) { float* dst = PART + ((size_t)tt[z] * 8 + x) * 128; dst[lane] = pb[z * 128 + lane]; dst[64 + lane] = pb[z * 128 + 64 + lane]; }
        LDS_WAIT(); __builtin_amdgcn_wave_barrier();
    }
}
__device__ __forceinline__ void peer_w_phase(const Params& P, int bid, int nblk) {
    const float* PART = (const float*)(P.ws + WS_PART); const float* EG = (const float*)(P.ws + WS_EGATE); float* EW = (float*)(P.ws + WS_EW);
    const int gt = bid * NT + tid_opaque(), NGT = nblk * NT;
    for (int i = gt; i < S_ * 128; i += NGT) { const int t = i >> 7, k = i & 127; float d = 0.f;
#pragma unroll
        for (int x = 0; x < 8; ++x) d += PART[((size_t)t * 8 + x) * 128 + k];
        EW[i] = EG[i] * 0.5f * d * (1.0f + erff(d * 0.70710678118654752f)); }
}
__device__ __forceinline__ void peer_e2_phase(const Params& P, int bid, int nblk) {
    const int* EIDX = (const int*)(P.ws + WS_EIDX); const float* EW = (const float*)(P.ws + WS_EW);
    const int tid = tid_opaque(), lane = tid & 63, wave = __builtin_amdgcn_readfirstlane(tid >> 6), g = lane >> 3, c16 = (lane & 7) * 16;
    const int x = bid & 7, rank = bid >> 3, nr = nblk >> 3, tstep = nr * 8;
    const unsigned char* tab = P.ws + WS_VBS + (size_t)x * NEXP * 128 + c16;
    for (int t0 = rank * 8 + wave; t0 < S_; t0 += 2 * tstep) {
        int tt[2] = {t0, (t0 + tstep < S_) ? t0 + tstep : t0};
        int e_lo[2], e_hi[2]; float w_lo[2], w_hi[2];
#pragma unroll
        for (int z = 0; z < 2; ++z) { e_lo[z] = EIDX[(size_t)tt[z] * 128 + lane]; e_hi[z] = EIDX[(size_t)tt[z] * 128 + 64 + lane]; w_lo[z] = EW[(size_t)tt[z] * 128 + lane]; w_hi[z] = EW[(size_t)tt[z] * 128 + 64 + lane]; }
        u32x4 vw[2][16]; float wk[2][16];
#pragma unroll
        for (int z = 0; z < 2; ++z)
#pragma unroll
            for (int i = 0; i < 16; ++i) { const int e = __shfl((i < 8) ? e_lo[z] : e_hi[z], (8 * i + g) & 63); wk[z][i] = __shfl((i < 8) ? w_lo[z] : w_hi[z], (8 * i + g) & 63); vw[z][i] = *(const u32x4*)(tab + (size_t)e * 128); }
#pragma unroll
        for (int z = 0; z < 2; ++z) { float o[16];
#pragma unroll
            for (int c = 0; c < 16; ++c) o[c] = 0.f;
#pragma unroll
            for (int i = 0; i < 16; ++i) { float v16[16]; f8x16(vw[z][i], v16); const float wv = wk[z][i];
#pragma unroll
                for (int j = 0; j < 16; ++j) o[j] += wv * v16[j]; }
#pragma unroll
            for (int c = 0; c < 16; ++c) { o[c] += dppf<0x128>(o[c]); o[c] = sum_x16(o[c]); o[c] = sum_x32(o[c]); }
            if (g == 0 && (z == 0 || tt[1] != tt[0])) { float* hp = P.out + (size_t)tt[z] * 1024 + 128 * x + c16;
#pragma unroll
                for (int c4 = 0; c4 < 4; ++c4) { const f32x4 a = *(const f32x4*)(hp + 4 * c4);
                    *(f32x4*)(hp + 4 * c4) = (f32x4){a[0] + o[4 * c4] * (1.0f / PEER_VSCALE), a[1] + o[4 * c4 + 1] * (1.0f / PEER_VSCALE), a[2] + o[4 * c4 + 2] * (1.0f / PEER_VSCALE), a[3] + o[4 * c4 + 3] * (1.0f / PEER_VSCALE)}; } } }
    }
}
#define XB_TMO      128
#define XB_XCNT(j)  (256  + 64 * (j))
#define XB_XSUB(j)  (1280 + 64 * (j))
#define XB_XGEN(j)  (2304 + 64 * (j))
#define XB_TOP      3328
#define XB_TOPGEN   3392
#define XCD_BAR_WORDS 3456
#define XB_SPIN_CAP (1u << 18)

__device__ __forceinline__ unsigned xb_ld(unsigned* p)              { return __hip_atomic_load(p, __ATOMIC_RELAXED, __HIP_MEMORY_SCOPE_AGENT); }
__device__ __forceinline__ unsigned xb_add(unsigned* p, unsigned v) { return __hip_atomic_fetch_add(p, v, __ATOMIC_RELAXED, __HIP_MEMORY_SCOPE_AGENT); }
__device__ __forceinline__ unsigned xb_xcc_id() { return (unsigned)__builtin_amdgcn_s_getreg((3 << 11) | 20) & 0xFu; }
#define XB_SPIN(cond, bar) do { unsigned _sp = 0; while (cond) { __builtin_amdgcn_s_sleep(1); \
    if ((++_sp & 255u) == 0u) { if (xb_ld(&(bar)[XB_TMO])) break; if (_sp > XB_SPIN_CAP) { atomicAdd(&(bar)[XB_TMO], 1u); break; } } } } while (0)

struct XcdBarrier {
    unsigned* bar; unsigned x;
    volatile LAS unsigned* st;
};

__device__ __forceinline__ XcdBarrier xcd_barrier_post(unsigned* bar, volatile LAS unsigned* st) {
    XcdBarrier b; b.bar = bar; b.x = xb_xcc_id(); b.st = st;
    if (threadIdx.x == 0) (void)xb_add(&bar[XB_XCNT(b.x)], 1u);
    return b;
}
__device__ __forceinline__ void xcd_barrier_complete(unsigned* bar, unsigned x, unsigned& nloc, unsigned& nx) {
    const unsigned G = gridDim.x * gridDim.y * gridDim.z;
    unsigned sum, cnt, mine, sp = 0u;
    for (;;) {
        sum = 0u; cnt = 0u; mine = 0u;
#pragma unroll
        for (unsigned j = 0; j < 16; ++j) { const unsigned c = xb_ld(&bar[XB_XCNT(j)]); sum += c; cnt += (c > 0u) ? 1u : 0u; mine = (j == x) ? c : mine; }
        if (sum == G) break;
        __builtin_amdgcn_s_sleep(1);
        if ((++sp & 255u) == 0u) { if (xb_ld(&bar[XB_TMO])) break; if (sp > XB_SPIN_CAP) { atomicAdd(&bar[XB_TMO], 1u); break; } }
    }
    nloc = mine > 0u ? mine : 1u; nx = cnt > 0u ? cnt : 1u;
}

__device__ __forceinline__ void xcd_barrier(const XcdBarrier& b) {
    asm volatile("s_waitcnt vmcnt(0)" ::: "memory");
    __syncthreads();
    if (threadIdx.x == 0) {
        unsigned* bar = b.bar;
        __builtin_amdgcn_s_waitcnt(0);
        unsigned nloc = b.st[0], nx = b.st[1];
        if (nloc == 0u) { xcd_barrier_complete(bar, b.x, nloc, nx); b.st[0] = nloc; b.st[1] = nx; }
        const unsigned old = xb_add(&bar[XB_XSUB(b.x)], 1u);
        const unsigned gen = old / nloc;
        if (old + 1u == (gen + 1u) * nloc) {
            __builtin_amdgcn_fence(__ATOMIC_RELEASE, "agent");
            asm volatile("s_waitcnt vmcnt(0)" ::: "memory");
            const unsigned og = xb_add(&bar[XB_TOP], 1u);
            const unsigned tg = og / nx;
            if (og + 1u == (tg + 1u) * nx) xb_add(&bar[XB_TOPGEN], 1u);
            else XB_SPIN(xb_ld(&bar[XB_TOPGEN]) == tg, bar);
            __builtin_amdgcn_fence(__ATOMIC_ACQUIRE, "agent");
            xb_add(&bar[XB_XGEN(b.x)], 1u);
            asm volatile("s_waitcnt vmcnt(0)" ::: "memory");
        } else {
            XB_SPIN(xb_ld(&bar[XB_XGEN(b.x)]) == gen, bar);
            __builtin_amdgcn_fence(__ATOMIC_ACQUIRE, "agent");
            asm volatile("s_waitcnt vmcnt(0)" ::: "memory");
        }
    }
    __syncthreads();
}

#include <hip/hip_cooperative_groups.h>
namespace cg = cooperative_groups;
extern __shared__ __attribute__((aligned(16))) unsigned char dyn_lds[];
#define LDSP ((LAS unsigned char*)dyn_lds)
constexpr int LDS_BYTES = 150 * 1024;
#ifndef REP_P1
#define REP_P1 1
#endif
#ifndef REP_RW
#define REP_RW 1
#endif
#ifndef REP_P4
#define REP_P4 1
#endif
#ifndef REP_P7
#define REP_P7 1
#endif
#ifndef REP_ATTN
#define REP_ATTN 1
#endif
#ifndef REP_IDX
#define REP_IDX 1
#endif
#ifndef REP_MEM
#define REP_MEM 1
#endif
#ifndef REP_E1
#define REP_E1 1
#endif
static_assert(MA_LDS_END <= LDS_BYTES - 64 && DA_END <= LDS_BYTES && RO_END <= LDS_BYTES && 131072 <= LDS_BYTES, "LDS budget");

typedef const __attribute__((address_space(4))) Params* KargPtr;
__device__ __forceinline__ Params load_params() {
    Params r;
#if defined(__HIP_DEVICE_COMPILE__)
    KargPtr kp = (KargPtr)__builtin_amdgcn_kernarg_segment_ptr(); asm volatile("" : "+s"(kp));
#pragma unroll
    for (int i = 0; i < 31; ++i) r.in[i] = kp->in[i];
    r.out = kp->out; r.ws = kp->ws;
#endif
    return r;
}
__global__ void __launch_bounds__(NT, 2) mega(Params P_unused) {
    cg::grid_group grid = cg::this_grid();
    const int bid = blockIdx.x, nb = gridDim.x;
#define PH_BEGIN const Params P = load_params(); unsigned char* ws = P.ws; unsigned char* dob = (unsigned char*)P.out; (void)ws; (void)dob;
#define GRID_BAR() do { PH_BEGIN XcdBarrier b_; b_.bar = (unsigned*)(ws + WS_CTL); b_.x = xb_xcc_id(); b_.st = (volatile LAS unsigned*)(LDSP + LDS_BYTES - 64); xcd_barrier(b_); } while (0)
    if (threadIdx.x < 16) ((LAS unsigned*)(LDSP + LDS_BYTES - 64))[threadIdx.x] = 0u;
    __syncthreads();
    { PH_BEGIN (void)xcd_barrier_post((unsigned*)(ws + WS_CTL), (volatile LAS unsigned*)(LDSP + LDS_BYTES - 64)); }
    PROBE_SEG_INIT(LDSP)
    { PROBE_T0(10, LDSP)
    { PH_BEGIN prologue_phase(P, LDSP, bid, nb); }
    PROBE_T1(10, LDSP) }
    grid.sync();
    PROBE_SEG(40, LDSP)
    PROBE_T0(11, LDSP)
    { PH_BEGIN
        pg8::Gemm g{(const bf16*)(ws + WS_MB), (const bf16*)(ws + WS_WMEM), 256, 1024, 1024, 1024, 1024, 0, 256 * 1024};
        pg8::StaticOrder S; S.init(g.M, g.N, nb, bid);
        EpiF32 E{(float*)(ws + WS_KMVM), 1024, (const float*)(ws + WS_RSTDM)};
        pg8::gemm_phase<false>(LDSP, g, S, E);
    }
    for (int rep = 0; rep < REP_P1; ++rep) { PH_BEGIN
        pg8::Gemm g{(const bf16*)(ws + WS_XB), (const bf16*)(ws + WS_WIN), S_, P1_N, 1024, 1024, 1024, 0, 256 * 1024};
        pg8::StaticOrder S; S.init(g.M, g.N, nb, bid);
        EpiP1 E{(const float*)(ws + WS_RSTDX), (const float*)(ws + WS_COS), (const float*)(ws + WS_SIN), P.in[6], P.in[7],
                (bf16*)(ws + WS_Q), (bf16*)(ws + WS_K), (bf16*)(ws + WS_V), (bf16*)(ws + WS_RWP), (bf16*)(ws + WS_MEMQ), (half_t*)(ws + WS_IQ), (half_t*)(ws + WS_IK), (float*)(ws + WS_IW)};
        pg8::gemm_phase<false>(LDSP, g, S, E);
    }
    if (bid >= 64) { PH_BEGIN prologue_rest_phase(P, LDSP, bid - 64, nb - 64); }
    PROBE_T1(11, LDSP)
    GRID_BAR();
    PROBE_SEG(41, LDSP)
    PROBE_T0(35, LDSP)
    { PROBE_T0(13, LDSP)
    { PH_BEGIN dsa_index_phase(P, LDSP, bid, nb); }
    PROBE_T1(13, LDSP) }
    { PROBE_T0(14, LDSP)
    { PH_BEGIN mem_attn_phase(P, LDSP, bid, nb); }
    PROBE_T1(14, LDSP) }
    __syncthreads();
    { PROBE_T0(15, LDSP)
    { PH_BEGIN rw_units_phase<false>(P, LDSP, bid, nb); }
    PROBE_T1(15, LDSP) }
    PROBE_T1(35, LDSP)
    PROBE_T0(36, LDSP)
    GRID_BAR();
    PROBE_T1(36, LDSP)
    PROBE_SEG(44, LDSP)
    if (bid >= nb - 8) { PROBE_T0(30, LDSP) { PH_BEGIN rw_scan_phase(P, LDSP, bid - (nb - 8)); } PROBE_T1(30, LDSP) }
    else    { PROBE_T0(16, LDSP)
    for (int rep = 0; rep < REP_ATTN; ++rep) { PH_BEGIN dsa_attn_phase(P, LDSP, bid, nb); }
    PROBE_T1(16, LDSP) }
    GRID_BAR();
    PROBE_SEG(45, LDSP)
    { PROBE_T0(17, LDSP)
    for (int rep = 0; rep < REP_RW; ++rep) { PH_BEGIN rw_units_phase<true>(P, LDSP, bid, nb); }
    PROBE_T1(17, LDSP) }
    { PH_BEGIN xb_phase(P, bid, nb); }
    GRID_BAR();
    PROBE_SEG(46, LDSP)
    PROBE_T0(18, LDSP)
    for (int rep4 = 0; rep4 < REP_P4; ++rep4) {
    { PH_BEGIN
        pg8::Gemm g{(const bf16*)(ws + WS_XB), (const bf16*)(ws + WS_WG), S_, 3072, 1024, 1024, 1024, 0, 256 * 1024};
        pg8::PanelOrder S; S.init(S_, nb, bid, 3);
        EpiGate E{(bf16*)(ws + WS_GATES), (const float*)(ws + WS_RSTDX), P.in[5]};
        PROBE_T0(31, LDSP)
        pg8::gemm_phase<false>(LDSP, g, S, E);
        PROBE_T1(31, LDSP)
    }
    for (int c = 0; c < 3; ++c) { PH_BEGIN
        pg8::Gemm g{(const bf16*)(ws + WS_Y) + c * 512, (const bf16*)(ws + WS_WUP) + (size_t)c * 1024 * 512, S_, 1024, 512, 1536, 512, 0, 256 * 512};
        pg8::StaticOrder S; S.init(g.M, g.N, nb, bid);
        EpiMerge E{(const bf16*)(ws + WS_GATES), P.out, (bf16*)(ws + WS_MERGED), c};
        pg8::gemm_phase<false>(LDSP, g, S, E);
    }
    }
    PROBE_T1(18, LDSP)
    GRID_BAR();
    PROBE_SEG(47, LDSP)
    { PROBE_T0(19, LDSP)
    { PH_BEGIN peer_conv_phase(P, bid, nb); }
    PROBE_T1(19, LDSP) }
    PROBE_T0(20, LDSP)
    { PH_BEGIN
        pg8::Gemm g{(const bf16*)(ws + WS_MERGED), (const bf16*)(ws + WS_WOUT), S_, 1024, 1024, 1024, 1024, 0, 256 * 1024};
        pg8::StaticOrder S; S.init(g.M, g.N, nb, bid);
        EpiOut E{P.in[0], P.out, (bf16*)(ws + WS_XB), (float*)(ws + WS_HSQ)};
        pg8::gemm_phase<false>(LDSP, g, S, E);
    }
    PROBE_T1(20, LDSP)
    GRID_BAR();
    PROBE_SEG(48, LDSP)
    PROBE_T0(21, LDSP)
    { PH_BEGIN
        pg8::Gemm g{(const bf16*)(ws + WS_XB), (const bf16*)(ws + WS_WQ), S_, 2048, 1024, 1024, 1024, 0, 256 * 1024};
        pg8::StaticOrder S; S.init(g.M, g.N, nb, bid);
        EpiPQ E{(half_t*)(ws + WS_PQ), (const float*)(ws + WS_HSQ)};
        pg8::gemm_phase<true>(LDSP, g, S, E);
    }
    PROBE_T1(21, LDSP)
    GRID_BAR();
    PROBE_SEG(49, LDSP)
    PROBE_T0(25, LDSP)
    for (int rep = 0; rep < REP_P7; ++rep) { PH_BEGIN
        pg8::Gemm g{(const bf16*)(ws + WS_PQ), (const bf16*)(ws + WS_KEYBD), S_, 2048, 256, 2048, 256, 256, 0};
        pg8::StaticOrder S; S.init(g.M, g.N, nb, bid);
        float* scr = (float*)(ws + WS_SC) + (size_t)bid * 65536;
        pg8::Unit u;
        for (int i = 0; S.next(i, u); ++i) {
            pg8::OneUnit O{u}; EpiTile E{scr};
            pg8::gemm_phase<true>(LDSP, g, O, E);
            __syncthreads();
            peer_topk_tile(scr, u.pm, u.pn, (int*)(ws + WS_EIDX), (float*)(ws + WS_EGATE), (LAS unsigned*)LDSP);
            __syncthreads();
        }
    }
    PROBE_T1(25, LDSP)
    GRID_BAR();
    PROBE_SEG(50, LDSP)
    { PROBE_T0(22, LDSP)
    for (int rep = 0; rep < REP_E1; ++rep) { PH_BEGIN peer_e1_phase(P, LDSP, bid, nb); }
    PROBE_T1(22, LDSP) }
    GRID_BAR();
    PROBE_SEG(51, LDSP)
    { PROBE_T0(23, LDSP)
    { PH_BEGIN peer_w_phase(P, bid, nb); }
    PROBE_T1(23, LDSP) }
    GRID_BAR();
    PROBE_SEG(52, LDSP)
    { PROBE_T0(24, LDSP)
    { PH_BEGIN peer_e2_phase(P, bid, nb); }
    PROBE_T1(24, LDSP) }
#if PROBE_ID
    GRID_BAR();
    if (bid == PROBE_BLK && threadIdx.x == 0) { PH_BEGIN P.out[0] += 1.0f + (float)(*(LAS unsigned*)(LDSP + PROBE_LDS_OFF)) * 1e-3f; }
#endif
#undef GRID_BAR
#undef PH_BEGIN
}

extern "C" void kernel_launch(void* const* d_in, const int* in_sizes, int n_in, void* d_out, int out_size, void* d_ws, size_t ws_size, hipStream_t stream) {
    static int grid = 0;
    if (grid == 0) {
        if (n_in != 31 || out_size != S_ * D_ || ws_size < WS_END) { fprintf(stderr, "kernel_launch: unexpected problem (n_in %d out %d ws %zu)\n", n_in, out_size, ws_size); grid = -1; return; }
        int dev = 0, cus = 0, per_cu = 0;
        if (hipGetDevice(&dev) != hipSuccess || hipDeviceGetAttribute(&cus, hipDeviceAttributeMultiprocessorCount, dev) != hipSuccess) { grid = -1; return; }
        if (hipFuncSetAttribute((const void*)mega, hipFuncAttributeMaxDynamicSharedMemorySize, LDS_BYTES) != hipSuccess) { fprintf(stderr, "kernel_launch: hipFuncSetAttribute failed\n"); grid = -1; return; }
        if (hipOccupancyMaxActiveBlocksPerMultiprocessor(&per_cu, (const void*)mega, NT, LDS_BYTES) != hipSuccess || per_cu < 1) { fprintf(stderr, "kernel_launch: occupancy query failed (%d)\n", per_cu); grid = -1; return; }
        grid = cus;
        if (grid != 256) { fprintf(stderr, "kernel_launch: built for 256 CUs, device has %d\n", cus); grid = -1; return; }
    }
    if (grid < 0) return;
    Params P{};
    for (int i = 0; i < 31; ++i) P.in[i] = (const float*)d_in[i];
    P.out = (float*)d_out; P.ws = (unsigned char*)d_ws;
    if (hipMemsetAsync(d_ws, 0, 16384, stream) != hipSuccess) { fprintf(stderr, "kernel_launch: memset of the barrier words failed\n"); return; }
    void* args[] = {&P};
    hipError_t e = hipLaunchCooperativeKernel((const void*)mega, dim3(grid), dim3(NT), args, LDS_BYTES, stream);
    if (e != hipSuccess) fprintf(stderr, "kernel_launch: cooperative launch failed: %s\n", hipGetErrorString(e));
}
```
